# Optimizing an MI355X kernel written in HIP

```python
import jax, jax.numpy as jnp
from jax import lax
import numpy as np

D_MODEL = 1024
BATCH = 2
SEQ = 16384
DEPTH = 2

CONV_WIDTH = 3
HEAD_DIM = 64
N_HEADS = D_MODEL // HEAD_DIM
N_KV_GROUPS = 4
HEADS_PER_GROUP = N_HEADS // N_KV_GROUPS
N_BRANCH = 3
N_KV_SLOTS = 2 * N_BRANCH
CMP_BLOCK = 32
CMP_STRIDE = 16
CMP_HIDDEN = 256
SLC_BLOCK = 64
N_SELECT = 16
WINDOW = 512
Q_BLOCK = 128
FORCE_BONUS = 1000.0
ROPE_THETA = 10000.0
N_GROUPS = 4
EXPERTS_PER_GROUP = 8
N_EXPERTS = N_GROUPS * EXPERTS_PER_GROUP
TOP_K_INNER = 2
D_EXPERT = D_MODEL // 2
DISPATCH_ROWS = 256
RMS_EPS = 1e-6

kernel_name = 'hybrid_shortconv_nsa_hmoe'


def rmsnorm(x, g):
    xf = x.astype(jnp.float32)
    y = xf * lax.rsqrt(jnp.mean(xf * xf, axis=-1, keepdims=True) + RMS_EPS)
    return (y * g.astype(jnp.float32)).astype(x.dtype)


def rope(t, positions):
    half = HEAD_DIM // 2
    inv = ROPE_THETA ** (-jnp.arange(half, dtype=jnp.float32) / half)
    ang = positions.astype(jnp.float32)[..., None] * inv
    cos = jnp.cos(ang)[:, :, None, :]
    sin = jnp.sin(ang)[:, :, None, :]
    t1 = t[..., :half].astype(jnp.float32)
    t2 = t[..., half:].astype(jnp.float32)
    return jnp.concatenate([t1 * cos - t2 * sin, t2 * cos + t1 * sin], axis=-1).astype(t.dtype)


def masked_softmax(s, mask):
    s = jnp.where(mask, s.astype(jnp.float32), -jnp.inf)
    m = jnp.max(s, axis=-1, keepdims=True)
    m = jnp.where(jnp.isfinite(m), m, 0.0)
    e = jnp.exp(s - m)
    d = jnp.sum(e, axis=-1, keepdims=True)
    return e / jnp.maximum(d, jnp.float32(1e-30))


def short_conv_mixer(h, w_in, conv_w, w_out):
    d = h.shape[-1]
    proj = h @ w_in
    b_gate, c_gate, v = jnp.split(proj, 3, axis=-1)
    u = c_gate * v
    y = lax.conv_general_dilated(
        u, conv_w.astype(u.dtype)[:, None, :], window_strides=(1,),
        padding=[(CONV_WIDTH - 1, 0)], dimension_numbers=('NWC', 'WIO', 'NWC'),
        feature_group_count=d)
    return (b_gate * y) @ w_out


def nsa_shared_kv(h, positions, w_kv, cmp_pos_k, cmp_w1_k, cmp_w2_k, cmp_pos_v, cmp_w1_v, cmp_w2_v):
    b, s, _ = h.shape
    kv = (h @ w_kv).reshape(b, s, N_KV_SLOTS, N_KV_GROUPS, HEAD_DIM)
    k_c, v_c, k_s, v_s, k_w, v_w = [kv[:, :, i] for i in range(N_KV_SLOTS)]
    k_s = rope(k_s, positions)
    k_w = rope(k_w, positions)
    n_cmp = (s - CMP_BLOCK) // CMP_STRIDE + 1
    idx = jnp.arange(n_cmp)[:, None] * CMP_STRIDE + jnp.arange(CMP_BLOCK)[None, :]

    def compress(t, pos, w1, w2):
        blk = t[:, idx] + pos[None, None, :, None, :]
        blk = blk.transpose(0, 1, 3, 2, 4).reshape(b, n_cmp, N_KV_GROUPS, CMP_BLOCK * HEAD_DIM)
        return jax.nn.gelu(blk @ w1) @ w2

    k_cmp = compress(k_c, cmp_pos_k, cmp_w1_k, cmp_w2_k)
    v_cmp = compress(v_c, cmp_pos_v, cmp_w1_v, cmp_w2_v)
    n_slc = s // SLC_BLOCK
    k_slc = k_s.reshape(b, n_slc, SLC_BLOCK, N_KV_GROUPS, HEAD_DIM).transpose(0, 3, 1, 2, 4)
    v_slc = v_s.reshape(b, n_slc, SLC_BLOCK, N_KV_GROUPS, HEAD_DIM).transpose(0, 3, 1, 2, 4)
    pad = ((0, 0), (WINDOW, 0), (0, 0), (0, 0))
    k_win = jnp.pad(k_w, pad)
    v_win = jnp.pad(v_w, pad)
    return k_cmp, v_cmp, k_slc, v_slc, k_win, v_win


def selection_map(n_cmp, n_slc):
    c0 = jnp.arange(n_cmp) * CMP_STRIDE
    j0 = jnp.arange(n_slc) * SLC_BLOCK
    ov = jnp.minimum(c0[:, None] + CMP_BLOCK, j0[None, :] + SLC_BLOCK) - jnp.maximum(c0[:, None], j0[None, :])
    return jnp.clip(ov, 0).astype(jnp.float32) / CMP_BLOCK


def nsa_attention(h, positions, w_in, w_out, k_cmp, v_cmp, k_slc, v_slc, k_win, v_win):
    b, s, _ = h.shape
    dtype = h.dtype
    qd = N_HEADS * HEAD_DIM
    proj = h @ w_in
    q = proj[..., :qd].reshape(b, s, N_HEADS, HEAD_DIM)
    gates = jax.nn.sigmoid(proj[..., qd:].astype(jnp.float32)).reshape(
        b, s, N_KV_GROUPS, HEADS_PER_GROUP, N_BRANCH)
    scale = HEAD_DIM ** -0.5
    q_rot = (rope(q, positions) * scale).reshape(b, s, N_KV_GROUPS, HEADS_PER_GROUP, HEAD_DIM)
    q_cmp = (q * scale).reshape(b, s, N_KV_GROUPS, HEADS_PER_GROUP, HEAD_DIM)
    n_cmp = k_cmp.shape[1]
    n_slc = k_slc.shape[2]
    n_sel = min(N_SELECT, n_slc)
    cmp_end = jnp.arange(n_cmp) * CMP_STRIDE + CMP_BLOCK - 1
    slc_map = selection_map(n_cmp, n_slc)
    blk_ids = jnp.arange(n_slc)
    bi = jnp.arange(b)[:, None, None, None]
    gi = jnp.arange(N_KV_GROUPS)[None, None, :, None]

    def one_block(i):
        qs = i * Q_BLOCK
        t = qs + jnp.arange(Q_BLOCK)
        qc = lax.dynamic_slice_in_dim(q_cmp, qs, Q_BLOCK, axis=1)
        qr = lax.dynamic_slice_in_dim(q_rot, qs, Q_BLOCK, axis=1)
        gt = lax.dynamic_slice_in_dim(gates, qs, Q_BLOCK, axis=1)
        s_c = jnp.einsum('bqghd,bcgd->bqghc', qc, k_cmp)
        m_c = (cmp_end[None, :] <= t[:, None])[None, :, None, None, :]
        p_c = masked_softmax(s_c, m_c)
        o_c = jnp.einsum('bqghc,bcgd->bqghd', p_c.astype(dtype), v_cmp)
        imp = jnp.einsum('bqghc,cj->bqgj', p_c, slc_map)
        cur = t // SLC_BLOCK
        valid = blk_ids[None, :] * SLC_BLOCK <= t[:, None]
        forced = (blk_ids[None, :] == 0) | (blk_ids[None, :] == cur[:, None]) | (blk_ids[None, :] == cur[:, None] - 1)
        score = jnp.where(valid[None, :, None, :],
                          imp + jnp.where(forced, FORCE_BONUS, 0.0)[None, :, None, :], -1.0)
        _, sel = lax.top_k(score, n_sel)
        k_g = k_slc[bi, gi, sel]
        v_g = v_slc[bi, gi, sel]
        kpos = sel[..., None] * SLC_BLOCK + jnp.arange(SLC_BLOCK)
        s_s = jnp.einsum('bqghd,bqgnkd->bqghnk', qr, k_g).reshape(
            b, Q_BLOCK, N_KV_GROUPS, HEADS_PER_GROUP, n_sel * SLC_BLOCK)
        m_s = (kpos <= t[None, :, None, None, None]).reshape(b, Q_BLOCK, N_KV_GROUPS, 1, n_sel * SLC_BLOCK)
        p_s = masked_softmax(s_s, m_s).reshape(b, Q_BLOCK, N_KV_GROUPS, HEADS_PER_GROUP, n_sel, SLC_BLOCK)
        o_s = jnp.einsum('bqghnk,bqgnkd->bqghd', p_s.astype(dtype), v_g)
        kw = lax.dynamic_slice_in_dim(k_win, qs, Q_BLOCK + WINDOW, axis=1)
        vw = lax.dynamic_slice_in_dim(v_win, qs, Q_BLOCK + WINDOW, axis=1)
        wpos = qs - WINDOW + jnp.arange(Q_BLOCK + WINDOW)
        diff = t[:, None] - wpos[None, :]
        m_w = ((diff >= 0) & (diff < WINDOW) & (wpos[None, :] >= 0))[None, :, None, None, :]
        s_w = jnp.einsum('bqghd,bkgd->bqghk', qr, kw)
        p_w = masked_softmax(s_w, m_w)
        o_w = jnp.einsum('bqghk,bkgd->bqghd', p_w.astype(dtype), vw)
        o = (gt[..., 0:1] * o_c.astype(jnp.float32) + gt[..., 1:2] * o_s.astype(jnp.float32)
             + gt[..., 2:3] * o_w.astype(jnp.float32))
        return o.astype(dtype).reshape(b, Q_BLOCK, qd)

    out = lax.map(one_block, jnp.arange(s // Q_BLOCK))
    out = out.transpose(1, 0, 2, 3).reshape(b, s, qd)
    return out @ w_out


def hier_moe(h, w_rg, b_rg, w_re, b_re, w_gate, w_up, w_down):
    b, s, d = h.shape
    n_tok = b * s
    xf = h.reshape(n_tok, d)
    g_logits = (xf @ w_rg).astype(jnp.float32) + b_rg.astype(jnp.float32)
    g_prob = jax.nn.softmax(g_logits, axis=-1)
    g_top = jnp.argmax(g_logits, axis=-1)
    p_g = jnp.take_along_axis(g_prob, g_top[:, None], axis=1)[:, 0]
    e_logits = ((xf @ w_re).astype(jnp.float32) + b_re.astype(jnp.float32)).reshape(
        n_tok, N_GROUPS, EXPERTS_PER_GROUP)
    chosen = jnp.take_along_axis(e_logits, g_top[:, None, None], axis=1)[:, 0]
    top_vals, top_idx = lax.top_k(chosen, TOP_K_INNER)
    weights = p_g[:, None] * jax.nn.softmax(top_vals, axis=-1)
    expert = g_top[:, None] * EXPERTS_PER_GROUP + top_idx
    a_exp = expert.reshape(-1)
    a_tok = jnp.repeat(jnp.arange(n_tok), TOP_K_INNER)
    a_w = weights.reshape(-1)
    n_asg = n_tok * TOP_K_INNER
    onehot = jax.nn.one_hot(a_exp, N_EXPERTS, dtype=jnp.int32)
    rank = jnp.take_along_axis(jnp.cumsum(onehot, axis=0), a_exp[:, None], axis=1)[:, 0] - 1
    counts = jnp.sum(onehot, axis=0)
    padded = (counts + DISPATCH_ROWS - 1) // DISPATCH_ROWS * DISPATCH_ROWS
    pend = jnp.cumsum(padded)
    pstart = pend - padded
    dest = pstart[a_exp] + rank
    n_chunks = -(-n_asg // DISPATCH_ROWS) + N_EXPERTS
    n_rows = n_chunks * DISPATCH_ROWS
    row_tok = jnp.zeros((n_rows,), jnp.int32).at[dest].set(a_tok)
    row_w = jnp.zeros((n_rows,), jnp.float32).at[dest].set(a_w)
    chunk_exp = jnp.clip(jnp.searchsorted(pend, jnp.arange(n_chunks) * DISPATCH_ROWS, side='right'),
                         0, N_EXPERTS - 1)
    xs = xf[row_tok].reshape(n_chunks, DISPATCH_ROWS, d)

    def run_chunk(args):
        xc, e = args
        return (jax.nn.silu(xc @ w_gate[e]) * (xc @ w_up[e])) @ w_down[e]

    ys = lax.map(run_chunk, (xs, chunk_exp)).reshape(n_rows, d)
    out = jax.ops.segment_sum(ys * row_w[:, None].astype(ys.dtype), row_tok, num_segments=n_tok)
    return out.reshape(b, s, d).astype(h.dtype)


def setup_inputs(seed: int = 0) -> dict:
    key = jax.random.key(seed)
    ks = iter(jax.random.split(key, 32))
    f32 = jnp.float32

    def nrm(shape, scale):
        return jax.random.normal(next(ks), shape, f32) * scale

    d = D_MODEL
    n_a = DEPTH // 2
    n_b = DEPTH - n_a
    gd = N_KV_GROUPS * HEAD_DIM
    qd = N_HEADS * HEAD_DIM
    cin = CMP_BLOCK * HEAD_DIM
    return {
        'x': nrm((BATCH, SEQ, d), 1.0),
        'positions': jnp.tile(jnp.arange(SEQ, dtype=jnp.int32)[None, :], (BATCH, 1)),
        'norm_mix': 1.0 + nrm((DEPTH, d), 0.02),
        'norm_ffn': 1.0 + nrm((DEPTH, d), 0.02),
        'conv_w_in': nrm((n_a, d, 3 * d), d ** -0.5),
        'conv_w': nrm((n_a, CONV_WIDTH, d), CONV_WIDTH ** -0.5),
        'conv_w_out': nrm((n_a, d, d), d ** -0.5),
        'norm_kv': 1.0 + nrm((d,), 0.02),
        'w_kv': nrm((d, N_KV_SLOTS * gd), d ** -0.5),
        'cmp_pos_k': nrm((CMP_BLOCK, HEAD_DIM), 0.1),
        'cmp_w1_k': nrm((cin, CMP_HIDDEN), cin ** -0.5),
        'cmp_w2_k': nrm((CMP_HIDDEN, HEAD_DIM), CMP_HIDDEN ** -0.5),
        'cmp_pos_v': nrm((CMP_BLOCK, HEAD_DIM), 0.1),
        'cmp_w1_v': nrm((cin, CMP_HIDDEN), cin ** -0.5),
        'cmp_w2_v': nrm((CMP_HIDDEN, HEAD_DIM), CMP_HIDDEN ** -0.5),
        'attn_w_in': nrm((n_b, d, qd + N_BRANCH * N_HEADS), d ** -0.5),
        'attn_w_out': nrm((n_b, qd, d), qd ** -0.5),
        'router_group_w': nrm((DEPTH, d, N_GROUPS), d ** -0.5),
        'router_group_b': nrm((DEPTH, N_GROUPS), 0.01),
        'router_expert_w': nrm((DEPTH, d, N_EXPERTS), d ** -0.5),
        'router_expert_b': nrm((DEPTH, N_EXPERTS), 0.01),
        'expert_w_gate': nrm((DEPTH, N_EXPERTS, d, D_EXPERT), d ** -0.5),
        'expert_w_up': nrm((DEPTH, N_EXPERTS, d, D_EXPERT), d ** -0.5),
        'expert_w_down': nrm((DEPTH, N_EXPERTS, D_EXPERT, d), D_EXPERT ** -0.5),
        'norm_final': 1.0 + nrm((d,), 0.02),
    }


def reference(x, positions, norm_mix, norm_ffn, conv_w_in, conv_w, conv_w_out, norm_kv, w_kv,
              cmp_pos_k, cmp_w1_k, cmp_w2_k, cmp_pos_v, cmp_w1_v, cmp_w2_v, attn_w_in, attn_w_out,
              router_group_w, router_group_b, router_expert_w, router_expert_b,
              expert_w_gate, expert_w_up, expert_w_down, norm_final):
    n_a = DEPTH // 2
    shared = None
    for l in range(DEPTH):
        if l < n_a:
            h = rmsnorm(x, norm_mix[l])
            x = x + short_conv_mixer(h, conv_w_in[l], conv_w[l], conv_w_out[l])
        else:
            if shared is None:
                shared = nsa_shared_kv(rmsnorm(x, norm_kv), positions, w_kv, cmp_pos_k, cmp_w1_k, cmp_w2_k,
                                       cmp_pos_v, cmp_w1_v, cmp_w2_v)
            h = rmsnorm(x, norm_mix[l])
            x = x + nsa_attention(h, positions, attn_w_in[l - n_a], attn_w_out[l - n_a], *shared)
        x = x + hier_moe(rmsnorm(x, norm_ffn[l]), router_group_w[l], router_group_b[l],
                         router_expert_w[l], router_expert_b[l],
                         expert_w_gate[l], expert_w_up[l], expert_w_down[l])
    return rmsnorm(x, norm_final)
```

```cpp
#include <hip/hip_runtime.h>
#include <hip/hip_cooperative_groups.h>
#include <cstdio>
#include <cstdint>
#include <cmath>
namespace cg = cooperative_groups;

#define LAS __attribute__((address_space(3)))
typedef unsigned short bf16_t;
typedef short bf16x8 __attribute__((ext_vector_type(8)));
typedef short s16x4 __attribute__((ext_vector_type(4)));
typedef float f32x4 __attribute__((ext_vector_type(4)));
typedef float f32x2 __attribute__((ext_vector_type(2)));
typedef unsigned u32x4 __attribute__((ext_vector_type(4)));
typedef unsigned u32x2 __attribute__((ext_vector_type(2)));

constexpr int NB = 2, SEQ = 16384, NT = NB * SEQ, D = 1024, NG = 4, HD = 64, NH = 16;
constexpr int NE = 32, EPG = 8, DE = 512, ECAP = 65536;
constexpr int NQKV = 2816;
constexpr int NCMP = 1023, CMPH = 256;
constexpr float RMS_EPS = 1e-6f;
constexpr int NWAVES = 8, NTHREADS = 512;
#ifndef MK_PER_PHASE
#define MK_PER_PHASE 1
#endif

constexpr size_t MiB = 1u << 20, KiB = 1u << 10;
constexpr size_t WS_CTL = 0, CTL_BYTES = 64 * KiB;
constexpr size_t WS_R0 = 1 * MiB, WS_R1 = WS_R0 + 128 * KiB, WS_R2 = WS_R1 + 128 * KiB, WS_R3 = WS_R2 + 128 * KiB;
constexpr size_t WS_WGT = 2 * MiB;
constexpr size_t WS_RW = 2 * MiB + 512 * KiB;
constexpr size_t WS_BIASC = 3 * MiB;
constexpr size_t WS_W2T = 3 * MiB + 64 * KiB;
constexpr size_t WS_ROWL = 4 * MiB;
constexpr size_t WS_ROWR = 12 * MiB;
constexpr size_t WS_WIN = 20 * MiB, WS_WOUT = 26 * MiB, WS_WQKV = 28 * MiB, WS_WC1 = 34 * MiB, WS_WAO = 36 * MiB;
constexpr size_t WS_ROPE = 38 * MiB;
constexpr size_t WS_GATES = 46 * MiB;
constexpr size_t WS_EXPW = 52 * MiB;
constexpr size_t WS_RA = 148 * MiB;
constexpr size_t WS_RB = 212 * MiB;
constexpr size_t WS_RC = 276 * MiB;
constexpr size_t WS_RD = 340 * MiB;
constexpr size_t WS_END = 452 * MiB;
constexpr size_t KVSTRIDE = 17 * MiB;
constexpr size_t RD_KC = 0, RD_VC = 1 * KVSTRIDE, RD_KS = 2 * KVSTRIDE, RD_VTS = 3 * KVSTRIDE, RD_KW = 4 * KVSTRIDE, RD_VTW = 5 * KVSTRIDE;
constexpr size_t RD_HID = 102 * MiB, RD_KCMP = 110 * MiB, RD_VCMPT = 111 * MiB;
constexpr int ACT_ROWS = 2 * NT + NE * 256;
static_assert((size_t)ACT_ROWS * DE * 2 <= 72 * MiB, "ACT");
constexpr int CW_CNT = 1024, CW_BAR = 4096;

constexpr int LDS_BYTES = 147456;
constexpr int RING_BYTES = 131072;
constexpr int MISC_OFF = RING_BYTES;

__device__ __forceinline__ unsigned f2bf(float f) { unsigned u = __builtin_bit_cast(unsigned, f); return (u + 0x7fffu + ((u >> 16) & 1u)) >> 16; }
__device__ __forceinline__ unsigned pk2(float lo, float hi) {
    typedef float v2f __attribute__((ext_vector_type(2))); typedef __bf16 v2b __attribute__((ext_vector_type(2)));
    v2f v = {lo, hi}; v2b b = __builtin_convertvector(v, v2b); return __builtin_bit_cast(unsigned, b); }
__device__ __forceinline__ float bf2f(unsigned short b) { return __builtin_bit_cast(float, ((unsigned)b) << 16); }
__device__ __forceinline__ float bflo(unsigned w) { return __builtin_bit_cast(float, w << 16); }
__device__ __forceinline__ float bfhi(unsigned w) { return __builtin_bit_cast(float, w & 0xffff0000u); }
__device__ __forceinline__ float wave_sum(float v) {
#pragma unroll
    for (int o = 1; o < 64; o <<= 1) v += __shfl_xor(v, o);
    return v;
}
#define LDS_WAIT() asm volatile("s_waitcnt lgkmcnt(0)" ::: "memory")

__device__ __forceinline__ int slot_perm8(int c) {
    const int hi = c & ~31, fq = (c >> 3) & 3, n = (c >> 2) & 1, j = c & 3; return hi + 16 * n + 4 * fq + j; }
__device__ __forceinline__ int slot_pair128(int c, int n) {
    const int wc = c >> 5, fq = (c >> 3) & 3, bj = (c >> 2) & 1, j = c & 3; return 128 * bj + 32 * wc + 16 * n + 4 * fq + j; }
__device__ __forceinline__ int slot_rope64(int d) {
    const int n = d >> 5, dd = d & 31, wcl = dd >> 4, fq = (dd >> 2) & 3, j = dd & 3; return 32 * wcl + 16 * n + 4 * fq + j; }

namespace pg8 {
constexpr int BM = 256, BK = 64, HALF = 128, HTB = HALF * BK * 2, STAGE_BYTES = 8 * HTB, NXCD = 8, WGM = 8;
__host__ __device__ __forceinline__ int lds_byte(int r, int c) { const int st = (r >> 4) * 2 + (c >> 5), rr = r & 15, cc = c & 31, ob = rr * 64 + cc * 2; return st * 1024 + (ob ^ (((ob >> 9) & 1) << 5)); }
__host__ __device__ __forceinline__ void stage_rc(int b, int& R, int& C) { const int st = b / 1024, sb = b % 1024, swz = sb ^ (((sb >> 9) & 1) << 5); R = (st >> 1) * 16 + swz / 64; C = (st & 1) * 32 + (swz % 64) / 2; }

struct Unit { int pm, pn, e, nvalid; };
struct Gemm { int K, lda; };

template <class Epi, class Sched, bool GATHER, bool ALIGN_EPI = true, bool SP2 = true>
__device__ __forceinline__ void gemm_phase(LAS unsigned char* lds, int tid_in, const Gemm g, const Sched& S, const Epi& E) {
    int tid_ = tid_in; asm volatile("" : "+v"(tid_));
    const int tid = tid_, wid = __builtin_amdgcn_readfirstlane(tid >> 6), lane = tid & 63, wr = wid >> 2, wc = wid & 3, fr = lane & 15, fq = lane >> 4;
    const int K = g.K, nt = K / BK;
    int R0, C0; stage_rc(tid * 16, R0, C0);
    unsigned voffA[2], voffB[2];
#pragma unroll
    for (int i = 0; i < 2; ++i) { voffA[i] = (unsigned)((R0 + 64 * i) * g.lda + C0) * 2u; voffB[i] = (unsigned)((R0 + 64 * i) * K + C0) * 2u; }
    unsigned vgC[2][2], vgN[2][2];
    const size_t kstep = (size_t)(BK * 2);
    const size_t hstepA = (size_t)HALF * g.lda * 2, hstepB = (size_t)HALF * K * 2;
    const unsigned ldsw = (unsigned)wid * 1024u;
    const int aoff = lds_byte(wr * 64 + fr, fq * 8), boff = lds_byte(wc * 32 + fr, fq * 8);
#define PG8_SA(b, h) (((b) * 2 + (h)) * HTB)
#define PG8_SB(b, h) ((4 + (b) * 2 + (h)) * HTB)
#define PG8_GLDS(src, dstoff) __builtin_amdgcn_global_load_lds((const unsigned*)(src), (LAS unsigned*)(lds + (dstoff)), 16, 0, 0)
#define PG8_STAGE_B(bufoff, gbase) do { _Pragma("unroll") for (int _i = 0; _i < 2; ++_i) PG8_GLDS((const char*)(gbase) + voffB[_i], (bufoff) + ldsw + _i * 8192); } while (0)
#define PG8_STAGE_A(bufoff, gbase, h, VG) do { _Pragma("unroll") for (int _i = 0; _i < 2; ++_i) { \
        if constexpr (GATHER) PG8_GLDS((const char*)(gbase) + VG[h][_i], (bufoff) + ldsw + _i * 8192); \
        else PG8_GLDS((const char*)(gbase) + (h) * hstepA + voffA[_i], (bufoff) + ldsw + _i * 8192); } } while (0)
#define PG8_LDA(dst, b, h) do { _Pragma("unroll") for (int m = 0; m < 4; ++m) _Pragma("unroll") for (int k = 0; k < 2; ++k) dst[m][k] = *(const LAS bf16x8*)(lds + PG8_SA(b, h) + aoff + m * 2048 + k * 1024); } while (0)
#define PG8_LDB(dst, b, h) do { _Pragma("unroll") for (int n = 0; n < 2; ++n) _Pragma("unroll") for (int k = 0; k < 2; ++k) dst[n][k] = *(const LAS bf16x8*)(lds + PG8_SB(b, h) + boff + n * 2048 + k * 1024); } while (0)
#define PG8_MMA(ai, bj, At, Bt) do { __builtin_amdgcn_s_setprio(1); _Pragma("unroll") for (int m = 0; m < 4; ++m) _Pragma("unroll") for (int n = 0; n < 2; ++n) _Pragma("unroll") for (int k = 0; k < 2; ++k) \
        acc[ai][bj][m][n] = __builtin_amdgcn_mfma_f32_16x16x32_bf16(Bt[n][k], At[m][k], acc[ai][bj][m][n], 0, 0, 0); __builtin_amdgcn_s_setprio(0); } while (0)
#define PG8_WAIT_V(n) asm volatile("s_waitcnt vmcnt(" #n ")" ::: "memory")
#define PG8_WAIT_L(n) asm volatile("s_waitcnt lgkmcnt(" #n ")" ::: "memory")
#define PG8_BAR __builtin_amdgcn_s_barrier()
#define PG8_SCHED __builtin_amdgcn_sched_barrier(0)
    Unit cur, nxt; int ui = 0;
    if (!S.next(0, cur)) return;
    f32x4 acc[2][2][4][2];
#pragma unroll
    for (int a = 0; a < 2; ++a)
#pragma unroll
        for (int b = 0; b < 2; ++b)
#pragma unroll
            for (int m = 0; m < 4; ++m)
#pragma unroll
                for (int n = 0; n < 2; ++n) acc[a][b][m][n] = (f32x4){0.f, 0.f, 0.f, 0.f};
    bf16x8 At[4][2], B0[2][2], B1[2][2];
    const char* cA = S.a_base(cur); const char* cB = S.b_base(cur);
    if constexpr (GATHER) {
#pragma unroll
        for (int h = 0; h < 2; ++h)
#pragma unroll
            for (int i = 0; i < 2; ++i) vgC[h][i] = S.a_off(cur, h * HALF + R0 + 64 * i) + (unsigned)C0 * 2u;
    }
    if constexpr (SP2) {
        PG8_STAGE_B(PG8_SB(0, 0), cB); PG8_STAGE_B(PG8_SB(0, 1), cB + hstepB); PG8_STAGE_A(PG8_SA(0, 0), cA, 0, vgC); PG8_STAGE_A(PG8_SA(0, 1), cA, 1, vgC);
        if (wr == 1) PG8_BAR;
        PG8_WAIT_V(2); PG8_BAR;
        PG8_STAGE_B(PG8_SB(1, 0), cB + kstep); PG8_STAGE_A(PG8_SA(1, 0), cA + kstep, 0, vgC); PG8_STAGE_B(PG8_SB(1, 1), cB + hstepB + kstep);
        PG8_WAIT_V(6); PG8_BAR;
    } else {
        PG8_STAGE_B(PG8_SB(0, 0), cB); PG8_STAGE_A(PG8_SA(0, 0), cA, 0, vgC); PG8_STAGE_B(PG8_SB(0, 1), cB + hstepB); PG8_STAGE_A(PG8_SA(0, 1), cA, 1, vgC);
        if (wr == 1) PG8_BAR;
        PG8_WAIT_V(4); PG8_BAR;
        PG8_STAGE_B(PG8_SB(1, 0), cB + kstep); PG8_STAGE_A(PG8_SA(1, 0), cA + kstep, 0, vgC); PG8_STAGE_B(PG8_SB(1, 1), cB + hstepB + kstep);
        PG8_WAIT_V(6); PG8_BAR;
    }
    for (;;) {
        const bool has_next = S.next(ui + 1, nxt);
        const char* nA = has_next ? S.a_base(nxt) : cA; const char* nB = has_next ? S.b_base(nxt) : cB;
        if constexpr (GATHER) {
#pragma unroll
            for (int h = 0; h < 2; ++h)
#pragma unroll
                for (int i = 0; i < 2; ++i) vgN[h][i] = has_next ? (S.a_off(nxt, h * HALF + R0 + 64 * i) + (unsigned)C0 * 2u) : vgC[h][i];
        }
        for (int t = 0; t < nt; t += 2) {
            const bool last = (t == nt - 2);
            const char* a1 = cA + (size_t)(t + 1) * kstep;
            const char* a2 = last ? nA : cA + (size_t)(t + 2) * kstep; const char* b2 = last ? nB : cB + (size_t)(t + 2) * kstep;
            const char* a3 = a2 + kstep; const char* b3 = b2 + kstep;
            unsigned vg2[2][2];
            if constexpr (GATHER) {
#pragma unroll
                for (int h = 0; h < 2; ++h)
#pragma unroll
                    for (int i = 0; i < 2; ++i) vg2[h][i] = last ? vgN[h][i] : vgC[h][i];
            }
            if constexpr (SP2) {
            PG8_LDB(B0, 0, 0); PG8_LDB(B1, 0, 1); PG8_SCHED; PG8_LDA(At, 0, 0); PG8_STAGE_A(PG8_SA(1, 1), a1, 1, vgC);
            PG8_WAIT_V(8); PG8_WAIT_L(0); PG8_BAR; PG8_MMA(0, 0, At, B0); PG8_MMA(0, 1, At, B1); PG8_BAR; PG8_SCHED;
            PG8_LDA(At, 0, 1); PG8_STAGE_B(PG8_SB(0, 0), b2); PG8_STAGE_B(PG8_SB(0, 1), b2 + hstepB); PG8_STAGE_A(PG8_SA(0, 0), a2, 0, vg2);
            PG8_WAIT_V(8); PG8_WAIT_L(0); PG8_BAR; PG8_MMA(1, 0, At, B0); PG8_MMA(1, 1, At, B1); PG8_BAR; PG8_SCHED;
            PG8_LDB(B0, 1, 0); PG8_LDB(B1, 1, 1); PG8_SCHED; PG8_LDA(At, 1, 0); PG8_STAGE_A(PG8_SA(0, 1), a2, 1, vg2);
            PG8_WAIT_V(8); PG8_WAIT_L(0); PG8_BAR; PG8_MMA(0, 0, At, B0); PG8_MMA(0, 1, At, B1); PG8_BAR; PG8_SCHED;
            PG8_LDA(At, 1, 1); PG8_STAGE_B(PG8_SB(1, 0), b3); PG8_STAGE_B(PG8_SB(1, 1), b3 + hstepB); PG8_STAGE_A(PG8_SA(1, 0), a3, 0, vg2);
            PG8_WAIT_V(8); PG8_WAIT_L(0); PG8_BAR; PG8_MMA(1, 0, At, B0); PG8_MMA(1, 1, At, B1); PG8_BAR; PG8_SCHED;
            } else {
            PG8_LDB(B0, 0, 0); PG8_SCHED; PG8_LDA(At, 0, 0); PG8_STAGE_A(PG8_SA(1, 1), a1, 1, vgC);
            PG8_WAIT_L(8); PG8_BAR; PG8_WAIT_L(0); PG8_MMA(0, 0, At, B0); PG8_BAR; PG8_SCHED;
            PG8_LDB(B1, 0, 1); PG8_STAGE_B(PG8_SB(0, 0), b2);
            PG8_BAR; PG8_WAIT_L(0); PG8_MMA(0, 1, At, B1); PG8_BAR;
            PG8_LDA(At, 0, 1); PG8_STAGE_A(PG8_SA(0, 0), a2, 0, vg2);
            PG8_BAR; PG8_WAIT_L(0); PG8_MMA(1, 0, At, B0); PG8_BAR; PG8_SCHED;
            PG8_STAGE_B(PG8_SB(0, 1), b2 + hstepB);
            PG8_WAIT_V(6); PG8_BAR; PG8_MMA(1, 1, At, B1); PG8_BAR;
            PG8_LDB(B0, 1, 0); PG8_SCHED; PG8_LDA(At, 1, 0); PG8_STAGE_A(PG8_SA(0, 1), a2, 1, vg2);
            PG8_WAIT_L(8); PG8_BAR; PG8_WAIT_L(0); PG8_MMA(0, 0, At, B0); PG8_BAR; PG8_SCHED;
            PG8_LDB(B1, 1, 1); PG8_STAGE_B(PG8_SB(1, 0), b3);
            PG8_BAR; PG8_WAIT_L(0); PG8_MMA(0, 1, At, B1); PG8_BAR;
            PG8_LDA(At, 1, 1); PG8_STAGE_A(PG8_SA(1, 0), a3, 0, vg2);
            PG8_BAR; PG8_WAIT_L(0); PG8_MMA(1, 0, At, B0); PG8_BAR; PG8_SCHED;
            PG8_STAGE_B(PG8_SB(1, 1), b3 + hstepB);
            PG8_WAIT_V(6); PG8_BAR; PG8_MMA(1, 1, At, B1); PG8_BAR;
            }
        }
        if constexpr (ALIGN_EPI) { if (wr == 0) PG8_BAR; }
        E(acc, cur, wr, wc, fr, fq);
        if (!has_next) break;
#pragma unroll
        for (int a = 0; a < 2; ++a)
#pragma unroll
            for (int b = 0; b < 2; ++b)
#pragma unroll
                for (int m = 0; m < 4; ++m)
#pragma unroll
                    for (int n = 0; n < 2; ++n) acc[a][b][m][n] = (f32x4){0.f, 0.f, 0.f, 0.f};
        cur = nxt; cA = nA; cB = nB; ++ui;
        if constexpr (GATHER) {
#pragma unroll
            for (int h = 0; h < 2; ++h)
#pragma unroll
                for (int i = 0; i < 2; ++i) vgC[h][i] = vgN[h][i];
        }
        if constexpr (ALIGN_EPI) { if (wr == 1) PG8_BAR; }
    }
    PG8_WAIT_V(0);
    if constexpr (!ALIGN_EPI) { if (wr == 0) PG8_BAR; }
    PG8_BAR;
#undef PG8_SA
#undef PG8_SB
#undef PG8_GLDS
#undef PG8_STAGE_A
#undef PG8_STAGE_B
#undef PG8_LDA
#undef PG8_LDB
#undef PG8_MMA
#undef PG8_WAIT_V
#undef PG8_WAIT_L
#undef PG8_BAR
#undef PG8_SCHED
}
}

struct Args {
    const float* in[25]; float* out; unsigned char* ws;
    float inv_freq[32];
    int ph_lo, ph_hi;
};
enum { I_X = 0, I_POS, I_NMIX, I_NFFN, I_CWIN, I_CW, I_CWOUT, I_NKV, I_WKV, I_CPK, I_CW1K, I_CW2K, I_CPV, I_CW1V, I_CW2V, I_AWIN, I_AWOUT,
       I_RGW, I_RGB, I_REW, I_REB, I_EWG, I_EWU, I_EWD, I_NFIN };

struct Frame {
    LAS unsigned char* lds;
    unsigned char* ws;
    int tid, lane, wave, vcu, G;
};

__device__ __forceinline__ int mytid(const Frame& F) { return F.wave * 64 + (int)__builtin_amdgcn_mbcnt_hi(~0u, __builtin_amdgcn_mbcnt_lo(~0u, 0u)); }
__device__ __forceinline__ Frame refresh(const Frame& F0) {
    Frame F = F0; int t = mytid(F0); asm volatile("" : "+v"(t)); F.tid = t; F.lane = t & 63; return F; }

struct DenseOrder {
    const char* A; const char* Bt; size_t tstepA, tstepB; int nM, nN, nwg, G, c;
    __device__ __forceinline__ void init(const void* A_, const void* Bt_, int M, int N, int K, int lda, int G_, int c_) {
        A = (const char*)A_; Bt = (const char*)Bt_; nM = M / 256; nN = N / 256; nwg = nM * nN; G = G_; c = c_; tstepA = (size_t)256 * lda * 2; tstepB = (size_t)256 * K * 2; }
    __device__ __forceinline__ bool next(int i, pg8::Unit& u) const {
        const long L = (long)i * G + c; if (L >= nwg) return false;
        int wgid = (int)L; { const int q = nwg / 8, r = nwg % 8, xcd = wgid % 8, off = wgid / 8; wgid = (xcd < r ? xcd * (q + 1) : r * (q + 1) + (xcd - r) * q) + off; }
        const int nig = 8 * nN, gid = wgid / nig, fm = gid * 8, gsz = (nM - fm) < 8 ? (nM - fm) : 8;
        u.pm = fm + ((wgid % nig) % gsz); u.pn = (wgid % nig) / gsz; u.e = 0; u.nvalid = 256; return true; }
    __device__ __forceinline__ const char* a_base(const pg8::Unit& u) const { return A + (size_t)u.pm * tstepA; }
    __device__ __forceinline__ const char* b_base(const pg8::Unit& u) const { return Bt + (size_t)u.pn * tstepB; }
    __device__ __forceinline__ unsigned a_off(const pg8::Unit&, int) const { return 0u; }
};
struct CmpOrder {
    const char* A0; const char* A1; const char* Bt; int G, c;
    __device__ __forceinline__ bool next(int i, pg8::Unit& u) const { const int L = i * G + c; if (L >= 64) return false; u.e = L >> 5; u.pm = L & 31; u.pn = 0; u.nvalid = 256; return true; }
    __device__ __forceinline__ const char* a_base(const pg8::Unit& u) const { return (u.e ? A1 : A0) + (size_t)u.pm * 256 * 1024 * 2; }
    __device__ __forceinline__ const char* b_base(const pg8::Unit& u) const { return Bt + (size_t)u.e * 256 * 2048 * 2; }
    __device__ __forceinline__ unsigned a_off(const pg8::Unit&, int) const { return 0u; }
};
struct MoeTab { volatile LAS int* tstart; volatile LAS int* cnt; };
__device__ __forceinline__ bool moe_unit(const MoeTab& T, int L, pg8::Unit& u) {
    const int total = T.tstart[32]; if (L >= 4 * total) return false;
    u.pn = L & 3; const int mt = L >> 2; int e = 0;
#pragma unroll 1
    for (int k = 1; k < 32; ++k) e += (T.tstart[k] <= mt) ? 1 : 0;
    u.e = e; u.pm = mt - T.tstart[e]; u.nvalid = T.cnt[e] - u.pm * 256; return true;
}
struct MoeGuOrder {
    MoeTab T; const char* X; const int* rowl; const char* W; int G, c;
    __device__ __forceinline__ bool next(int i, pg8::Unit& u) const { return moe_unit(T, i * G + c, u); }
    __device__ __forceinline__ const char* a_base(const pg8::Unit&) const { return X; }
    __device__ __forceinline__ const char* b_base(const pg8::Unit& u) const { return W + (size_t)u.e * 3 * MiB + (size_t)u.pn * 256 * 1024 * 2; }
    __device__ __forceinline__ unsigned a_off(const pg8::Unit& u, int R) const {
        int idx = u.pm * 256 + R; const int lim = u.pm * 256 + u.nvalid - 1; idx = idx < lim ? idx : lim;
        const int id = rowl[(size_t)u.e * ECAP + idx]; return (unsigned)(id >> 1) * 2048u; }
};
struct MoeDnOrder {
    MoeTab T; const char* ACT; const char* W; int G, c;
    __device__ __forceinline__ bool next(int i, pg8::Unit& u) const { return moe_unit(T, i * G + c, u); }
    __device__ __forceinline__ const char* a_base(const pg8::Unit& u) const { return ACT + (size_t)(T.tstart[u.e] + u.pm) * 256 * 512 * 2; }
    __device__ __forceinline__ const char* b_base(const pg8::Unit& u) const { return W + (size_t)u.e * 3 * MiB + 2 * MiB + (size_t)u.pn * 256 * 512 * 2; }
    __device__ __forceinline__ unsigned a_off(const pg8::Unit&, int) const { return 0u; }
};

#define EPI_ARGS const f32x4 (&acc)[2][2][4][2], const pg8::Unit& u, int wr, int wc, int fr, int fq
__device__ __forceinline__ u32x4 pack8(const f32x4& a, const f32x4& b) { u32x4 w; w.x = pk2(a[0], a[1]); w.y = pk2(a[2], a[3]); w.z = pk2(b[0], b[1]); w.w = pk2(b[2], b[3]); return w; }
__device__ __forceinline__ u32x2 pack4(const f32x4& a) { u32x2 w; w.x = pk2(a[0], a[1]); w.y = pk2(a[2], a[3]); return w; }

struct EpiInProj {
    const float* r0; bf16_t* BG; bf16_t* U;
    __device__ __forceinline__ void operator()(EPI_ARGS) const {
#pragma unroll
        for (int ai = 0; ai < 2; ++ai)
#pragma unroll
            for (int m = 0; m < 4; ++m) {
                const int row = u.pm * 256 + ai * 128 + wr * 64 + m * 16 + fr; const float rs = r0[row];
                if (u.pn < 4) {
#pragma unroll
                    for (int bj = 0; bj < 2; ++bj) *(u32x4*)(BG + (size_t)row * D + u.pn * 256 + bj * 128 + wc * 32 + 8 * fq) = pack8(acc[ai][bj][m][0] * rs, acc[ai][bj][m][1] * rs);
                } else {
                    const float rs2 = rs * rs;
                    *(u32x4*)(U + (size_t)row * D + (u.pn - 4) * 128 + wc * 32 + 8 * fq) = pack8(acc[ai][0][m][0] * acc[ai][0][m][1] * rs2, acc[ai][1][m][0] * acc[ai][1][m][1] * rs2);
                }
            }
    }
};
struct EpiResid {
    const float* base; float* out;
    __device__ __forceinline__ void operator()(EPI_ARGS) const {
#pragma unroll
        for (int ai = 0; ai < 2; ++ai)
#pragma unroll
            for (int m = 0; m < 4; ++m) {
                const size_t off = (size_t)(u.pm * 256 + ai * 128 + wr * 64 + m * 16 + fr) * D + u.pn * 256 + wc * 32 + 4 * fq;
#pragma unroll
                for (int bj = 0; bj < 2; ++bj)
#pragma unroll
                    for (int n = 0; n < 2; ++n) { const size_t o = off + bj * 128 + n * 16; *(f32x4*)(out + o) = *(const f32x4*)(base + o) + acc[ai][bj][m][n]; }
            }
    }
};
struct EpiQKV {
    const float* r2; const f32x2* rope; unsigned char* kv; bf16_t* Q; float* gates;
    __device__ __forceinline__ void operator()(EPI_ARGS) const {
        const int pn = u.pn;
#pragma unroll
        for (int ai = 0; ai < 2; ++ai)
#pragma unroll
            for (int m = 0; m < 4; ++m) {
                const int row = u.pm * 256 + ai * 128 + wr * 64 + m * 16 + fr; const float rs = r2[row];
                const int b = row >> 14, s = row & (SEQ - 1);
                if (pn < 6) {
#pragma unroll
                    for (int bj = 0; bj < 2; ++bj) {
                        const int gg = 2 * bj + (wc >> 1), d0 = 16 * (wc & 1) + 4 * fq;
                        f32x4 v0 = acc[ai][bj][m][0] * rs, v1 = acc[ai][bj][m][1] * rs;
                        if (pn == 2 || pn == 4) {
                            const f32x4 cs0 = *(const f32x4*)(rope + (size_t)row * 32 + d0), cs1 = *(const f32x4*)(rope + (size_t)row * 32 + d0 + 2);
                            const f32x4 c = {cs0[0], cs0[2], cs1[0], cs1[2]}, sn = {cs0[1], cs0[3], cs1[1], cs1[3]};
                            const f32x4 o0 = v0 * c - v1 * sn, o1 = v1 * c + v0 * sn; v0 = o0; v1 = o1;
                        }
                        if (pn == 3 || pn == 5) {
                            bf16_t* vt = (bf16_t*)(kv + (size_t)pn * KVSTRIDE) + ((size_t)(b * 4 + gg) * 64 + d0) * SEQ + s;
#pragma unroll
                            for (int j = 0; j < 4; ++j) { vt[(size_t)j * SEQ] = (bf16_t)f2bf(v0[j]); vt[(size_t)(j + 32) * SEQ] = (bf16_t)f2bf(v1[j]); }
                        } else {
                            bf16_t* kp = (bf16_t*)(kv + (size_t)pn * KVSTRIDE) + ((size_t)(b * 4 + gg) * SEQ + s) * 64 + d0;
                            *(u32x2*)kp = pack4(v0); *(u32x2*)(kp + 32) = pack4(v1);
                        }
                    }
                } else if (pn < 10) {
#pragma unroll
                    for (int bj = 0; bj < 2; ++bj) {
                        const int head = 4 * (pn - 6) + 2 * bj + (wc >> 1), d0 = 16 * (wc & 1) + 4 * fq; const float sc = rs * 0.125f;
                        bf16_t* qp = Q + (size_t)row * D + head * 64 + d0;
                        *(u32x2*)qp = pack4(acc[ai][bj][m][0] * sc); *(u32x2*)(qp + 32) = pack4(acc[ai][bj][m][1] * sc);
                    }
                } else {
#pragma unroll
                    for (int n = 0; n < 2; ++n) { const int sl = 32 * wc + 16 * n + 4 * fq;
                        if (sl < 48) { f32x4 v = acc[ai][0][m][n] * rs;
#pragma unroll
                            for (int j = 0; j < 4; ++j) v[j] = 1.0f / (1.0f + __expf(-v[j]));
                            *(f32x4*)(gates + (size_t)row * 48 + sl) = v; } }
                }
            }
    }
};
__device__ __forceinline__ float gelu_tanh(float x) { const float y = 0.7978845608028654f * (x + 0.044715f * x * x * x); const float t = 1.0f - 2.0f / (1.0f + __expf(2.0f * y)); return 0.5f * x * (1.0f + t); }
struct EpiCmp1 {
    const float* bias; bf16_t* HID;
    __device__ __forceinline__ void operator()(EPI_ARGS) const {
        f32x4 bv[2][2];
#pragma unroll
        for (int bj = 0; bj < 2; ++bj)
#pragma unroll
            for (int n = 0; n < 2; ++n) bv[bj][n] = *(const f32x4*)(bias + u.e * 256 + bj * 128 + wc * 32 + 8 * fq + 4 * n);
#pragma unroll
        for (int ai = 0; ai < 2; ++ai)
#pragma unroll
            for (int m = 0; m < 4; ++m) {
                const int row = u.pm * 256 + ai * 128 + wr * 64 + m * 16 + fr;
#pragma unroll
                for (int bj = 0; bj < 2; ++bj) { f32x4 v0 = acc[ai][bj][m][0] + bv[bj][0], v1 = acc[ai][bj][m][1] + bv[bj][1];
#pragma unroll
                    for (int j = 0; j < 4; ++j) { v0[j] = gelu_tanh(v0[j]); v1[j] = gelu_tanh(v1[j]); }
                    *(u32x4*)(HID + ((size_t)u.e * 8192 + row) * 256 + bj * 128 + wc * 32 + 8 * fq) = pack8(v0, v1); }
            }
    }
};
struct EpiGU {
    MoeTab T; const float* rowr; bf16_t* ACT;
    __device__ __forceinline__ void operator()(EPI_ARGS) const {
        const size_t arow0 = (size_t)(T.tstart[u.e] + u.pm) * 256;
#pragma unroll
        for (int ai = 0; ai < 2; ++ai)
#pragma unroll
            for (int m = 0; m < 4; ++m) {
                const int rl = ai * 128 + wr * 64 + m * 16 + fr; const float rs = rowr[(size_t)u.e * ECAP + u.pm * 256 + rl];
                f32x4 a[2];
#pragma unroll
                for (int bj = 0; bj < 2; ++bj) { const f32x4 g = acc[ai][bj][m][0] * rs, up = acc[ai][bj][m][1] * rs;
#pragma unroll
                    for (int j = 0; j < 4; ++j) a[bj][j] = g[j] / (1.0f + __expf(-g[j])) * up[j]; }
                *(u32x4*)(ACT + (arow0 + rl) * DE + u.pn * 128 + wc * 32 + 8 * fq) = pack8(a[0], a[1]);
            }
    }
};
struct EpiDN {
    const int* rowl; const float* wgt; bf16_t* Y;
    __device__ __forceinline__ void operator()(EPI_ARGS) const {
#pragma unroll
        for (int ai = 0; ai < 2; ++ai)
#pragma unroll
            for (int m = 0; m < 4; ++m) {
                const int rl = ai * 128 + wr * 64 + m * 16 + fr;
                if (rl < u.nvalid) {
                    const int id = rowl[(size_t)u.e * ECAP + u.pm * 256 + rl]; const float w = wgt[id];
#pragma unroll
                    for (int bj = 0; bj < 2; ++bj) *(u32x4*)(Y + (size_t)id * D + u.pn * 256 + bj * 128 + wc * 32 + 8 * fq) = pack8(acc[ai][bj][m][0] * w, acc[ai][bj][m][1] * w);
                }
            }
    }
};

template <class RowMap>
__device__ __forceinline__ void transpose_item(const float* W, int K, int N, bf16_t* WT, const float* gain, LAS float* scr, int item, int lane, const RowMap& rm) {
    const int nblk = (N + 31) / 32, kb = item / nblk, nb = item % nblk, k0 = 64 * kb, n0 = 32 * nb;
    const int nn = n0 + (lane & 31); const bool ok = nn < N;
#pragma unroll 8
    for (int i = 0; i < 32; ++i) { const int kk = 2 * i + (lane >> 5); float v = ok ? W[(size_t)(k0 + kk) * N + nn] : 0.f; if (gain) v *= gain[k0 + kk]; scr[kk * 33 + (lane & 31)] = v; }
    LDS_WAIT(); asm volatile("" ::: "memory");
    const int c = lane & 7;
#pragma unroll
    for (int j = 0; j < 4; ++j) { const int n = (lane >> 3) + 8 * j; const LAS float* s = scr + (8 * c) * 33 + n;
        u32x4 o; o.x = pk2(s[0 * 33], s[1 * 33]); o.y = pk2(s[2 * 33], s[3 * 33]); o.z = pk2(s[4 * 33], s[5 * 33]); o.w = pk2(s[6 * 33], s[7 * 33]);
        if (n0 + n < N) *(u32x4*)(WT + (size_t)rm(n0 + n) * K + k0 + 8 * c) = o; }
    LDS_WAIT(); asm volatile("" ::: "memory");
}
struct MapIdent { __device__ __forceinline__ int operator()(int c) const { return c; } };
struct MapPerm8 { __device__ __forceinline__ int operator()(int c) const { return slot_perm8(c); } };
struct MapWin { __device__ __forceinline__ int operator()(int c) const {
    if (c < 1024) return slot_perm8(c);
    const int n = (c >= 2048) ? 1 : 0, ch = c - 1024 - 1024 * n; return 1024 + (ch >> 7) * 256 + slot_pair128(ch & 127, n); } };
struct MapKV { __device__ __forceinline__ int operator()(int c) const { return (c & ~63) + slot_rope64(c & 63); } };
struct MapAIn { __device__ __forceinline__ int operator()(int c) const { return c < 1024 ? 1536 + (c & ~63) + slot_rope64(c & 63) : 2560 + (c - 1024); } };
struct MapGU { int n; __device__ __forceinline__ int operator()(int c) const { return (c >> 7) * 256 + slot_pair128(c & 127, n); } };

__device__ __forceinline__ void convert_experts(const Args& a, const Frame& F, int layer, int gw, int NGW, LAS float* scr) {
    const float* nf = a.in[I_NFFN] + layer * D;
    for (int it = gw; it < NE * 768; it += NGW) {
        const int e = it / 768, r = it % 768; bf16_t* base = (bf16_t*)(F.ws + WS_EXPW + (size_t)e * 3 * MiB);
        const size_t eo = ((size_t)layer * NE + e) * (size_t)D * DE;
        if (r < 256) transpose_item(a.in[I_EWG] + eo, D, DE, base, nf, scr, r, F.lane, MapGU{0});
        else if (r < 512) transpose_item(a.in[I_EWU] + eo, D, DE, base, nf, scr, r - 256, F.lane, MapGU{1});
        else transpose_item(a.in[I_EWD] + eo, DE, D, base + (size_t)1024 * 1024, nullptr, scr, r - 512, F.lane, MapPerm8{});
    }
}

__device__ __forceinline__ void phase_prep(const Args& a, const Frame& F0) {
    const Frame F = refresh(F0);
    LAS float* scr = (LAS float*)(F.lds + F.wave * 16384);
    const int gw = F.vcu * NWAVES + F.wave, NGW = F.G * NWAVES;
    const int gt = gw * 64 + F.lane, NGT = NGW * 64;
    unsigned char* ws = F.ws;
    { const float* x = a.in[I_X]; bf16_t* XB = (bf16_t*)(ws + WS_RA); float* R0 = (float*)(ws + WS_R0);
      for (int m = gw; m < NT; m += NGW) { const f32x4* xr = (const f32x4*)(x + (size_t)m * D) + F.lane; f32x4 v[4]; float s = 0.f;
#pragma unroll
          for (int j = 0; j < 4; ++j) { v[j] = xr[64 * j]; s += (v[j][0] * v[j][0] + v[j][1] * v[j][1]) + (v[j][2] * v[j][2] + v[j][3] * v[j][3]); }
          s = wave_sum(s); if (F.lane == 0) R0[m] = 1.0f / sqrtf(s * (1.0f / D) + RMS_EPS);
          u32x2* o8 = (u32x2*)(XB + (size_t)m * D) + F.lane;
#pragma unroll
          for (int j = 0; j < 4; ++j) o8[64 * j] = pack4(v[j]); } }
    { const int* pos = (const int*)a.in[I_POS]; f32x2* rope = (f32x2*)(ws + WS_ROPE);
      for (int i = gt; i < NT * 32; i += NGT) { const float ang = (float)pos[i >> 5] * a.inv_freq[i & 31];
          double rev = (double)ang * 0.15915494309189533577; rev -= __builtin_rint(rev); const float rf = (float)rev;
          rope[i] = (f32x2){__builtin_amdgcn_cosf(rf), __builtin_amdgcn_sinf(rf)}; } }
    { constexpr int I_IN = 16 * 96, I_OUT = 16 * 32, I_KV = 16 * 48, I_AIN = 16 * 34, I_C1 = 32 * 8, I_AO = 16 * 32;
      constexpr int NI = I_IN + I_OUT + I_KV + I_AIN + 2 * I_C1 + I_AO;
      for (int it = gw; it < NI; it += NGW) { int r = it;
          if (r < I_IN) { transpose_item(a.in[I_CWIN], D, 3 * D, (bf16_t*)(ws + WS_WIN), a.in[I_NMIX], scr, r, F.lane, MapWin{}); continue; } r -= I_IN;
          if (r < I_OUT) { transpose_item(a.in[I_CWOUT], D, D, (bf16_t*)(ws + WS_WOUT), nullptr, scr, r, F.lane, MapIdent{}); continue; } r -= I_OUT;
          if (r < I_KV) { transpose_item(a.in[I_WKV], D, 1536, (bf16_t*)(ws + WS_WQKV), a.in[I_NKV], scr, r, F.lane, MapKV{}); continue; } r -= I_KV;
          if (r < I_AIN) { transpose_item(a.in[I_AWIN], D, 1072, (bf16_t*)(ws + WS_WQKV), a.in[I_NMIX] + D, scr, r, F.lane, MapAIn{}); continue; } r -= I_AIN;
          if (r < I_C1) { transpose_item(a.in[I_CW1K], 2048, 256, (bf16_t*)(ws + WS_WC1), nullptr, scr, r, F.lane, MapPerm8{}); continue; } r -= I_C1;
          if (r < I_C1) { transpose_item(a.in[I_CW1V], 2048, 256, (bf16_t*)(ws + WS_WC1) + 256 * 2048, nullptr, scr, r, F.lane, MapPerm8{}); continue; } r -= I_C1;
          transpose_item(a.in[I_AWOUT], D, D, (bf16_t*)(ws + WS_WAO), nullptr, scr, r, F.lane, MapIdent{});
      } }
    convert_experts(a, F, 0, gw, NGW, scr);
    { unsigned* z = (unsigned*)((bf16_t*)(ws + WS_WQKV) + (size_t)2608 * D); for (int i = gt; i < 208 * D / 2; i += NGT) z[i] = 0u; }
    { float* bc = (float*)(ws + WS_BIASC);
      for (int o = gw; o < 512; o += NGW) { const int kv = o >> 8, n = o & 255; const float* pos = a.in[kv ? I_CPV : I_CPK]; const float* w1 = a.in[kv ? I_CW1V : I_CW1K]; float s = 0.f;
          for (int i = F.lane; i < 2048; i += 64) s += pos[i] * w1[(size_t)i * 256 + n];
          s = wave_sum(s); if (F.lane == 0) bc[o] = s; } }
    { float* rw = (float*)(ws + WS_RW);
      for (int i = gt; i < 2 * 36 * 1024; i += NGT) { const int l = i / (36 * 1024), r = i % (36 * 1024), o = r >> 10, k = r & 1023;
          const float g = a.in[I_NFFN][l * D + k]; rw[i] = g * (o < 32 ? a.in[I_REW][((size_t)l * D + k) * 32 + o] : a.in[I_RGW][((size_t)l * D + k) * 4 + (o - 32)]); } }
    { bf16_t* w2t = (bf16_t*)(ws + WS_W2T);
      for (int i = gt; i < 2 * 64 * 256; i += NGT) { const int kv = i >> 14, r = i & 16383, n = r >> 8, k = r & 255; w2t[i] = (bf16_t)f2bf(a.in[kv ? I_CW2V : I_CW2K][k * 64 + n]); } }
}

__device__ __forceinline__ void phase_conv(const Args& a, const Frame& F0) {
    const Frame F = refresh(F0);
    const bf16_t* BG = (const bf16_t*)(F.ws + WS_RB); const bf16_t* U = (const bf16_t*)(F.ws + WS_RC); bf16_t* Z = (bf16_t*)(F.ws + WS_RA);
    const float* cw = a.in[I_CW];
    const int cg8 = (F.tid & 127) * 8, tq = F.tid >> 7;
    float w0[8], w1[8], w2[8];
#pragma unroll
    for (int j = 0; j < 8; ++j) { w0[j] = cw[cg8 + j]; w1[j] = cw[D + cg8 + j]; w2[j] = cw[2 * D + cg8 + j]; }
    for (int ch = F.vcu; ch < NT / 32; ch += F.G) {
        const int t0 = ch * 32 + tq * 8; const int s0 = t0 & (SEQ - 1);
        float um2[8], um1[8];
        { u32x4 p = {0u, 0u, 0u, 0u}, q = {0u, 0u, 0u, 0u};
          if (s0 >= 2) p = *(const u32x4*)(U + (size_t)(t0 - 2) * D + cg8);
          if (s0 >= 1) q = *(const u32x4*)(U + (size_t)(t0 - 1) * D + cg8);
#pragma unroll
          for (int j = 0; j < 4; ++j) { um2[2 * j] = bflo(p[j]); um2[2 * j + 1] = bfhi(p[j]); um1[2 * j] = bflo(q[j]); um1[2 * j + 1] = bfhi(q[j]); } }
#pragma unroll
        for (int i = 0; i < 8; ++i) {
            const u32x4 uu = *(const u32x4*)(U + (size_t)(t0 + i) * D + cg8), bb = *(const u32x4*)(BG + (size_t)(t0 + i) * D + cg8);
            float z[8];
#pragma unroll
            for (int j = 0; j < 4; ++j) { const float u0 = bflo(uu[j]), u1 = bfhi(uu[j]);
                z[2 * j] = bflo(bb[j]) * (w0[2 * j] * um2[2 * j] + w1[2 * j] * um1[2 * j] + w2[2 * j] * u0);
                z[2 * j + 1] = bfhi(bb[j]) * (w0[2 * j + 1] * um2[2 * j + 1] + w1[2 * j + 1] * um1[2 * j + 1] + w2[2 * j + 1] * u1);
                um2[2 * j] = um1[2 * j]; um2[2 * j + 1] = um1[2 * j + 1]; um1[2 * j] = u0; um1[2 * j + 1] = u1; }
            u32x4 o; o.x = pk2(z[0], z[1]); o.y = pk2(z[2], z[3]); o.z = pk2(z[4], z[5]); o.w = pk2(z[6], z[7]);
            *(u32x4*)(Z + (size_t)(t0 + i) * D + cg8) = o;
        }
    }
}

__device__ __forceinline__ void phase_router(const Args& a, const Frame& F0, int layer, const float* X, bf16_t* XnB, float* Rout) {
    const Frame F = refresh(F0);
    unsigned char* ws = F.ws;
    const float* rw = (const float*)(ws + WS_RW) + (size_t)layer * 36 * 1024;
    const float* brg = a.in[I_RGB] + layer * 4; const float* bre = a.in[I_REB] + layer * 32;
    unsigned* gcnt = (unsigned*)(ws + WS_CTL) + CW_CNT + layer * 32;
    int* rowl = (int*)(ws + WS_ROWL); float* rowr = (float*)(ws + WS_ROWR); float* wgt = (float*)(ws + WS_WGT);
    LAS float* lg = (LAS float*)(F.lds) + F.wave * (16 * 36);
    LAS unsigned* cntl = (LAS unsigned*)(F.lds + 32768); LAS unsigned* basel = cntl + 32;
    const int l15 = F.lane & 15, quad = F.lane >> 4;
    for (int base = F.vcu * 128; base < NT; base += F.G * 128) {
        if (F.tid < 32) cntl[F.tid] = 0u;
        const int tok = base + F.wave * 16 + l15;
        const float* xr = X + (size_t)tok * D + 4 * quad;
        const float* w0 = rw + (size_t)l15 * 1024 + 4 * quad; const float* w1 = w0 + 16 * 1024; const float* w2 = rw + (size_t)(32 + (l15 & 3)) * 1024 + 4 * quad;
        bf16_t* xo = XnB + (size_t)tok * D + 4 * quad;
        f32x4 acc0 = {0.f, 0.f, 0.f, 0.f}, acc1 = acc0, acc2 = acc0; float ss = 0.f;
#pragma unroll 4
        for (int it = 0; it < 64; ++it) {
            const f32x4 xv = *(const f32x4*)(xr + 16 * it), b0 = *(const f32x4*)(w0 + 16 * it), b1 = *(const f32x4*)(w1 + 16 * it), b2 = *(const f32x4*)(w2 + 16 * it);
            ss += (xv[0] * xv[0] + xv[1] * xv[1]) + (xv[2] * xv[2] + xv[3] * xv[3]);
            *(u32x2*)(xo + 16 * it) = pack4(xv);
#pragma unroll
            for (int jj = 0; jj < 4; ++jj) {
                acc0 = __builtin_amdgcn_mfma_f32_16x16x4f32(xv[jj], b0[jj], acc0, 0, 0, 0);
                acc1 = __builtin_amdgcn_mfma_f32_16x16x4f32(xv[jj], b1[jj], acc1, 0, 0, 0);
                acc2 = __builtin_amdgcn_mfma_f32_16x16x4f32(xv[jj], b2[jj], acc2, 0, 0, 0);
            }
        }
        ss += __shfl_xor(ss, 16); ss += __shfl_xor(ss, 32);
        const float r = 1.0f / sqrtf(ss * (1.0f / D) + RMS_EPS);
        if (quad == 0) Rout[tok] = r;
#pragma unroll
        for (int i = 0; i < 4; ++i) { const float rt = __shfl(r, 4 * quad + i); const int trow = 4 * quad + i;
            lg[trow * 36 + l15] = acc0[i] * rt + bre[l15]; lg[trow * 36 + 16 + l15] = acc1[i] * rt + bre[16 + l15];
            if (l15 < 4) lg[trow * 36 + 32 + l15] = acc2[i] * rt + brg[l15]; }
        __syncthreads();
        int e0 = 0, e1 = 0, rk0 = 0, rk1 = 0; float wt0 = 0.f, wt1 = 0.f;
        if (F.lane < 16) {
            const LAS float* L = lg + F.lane * 36;
            const float g0 = L[32], g1 = L[33], g2 = L[34], g3 = L[35];
            float gm = g0; int gt = 0; if (g1 > gm) { gm = g1; gt = 1; } if (g2 > gm) { gm = g2; gt = 2; } if (g3 > gm) { gm = g3; gt = 3; }
            const float pg = 1.0f / (expf(g0 - gm) + expf(g1 - gm) + expf(g2 - gm) + expf(g3 - gm));
            float v0 = -INFINITY, v1 = -INFINITY; int i0 = 0, i1 = 0;
#pragma unroll
            for (int k = 0; k < 8; ++k) { const float v = L[8 * gt + k]; if (v > v0) { v1 = v0; i1 = i0; v0 = v; i0 = k; } else if (v > v1) { v1 = v; i1 = k; } }
            const float ex = expf(v1 - v0); const float s0 = 1.0f / (1.0f + ex);
            wt0 = pg * s0; wt1 = pg * (ex * s0); e0 = 8 * gt + i0; e1 = 8 * gt + i1;
            rk0 = (int)atomicAdd((unsigned*)&cntl[e0], 1u); rk1 = (int)atomicAdd((unsigned*)&cntl[e1], 1u);
        }
        __syncthreads();
        if (F.tid < 32) { const unsigned c = cntl[F.tid]; basel[F.tid] = c ? __hip_atomic_fetch_add(gcnt + F.tid, c, __ATOMIC_RELAXED, __HIP_MEMORY_SCOPE_AGENT) : 0u; }
        __syncthreads();
        if (F.lane < 16) {
            const int tk = base + F.wave * 16 + F.lane; const float rr = r;
            const size_t s0 = (size_t)e0 * ECAP + basel[e0] + rk0, s1 = (size_t)e1 * ECAP + basel[e1] + rk1;
            rowl[s0] = 2 * tk; rowr[s0] = rr; wgt[2 * tk] = wt0;
            rowl[s1] = 2 * tk + 1; rowr[s1] = rr; wgt[2 * tk + 1] = wt1;
        }
        __syncthreads();
    }
}

template <bool FINAL>
__device__ __forceinline__ void phase_combine(const Args& a, const Frame& F0, float* X, bf16_t* XnB, float* Rout) {
    const Frame F = refresh(F0);
    const bf16_t* Y = (const bf16_t*)(F.ws + WS_RB);
    const int gw = F.vcu * NWAVES + F.wave, NGW = F.G * NWAVES;
    for (int m = gw; m < NT; m += NGW) {
        f32x4* xr = (f32x4*)(X + (size_t)m * D) + F.lane; const u32x2* y0 = (const u32x2*)(Y + (size_t)(2 * m) * D) + F.lane; const u32x2* y1 = (const u32x2*)(Y + (size_t)(2 * m + 1) * D) + F.lane;
        f32x4 v[4]; float s = 0.f;
#pragma unroll
        for (int j = 0; j < 4; ++j) { v[j] = xr[64 * j]; const u32x2 p = y0[64 * j], q = y1[64 * j];
            v[j][0] += bflo(p[0]) + bflo(q[0]); v[j][1] += bfhi(p[0]) + bfhi(q[0]); v[j][2] += bflo(p[1]) + bflo(q[1]); v[j][3] += bfhi(p[1]) + bfhi(q[1]);
            s += (v[j][0] * v[j][0] + v[j][1] * v[j][1]) + (v[j][2] * v[j][2] + v[j][3] * v[j][3]); }
        s = wave_sum(s); const float r = 1.0f / sqrtf(s * (1.0f / D) + RMS_EPS);
        if constexpr (FINAL) {
            const f32x4* g = (const f32x4*)a.in[I_NFIN] + F.lane;
#pragma unroll
            for (int j = 0; j < 4; ++j) xr[64 * j] = v[j] * r * g[64 * j];
        } else {
            if (F.lane == 0) Rout[m] = r;
            u32x2* o8 = (u32x2*)(XnB + (size_t)m * D) + F.lane;
#pragma unroll
            for (int j = 0; j < 4; ++j) { xr[64 * j] = v[j]; o8[64 * j] = pack4(v[j]); }
        }
    }
}

__device__ __forceinline__ void phase_cmp2(const Frame& F0) {
    const Frame F = refresh(F0);
    const bf16_t* HID = (const bf16_t*)(F.ws + WS_RD + RD_HID); const bf16_t* W2T = (const bf16_t*)(F.ws + WS_W2T);
    bf16_t* KCMP = (bf16_t*)(F.ws + WS_RD + RD_KCMP); bf16_t* VCMPT = (bf16_t*)(F.ws + WS_RD + RD_VCMPT);
    const int gw = F.vcu * NWAVES + F.wave, NGW = F.G * NWAVES, l15 = F.lane & 15, quad = F.lane >> 4;
    for (int task = gw; task < 1024; task += NGW) {
        const int kv = task >> 9, r0 = (task & 511) * 16;
        const bf16_t* ap = HID + ((size_t)kv * 8192 + r0 + l15) * 256 + 8 * quad; const bf16_t* bp = W2T + (size_t)kv * 64 * 256 + (size_t)l15 * 256 + 8 * quad;
        f32x4 acc[4];
#pragma unroll
        for (int cb = 0; cb < 4; ++cb) acc[cb] = (f32x4){0.f, 0.f, 0.f, 0.f};
#pragma unroll
        for (int ks = 0; ks < 8; ++ks) { const bf16x8 af = *(const bf16x8*)(ap + 32 * ks);
#pragma unroll
            for (int cb = 0; cb < 4; ++cb) acc[cb] = __builtin_amdgcn_mfma_f32_16x16x32_bf16(af, *(const bf16x8*)(bp + (size_t)cb * 16 * 256 + 32 * ks), acc[cb], 0, 0, 0); }
#pragma unroll
        for (int cb = 0; cb < 4; ++cb)
#pragma unroll
            for (int i = 0; i < 4; ++i) { const int row = r0 + 4 * quad + i, bg = row >> 10, c = row & 1023, col = l15 + 16 * cb;
                if (kv == 0) KCMP[((size_t)bg * 1024 + c) * 64 + col] = (bf16_t)f2bf(acc[cb][i]);
                else VCMPT[((size_t)bg * 64 + col) * 1024 + c] = (bf16_t)f2bf(acc[cb][i]); }
    }
}

namespace nsa {
constexpr int ROWB = 144;
constexpr int A_K = 0, A_V = 2 * 64 * ROWB, A_IMP = 4 * 64 * ROWB, IMP_LD = 260, A_SELM = A_IMP + 64 * IMP_LD * 4, A_UW = A_SELM + 64 * 8 * 4, A_UB = A_UW + 64 * 4, A_TL = A_UB + 64, A_END = A_TL + 260 * 4;
static_assert(A_END <= RING_BYTES, "attention LDS");
struct Ctx { int tid, lane, wave, l15, quad, qi, h; LAS unsigned char* lds; };
struct SubState { float m, l; f32x4 O[4]; };

template <int MODE>
__device__ __forceinline__ void tile_compute(const Ctx& c, int buf, const bf16x8 (&qf)[2][2], SubState (&st)[2], const int (&lo)[2], const int (&hi)[2], const bool (&act)[2], int kidx0, const float (&invl)[2]) {
    const LAS unsigned char* kb = c.lds + A_K + buf * 64 * ROWB + c.l15 * ROWB + 16 * c.quad;
    const LAS unsigned char* vb = c.lds + A_V + buf * 64 * ROWB + c.l15 * ROWB + 8 * c.quad;
    if (!act[0] && !act[1]) return;
    f32x4 S[2][4];
#pragma unroll
    for (int mb = 0; mb < 4; ++mb) {
        const bf16x8 k0 = *(const LAS bf16x8*)(kb + mb * 16 * ROWB), k1 = *(const LAS bf16x8*)(kb + mb * 16 * ROWB + 64);
#pragma unroll
        for (int sg = 0; sg < 2; ++sg) if (act[sg]) {
            S[sg][mb] = __builtin_amdgcn_mfma_f32_16x16x32_bf16(k0, qf[sg][0], (f32x4){0.f, 0.f, 0.f, 0.f}, 0, 0, 0);
            S[sg][mb] = __builtin_amdgcn_mfma_f32_16x16x32_bf16(k1, qf[sg][1], S[sg][mb], 0, 0, 0); }
    }
    bf16x8 pf[2][2];
#pragma unroll
    for (int sg = 0; sg < 2; ++sg) {
        if (!act[sg]) continue;
        float tmax = -INFINITY;
#pragma unroll
        for (int mb = 0; mb < 4; ++mb)
#pragma unroll
            for (int i = 0; i < 4; ++i) { const int off = 16 * mb + 4 * c.quad + i; const bool ok = off >= lo[sg] && off <= hi[sg]; S[sg][mb][i] = ok ? S[sg][mb][i] : -INFINITY; tmax = fmaxf(tmax, S[sg][mb][i]); }
        float mref;
        if (MODE == 1) { mref = (st[sg].m == -INFINITY) ? 0.f : st[sg].m; }
        else {
            tmax = fmaxf(tmax, __shfl_xor(tmax, 16)); tmax = fmaxf(tmax, __shfl_xor(tmax, 32));
            const float mnew = fmaxf(st[sg].m, tmax); mref = (mnew == -INFINITY) ? 0.f : mnew;
            const float alpha = __expf(st[sg].m - mref); st[sg].m = mnew; st[sg].l *= alpha;
            if (MODE != 0) {
#pragma unroll
                for (int db = 0; db < 4; ++db) st[sg].O[db] = st[sg].O[db] * alpha; }
        }
        float ps = 0.f;
#pragma unroll
        for (int mb = 0; mb < 4; ++mb)
#pragma unroll
            for (int i = 0; i < 4; ++i) { float p = __expf(S[sg][mb][i] - mref); if (MODE == 1) p *= invl[sg]; S[sg][mb][i] = p; ps += p; }
        if (MODE != 1) st[sg].l += ps;
        if (MODE == 0) continue;
        if (MODE == 1) {
            LAS float* imp = (LAS float*)(c.lds + A_IMP) + (c.wave * 8 + sg * 4 + c.qi) * IMP_LD + (kidx0 >> 2) + c.quad;
#pragma unroll
            for (int mb = 0; mb < 4; ++mb) { float a = (S[sg][mb][0] + S[sg][mb][1]) + (S[sg][mb][2] + 0.5f * S[sg][mb][3]), b = 0.5f * S[sg][mb][3];
                a += __shfl_xor(a, 1); a += __shfl_xor(a, 2); b += __shfl_xor(b, 1); b += __shfl_xor(b, 2);
                if (c.h == 0) { __hip_atomic_fetch_add(imp + 4 * mb, a, __ATOMIC_RELAXED, __HIP_MEMORY_SCOPE_WORKGROUP); __hip_atomic_fetch_add(imp + 4 * mb + 1, b, __ATOMIC_RELAXED, __HIP_MEMORY_SCOPE_WORKGROUP); } }
        }
#pragma unroll
        for (int k2 = 0; k2 < 2; ++k2) { const u32x4 w = pack8(S[sg][2 * k2], S[sg][2 * k2 + 1]); pf[sg][k2] = __builtin_bit_cast(bf16x8, w); }
    }
    if (MODE == 0) return;
#pragma unroll
    for (int db = 0; db < 4; ++db)
#pragma unroll
        for (int k2 = 0; k2 < 2; ++k2) {
            const s16x4 a = *(const LAS s16x4*)(vb + db * 16 * ROWB + k2 * 64), b = *(const LAS s16x4*)(vb + db * 16 * ROWB + k2 * 64 + 32);
            const bf16x8 vf = (bf16x8){a[0], a[1], a[2], a[3], b[0], b[1], b[2], b[3]};
#pragma unroll
            for (int sg = 0; sg < 2; ++sg) if (act[sg]) st[sg].O[db] = __builtin_amdgcn_mfma_f32_16x16x32_bf16(vf, pf[sg][k2], st[sg].O[db], 0, 0, 0);
        }
}
}

namespace nsa {
struct Tensors { const bf16_t* Q; const f32x2* rope; const float* gates; const bf16_t *KS, *VTS, *KW, *VTW, *KCMP, *VCMPT; bf16_t* O; };

struct Stager {
    int row, ch;
    __device__ __forceinline__ void load(const bf16_t* K, const bf16_t* VT, size_t vpitch, int kidx0, bool withv, u32x4& kr, u32x4& vr) const {
        kr = *(const u32x4*)(K + (size_t)(kidx0 + row) * 64 + ch * 8);
        if (withv) vr = *(const u32x4*)(VT + (size_t)row * vpitch + kidx0 + ch * 8);
    }
    __device__ __forceinline__ void store(LAS unsigned char* lds, int buf, bool withv, const u32x4& kr, const u32x4& vr) const {
        *(LAS u32x4*)(lds + A_K + buf * 64 * ROWB + row * ROWB + ch * 16) = kr;
        if (withv) *(LAS u32x4*)(lds + A_V + buf * 64 * ROWB + row * ROWB + ch * 16) = vr;
    }
};

__device__ __forceinline__ void attn_unit(const Tensors& T, LAS unsigned char* lds, int tid_in, int b, int g, int qt) {
    Ctx c; { int t_ = tid_in; asm volatile("" : "+v"(t_)); c.tid = t_; } c.lane = c.tid & 63; c.wave = __builtin_amdgcn_readfirstlane(c.tid >> 6); c.l15 = c.lane & 15; c.quad = c.lane >> 4; c.qi = c.l15 >> 2; c.h = c.l15 & 3; c.lds = lds;
    const int t0 = qt * 64, bg = b * 4 + g; const size_t tokbase = (size_t)b * SEQ;
    Stager sg_; sg_.row = c.tid >> 3; sg_.ch = c.tid & 7;
    int tq[2]; tq[0] = t0 + c.wave * 8 + c.qi; tq[1] = tq[0] + 4;
    bf16x8 qc[2][2], qr[2][2];
#pragma unroll
    for (int s = 0; s < 2; ++s) {
        const bf16_t* qp = T.Q + (tokbase + tq[s]) * D + (g * 4 + c.h) * 64 + 8 * c.quad;
        qc[s][0] = *(const bf16x8*)qp; qc[s][1] = *(const bf16x8*)(qp + 32);
        const f32x4* rp = (const f32x4*)(T.rope + (tokbase + tq[s]) * 32 + 8 * c.quad);
        u32x4 w0, w1;
#pragma unroll
        for (int p = 0; p < 4; ++p) { const f32x4 cs = rp[p];
            const float a0 = bf2f((unsigned short)qc[s][0][2 * p]), a1 = bf2f((unsigned short)qc[s][0][2 * p + 1]), b0 = bf2f((unsigned short)qc[s][1][2 * p]), b1 = bf2f((unsigned short)qc[s][1][2 * p + 1]);
            w0[p] = pk2(a0 * cs[0] - b0 * cs[1], a1 * cs[2] - b1 * cs[3]); w1[p] = pk2(b0 * cs[0] + a0 * cs[1], b1 * cs[2] + a1 * cs[3]); }
        qr[s][0] = __builtin_bit_cast(bf16x8, w0); qr[s][1] = __builtin_bit_cast(bf16x8, w1);
    }
    float gate[2][3];
#pragma unroll
    for (int s = 0; s < 2; ++s)
#pragma unroll
        for (int br = 0; br < 3; ++br) gate[s][br] = T.gates[(tokbase + tq[s]) * 48 + (g * 4 + c.h) * 3 + br];
    f32x4 tot[2][4];
#pragma unroll
    for (int s = 0; s < 2; ++s)
#pragma unroll
        for (int db = 0; db < 4; ++db) tot[s][db] = (f32x4){0.f, 0.f, 0.f, 0.f};
    for (int i = c.tid; i < 64 * IMP_LD; i += NTHREADS) ((LAS float*)(lds + A_IMP))[i] = 0.f;

    SubState st[2]; int lo[2], hi[2]; bool act[2]; float invl[2] = {0.f, 0.f};
    u32x4 kr, vr = {0u, 0u, 0u, 0u};
#define RESET_ST() do { _Pragma("unroll") for (int s = 0; s < 2; ++s) { st[s].m = -INFINITY; st[s].l = 0.f; _Pragma("unroll") for (int db = 0; db < 4; ++db) st[s].O[db] = (f32x4){0.f, 0.f, 0.f, 0.f}; } } while (0)
    const int ncmp = min(NCMP, t0 / 16 + 3), ntc = (ncmp + 63) >> 6;
    const bf16_t* Kc = T.KCMP + (size_t)bg * 1024 * 64; const bf16_t* Vc = T.VCMPT + (size_t)bg * 64 * 1024;
    int lim[2];
#pragma unroll
    for (int s = 0; s < 2; ++s) lim[s] = tq[s] >= 31 ? ((tq[s] - 31) >> 4) : -1;
    RESET_ST();
    {
        sg_.load(Kc, Vc, 1024, 0, false, kr, vr); sg_.store(lds, 0, false, kr, vr); __syncthreads();
#pragma unroll 1
        for (int t = 0; t < ntc; ++t) {
            const bool nx = t + 1 < ntc; if (nx) sg_.load(Kc, Vc, 1024, 64 * (t + 1), false, kr, vr);
#pragma unroll
            for (int s = 0; s < 2; ++s) { lo[s] = 0; hi[s] = lim[s] - 64 * t; act[s] = true; }
            tile_compute<0>(c, t & 1, qc, st, lo, hi, act, 64 * t, invl);
            if (nx) sg_.store(lds, (t + 1) & 1, false, kr, vr);
            __syncthreads();
        }
    }
#pragma unroll
    for (int s = 0; s < 2; ++s) { float l = st[s].l; l += __shfl_xor(l, 16); l += __shfl_xor(l, 32); invl[s] = l > 0.f ? 1.0f / l : 0.f; }
    {
        sg_.load(Kc, Vc, 1024, 0, true, kr, vr); sg_.store(lds, 0, true, kr, vr); __syncthreads();
#pragma unroll 1
        for (int t = 0; t < ntc; ++t) {
            const bool nx = t + 1 < ntc; if (nx) sg_.load(Kc, Vc, 1024, 64 * (t + 1), true, kr, vr);
#pragma unroll
            for (int s = 0; s < 2; ++s) { lo[s] = 0; hi[s] = lim[s] - 64 * t; act[s] = true; }
            tile_compute<1>(c, t & 1, qc, st, lo, hi, act, 64 * t, invl);
            if (nx) sg_.store(lds, (t + 1) & 1, true, kr, vr);
            __syncthreads();
        }
    }
#pragma unroll
    for (int s = 0; s < 2; ++s)
#pragma unroll
        for (int db = 0; db < 4; ++db) tot[s][db] = st[s].O[db] * gate[s][0];
    {
        LAS float* impw = (LAS float*)(lds + A_IMP) + (c.wave * 8) * IMP_LD;
        unsigned uw = 0u;
#pragma unroll 1
        for (int qq = 0; qq < 8; ++qq) {
            const int tqq = t0 + c.wave * 8 + qq, cur = tqq >> 6;
            unsigned long long key[4];
#pragma unroll
            for (int e = 0; e < 4; ++e) { const int j = c.lane + 64 * e; const bool valid = j <= cur; const bool forced = (j == 0) || (j == cur) || (j == cur - 1);
                const float sc = impw[qq * IMP_LD + j] + (forced ? 1000.0f : 0.0f);
                key[e] = valid ? ((((unsigned long long)(__float_as_uint(sc) + 1u)) << 32) | (unsigned)(255 - j)) : 0ull; }
            unsigned myword = 0u;
#pragma unroll 1
            for (int r = 0; r < 16; ++r) {
                unsigned long long best = key[0] > key[1] ? key[0] : key[1]; const unsigned long long b2 = key[2] > key[3] ? key[2] : key[3]; best = best > b2 ? best : b2;
#pragma unroll
                for (int o = 1; o < 64; o <<= 1) { const unsigned long long ot = __shfl_xor(best, o); best = ot > best ? ot : best; }
                if (best == 0ull) break;
                const int j = 255 - (int)(best & 0xffu);
#pragma unroll
                for (int e = 0; e < 4; ++e) key[e] = (key[e] == best) ? 0ull : key[e];
                if (c.lane == (j >> 5)) myword |= 1u << (j & 31);
            }
            if (c.lane < 8) ((LAS unsigned*)(lds + A_SELM))[(c.wave * 8 + qq) * 8 + c.lane] = myword;
            uw |= myword;
        }
        if (c.lane < 8) ((LAS unsigned*)(lds + A_UW))[c.wave * 8 + c.lane] = uw;
        __syncthreads();
        if (c.tid < 8) { unsigned u = 0u;
#pragma unroll
            for (int w = 0; w < 8; ++w) u |= ((LAS unsigned*)(lds + A_UW))[w * 8 + c.tid];
            ((LAS unsigned*)(lds + A_UB))[c.tid] = u; }
        __syncthreads();
        if (c.tid < 256) { const LAS unsigned* ub = (const LAS unsigned*)(lds + A_UB); const int wj = c.tid >> 5, bj = c.tid & 31; int pos = 0;
#pragma unroll
            for (int w = 0; w < 8; ++w) { const unsigned x = ub[w]; pos += (w < wj) ? __popc(x) : 0; }
            const unsigned xw = ub[wj]; pos += __popc(xw & ((1u << bj) - 1u));
            if ((xw >> bj) & 1u) ((LAS int*)(lds + A_TL))[pos] = c.tid; }
        __syncthreads();
    }
    {
        const LAS unsigned* ub = (const LAS unsigned*)(lds + A_UB); int nsel = 0;
#pragma unroll
        for (int w = 0; w < 8; ++w) nsel += __popc(ub[w]);
        nsel = __builtin_amdgcn_readfirstlane(nsel);
        const LAS int* TL = (const LAS int*)(lds + A_TL); const LAS unsigned* selm = (const LAS unsigned*)(lds + A_SELM);
        const bf16_t* Ks = T.KS + (size_t)bg * SEQ * 64; const bf16_t* Vs = T.VTS + (size_t)bg * 64 * SEQ;
        RESET_ST();
        int j = __builtin_amdgcn_readfirstlane(TL[0]);
        sg_.load(Ks, Vs, SEQ, 64 * j, true, kr, vr); sg_.store(lds, 0, true, kr, vr); __syncthreads();
#pragma unroll 1
        for (int t = 0; t < nsel; ++t) {
            const bool nx = t + 1 < nsel; int jn = 0;
            if (nx) { jn = __builtin_amdgcn_readfirstlane(TL[t + 1]); sg_.load(Ks, Vs, SEQ, 64 * jn, true, kr, vr); }
#pragma unroll
            for (int s = 0; s < 2; ++s) { const unsigned w = selm[(c.wave * 8 + 4 * s + c.qi) * 8 + (j >> 5)]; const bool sel = (w >> (j & 31)) & 1u;
                lo[s] = 0; hi[s] = sel ? (tq[s] - 64 * j) : -1; act[s] = __any(sel ? 1 : 0) != 0; }
            tile_compute<2>(c, t & 1, qr, st, lo, hi, act, 64 * j, invl);
            if (nx) sg_.store(lds, (t + 1) & 1, true, kr, vr);
            __syncthreads();
            j = jn;
        }
#pragma unroll
        for (int s = 0; s < 2; ++s) { float l = st[s].l; l += __shfl_xor(l, 16); l += __shfl_xor(l, 32); const float f = (l > 0.f ? 1.0f / l : 0.f) * gate[s][1];
#pragma unroll
            for (int db = 0; db < 4; ++db) tot[s][db] += st[s].O[db] * f; }
    }
    {
        const bf16_t* Kw = T.KW + (size_t)bg * SEQ * 64; const bf16_t* Vw = T.VTW + (size_t)bg * 64 * SEQ;
        const int kt1 = qt, kt0 = max(0, qt - 8), nw = kt1 - kt0 + 1;
        RESET_ST();
        sg_.load(Kw, Vw, SEQ, 64 * kt0, true, kr, vr); sg_.store(lds, 0, true, kr, vr); __syncthreads();
#pragma unroll 1
        for (int t = 0; t < nw; ++t) {
            const int k0 = 64 * (kt0 + t); const bool nx = t + 1 < nw; if (nx) sg_.load(Kw, Vw, SEQ, k0 + 64, true, kr, vr);
#pragma unroll
            for (int s = 0; s < 2; ++s) { hi[s] = tq[s] - k0; lo[s] = tq[s] - 511 - k0; act[s] = true; }
            tile_compute<3>(c, t & 1, qr, st, lo, hi, act, k0, invl);
            if (nx) sg_.store(lds, (t + 1) & 1, true, kr, vr);
            __syncthreads();
        }
#pragma unroll
        for (int s = 0; s < 2; ++s) { float l = st[s].l; l += __shfl_xor(l, 16); l += __shfl_xor(l, 32); const float f = (l > 0.f ? 1.0f / l : 0.f) * gate[s][2];
#pragma unroll
            for (int db = 0; db < 4; ++db) tot[s][db] += st[s].O[db] * f; }
    }
#pragma unroll
    for (int s = 0; s < 2; ++s) { bf16_t* op = T.O + (tokbase + tq[s]) * D + (g * 4 + c.h) * 64 + 4 * c.quad;
#pragma unroll
        for (int db = 0; db < 4; ++db) *(u32x2*)(op + 16 * db) = pack4(tot[s][db]); }
#undef RESET_ST
}
}


#define XB_TMO      128
#define XB_XCNT(j)  (256  + 64 * (j))
#define XB_XSUB(j)  (1280 + 64 * (j))
#define XB_XGEN(j)  (2304 + 64 * (j))
#define XB_TOP      3328
#define XB_TOPGEN   3392
#define XCD_BAR_WORDS 3456
#define XB_SPIN_CAP (1u << 22)
__device__ __forceinline__ unsigned xb_ld(unsigned* p)              { return __hip_atomic_load(p, __ATOMIC_RELAXED, __HIP_MEMORY_SCOPE_AGENT); }
__device__ __forceinline__ unsigned xb_add(unsigned* p, unsigned v) { return __hip_atomic_fetch_add(p, v, __ATOMIC_RELAXED, __HIP_MEMORY_SCOPE_AGENT); }
__device__ __forceinline__ unsigned xb_xcc_id() { return (unsigned)__builtin_amdgcn_s_getreg((3 << 11) | 20) & 0xFu; }
#define XB_SPIN(cond, bar) do { unsigned _sp = 0; while (cond) { __builtin_amdgcn_s_sleep(1); \
    if ((++_sp & 255u) == 0u) { if (xb_ld(&(bar)[XB_TMO])) break; if (_sp > XB_SPIN_CAP) { atomicAdd(&(bar)[XB_TMO], 1u); break; } } } } while (0)
struct XcdBarrier { unsigned* bar; unsigned x; volatile LAS unsigned* st; };
__device__ __forceinline__ XcdBarrier xcd_barrier_post(unsigned* bar, volatile LAS unsigned* st, bool t0) {
    XcdBarrier b; b.bar = bar; b.x = xb_xcc_id(); b.st = st;
    if (t0) (void)xb_add(&bar[XB_XCNT(b.x)], 1u);
    return b;
}
__device__ __forceinline__ void xcd_barrier_complete(unsigned* bar, unsigned x, unsigned& nloc, unsigned& nx) {
    const unsigned G = gridDim.x;
    unsigned sum, cnt, mine, sp = 0u;
    for (;;) {
        sum = 0u; cnt = 0u; mine = 0u;
#pragma unroll
        for (unsigned j = 0; j < 16; ++j) { const unsigned c = xb_ld(&bar[XB_XCNT(j)]); sum += c; cnt += (c > 0u) ? 1u : 0u; mine = (j == x) ? c : mine; }
        if (sum == G) break;
        __builtin_amdgcn_s_sleep(1);
        if ((++sp & 255u) == 0u) { if (xb_ld(&bar[XB_TMO])) break; if (sp > XB_SPIN_CAP) { atomicAdd(&bar[XB_TMO], 1u); break; } }
    }
    nloc = mine > 0u ? mine : 1u; nx = cnt > 0u ? cnt : 1u;
}
__device__ __forceinline__ void xcd_barrier(const XcdBarrier& b, bool t0) {
    asm volatile("s_waitcnt vmcnt(0)" ::: "memory");
    __syncthreads();
    if (t0) {
        unsigned* bar = b.bar;
        __builtin_amdgcn_s_waitcnt(0);
        unsigned nloc = b.st[0], nx = b.st[1];
        if (nloc == 0u) { xcd_barrier_complete(bar, b.x, nloc, nx); b.st[0] = nloc; b.st[1] = nx; }
        const unsigned old = xb_add(&bar[XB_XSUB(b.x)], 1u);
        const unsigned gen = old / nloc;
        if (old + 1u == (gen + 1u) * nloc) {
            __builtin_amdgcn_fence(__ATOMIC_RELEASE, "agent");
            asm volatile("s_waitcnt vmcnt(0)" ::: "memory");
            const unsigned og = xb_add(&bar[XB_TOP], 1u);
            const unsigned tg = og / nx;
            if (og + 1u == (tg + 1u) * nx) xb_add(&bar[XB_TOPGEN], 1u);
            else XB_SPIN(xb_ld(&bar[XB_TOPGEN]) == tg, bar);
            __builtin_amdgcn_fence(__ATOMIC_ACQUIRE, "agent");
            xb_add(&bar[XB_XGEN(b.x)], 1u);
            asm volatile("s_waitcnt vmcnt(0)" ::: "memory");
        } else {
            XB_SPIN(xb_ld(&bar[XB_XGEN(b.x)]) == gen, bar);
            __builtin_amdgcn_fence(__ATOMIC_ACQUIRE, "agent");
            asm volatile("s_waitcnt vmcnt(0)" ::: "memory");
        }
    }
    __syncthreads();
}

__device__ __forceinline__ MoeTab moe_tables(const Frame& F0, int layer) {
    const Frame F = refresh(F0);
    MoeTab T; T.tstart = (volatile LAS int*)(F.lds + MISC_OFF); T.cnt = T.tstart + 64;
    const unsigned* gcnt = (const unsigned*)(F.ws + WS_CTL) + CW_CNT + layer * 32;
    __syncthreads();
    if (F.tid < 32) T.cnt[F.tid] = (int)__hip_atomic_load(gcnt + F.tid, __ATOMIC_RELAXED, __HIP_MEMORY_SCOPE_AGENT);
    __syncthreads();
    if (F.tid == 0) { int acc = 0; for (int e = 0; e < 32; ++e) { T.tstart[e] = acc; acc += (T.cnt[e] + 255) >> 8; } T.tstart[32] = acc; }
    __syncthreads();
    return T;
}

constexpr int N_PHASES = 17;
__global__ void __launch_bounds__(NTHREADS, 2) nsa_fwd(Args args) {
    extern __shared__ __attribute__((aligned(16))) unsigned char lds_raw[];
    cg::grid_group grid = cg::this_grid();
    Frame F; F.lds = (LAS unsigned char*)lds_raw; F.ws = args.ws;
    { const int t = threadIdx.x; F.wave = __builtin_amdgcn_readfirstlane(t >> 6); F.tid = t; F.lane = t & 63; }
    F.G = gridDim.x; { const int bx = blockIdx.x; F.vcu = (F.G % 8 == 0) ? (bx % 8) * (F.G / 8) + bx / 8 : bx; }
    unsigned char* ws = args.ws;
    float* X = args.out;
    const int lo = args.ph_lo, hi = args.ph_hi;
    volatile LAS unsigned* bst = (volatile LAS unsigned*)(F.lds + MISC_OFF + 1024);
    if (F.tid < 2) bst[F.tid] = 0u;
    __syncthreads();
    XcdBarrier xb; xb.bar = (unsigned*)(ws + WS_CTL) + CW_BAR; xb.x = 0; xb.st = bst;
    if (hi - lo > 1) xb = xcd_barrier_post((unsigned*)(ws + WS_CTL) + CW_BAR, bst, F.tid == 0);
#ifndef PH_MASK
#define PH_MASK 0x1ffff
#endif
#define IN(k) (((PH_MASK >> (k)) & 1) && lo <= (k) && (k) < hi)
#define SEAM(k) do { if (IN(k) && IN((k) + 1)) { if ((k) == 0) grid.sync(); else xcd_barrier(xb, mytid(F) == 0); } } while (0)
    LAS unsigned char* ring = F.lds;

    if (IN(0)) { phase_prep(args, F); } SEAM(0);
    if (IN(1)) {
        DenseOrder S; S.init(ws + WS_RA, ws + WS_WIN, NT, 3 * D, D, D, F.G, (int)blockIdx.x);
        EpiInProj E{(const float*)(ws + WS_R0), (bf16_t*)(ws + WS_RB), (bf16_t*)(ws + WS_RC)};
        pg8::gemm_phase<EpiInProj, DenseOrder, false>(ring, mytid(F), pg8::Gemm{D, D}, S, E);
    } SEAM(1);
    if (IN(2)) { phase_conv(args, F); } SEAM(2);
    if (IN(3)) {
        DenseOrder S; S.init(ws + WS_RA, ws + WS_WOUT, NT, D, D, D, F.G, (int)blockIdx.x);
        EpiResid E{args.in[I_X], X};
        pg8::gemm_phase<EpiResid, DenseOrder, false>(ring, mytid(F), pg8::Gemm{D, D}, S, E);
    } SEAM(3);
    {
        if (IN(4)) { phase_router(args, F, 0, X, (bf16_t*)(ws + WS_RA), (float*)(ws + WS_R1)); } SEAM(4);
        if (IN(5)) {
            MoeTab T = moe_tables(F, 0);
            MoeGuOrder S{T, (const char*)(ws + WS_RA), (const int*)(ws + WS_ROWL), (const char*)(ws + WS_EXPW), F.G, F.vcu};
            EpiGU E{T, (const float*)(ws + WS_ROWR), (bf16_t*)(ws + WS_RD)};
            pg8::gemm_phase<EpiGU, MoeGuOrder, true>(ring, mytid(F), pg8::Gemm{D, D}, S, E);
        } SEAM(5);
        if (IN(6)) {
            MoeTab T = moe_tables(F, 0);
            MoeDnOrder S{T, (const char*)(ws + WS_RD), (const char*)(ws + WS_EXPW), F.G, F.vcu};
            EpiDN E{(const int*)(ws + WS_ROWL), (const float*)(ws + WS_WGT), (bf16_t*)(ws + WS_RB)};
            pg8::gemm_phase<EpiDN, MoeDnOrder, false>(ring, mytid(F), pg8::Gemm{DE, DE}, S, E);
        } SEAM(6);
    }
    {
            if (IN(7)) { phase_combine<false>(args, F, X, (bf16_t*)(ws + WS_RA), (float*)(ws + WS_R2)); } SEAM(7);
            if (IN(8)) {
                DenseOrder S; S.init(ws + WS_RA, ws + WS_WQKV, NT, NQKV, D, D, F.G, (int)blockIdx.x);
                EpiQKV E{(const float*)(ws + WS_R2), (const f32x2*)(ws + WS_ROPE), ws + WS_RD, (bf16_t*)(ws + WS_RC), (float*)(ws + WS_GATES)};
                pg8::gemm_phase<EpiQKV, DenseOrder, false>(ring, mytid(F), pg8::Gemm{D, D}, S, E);
            } SEAM(8);
            if (IN(9)) {
                CmpOrder S{(const char*)(ws + WS_RD + RD_KC), (const char*)(ws + WS_RD + RD_VC), (const char*)(ws + WS_WC1), F.G, (int)blockIdx.x};
                EpiCmp1 E{(const float*)(ws + WS_BIASC), (bf16_t*)(ws + WS_RD + RD_HID)};
                pg8::gemm_phase<EpiCmp1, CmpOrder, false>(ring, mytid(F), pg8::Gemm{2048, 1024}, S, E);
                const Frame F9 = refresh(F); LAS float* scr = (LAS float*)(F.lds + F.wave * 16384);
                if (F.G > 64) { if ((int)blockIdx.x >= 64) convert_experts(args, F9, 1, ((int)blockIdx.x - 64) * NWAVES + F.wave, (F.G - 64) * NWAVES, scr); }
                else convert_experts(args, F9, 1, (int)blockIdx.x * NWAVES + F.wave, F.G * NWAVES, scr);
            } SEAM(9);
            if (IN(10)) { phase_cmp2(F); } SEAM(10);
            if (IN(11)) {
                nsa::Tensors T{(const bf16_t*)(ws + WS_RC), (const f32x2*)(ws + WS_ROPE), (const float*)(ws + WS_GATES),
                               (const bf16_t*)(ws + WS_RD + RD_KS), (const bf16_t*)(ws + WS_RD + RD_VTS), (const bf16_t*)(ws + WS_RD + RD_KW), (const bf16_t*)(ws + WS_RD + RD_VTW),
                               (const bf16_t*)(ws + WS_RD + RD_KCMP), (const bf16_t*)(ws + WS_RD + RD_VCMPT), (bf16_t*)(ws + WS_RB)};
                for (int u = F.vcu; u < 2048; u += F.G) { const int qt = 255 - (u >> 3), bg = u & 7; nsa::attn_unit(T, ring, mytid(F), bg >> 2, bg & 3, qt); }
            } SEAM(11);
            if (IN(12)) {
                DenseOrder S; S.init(ws + WS_RB, ws + WS_WAO, NT, D, D, D, F.G, (int)blockIdx.x);
                EpiResid E{X, X};
                pg8::gemm_phase<EpiResid, DenseOrder, false>(ring, mytid(F), pg8::Gemm{D, D}, S, E);
            } SEAM(12);
    }
    {
        if (IN(13)) { phase_router(args, F, 1, X, (bf16_t*)(ws + WS_RA), (float*)(ws + WS_R3)); } SEAM(13);
        if (IN(14)) {
            MoeTab T = moe_tables(F, 1);
            MoeGuOrder S{T, (const char*)(ws + WS_RA), (const int*)(ws + WS_ROWL), (const char*)(ws + WS_EXPW), F.G, F.vcu};
            EpiGU E{T, (const float*)(ws + WS_ROWR), (bf16_t*)(ws + WS_RD)};
            pg8::gemm_phase<EpiGU, MoeGuOrder, true>(ring, mytid(F), pg8::Gemm{D, D}, S, E);
        } SEAM(14);
        if (IN(15)) {
            MoeTab T = moe_tables(F, 1);
            MoeDnOrder S{T, (const char*)(ws + WS_RD), (const char*)(ws + WS_EXPW), F.G, F.vcu};
            EpiDN E{(const int*)(ws + WS_ROWL), (const float*)(ws + WS_WGT), (bf16_t*)(ws + WS_RB)};
            pg8::gemm_phase<EpiDN, MoeDnOrder, false>(ring, mytid(F), pg8::Gemm{DE, DE}, S, E);
        } SEAM(15);
    }
    if (IN(16)) { phase_combine<true>(args, F, X, nullptr, nullptr); }
#undef IN
#undef SEAM
}

extern "C" void kernel_launch(void* const* d_in, const int* in_sizes, int n_in, void* d_out, int out_size, void* d_ws, size_t ws_size, hipStream_t stream) {
    static int grid = 0;
    if (grid == 0) {
        if (n_in != 25 || out_size != NT * D || ws_size < WS_END) { fprintf(stderr, "kernel_launch: unexpected problem (n_in %d, out %d, ws %zu < %zu)\n", n_in, out_size, ws_size, (size_t)WS_END); grid = -1; return; }
        int dev = 0, cus = 0, per_cu = 0;
        hipGetDevice(&dev); hipDeviceGetAttribute(&cus, hipDeviceAttributeMultiprocessorCount, dev);
        hipFuncSetAttribute((const void*)nsa_fwd, hipFuncAttributeMaxDynamicSharedMemorySize, LDS_BYTES);
        hipOccupancyMaxActiveBlocksPerMultiprocessor(&per_cu, (const void*)nsa_fwd, NTHREADS, LDS_BYTES);
        if (per_cu < 1) { fprintf(stderr, "kernel_launch: occupancy query says %d blocks/CU\n", per_cu); per_cu = 1; }
        grid = cus;
        (void)hipGetLastError();
    }
    if (grid < 0) return;
    hipMemsetAsync((char*)d_ws + WS_CTL, 0, CTL_BYTES, stream);
    Args a{};
    for (int i = 0; i < 25; ++i) a.in[i] = (const float*)d_in[i];
    a.out = (float*)d_out; a.ws = (unsigned char*)d_ws;
    for (int i = 0; i < 32; ++i) a.inv_freq[i] = powf(10000.0f, -(float)i / 32.0f);
#if MK_PER_PHASE
    for (int p = 0; p < N_PHASES; ++p) { a.ph_lo = p; a.ph_hi = p + 1; void* kargs[] = {&a};
        hipError_t e = hipLaunchCooperativeKernel((const void*)nsa_fwd, dim3(grid), dim3(NTHREADS), kargs, LDS_BYTES, stream);
        if (e != hipSuccess) { fprintf(stderr, "launch %d failed: %s\n", p, hipGetErrorString(e)); break; } }
#else
    a.ph_lo = 0; a.ph_hi = N_PHASES; void* kargs[] = {&a};
    hipError_t e = hipLaunchCooperativeKernel((const void*)nsa_fwd, dim3(grid), dim3(NTHREADS), kargs, LDS_BYTES, stream);
    if (e != hipSuccess) fprintf(stderr, "cooperative launch failed: %s (grid %d)\n", hipGetErrorString(e), grid);
#endif
}
```

```cpp
#include <hip/hip_runtime.h>
#include <hip/hip_cooperative_groups.h>
#include <cstdio>
#include <cstdint>
#include <cmath>
namespace cg = cooperative_groups;

#define LAS __attribute__((address_space(3)))
typedef unsigned short bf16_t;
typedef short bf16x8 __attribute__((ext_vector_type(8)));
typedef short s16x4 __attribute__((ext_vector_type(4)));
typedef float f32x4 __attribute__((ext_vector_type(4)));
typedef float f32x2 __attribute__((ext_vector_type(2)));
typedef unsigned u32x4 __attribute__((ext_vector_type(4)));
typedef unsigned u32x2 __attribute__((ext_vector_type(2)));

constexpr int NB = 2, SEQ = 16384, NT = NB * SEQ, D = 1024, NG = 4, HD = 64, NH = 16;
constexpr int NE = 32, EPG = 8, DE = 512, ECAP = 65536;
constexpr int NQKV = 2816;
constexpr int NCMP = 1023, CMPH = 256;
constexpr float RMS_EPS = 1e-6f;
constexpr int NWAVES = 8, NTHREADS = 512;
#ifndef MK_PER_PHASE
#define MK_PER_PHASE 0
#endif

#ifndef PROBE_PHASE
#define PROBE_PHASE (-1)
#endif
#ifndef PROBE_T
#define PROBE_T 0
#endif
#ifndef PROBE_NOMERGE
#define PROBE_NOMERGE 0
#endif
#ifndef SEL_INVERTED
#define SEL_INVERTED 1
#endif
#ifndef ATT_SKIP
#define ATT_SKIP 0
#endif
#ifndef NSA_CHECK
#define NSA_CHECK 0
#endif
#ifndef NSA_CHECK_PROJ
#define NSA_CHECK_PROJ 1
#endif
#ifndef NSA_CHECK_BR
#define NSA_CHECK_BR (-1)
#endif
#ifndef NSA_CHECK_N
#define NSA_CHECK_N 1024
#endif
#ifndef NSA_CHECK_ABS
#define NSA_CHECK_ABS 0.012f
#endif
#ifndef NSA_CHECK_REL
#define NSA_CHECK_REL 0.01f
#endif

constexpr size_t MiB = 1u << 20, KiB = 1u << 10;
constexpr size_t WS_CTL = 0, CTL_BYTES = 64 * KiB;
constexpr size_t WS_R0 = 1 * MiB, WS_R1 = WS_R0 + 128 * KiB, WS_R2 = WS_R1 + 128 * KiB, WS_R3 = WS_R2 + 128 * KiB;
constexpr size_t WS_WGT = 2 * MiB;
constexpr size_t WS_RW = 2 * MiB + 512 * KiB;
constexpr size_t WS_BIASC = 3 * MiB;
constexpr size_t WS_W2T = 3 * MiB + 64 * KiB;
constexpr size_t WS_ROWL = 4 * MiB;
constexpr size_t WS_ROWR = 12 * MiB;
constexpr size_t WS_WIN = 20 * MiB, WS_WOUT = 26 * MiB, WS_WQKV = 28 * MiB, WS_WC1 = 34 * MiB, WS_WAO = 36 * MiB;
constexpr size_t WS_ROPE = 38 * MiB;
constexpr size_t WS_GATES = 46 * MiB;
constexpr size_t WS_EXPW = 52 * MiB;
constexpr size_t WS_RA = 148 * MiB;
constexpr size_t WS_RB = 212 * MiB;
constexpr size_t WS_RC = 276 * MiB;
constexpr size_t WS_RD = 340 * MiB;
constexpr size_t WS_ATTS = 452 * MiB;
constexpr size_t WS_END = 468 * MiB;
constexpr size_t KVSTRIDE = 17 * MiB;
constexpr size_t RD_KC = 0, RD_VC = 1 * KVSTRIDE, RD_KS = 2 * KVSTRIDE, RD_VTS = 3 * KVSTRIDE, RD_KW = 4 * KVSTRIDE, RD_VTW = 5 * KVSTRIDE;
constexpr size_t RD_HID = 102 * MiB, RD_KCMP = 110 * MiB, RD_VCMPT = 111 * MiB;
constexpr int ACT_ROWS = 2 * NT + NE * 256;
static_assert((size_t)ACT_ROWS * DE * 2 <= 72 * MiB, "ACT");
constexpr int CW_CNT = 1024, CW_BAR = 4096;

constexpr int LDS_BYTES = 151552;
constexpr int RING_BYTES = 131072;
constexpr int MISC_OFF = LDS_BYTES - 2048;

__device__ __forceinline__ unsigned f2bf(float f) { unsigned u = __builtin_bit_cast(unsigned, f); return (u + 0x7fffu + ((u >> 16) & 1u)) >> 16; }
__device__ __forceinline__ unsigned pk2(float lo, float hi) {
    typedef float v2f __attribute__((ext_vector_type(2))); typedef __bf16 v2b __attribute__((ext_vector_type(2)));
    v2f v = {lo, hi}; v2b b = __builtin_convertvector(v, v2b); return __builtin_bit_cast(unsigned, b); }
__device__ __forceinline__ float bf2f(unsigned short b) { return __builtin_bit_cast(float, ((unsigned)b) << 16); }
__device__ __forceinline__ float bflo(unsigned w) { return __builtin_bit_cast(float, w << 16); }
__device__ __forceinline__ float bfhi(unsigned w) { return __builtin_bit_cast(float, w & 0xffff0000u); }
__device__ __forceinline__ float wave_sum(float v) {
#pragma unroll
    for (int o = 1; o < 64; o <<= 1) v += __shfl_xor(v, o);
    return v;
}
#define LDS_WAIT() asm volatile("s_waitcnt lgkmcnt(0)" ::: "memory")
__device__ __forceinline__ float max_x16(float v) { auto r = __builtin_amdgcn_permlane16_swap(__float_as_uint(v), __float_as_uint(v), false, false); return fmaxf(__uint_as_float(r[0]), __uint_as_float(r[1])); }
__device__ __forceinline__ float max_x32(float v) { auto r = __builtin_amdgcn_permlane32_swap(__float_as_uint(v), __float_as_uint(v), false, false); return fmaxf(__uint_as_float(r[0]), __uint_as_float(r[1])); }
__device__ __forceinline__ float sum_x16(float v) { auto r = __builtin_amdgcn_permlane16_swap(__float_as_uint(v), __float_as_uint(v), false, false); return __uint_as_float(r[0]) + __uint_as_float(r[1]); }
__device__ __forceinline__ float sum_x32(float v) { auto r = __builtin_amdgcn_permlane32_swap(__float_as_uint(v), __float_as_uint(v), false, false); return __uint_as_float(r[0]) + __uint_as_float(r[1]); }
__device__ __forceinline__ float max3f(float a, float b, float c) { float r; asm("v_max3_f32 %0, %1, %2, %3" : "=v"(r) : "v"(a), "v"(b), "v"(c)); return r; }
__device__ __forceinline__ float dpp_x1(float v) { return __uint_as_float((unsigned)__builtin_amdgcn_mov_dpp((int)__float_as_uint(v), 0xB1, 0xF, 0xF, true)); }
__device__ __forceinline__ float dpp_x2(float v) { return __uint_as_float((unsigned)__builtin_amdgcn_mov_dpp((int)__float_as_uint(v), 0x4E, 0xF, 0xF, true)); }


__device__ __forceinline__ int slot_perm8(int c) {
    const int hi = c & ~31, fq = (c >> 3) & 3, n = (c >> 2) & 1, j = c & 3; return hi + 16 * n + 4 * fq + j; }
__device__ __forceinline__ int slot_pair128(int c, int n) {
    const int wc = c >> 5, fq = (c >> 3) & 3, bj = (c >> 2) & 1, j = c & 3; return 128 * bj + 32 * wc + 16 * n + 4 * fq + j; }
__device__ __forceinline__ int slot_rope64(int d) {
    const int n = d >> 5, dd = d & 31, wcl = dd >> 4, fq = (dd >> 2) & 3, j = dd & 3; return 32 * wcl + 16 * n + 4 * fq + j; }

namespace pg8 {
constexpr int BM = 256, BK = 64, HALF = 128, HTB = HALF * BK * 2, STAGE_BYTES = 8 * HTB, NXCD = 8, WGM = 8;
__host__ __device__ __forceinline__ int lds_byte(int r, int c) { const int st = (r >> 4) * 2 + (c >> 5), rr = r & 15, cc = c & 31, ob = rr * 64 + cc * 2; return st * 1024 + (ob ^ (((ob >> 9) & 1) << 5)); }
__host__ __device__ __forceinline__ void stage_rc(int b, int& R, int& C) { const int st = b / 1024, sb = b % 1024, swz = sb ^ (((sb >> 9) & 1) << 5); R = (st >> 1) * 16 + swz / 64; C = (st & 1) * 32 + (swz % 64) / 2; }

struct Unit { int pm, pn, e, nvalid; };
struct Gemm { int K, lda; };

template <class Epi, class Sched, bool GATHER, bool ALIGN_EPI = true, bool SP2 = true>
__device__ __forceinline__ void gemm_phase(LAS unsigned char* lds, int tid_in, const Gemm g, const Sched& S, const Epi& E) {
    int tid_ = tid_in; asm volatile("" : "+v"(tid_));
    const int tid = tid_, wid = __builtin_amdgcn_readfirstlane(tid >> 6), lane = tid & 63, wr = wid >> 2, wc = wid & 3, fr = lane & 15, fq = lane >> 4;
    const int K = g.K, nt = K / BK;
    int R0, C0; stage_rc(tid * 16, R0, C0);
    unsigned voffA[2], voffB[2];
#pragma unroll
    for (int i = 0; i < 2; ++i) { voffA[i] = (unsigned)((R0 + 64 * i) * g.lda + C0) * 2u; voffB[i] = (unsigned)((R0 + 64 * i) * K + C0) * 2u; }
    unsigned vgC[2][2], vgN[2][2];
    const size_t kstep = (size_t)(BK * 2);
    const size_t hstepA = (size_t)HALF * g.lda * 2, hstepB = (size_t)HALF * K * 2;
    const unsigned ldsw = (unsigned)wid * 1024u;
    const int aoff = lds_byte(wr * 64 + fr, fq * 8), boff = lds_byte(wc * 32 + fr, fq * 8);
#define PG8_SA(b, h) (((b) * 2 + (h)) * HTB)
#define PG8_SB(b, h) ((4 + (b) * 2 + (h)) * HTB)
#define PG8_GLDS(src, dstoff) __builtin_amdgcn_global_load_lds((const unsigned*)(src), (LAS unsigned*)(lds + (dstoff)), 16, 0, 0)
#define PG8_STAGE_B(bufoff, gbase) do { _Pragma("unroll") for (int _i = 0; _i < 2; ++_i) PG8_GLDS((const char*)(gbase) + voffB[_i], (bufoff) + ldsw + _i * 8192); } while (0)
#define PG8_STAGE_A(bufoff, gbase, h, VG) do { _Pragma("unroll") for (int _i = 0; _i < 2; ++_i) { \
        if constexpr (GATHER) PG8_GLDS((const char*)(gbase) + VG[h][_i], (bufoff) + ldsw + _i * 8192); \
        else PG8_GLDS((const char*)(gbase) + (h) * hstepA + voffA[_i], (bufoff) + ldsw + _i * 8192); } } while (0)
#define PG8_LDA(dst, b, h) do { _Pragma("unroll") for (int m = 0; m < 4; ++m) _Pragma("unroll") for (int k = 0; k < 2; ++k) dst[m][k] = *(const LAS bf16x8*)(lds + PG8_SA(b, h) + aoff + m * 2048 + k * 1024); } while (0)
#define PG8_LDB(dst, b, h) do { _Pragma("unroll") for (int n = 0; n < 2; ++n) _Pragma("unroll") for (int k = 0; k < 2; ++k) dst[n][k] = *(const LAS bf16x8*)(lds + PG8_SB(b, h) + boff + n * 2048 + k * 1024); } while (0)
#define PG8_MMA(ai, bj, At, Bt) do { __builtin_amdgcn_s_setprio(1); _Pragma("unroll") for (int m = 0; m < 4; ++m) _Pragma("unroll") for (int n = 0; n < 2; ++n) _Pragma("unroll") for (int k = 0; k < 2; ++k) \
        acc[ai][bj][m][n] = __builtin_amdgcn_mfma_f32_16x16x32_bf16(Bt[n][k], At[m][k], acc[ai][bj][m][n], 0, 0, 0); __builtin_amdgcn_s_setprio(0); } while (0)
#define PG8_WAIT_V(n) asm volatile("s_waitcnt vmcnt(" #n ")" ::: "memory")
#define PG8_WAIT_L(n) asm volatile("s_waitcnt lgkmcnt(" #n ")" ::: "memory")
#define PG8_BAR __builtin_amdgcn_s_barrier()
#define PG8_SCHED __builtin_amdgcn_sched_barrier(0)
    Unit cur, nxt; int ui = 0;
    if (!S.next(0, cur)) return;
    f32x4 acc[2][2][4][2];
#pragma unroll
    for (int a = 0; a < 2; ++a)
#pragma unroll
        for (int b = 0; b < 2; ++b)
#pragma unroll
            for (int m = 0; m < 4; ++m)
#pragma unroll
                for (int n = 0; n < 2; ++n) acc[a][b][m][n] = (f32x4){0.f, 0.f, 0.f, 0.f};
    bf16x8 At[4][2], B0[2][2], B1[2][2];
    const char* cA = S.a_base(cur); const char* cB = S.b_base(cur);
    if constexpr (GATHER) {
#pragma unroll
        for (int h = 0; h < 2; ++h)
#pragma unroll
            for (int i = 0; i < 2; ++i) vgC[h][i] = S.a_off(cur, h * HALF + R0 + 64 * i) + (unsigned)C0 * 2u;
    }
    if constexpr (SP2) {
        PG8_STAGE_B(PG8_SB(0, 0), cB); PG8_STAGE_B(PG8_SB(0, 1), cB + hstepB); PG8_STAGE_A(PG8_SA(0, 0), cA, 0, vgC); PG8_STAGE_A(PG8_SA(0, 1), cA, 1, vgC);
        if (wr == 1) PG8_BAR;
        PG8_WAIT_V(2); PG8_BAR;
        PG8_STAGE_B(PG8_SB(1, 0), cB + kstep); PG8_STAGE_A(PG8_SA(1, 0), cA + kstep, 0, vgC); PG8_STAGE_B(PG8_SB(1, 1), cB + hstepB + kstep);
        PG8_WAIT_V(6); PG8_BAR;
    } else {
        PG8_STAGE_B(PG8_SB(0, 0), cB); PG8_STAGE_A(PG8_SA(0, 0), cA, 0, vgC); PG8_STAGE_B(PG8_SB(0, 1), cB + hstepB); PG8_STAGE_A(PG8_SA(0, 1), cA, 1, vgC);
        if (wr == 1) PG8_BAR;
        PG8_WAIT_V(4); PG8_BAR;
        PG8_STAGE_B(PG8_SB(1, 0), cB + kstep); PG8_STAGE_A(PG8_SA(1, 0), cA + kstep, 0, vgC); PG8_STAGE_B(PG8_SB(1, 1), cB + hstepB + kstep);
        PG8_WAIT_V(6); PG8_BAR;
    }
    for (;;) {
        const bool has_next = S.next(ui + 1, nxt);
        const char* nA = has_next ? S.a_base(nxt) : cA; const char* nB = has_next ? S.b_base(nxt) : cB;
        if constexpr (GATHER) {
#pragma unroll
            for (int h = 0; h < 2; ++h)
#pragma unroll
                for (int i = 0; i < 2; ++i) vgN[h][i] = has_next ? (S.a_off(nxt, h * HALF + R0 + 64 * i) + (unsigned)C0 * 2u) : vgC[h][i];
        }
        for (int t = 0; t < nt; t += 2) {
            const bool last = (t == nt - 2);
            const char* a1 = cA + (size_t)(t + 1) * kstep;
            const char* a2 = last ? nA : cA + (size_t)(t + 2) * kstep; const char* b2 = last ? nB : cB + (size_t)(t + 2) * kstep;
            const char* a3 = a2 + kstep; const char* b3 = b2 + kstep;
            unsigned vg2[2][2];
            if constexpr (GATHER) {
#pragma unroll
                for (int h = 0; h < 2; ++h)
#pragma unroll
                    for (int i = 0; i < 2; ++i) vg2[h][i] = last ? vgN[h][i] : vgC[h][i];
            }
            if constexpr (SP2) {
            PG8_LDB(B0, 0, 0); PG8_LDB(B1, 0, 1); PG8_SCHED; PG8_LDA(At, 0, 0); PG8_STAGE_A(PG8_SA(1, 1), a1, 1, vgC);
            PG8_WAIT_V(8); PG8_WAIT_L(0); PG8_BAR; PG8_MMA(0, 0, At, B0); PG8_MMA(0, 1, At, B1); PG8_BAR; PG8_SCHED;
            PG8_LDA(At, 0, 1); PG8_STAGE_B(PG8_SB(0, 0), b2); PG8_STAGE_B(PG8_SB(0, 1), b2 + hstepB); PG8_STAGE_A(PG8_SA(0, 0), a2, 0, vg2);
            PG8_WAIT_V(8); PG8_WAIT_L(0); PG8_BAR; PG8_MMA(1, 0, At, B0); PG8_MMA(1, 1, At, B1); PG8_BAR; PG8_SCHED;
            PG8_LDB(B0, 1, 0); PG8_LDB(B1, 1, 1); PG8_SCHED; PG8_LDA(At, 1, 0); PG8_STAGE_A(PG8_SA(0, 1), a2, 1, vg2);
            PG8_WAIT_V(8); PG8_WAIT_L(0); PG8_BAR; PG8_MMA(0, 0, At, B0); PG8_MMA(0, 1, At, B1); PG8_BAR; PG8_SCHED;
            PG8_LDA(At, 1, 1); PG8_STAGE_B(PG8_SB(1, 0), b3); PG8_STAGE_B(PG8_SB(1, 1), b3 + hstepB); PG8_STAGE_A(PG8_SA(1, 0), a3, 0, vg2);
            PG8_WAIT_V(8); PG8_WAIT_L(0); PG8_BAR; PG8_MMA(1, 0, At, B0); PG8_MMA(1, 1, At, B1); PG8_BAR; PG8_SCHED;
            } else {
            PG8_LDB(B0, 0, 0); PG8_SCHED; PG8_LDA(At, 0, 0); PG8_STAGE_A(PG8_SA(1, 1), a1, 1, vgC);
            PG8_WAIT_L(8); PG8_BAR; PG8_WAIT_L(0); PG8_MMA(0, 0, At, B0); PG8_BAR; PG8_SCHED;
            PG8_LDB(B1, 0, 1); PG8_STAGE_B(PG8_SB(0, 0), b2);
            PG8_BAR; PG8_WAIT_L(0); PG8_MMA(0, 1, At, B1); PG8_BAR;
            PG8_LDA(At, 0, 1); PG8_STAGE_A(PG8_SA(0, 0), a2, 0, vg2);
            PG8_BAR; PG8_WAIT_L(0); PG8_MMA(1, 0, At, B0); PG8_BAR; PG8_SCHED;
            PG8_STAGE_B(PG8_SB(0, 1), b2 + hstepB);
            PG8_WAIT_V(6); PG8_BAR; PG8_MMA(1, 1, At, B1); PG8_BAR;
            PG8_LDB(B0, 1, 0); PG8_SCHED; PG8_LDA(At, 1, 0); PG8_STAGE_A(PG8_SA(0, 1), a2, 1, vg2);
            PG8_WAIT_L(8); PG8_BAR; PG8_WAIT_L(0); PG8_MMA(0, 0, At, B0); PG8_BAR; PG8_SCHED;
            PG8_LDB(B1, 1, 1); PG8_STAGE_B(PG8_SB(1, 0), b3);
            PG8_BAR; PG8_WAIT_L(0); PG8_MMA(0, 1, At, B1); PG8_BAR;
            PG8_LDA(At, 1, 1); PG8_STAGE_A(PG8_SA(1, 0), a3, 0, vg2);
            PG8_BAR; PG8_WAIT_L(0); PG8_MMA(1, 0, At, B0); PG8_BAR; PG8_SCHED;
            PG8_STAGE_B(PG8_SB(1, 1), b3 + hstepB);
            PG8_WAIT_V(6); PG8_BAR; PG8_MMA(1, 1, At, B1); PG8_BAR;
            }
        }
        if constexpr (ALIGN_EPI) { if (wr == 0) PG8_BAR; }
        E(acc, cur, wr, wc, fr, fq);
        if (!has_next) break;
#pragma unroll
        for (int a = 0; a < 2; ++a)
#pragma unroll
            for (int b = 0; b < 2; ++b)
#pragma unroll
                for (int m = 0; m < 4; ++m)
#pragma unroll
                    for (int n = 0; n < 2; ++n) acc[a][b][m][n] = (f32x4){0.f, 0.f, 0.f, 0.f};
        cur = nxt; cA = nA; cB = nB; ++ui;
        if constexpr (GATHER) {
#pragma unroll
            for (int h = 0; h < 2; ++h)
#pragma unroll
                for (int i = 0; i < 2; ++i) vgC[h][i] = vgN[h][i];
        }
        if constexpr (ALIGN_EPI) { if (wr == 1) PG8_BAR; }
    }
    PG8_WAIT_V(0);
    if constexpr (!ALIGN_EPI) { if (wr == 0) PG8_BAR; }
    PG8_BAR;
#undef PG8_SA
#undef PG8_SB
#undef PG8_GLDS
#undef PG8_STAGE_A
#undef PG8_STAGE_B
#undef PG8_LDA
#undef PG8_LDB
#undef PG8_MMA
#undef PG8_WAIT_V
#undef PG8_WAIT_L
#undef PG8_BAR
#undef PG8_SCHED
}
}

struct Args {
    const float* in[25]; float* out; unsigned char* ws;
    float inv_freq[32];
    int ph_lo, ph_hi;
};
enum { I_X = 0, I_POS, I_NMIX, I_NFFN, I_CWIN, I_CW, I_CWOUT, I_NKV, I_WKV, I_CPK, I_CW1K, I_CW2K, I_CPV, I_CW1V, I_CW2V, I_AWIN, I_AWOUT,
       I_RGW, I_RGB, I_REW, I_REB, I_EWG, I_EWU, I_EWD, I_NFIN };

struct Frame {
    LAS unsigned char* lds;
    unsigned char* ws;
    int tid, lane, wave, vcu, G;
};

__device__ __forceinline__ int mytid(const Frame& F) { return F.wave * 64 + (int)__builtin_amdgcn_mbcnt_hi(~0u, __builtin_amdgcn_mbcnt_lo(~0u, 0u)); }
__device__ __forceinline__ Frame refresh(const Frame& F0) {
    Frame F = F0; int t = mytid(F0); asm volatile("" : "+v"(t)); F.tid = t; F.lane = t & 63; return F; }

struct DenseOrder {
    const char* A; const char* Bt; size_t tstepA, tstepB; int nM, nN, nwg, G, c;
    __device__ __forceinline__ void init(const void* A_, const void* Bt_, int M, int N, int K, int lda, int G_, int c_) {
        A = (const char*)A_; Bt = (const char*)Bt_; nM = M / 256; nN = N / 256; nwg = nM * nN; G = G_; c = c_; tstepA = (size_t)256 * lda * 2; tstepB = (size_t)256 * K * 2; }
    __device__ __forceinline__ bool next(int i, pg8::Unit& u) const {
        const long L = (long)i * G + c; if (L >= nwg) return false;
        int wgid = (int)L; { const int q = nwg / 8, r = nwg % 8, xcd = wgid % 8, off = wgid / 8; wgid = (xcd < r ? xcd * (q + 1) : r * (q + 1) + (xcd - r) * q) + off; }
        const int nig = 8 * nN, gid = wgid / nig, fm = gid * 8, gsz = (nM - fm) < 8 ? (nM - fm) : 8;
        u.pm = fm + ((wgid % nig) % gsz); u.pn = (wgid % nig) / gsz; u.e = 0; u.nvalid = 256; return true; }
    __device__ __forceinline__ const char* a_base(const pg8::Unit& u) const { return A + (size_t)u.pm * tstepA; }
    __device__ __forceinline__ const char* b_base(const pg8::Unit& u) const { return Bt + (size_t)u.pn * tstepB; }
    __device__ __forceinline__ unsigned a_off(const pg8::Unit&, int) const { return 0u; }
};
struct CmpOrder {
    const char* A0; const char* A1; const char* Bt; int G, c;
    __device__ __forceinline__ bool next(int i, pg8::Unit& u) const { const int L = i * G + c; if (L >= 64) return false; u.e = L >> 5; u.pm = L & 31; u.pn = 0; u.nvalid = 256; return true; }
    __device__ __forceinline__ const char* a_base(const pg8::Unit& u) const { return (u.e ? A1 : A0) + (size_t)u.pm * 256 * 1024 * 2; }
    __device__ __forceinline__ const char* b_base(const pg8::Unit& u) const { return Bt + (size_t)u.e * 256 * 2048 * 2; }
    __device__ __forceinline__ unsigned a_off(const pg8::Unit&, int) const { return 0u; }
};
struct MoeTab { volatile LAS int* tstart; volatile LAS int* cnt; };
__device__ __forceinline__ bool moe_unit(const MoeTab& T, int L, pg8::Unit& u) {
    const int total = T.tstart[32]; if (L >= 4 * total) return false;
    u.pn = L & 3; const int mt = L >> 2; int e = 0;
#pragma unroll 1
    for (int k = 1; k < 32; ++k) e += (T.tstart[k] <= mt) ? 1 : 0;
    u.e = e; u.pm = mt - T.tstart[e]; u.nvalid = T.cnt[e] - u.pm * 256; return true;
}
struct MoeGuOrder {
    MoeTab T; const char* X; const int* rowl; const char* W; int G, c;
    __device__ __forceinline__ bool next(int i, pg8::Unit& u) const { return moe_unit(T, i * G + c, u); }
    __device__ __forceinline__ const char* a_base(const pg8::Unit&) const { return X; }
    __device__ __forceinline__ const char* b_base(const pg8::Unit& u) const { return W + (size_t)u.e * 3 * MiB + (size_t)u.pn * 256 * 1024 * 2; }
    __device__ __forceinline__ unsigned a_off(const pg8::Unit& u, int R) const {
        int idx = u.pm * 256 + R; const int lim = u.pm * 256 + u.nvalid - 1; idx = idx < lim ? idx : lim;
        const int id = rowl[(size_t)u.e * ECAP + idx]; return (unsigned)(id >> 1) * 2048u; }
};
struct MoeDnOrder {
    MoeTab T; const char* ACT; const char* W; int G, c;
    __device__ __forceinline__ bool next(int i, pg8::Unit& u) const { return moe_unit(T, i * G + c, u); }
    __device__ __forceinline__ const char* a_base(const pg8::Unit& u) const { return ACT + (size_t)(T.tstart[u.e] + u.pm) * 256 * 512 * 2; }
    __device__ __forceinline__ const char* b_base(const pg8::Unit& u) const { return W + (size_t)u.e * 3 * MiB + 2 * MiB + (size_t)u.pn * 256 * 512 * 2; }
    __device__ __forceinline__ unsigned a_off(const pg8::Unit&, int) const { return 0u; }
};

#define EPI_ARGS const f32x4 (&acc)[2][2][4][2], const pg8::Unit& u, int wr, int wc, int fr, int fq
__device__ __forceinline__ u32x4 pack8(const f32x4& a, const f32x4& b) { u32x4 w; w.x = pk2(a[0], a[1]); w.y = pk2(a[2], a[3]); w.z = pk2(b[0], b[1]); w.w = pk2(b[2], b[3]); return w; }
__device__ __forceinline__ u32x2 pack4(const f32x4& a) { u32x2 w; w.x = pk2(a[0], a[1]); w.y = pk2(a[2], a[3]); return w; }

struct EpiInProj {
    const float* r0; bf16_t* BG; bf16_t* U;
    __device__ __forceinline__ void operator()(EPI_ARGS) const {
        float rsv[2][4];
#pragma unroll
        for (int ai = 0; ai < 2; ++ai)
#pragma unroll
            for (int m = 0; m < 4; ++m) rsv[ai][m] = r0[u.pm * 256 + ai * 128 + wr * 64 + m * 16 + fr];
#pragma unroll
        for (int ai = 0; ai < 2; ++ai)
#pragma unroll
            for (int m = 0; m < 4; ++m) {
                const int row = u.pm * 256 + ai * 128 + wr * 64 + m * 16 + fr; const float rs = rsv[ai][m];
                if (u.pn < 4) {
#pragma unroll
                    for (int bj = 0; bj < 2; ++bj) *(u32x4*)(BG + (size_t)row * D + u.pn * 256 + bj * 128 + wc * 32 + 8 * fq) = pack8(acc[ai][bj][m][0] * rs, acc[ai][bj][m][1] * rs);
                } else {
                    const float rs2 = rs * rs;
                    *(u32x4*)(U + (size_t)row * D + (u.pn - 4) * 128 + wc * 32 + 8 * fq) = pack8(acc[ai][0][m][0] * acc[ai][0][m][1] * rs2, acc[ai][1][m][0] * acc[ai][1][m][1] * rs2);
                }
            }
    }
};
struct EpiResid {
    const float* base; float* out;
    __device__ __forceinline__ void operator()(EPI_ARGS) const {
#pragma unroll
        for (int ai = 0; ai < 2; ++ai)
#pragma unroll
            for (int mp = 0; mp < 2; ++mp) {
                f32x4 bv[2][2][2];
#pragma unroll
                for (int mm = 0; mm < 2; ++mm) { const size_t off = (size_t)(u.pm * 256 + ai * 128 + wr * 64 + (2 * mp + mm) * 16 + fr) * D + u.pn * 256 + wc * 32 + 4 * fq;
#pragma unroll
                    for (int bj = 0; bj < 2; ++bj)
#pragma unroll
                        for (int n = 0; n < 2; ++n) bv[mm][bj][n] = *(const f32x4*)(base + off + bj * 128 + n * 16); }
#pragma unroll
                for (int mm = 0; mm < 2; ++mm) { const size_t off = (size_t)(u.pm * 256 + ai * 128 + wr * 64 + (2 * mp + mm) * 16 + fr) * D + u.pn * 256 + wc * 32 + 4 * fq;
#pragma unroll
                    for (int bj = 0; bj < 2; ++bj)
#pragma unroll
                        for (int n = 0; n < 2; ++n) *(f32x4*)(out + off + bj * 128 + n * 16) = bv[mm][bj][n] + acc[ai][bj][2 * mp + mm][n]; }
            }
    }
};
struct EpiQKV {
    const float* r2; const f32x2* rope; unsigned char* kv; bf16_t* Q; float* gates;
    __device__ __forceinline__ void operator()(EPI_ARGS) const {
        const int pn = u.pn;
        float rsv[2][4];
#pragma unroll
        for (int ai = 0; ai < 2; ++ai)
#pragma unroll
            for (int m = 0; m < 4; ++m) rsv[ai][m] = r2[u.pm * 256 + ai * 128 + wr * 64 + m * 16 + fr];
#pragma unroll
        for (int ai = 0; ai < 2; ++ai)
#pragma unroll
            for (int m = 0; m < 4; ++m) {
                const int row = u.pm * 256 + ai * 128 + wr * 64 + m * 16 + fr; const float rs = rsv[ai][m];
                const int b = row >> 14, s = row & (SEQ - 1);
                f32x4 ropev[2][2];
                if (pn == 2 || pn == 4) {
#pragma unroll
                    for (int bj = 0; bj < 2; ++bj) { const int d0 = 16 * (wc & 1) + 4 * fq; ropev[bj][0] = *(const f32x4*)(rope + (size_t)row * 32 + d0); ropev[bj][1] = *(const f32x4*)(rope + (size_t)row * 32 + d0 + 2); }
                }
                if (pn < 6) {
#pragma unroll
                    for (int bj = 0; bj < 2; ++bj) {
                        const int gg = 2 * bj + (wc >> 1), d0 = 16 * (wc & 1) + 4 * fq;
                        f32x4 v0 = acc[ai][bj][m][0] * rs, v1 = acc[ai][bj][m][1] * rs;
                        if (pn == 2 || pn == 4) {
                            const f32x4 cs0 = ropev[bj][0], cs1 = ropev[bj][1];
                            const f32x4 c = {cs0[0], cs0[2], cs1[0], cs1[2]}, sn = {cs0[1], cs0[3], cs1[1], cs1[3]};
                            const f32x4 o0 = v0 * c - v1 * sn, o1 = v1 * c + v0 * sn; v0 = o0; v1 = o1;
                        }
                        if (pn == 3 || pn == 5) {
                            bf16_t* vt = (bf16_t*)(kv + (size_t)pn * KVSTRIDE) + ((size_t)(b * 4 + gg) * 64 + d0) * SEQ + s;
#pragma unroll
                            for (int j = 0; j < 4; ++j) { vt[(size_t)j * SEQ] = (bf16_t)f2bf(v0[j]); vt[(size_t)(j + 32) * SEQ] = (bf16_t)f2bf(v1[j]); }
                        } else {
                            bf16_t* kp = (bf16_t*)(kv + (size_t)pn * KVSTRIDE) + ((size_t)(b * 4 + gg) * SEQ + s) * 64 + d0;
                            *(u32x2*)kp = pack4(v0); *(u32x2*)(kp + 32) = pack4(v1);
                        }
                    }
                } else if (pn < 10) {
#pragma unroll
                    for (int bj = 0; bj < 2; ++bj) {
                        const int head = 4 * (pn - 6) + 2 * bj + (wc >> 1), d0 = 16 * (wc & 1) + 4 * fq; const float sc = rs * (0.125f * 1.4426950408889634f);
                        bf16_t* qp = Q + (size_t)row * D + head * 64 + d0;
                        *(u32x2*)qp = pack4(acc[ai][bj][m][0] * sc); *(u32x2*)(qp + 32) = pack4(acc[ai][bj][m][1] * sc);
                    }
                } else {
#pragma unroll
                    for (int n = 0; n < 2; ++n) { const int sl = 32 * wc + 16 * n + 4 * fq;
                        if (sl < 48) { f32x4 v = acc[ai][0][m][n] * rs;
#pragma unroll
                            for (int j = 0; j < 4; ++j) v[j] = 1.0f / (1.0f + __expf(-v[j]));
                            *(f32x4*)(gates + (size_t)row * 48 + sl) = v; } }
                }
            }
    }
};
__device__ __forceinline__ float gelu_tanh(float x) { const float y = 0.7978845608028654f * (x + 0.044715f * x * x * x); const float t = 1.0f - 2.0f / (1.0f + __expf(2.0f * y)); return 0.5f * x * (1.0f + t); }
struct EpiCmp1 {
    const float* bias; bf16_t* HID;
    __device__ __forceinline__ void operator()(EPI_ARGS) const {
        f32x4 bv[2][2];
#pragma unroll
        for (int bj = 0; bj < 2; ++bj)
#pragma unroll
            for (int n = 0; n < 2; ++n) bv[bj][n] = *(const f32x4*)(bias + u.e * 256 + bj * 128 + wc * 32 + 8 * fq + 4 * n);
#pragma unroll
        for (int ai = 0; ai < 2; ++ai)
#pragma unroll
            for (int m = 0; m < 4; ++m) {
                const int row = u.pm * 256 + ai * 128 + wr * 64 + m * 16 + fr;
#pragma unroll
                for (int bj = 0; bj < 2; ++bj) { f32x4 v0 = acc[ai][bj][m][0] + bv[bj][0], v1 = acc[ai][bj][m][1] + bv[bj][1];
#pragma unroll
                    for (int j = 0; j < 4; ++j) { v0[j] = gelu_tanh(v0[j]); v1[j] = gelu_tanh(v1[j]); }
                    *(u32x4*)(HID + ((size_t)u.e * 8192 + row) * 256 + bj * 128 + wc * 32 + 8 * fq) = pack8(v0, v1); }
            }
    }
};
struct EpiGU {
    MoeTab T; const float* rowr; bf16_t* ACT;
    __device__ __forceinline__ void operator()(EPI_ARGS) const {
        const size_t arow0 = (size_t)(T.tstart[u.e] + u.pm) * 256;
        float rsv[2][4];
#pragma unroll
        for (int ai = 0; ai < 2; ++ai)
#pragma unroll
            for (int m = 0; m < 4; ++m) rsv[ai][m] = rowr[(size_t)u.e * ECAP + u.pm * 256 + ai * 128 + wr * 64 + m * 16 + fr];
#pragma unroll
        for (int ai = 0; ai < 2; ++ai)
#pragma unroll
            for (int m = 0; m < 4; ++m) {
                const int rl = ai * 128 + wr * 64 + m * 16 + fr; const float rs = rsv[ai][m];
                f32x4 a[2];
#pragma unroll
                for (int bj = 0; bj < 2; ++bj) { const f32x4 g = acc[ai][bj][m][0] * rs, up = acc[ai][bj][m][1] * rs;
#pragma unroll
                    for (int j = 0; j < 4; ++j) a[bj][j] = g[j] / (1.0f + __expf(-g[j])) * up[j]; }
                *(u32x4*)(ACT + (arow0 + rl) * DE + u.pn * 128 + wc * 32 + 8 * fq) = pack8(a[0], a[1]);
            }
    }
};
struct EpiDN {
    const int* rowl; const float* wgt; bf16_t* Y;
    __device__ __forceinline__ void operator()(EPI_ARGS) const {
        int idv[2][4]; float wv[2][4];
#pragma unroll
        for (int ai = 0; ai < 2; ++ai)
#pragma unroll
            for (int m = 0; m < 4; ++m) { const int rl = ai * 128 + wr * 64 + m * 16 + fr; const int lim = u.nvalid - 1; idv[ai][m] = rowl[(size_t)u.e * ECAP + u.pm * 256 + (rl < lim ? rl : lim)]; }
#pragma unroll
        for (int ai = 0; ai < 2; ++ai)
#pragma unroll
            for (int m = 0; m < 4; ++m) wv[ai][m] = wgt[idv[ai][m]];
#pragma unroll
        for (int ai = 0; ai < 2; ++ai)
#pragma unroll
            for (int m = 0; m < 4; ++m) {
                const int rl = ai * 128 + wr * 64 + m * 16 + fr;
                if (rl < u.nvalid) {
                    const int id = idv[ai][m]; const float w = wv[ai][m];
#pragma unroll
                    for (int bj = 0; bj < 2; ++bj) *(u32x4*)(Y + (size_t)id * D + u.pn * 256 + bj * 128 + wc * 32 + 8 * fq) = pack8(acc[ai][bj][m][0] * w, acc[ai][bj][m][1] * w);
                }
            }
    }
};

template <class RowMap>
__device__ __forceinline__ void transpose_item(const float* W, int K, int N, bf16_t* WT, const float* gain, LAS float*  , int item, int lane, const RowMap& rm) {
    const int nblk = (N + 31) / 32, kb = item / nblk, nb = item % nblk, k0 = 64 * kb + 8 * (lane & 7), nc = 32 * nb + 4 * (lane >> 3);
    if (nc >= N) return;
    f32x4 v[8];
#pragma unroll
    for (int i = 0; i < 8; ++i) v[i] = *(const f32x4*)(W + (size_t)(k0 + i) * N + nc);
    if (gain) { const f32x4 g0 = *(const f32x4*)(gain + k0), g1 = *(const f32x4*)(gain + k0 + 4);
#pragma unroll
        for (int i = 0; i < 4; ++i) { v[i] = v[i] * g0[i]; v[4 + i] = v[4 + i] * g1[i]; } }
#pragma unroll
    for (int j = 0; j < 4; ++j) { u32x4 o; o.x = pk2(v[0][j], v[1][j]); o.y = pk2(v[2][j], v[3][j]); o.z = pk2(v[4][j], v[5][j]); o.w = pk2(v[6][j], v[7][j]);
        *(u32x4*)(WT + (size_t)rm(nc + j) * K + k0) = o; }
}
struct MapIdent { __device__ __forceinline__ int operator()(int c) const { return c; } };
struct MapPerm8 { __device__ __forceinline__ int operator()(int c) const { return slot_perm8(c); } };
struct MapWin { __device__ __forceinline__ int operator()(int c) const {
    if (c < 1024) return slot_perm8(c);
    const int n = (c >= 2048) ? 1 : 0, ch = c - 1024 - 1024 * n; return 1024 + (ch >> 7) * 256 + slot_pair128(ch & 127, n); } };
struct MapKV { __device__ __forceinline__ int operator()(int c) const { return (c & ~63) + slot_rope64(c & 63); } };
struct MapAIn { __device__ __forceinline__ int operator()(int c) const { return c < 1024 ? 1536 + (c & ~63) + slot_rope64(c & 63) : 2560 + (c - 1024); } };
struct MapGU { int n; __device__ __forceinline__ int operator()(int c) const { return (c >> 7) * 256 + slot_pair128(c & 127, n); } };

struct ConvItem {
    f32x4 v[8], g0, g1; bf16_t* dst; int K, kind, nc; bool hasg;
    __device__ __forceinline__ void load(const Args& a, unsigned char* ws, int layer, int it, int lane) {
        const int e = it / 768, r = it % 768; kind = r < 256 ? 0 : (r < 512 ? 1 : 2); const int item = r & 255;
        const size_t eo = ((size_t)layer * NE + e) * (size_t)D * DE;
        const float* W = (kind == 0 ? a.in[I_EWG] : kind == 1 ? a.in[I_EWU] : a.in[I_EWD]) + eo;
        const int N = kind == 2 ? D : DE; K = kind == 2 ? DE : D; hasg = kind != 2;
        const int nblk = N / 32, kb = item / nblk, nb = item % nblk, k0 = 64 * kb + 8 * (lane & 7); nc = 32 * nb + 4 * (lane >> 3);
        dst = (bf16_t*)(ws + WS_EXPW + (size_t)e * 3 * MiB) + (kind == 2 ? (size_t)1024 * 1024 : 0) + k0;
#pragma unroll
        for (int i = 0; i < 8; ++i) v[i] = *(const f32x4*)(W + (size_t)(k0 + i) * N + nc);
        const float* gp = a.in[I_NFFN] + layer * D + (hasg ? k0 : 0); g0 = *(const f32x4*)gp; g1 = *(const f32x4*)(gp + 4);
    }
    __device__ __forceinline__ void store() {
        if (hasg) {
#pragma unroll
            for (int i = 0; i < 4; ++i) { v[i] = v[i] * g0[i]; v[4 + i] = v[4 + i] * g1[i]; } }
#pragma unroll
        for (int j = 0; j < 4; ++j) { u32x4 o; o.x = pk2(v[0][j], v[1][j]); o.y = pk2(v[2][j], v[3][j]); o.z = pk2(v[4][j], v[5][j]); o.w = pk2(v[6][j], v[7][j]);
            const int c = nc + j; const int slot = kind == 2 ? slot_perm8(c) : (c >> 7) * 256 + slot_pair128(c & 127, kind);
            *(u32x4*)(dst + (size_t)slot * K) = o; }
    }
};
__device__ __forceinline__ void convert_experts(const Args& a, const Frame& F, int layer, int gw, int NGW, LAS float*  ) {
    constexpr int NIT = NE * 768;
    if (gw >= NIT) return;
    ConvItem cur, nxt; cur.load(a, F.ws, layer, gw, F.lane);
#pragma unroll 1
    for (int it = gw; it < NIT; it += NGW) {
        const int itn = it + NGW < NIT ? it + NGW : it;
        nxt.load(a, F.ws, layer, itn, F.lane);
        cur.store();
        cur = nxt;
    }
}

__device__ __forceinline__ void phase_prep(const Args& a, const Frame& F0) {
    const Frame F = refresh(F0);
    LAS float* scr = (LAS float*)(F.lds + F.wave * 16384);
    const int gw = F.vcu * NWAVES + F.wave, NGW = F.G * NWAVES;
    const int gt = gw * 64 + F.lane, NGT = NGW * 64;
    unsigned char* ws = F.ws;
    { const float* x = a.in[I_X]; bf16_t* XB = (bf16_t*)(ws + WS_RA); float* R0 = (float*)(ws + WS_R0);
      for (int m = gw; m < NT; m += NGW) { const f32x4* xr = (const f32x4*)(x + (size_t)m * D) + F.lane; f32x4 v[4]; float s = 0.f;
#pragma unroll
          for (int j = 0; j < 4; ++j) { v[j] = xr[64 * j]; s += (v[j][0] * v[j][0] + v[j][1] * v[j][1]) + (v[j][2] * v[j][2] + v[j][3] * v[j][3]); }
          s = wave_sum(s); if (F.lane == 0) R0[m] = 1.0f / sqrtf(s * (1.0f / D) + RMS_EPS);
          u32x2* o8 = (u32x2*)(XB + (size_t)m * D) + F.lane;
#pragma unroll
          for (int j = 0; j < 4; ++j) o8[64 * j] = pack4(v[j]); } }
    { const int* pos = (const int*)a.in[I_POS]; f32x2* rope = (f32x2*)(ws + WS_ROPE);
      for (int i = gt; i < NT * 32; i += NGT) { const float ang = (float)pos[i >> 5] * a.inv_freq[i & 31];
          double rev = (double)ang * 0.15915494309189533577; rev -= __builtin_rint(rev); const float rf = (float)rev;
          rope[i] = (f32x2){__builtin_amdgcn_cosf(rf), __builtin_amdgcn_sinf(rf)}; } }
    { constexpr int I_IN = 16 * 96, I_OUT = 16 * 32, I_KV = 16 * 48, I_AIN = 16 * 34, I_C1 = 32 * 8, I_AO = 16 * 32;
      constexpr int NI = I_IN + I_OUT + I_KV + I_AIN + 2 * I_C1 + I_AO;
      for (int it = gw; it < NI; it += NGW) { int r = it;
          if (r < I_IN) { transpose_item(a.in[I_CWIN], D, 3 * D, (bf16_t*)(ws + WS_WIN), a.in[I_NMIX], scr, r, F.lane, MapWin{}); continue; } r -= I_IN;
          if (r < I_OUT) { transpose_item(a.in[I_CWOUT], D, D, (bf16_t*)(ws + WS_WOUT), nullptr, scr, r, F.lane, MapIdent{}); continue; } r -= I_OUT;
          if (r < I_KV) { transpose_item(a.in[I_WKV], D, 1536, (bf16_t*)(ws + WS_WQKV), a.in[I_NKV], scr, r, F.lane, MapKV{}); continue; } r -= I_KV;
          if (r < I_AIN) { transpose_item(a.in[I_AWIN], D, 1072, (bf16_t*)(ws + WS_WQKV), a.in[I_NMIX] + D, scr, r, F.lane, MapAIn{}); continue; } r -= I_AIN;
          if (r < I_C1) { transpose_item(a.in[I_CW1K], 2048, 256, (bf16_t*)(ws + WS_WC1), nullptr, scr, r, F.lane, MapPerm8{}); continue; } r -= I_C1;
          if (r < I_C1) { transpose_item(a.in[I_CW1V], 2048, 256, (bf16_t*)(ws + WS_WC1) + 256 * 2048, nullptr, scr, r, F.lane, MapPerm8{}); continue; } r -= I_C1;
          transpose_item(a.in[I_AWOUT], D, D, (bf16_t*)(ws + WS_WAO), nullptr, scr, r, F.lane, MapIdent{});
      } }
    convert_experts(a, F, 0, gw, NGW, scr);
    { unsigned* z = (unsigned*)((bf16_t*)(ws + WS_WQKV) + (size_t)2608 * D); for (int i = gt; i < 208 * D / 2; i += NGT) z[i] = 0u; }
    { float* bc = (float*)(ws + WS_BIASC);
      for (int o = gw; o < 512; o += NGW) { const int kv = o >> 8, n = o & 255; const float* pos = a.in[kv ? I_CPV : I_CPK]; const float* w1 = a.in[kv ? I_CW1V : I_CW1K]; float s = 0.f;
          for (int i = F.lane; i < 2048; i += 64) s += pos[i] * w1[(size_t)i * 256 + n];
          s = wave_sum(s); if (F.lane == 0) bc[o] = s; } }
    { float* rw = (float*)(ws + WS_RW);
      for (int i = gt; i < 2 * 36 * 1024; i += NGT) { const int l = i / (36 * 1024), r = i % (36 * 1024), o = r >> 10, k = r & 1023;
          const float g = a.in[I_NFFN][l * D + k]; rw[i] = g * (o < 32 ? a.in[I_REW][((size_t)l * D + k) * 32 + o] : a.in[I_RGW][((size_t)l * D + k) * 4 + (o - 32)]); } }
    { bf16_t* w2t = (bf16_t*)(ws + WS_W2T);
      for (int i = gt; i < 2 * 64 * 256; i += NGT) { const int kv = i >> 14, r = i & 16383, n = r >> 8, k = r & 255; w2t[i] = (bf16_t)f2bf(a.in[kv ? I_CW2V : I_CW2K][k * 64 + n]); } }
}

__device__ __forceinline__ void phase_conv(const Args& a, const Frame& F0) {
    const Frame F = refresh(F0);
    const bf16_t* BG = (const bf16_t*)(F.ws + WS_RB); const bf16_t* U = (const bf16_t*)(F.ws + WS_RC); bf16_t* Z = (bf16_t*)(F.ws + WS_RA);
    const float* cw = a.in[I_CW];
    const int cg8 = (F.tid & 127) * 8, tq = F.tid >> 7;
    float w0[8], w1[8], w2[8];
#pragma unroll
    for (int j = 0; j < 8; ++j) { w0[j] = cw[cg8 + j]; w1[j] = cw[D + cg8 + j]; w2[j] = cw[2 * D + cg8 + j]; }
    for (int ch = F.vcu; ch < NT / 32; ch += F.G) {
        const int t0 = ch * 32 + tq * 8; const int s0 = t0 & (SEQ - 1);
        float um2[8], um1[8];
        { u32x4 p = {0u, 0u, 0u, 0u}, q = {0u, 0u, 0u, 0u};
          if (s0 >= 2) p = *(const u32x4*)(U + (size_t)(t0 - 2) * D + cg8);
          if (s0 >= 1) q = *(const u32x4*)(U + (size_t)(t0 - 1) * D + cg8);
#pragma unroll
          for (int j = 0; j < 4; ++j) { um2[2 * j] = bflo(p[j]); um2[2 * j + 1] = bfhi(p[j]); um1[2 * j] = bflo(q[j]); um1[2 * j + 1] = bfhi(q[j]); } }
#pragma unroll
        for (int i = 0; i < 8; ++i) {
            const u32x4 uu = *(const u32x4*)(U + (size_t)(t0 + i) * D + cg8), bb = *(const u32x4*)(BG + (size_t)(t0 + i) * D + cg8);
            float z[8];
#pragma unroll
            for (int j = 0; j < 4; ++j) { const float u0 = bflo(uu[j]), u1 = bfhi(uu[j]);
                z[2 * j] = bflo(bb[j]) * (w0[2 * j] * um2[2 * j] + w1[2 * j] * um1[2 * j] + w2[2 * j] * u0);
                z[2 * j + 1] = bfhi(bb[j]) * (w0[2 * j + 1] * um2[2 * j + 1] + w1[2 * j + 1] * um1[2 * j + 1] + w2[2 * j + 1] * u1);
                um2[2 * j] = um1[2 * j]; um2[2 * j + 1] = um1[2 * j + 1]; um1[2 * j] = u0; um1[2 * j + 1] = u1; }
            u32x4 o; o.x = pk2(z[0], z[1]); o.y = pk2(z[2], z[3]); o.z = pk2(z[4], z[5]); o.w = pk2(z[6], z[7]);
            *(u32x4*)(Z + (size_t)(t0 + i) * D + cg8) = o;
        }
    }
}

__device__ __forceinline__ void phase_router(const Args& a, const Frame& F0, int layer, const float* X, bf16_t* XnB, float* Rout) {
    const Frame F = refresh(F0);
    unsigned char* ws = F.ws;
    const float* rw = (const float*)(ws + WS_RW) + (size_t)layer * 36 * 1024;
    const float* brg = a.in[I_RGB] + layer * 4; const float* bre = a.in[I_REB] + layer * 32;
    unsigned* gcnt = (unsigned*)(ws + WS_CTL) + CW_CNT + layer * 32;
    int* rowl = (int*)(ws + WS_ROWL); float* rowr = (float*)(ws + WS_ROWR); float* wgt = (float*)(ws + WS_WGT);
    constexpr int XT_LD = 260;
    LAS float* xt = (LAS float*)(F.lds) + F.wave * (16 * XT_LD);
    LAS float* lg = xt;
    LAS unsigned* cntl = (LAS unsigned*)(F.lds + 8 * 16 * XT_LD * 4); LAS unsigned* basel = cntl + 32;
    const int l15 = F.lane & 15, quad = F.lane >> 4;
    for (int base = F.vcu * 128; base < NT; base += F.G * 128) {
        if (F.tid < 32) cntl[F.tid] = 0u;
        const int tok0 = base + F.wave * 16, tok = tok0 + l15;
        const float* w0 = rw + (size_t)l15 * 1024 + 4 * quad; const float* w1 = w0 + 16 * 1024; const float* w2 = rw + (size_t)(32 + (l15 & 3)) * 1024 + 4 * quad;
        f32x4 acc0 = {0.f, 0.f, 0.f, 0.f}, acc1 = acc0, acc2 = acc0; float ss = 0.f;
        f32x4 nxt[16];
#pragma unroll
        for (int r = 0; r < 16; ++r) nxt[r] = *(const f32x4*)(X + (size_t)(tok0 + r) * D + 4 * F.lane);
#pragma unroll 1
        for (int ch = 0; ch < 4; ++ch) {
#pragma unroll
            for (int r = 0; r < 16; ++r) { *(LAS f32x4*)(xt + r * XT_LD + 4 * F.lane) = nxt[r]; *(u32x2*)(XnB + (size_t)(tok0 + r) * D + 256 * ch + 4 * F.lane) = pack4(nxt[r]); }
            if (ch < 3) {
#pragma unroll
                for (int r = 0; r < 16; ++r) nxt[r] = *(const f32x4*)(X + (size_t)(tok0 + r) * D + 256 * (ch + 1) + 4 * F.lane); }
#pragma unroll 4
            for (int i = 0; i < 16; ++i) {
                const int k0 = 256 * ch + 16 * i;
                const f32x4 xv = *(const LAS f32x4*)(xt + l15 * XT_LD + 16 * i + 4 * quad), b0 = *(const f32x4*)(w0 + k0), b1 = *(const f32x4*)(w1 + k0), b2 = *(const f32x4*)(w2 + k0);
                ss += (xv[0] * xv[0] + xv[1] * xv[1]) + (xv[2] * xv[2] + xv[3] * xv[3]);
#pragma unroll
                for (int jj = 0; jj < 4; ++jj) {
                    acc0 = __builtin_amdgcn_mfma_f32_16x16x4f32(xv[jj], b0[jj], acc0, 0, 0, 0);
                    acc1 = __builtin_amdgcn_mfma_f32_16x16x4f32(xv[jj], b1[jj], acc1, 0, 0, 0);
                    acc2 = __builtin_amdgcn_mfma_f32_16x16x4f32(xv[jj], b2[jj], acc2, 0, 0, 0);
                }
            }
        }
        ss += __shfl_xor(ss, 16); ss += __shfl_xor(ss, 32);
        const float r = 1.0f / sqrtf(ss * (1.0f / D) + RMS_EPS);
        if (quad == 0) Rout[tok] = r;
#pragma unroll
        for (int i = 0; i < 4; ++i) { const float rt = __shfl(r, 4 * quad + i); const int trow = 4 * quad + i;
            lg[trow * 36 + l15] = acc0[i] * rt + bre[l15]; lg[trow * 36 + 16 + l15] = acc1[i] * rt + bre[16 + l15];
            if (l15 < 4) lg[trow * 36 + 32 + l15] = acc2[i] * rt + brg[l15]; }
        __syncthreads();
        int e0 = 0, e1 = 0, rk0 = 0, rk1 = 0; float wt0 = 0.f, wt1 = 0.f;
        if (F.lane < 16) {
            const LAS float* L = lg + F.lane * 36;
            const float g0 = L[32], g1 = L[33], g2 = L[34], g3 = L[35];
            float gm = g0; int gt = 0; if (g1 > gm) { gm = g1; gt = 1; } if (g2 > gm) { gm = g2; gt = 2; } if (g3 > gm) { gm = g3; gt = 3; }
            const float pg = 1.0f / (expf(g0 - gm) + expf(g1 - gm) + expf(g2 - gm) + expf(g3 - gm));
            float v0 = -INFINITY, v1 = -INFINITY; int i0 = 0, i1 = 0;
#pragma unroll
            for (int k = 0; k < 8; ++k) { const float v = L[8 * gt + k]; if (v > v0) { v1 = v0; i1 = i0; v0 = v; i0 = k; } else if (v > v1) { v1 = v; i1 = k; } }
            const float ex = expf(v1 - v0); const float s0 = 1.0f / (1.0f + ex);
            wt0 = pg * s0; wt1 = pg * (ex * s0); e0 = 8 * gt + i0; e1 = 8 * gt + i1;
            rk0 = (int)atomicAdd((unsigned*)&cntl[e0], 1u); rk1 = (int)atomicAdd((unsigned*)&cntl[e1], 1u);
        }
        __syncthreads();
        if (F.tid < 32) { const unsigned c = cntl[F.tid]; basel[F.tid] = c ? __hip_atomic_fetch_add(gcnt + F.tid, c, __ATOMIC_RELAXED, __HIP_MEMORY_SCOPE_AGENT) : 0u; }
        __syncthreads();
        if (F.lane < 16) {
            const int tk = base + F.wave * 16 + F.lane; const float rr = r;
            const size_t s0 = (size_t)e0 * ECAP + basel[e0] + rk0, s1 = (size_t)e1 * ECAP + basel[e1] + rk1;
            rowl[s0] = 2 * tk; rowr[s0] = rr; wgt[2 * tk] = wt0;
            rowl[s1] = 2 * tk + 1; rowr[s1] = rr; wgt[2 * tk + 1] = wt1;
        }
        __syncthreads();
    }
}

template <bool FINAL>
__device__ __forceinline__ void phase_combine(const Args& a, const Frame& F0, float* X, bf16_t* XnB, float* Rout) {
    const Frame F = refresh(F0);
    const bf16_t* Y = (const bf16_t*)(F.ws + WS_RB);
    const int gw = F.vcu * NWAVES + F.wave, NGW = F.G * NWAVES;
    for (int m = gw; m < NT; m += NGW) {
        f32x4* xr = (f32x4*)(X + (size_t)m * D) + F.lane; const u32x2* y0 = (const u32x2*)(Y + (size_t)(2 * m) * D) + F.lane; const u32x2* y1 = (const u32x2*)(Y + (size_t)(2 * m + 1) * D) + F.lane;
        f32x4 v[4]; float s = 0.f;
#pragma unroll
        for (int j = 0; j < 4; ++j) { v[j] = xr[64 * j]; const u32x2 p = y0[64 * j], q = y1[64 * j];
            v[j][0] += bflo(p[0]) + bflo(q[0]); v[j][1] += bfhi(p[0]) + bfhi(q[0]); v[j][2] += bflo(p[1]) + bflo(q[1]); v[j][3] += bfhi(p[1]) + bfhi(q[1]);
            s += (v[j][0] * v[j][0] + v[j][1] * v[j][1]) + (v[j][2] * v[j][2] + v[j][3] * v[j][3]); }
        s = wave_sum(s); const float r = 1.0f / sqrtf(s * (1.0f / D) + RMS_EPS);
        if constexpr (FINAL) {
            const f32x4* g = (const f32x4*)a.in[I_NFIN] + F.lane;
#pragma unroll
            for (int j = 0; j < 4; ++j) xr[64 * j] = v[j] * r * g[64 * j];
        } else {
            if (F.lane == 0) Rout[m] = r;
            u32x2* o8 = (u32x2*)(XnB + (size_t)m * D) + F.lane;
#pragma unroll
            for (int j = 0; j < 4; ++j) { xr[64 * j] = v[j]; o8[64 * j] = pack4(v[j]); }
        }
    }
}

__device__ __forceinline__ void phase_cmp2(const Frame& F0) {
    const Frame F = refresh(F0);
    const bf16_t* HID = (const bf16_t*)(F.ws + WS_RD + RD_HID); const bf16_t* W2T = (const bf16_t*)(F.ws + WS_W2T);
    bf16_t* KCMP = (bf16_t*)(F.ws + WS_RD + RD_KCMP); bf16_t* VCMPT = (bf16_t*)(F.ws + WS_RD + RD_VCMPT);
    const int gw = F.vcu * NWAVES + F.wave, NGW = F.G * NWAVES, l15 = F.lane & 15, quad = F.lane >> 4;
    for (int task = gw; task < 1024; task += NGW) {
        const int kv = task >> 9, r0 = (task & 511) * 16;
        const bf16_t* ap = HID + ((size_t)kv * 8192 + r0 + l15) * 256 + 8 * quad; const bf16_t* bp = W2T + (size_t)kv * 64 * 256 + (size_t)l15 * 256 + 8 * quad;
        f32x4 acc[4];
#pragma unroll
        for (int cb = 0; cb < 4; ++cb) acc[cb] = (f32x4){0.f, 0.f, 0.f, 0.f};
#pragma unroll
        for (int ks = 0; ks < 8; ++ks) { const bf16x8 af = *(const bf16x8*)(ap + 32 * ks);
#pragma unroll
            for (int cb = 0; cb < 4; ++cb) acc[cb] = __builtin_amdgcn_mfma_f32_16x16x32_bf16(af, *(const bf16x8*)(bp + (size_t)cb * 16 * 256 + 32 * ks), acc[cb], 0, 0, 0); }
#pragma unroll
        for (int cb = 0; cb < 4; ++cb)
#pragma unroll
            for (int i = 0; i < 4; ++i) { const int row = r0 + 4 * quad + i, bg = row >> 10, c = row & 1023, col = l15 + 16 * cb;
                if (kv == 0) KCMP[((size_t)bg * 1024 + c) * 64 + col] = (bf16_t)f2bf(acc[cb][i]);
                else VCMPT[((size_t)bg * 64 + col) * 1024 + c] = (bf16_t)f2bf(acc[cb][i]); }
    }
}

namespace nsa {
constexpr int SLOTB = 16384;
constexpr int NS_CMP = 4, NS_SW = 8;
constexpr int A_IMP = NS_CMP * SLOTB, IMP_LD = 260, A_SELM = 145408, A_UW = A_SELM + 64 * 8 * 4, A_UB = A_UW + 64 * 4, A_TL = A_UB + 64, A_END = A_TL + 260 * 4;
static_assert(A_IMP + 64 * IMP_LD * 4 <= A_SELM && NS_SW * SLOTB <= A_SELM && A_END <= MISC_OFF, "attention LDS");
struct Ctx { int tid, lane, wave, l15, quad, qi, h, sw; LAS unsigned char* lds; };
struct SubState { float m, l, L; f32x4 O[4]; };

template <int MODE>
__device__ __forceinline__ void sub_scores(const Ctx& c, const LAS unsigned char* kb, int kc0, int kc1, const bf16x8 (&qf)[2], SubState& st, int lo, int hi, bool rowsel, bool needmask, int kidx0, float invl, int sgi, bf16x8 (&pf)[2]) {
    constexpr float THR = 8.0f;
    const float mr = (st.m == -INFINITY) ? 0.f : st.m;
    const float cneg = (MODE == 2 && !rowsel) ? -INFINITY : -mr;
    const f32x4 cinit = {cneg, cneg, cneg, cneg};
    f32x4 S[4];
#pragma unroll
    for (int mb = 0; mb < 4; ++mb) {
        const bf16x8 k0 = *(const LAS bf16x8*)(kb + mb * 2048 + kc0), k1 = *(const LAS bf16x8*)(kb + mb * 2048 + kc1);
        S[mb] = __builtin_amdgcn_mfma_f32_16x16x32_bf16(k0, qf[0], cinit, 0, 0, 0);
        S[mb] = __builtin_amdgcn_mfma_f32_16x16x32_bf16(k1, qf[1], S[mb], 0, 0, 0); }
    if (needmask) {
#pragma unroll
        for (int mb = 0; mb < 4; ++mb)
#pragma unroll
            for (int i = 0; i < 4; ++i) { const int off = 16 * mb + 4 * c.quad + i; S[mb][i] = (off >= lo && off <= hi) ? S[mb][i] : -INFINITY; }
    }
    if (MODE != 1) {
        float tmax = max3f(S[0][0], S[0][1], S[0][2]), tmx2 = max3f(S[0][3], S[1][0], S[1][1]);
        tmax = max3f(tmax, S[1][2], S[1][3]); tmx2 = max3f(tmx2, S[2][0], S[2][1]); tmax = max3f(tmax, S[2][2], S[2][3]); tmx2 = max3f(tmx2, S[3][0], S[3][1]); tmax = max3f(tmax, S[3][2], S[3][3]); tmax = fmaxf(tmax, tmx2);
        const bool fresh = st.m == -INFINITY;
        if (__any((tmax > THR) || (fresh && tmax > -INFINITY))) {
            tmax = max_x16(tmax); tmax = max_x32(tmax);
            const bool upd = (tmax > THR) || (fresh && tmax > -INFINITY);
            const float d = upd ? tmax : 0.f;
            const float alpha = fresh ? 1.0f : __builtin_amdgcn_exp2f(-d);
#pragma unroll
            for (int mb = 0; mb < 4; ++mb) S[mb] = S[mb] - d;
            st.l *= alpha;
            if (MODE != 0) { st.L = st.L * alpha;
#pragma unroll
                for (int db = 0; db < 4; ++db) st.O[db] = st.O[db] * alpha; }
            st.m = upd ? mr + d : st.m;
        }
    }
    float ps = 0.f;
#pragma unroll
    for (int mb = 0; mb < 4; ++mb)
#pragma unroll
        for (int i = 0; i < 4; ++i) { float p = __builtin_amdgcn_exp2f(S[mb][i]); if (MODE == 1) p *= invl; S[mb][i] = p; if (MODE == 0) ps += p; }
    if (MODE == 0) { st.l += ps; return; }
    if (MODE == 1) {
        LAS float* imp = (LAS float*)(c.lds + A_IMP) + (c.wave * 8 + sgi * 4 + c.qi) * IMP_LD + (kidx0 >> 2) + c.quad;
#pragma unroll
        for (int mb = 0; mb < 4; ++mb) { float a = (S[mb][0] + S[mb][1]) + (S[mb][2] + 0.5f * S[mb][3]), b = 0.5f * S[mb][3];
            a += dpp_x1(a); a += dpp_x2(a); b += dpp_x1(b); b += dpp_x2(b);
            if (c.h == 0) { __hip_atomic_fetch_add(imp + 4 * mb, a, __ATOMIC_RELAXED, __HIP_MEMORY_SCOPE_WORKGROUP); __hip_atomic_fetch_add(imp + 4 * mb + 1, b, __ATOMIC_RELAXED, __HIP_MEMORY_SCOPE_WORKGROUP); } }
    }
#pragma unroll
    for (int k2 = 0; k2 < 2; ++k2) { const u32x4 w = pack8(S[2 * k2], S[2 * k2 + 1]); pf[k2] = __builtin_bit_cast(bf16x8, w); }
    if (MODE != 1) {
        const bf16x8 ones = {0x3F80, 0x3F80, 0x3F80, 0x3F80, 0x3F80, 0x3F80, 0x3F80, 0x3F80};
        f32x4 la = __builtin_amdgcn_mfma_f32_16x16x32_bf16(ones, pf[0], (f32x4){0.f, 0.f, 0.f, 0.f}, 0, 0, 0);
        la = __builtin_amdgcn_mfma_f32_16x16x32_bf16(ones, pf[1], la, 0, 0, 0); st.L += la[0]; }
}
template <int MODE, bool A0, bool A1>
__device__ __forceinline__ void tile_compute2(const Ctx& c, int slotoff, const bf16x8 (&qf)[2][2], SubState (&st)[2], const int (&lo)[2], const int (&hi)[2], const bool (&rowsel)[2], const bool (&needmask)[2], int kidx0, const float (&invl)[2]) {
    const LAS unsigned char* kb = c.lds + slotoff + c.l15 * 128;
    const LAS unsigned char* vb = c.lds + slotoff + 8192 + c.l15 * 128 + 8 * (c.quad & 1);
    const int kc0 = ((c.quad) ^ c.sw) * 16, kc1 = ((4 + c.quad) ^ c.sw) * 16;
    const int vq = c.quad >> 1;
    const int vc[2][2] = {{((vq) ^ c.sw) * 16, ((vq + 2) ^ c.sw) * 16}, {((4 + vq) ^ c.sw) * 16, ((6 + vq) ^ c.sw) * 16}};
    bf16x8 pf[2][2];
    if (A0) sub_scores<MODE>(c, kb, kc0, kc1, qf[0], st[0], lo[0], hi[0], rowsel[0], needmask[0], kidx0, invl[0], 0, pf[0]);
    if (A1) sub_scores<MODE>(c, kb, kc0, kc1, qf[1], st[1], lo[1], hi[1], rowsel[1], needmask[1], kidx0, invl[1], 1, pf[1]);
    if (MODE == 0) return;
#pragma unroll
    for (int db = 0; db < 4; ++db)
#pragma unroll
        for (int k2 = 0; k2 < 2; ++k2) {
            const s16x4 a = *(const LAS s16x4*)(vb + db * 2048 + vc[k2][0]), b = *(const LAS s16x4*)(vb + db * 2048 + vc[k2][1]);
            const bf16x8 vf = (bf16x8){a[0], a[1], a[2], a[3], b[0], b[1], b[2], b[3]};
            if (A0) st[0].O[db] = __builtin_amdgcn_mfma_f32_16x16x32_bf16(vf, pf[0][k2], st[0].O[db], 0, 0, 0);
            if (A1) st[1].O[db] = __builtin_amdgcn_mfma_f32_16x16x32_bf16(vf, pf[1][k2], st[1].O[db], 0, 0, 0);
        }
}
template <int MODE>
__device__ __forceinline__ void tile_compute(const Ctx& c, int slotoff, const bf16x8 (&qf)[2][2], SubState (&st)[2], const int (&lo)[2], const int (&hi)[2], const bool (&rowsel)[2], const bool (&act)[2], int kidx0, const float (&invl)[2]) {
    bool needmask[2];
#pragma unroll
    for (int s = 0; s < 2; ++s) needmask[s] = __any((MODE == 2 ? rowsel[s] : true) && (lo[s] > 0 || hi[s] < 63)) != 0;
    if (act[0] && act[1]) tile_compute2<MODE, true, true>(c, slotoff, qf, st, lo, hi, rowsel, needmask, kidx0, invl);
    else if (act[0]) tile_compute2<MODE, true, false>(c, slotoff, qf, st, lo, hi, rowsel, needmask, kidx0, invl);
    else if (act[1]) tile_compute2<MODE, false, true>(c, slotoff, qf, st, lo, hi, rowsel, needmask, kidx0, invl);
}
}

namespace nsa {
struct Tensors { const bf16_t* Q; const f32x2* rope; const float* gates; const bf16_t *KS, *VTS, *KW, *VTW, *KCMP, *VCMPT; bf16_t* O; bf16_t* DBG; float* SCR; float* PROBE; };

struct Dma {
    int wave; unsigned koff, voffrow, vchk;
    __device__ __forceinline__ void init(int wave_, int lane) { wave = wave_; const int row = 8 * wave_ + (lane >> 3), chs = (lane & 7) ^ ((row >> 1) & 7); koff = (unsigned)(row * 64 + chs * 8); voffrow = (unsigned)row; vchk = (unsigned)(chs * 8); }
    __device__ __forceinline__ void issue(LAS unsigned char* lds, int slotoff, const bf16_t* K, const bf16_t* VT, size_t vpitch, int kidx0, bool withv = true) const {
        __builtin_amdgcn_global_load_lds((const unsigned*)(K + (size_t)kidx0 * 64 + koff), (LAS unsigned*)(lds + slotoff + wave * 1024), 16, 0, 0);
        if (withv) __builtin_amdgcn_global_load_lds((const unsigned*)(VT + (size_t)voffrow * vpitch + kidx0 + vchk), (LAS unsigned*)(lds + slotoff + 8192 + wave * 1024), 16, 0, 0);
    }
};
#define NSA_WAIT_V(n) asm volatile("s_waitcnt vmcnt(" #n ")" ::: "memory")
#define NSA_BAR() do { asm volatile("" ::: "memory"); __builtin_amdgcn_s_barrier(); asm volatile("" ::: "memory"); } while (0)
#define NSA_RING_BG(G, WITHV, NTILES, TILE, BODY) do { \
        const int n_ = (NTILES); int so_ = 0; \
        _Pragma("unroll") for (int k_ = 0; k_ < (G); ++k_) if (k_ < n_) dma.issue(lds, k_ * SLOTB, KPTR, VPTR, VPITCH, TILE(k_), WITHV); \
        _Pragma("unroll 1") for (int i_ = 0; i_ < n_; ++i_) { \
            if ((i_ % (G)) == 0) { NSA_WAIT_V(0); NSA_BAR(); const int other_ = (((i_ / (G)) & 1) ? 0 : (G) * SLOTB); \
                _Pragma("unroll") for (int k_ = 0; k_ < (G); ++k_) if (i_ + (G) + k_ < n_) dma.issue(lds, other_ + k_ * SLOTB, KPTR, VPTR, VPITCH, TILE(i_ + (G) + k_), WITHV); } \
            BODY(i_, so_); \
            so_ = (so_ == (2 * (G) - 1) * SLOTB) ? 0 : so_ + SLOTB; } \
        NSA_WAIT_V(0); NSA_BAR(); } while (0)
#define NSA_RING_B4(NTILES, TILE, BODY) NSA_RING_BG(4, true, NTILES, TILE, BODY)
#define NSA_RING(NS, WITHV, NTILES, TILE, BODY) do { \
        const int n_ = (NTILES); int sl_issue_ = 0, sl_cur_ = 0; \
        _Pragma("unroll") for (int p_ = 0; p_ < (NS) - 1; ++p_) { const int ti_ = p_ < n_ ? p_ : n_ - 1; dma.issue(lds, sl_issue_, KPTR, VPTR, VPITCH, TILE(ti_), WITHV); sl_issue_ += SLOTB; } \
        _Pragma("unroll 1") for (int i_ = 0; i_ < n_; ++i_) { \
            static_assert((NS) == 3 || (NS) == 4, "ring depth"); \
            if ((NS) == 3) { if (WITHV) NSA_WAIT_V(2); else NSA_WAIT_V(1); } else { if (WITHV) NSA_WAIT_V(4); else NSA_WAIT_V(2); } \
            NSA_BAR(); \
            { const int ti_ = (i_ + (NS) - 1) < n_ ? (i_ + (NS) - 1) : n_ - 1; dma.issue(lds, sl_issue_, KPTR, VPTR, VPITCH, TILE(ti_), WITHV); sl_issue_ = (sl_issue_ == ((NS) - 1) * SLOTB) ? 0 : sl_issue_ + SLOTB; } \
            BODY(i_, sl_cur_); \
            sl_cur_ = (sl_cur_ == ((NS) - 1) * SLOTB) ? 0 : sl_cur_ + SLOTB; } \
        NSA_WAIT_V(0); NSA_BAR(); } while (0)


template <int MODE, bool WITHV, class TileFn, class MaskFn>
__device__ __forceinline__ void dense_tiles(const Ctx& c, const Dma& dma, LAS unsigned char* lds, const bf16_t* K, const bf16_t* VT, size_t vpitch, int n, const TileFn& tile, const MaskFn& mask,
                                            const bf16x8 (&qf)[2][2], SubState (&st)[2], const float (&invl)[2]) {
    constexpr float THR = 8.0f;
    const int kc0 = ((c.quad) ^ c.sw) * 16, kc1 = ((4 + c.quad) ^ c.sw) * 16;
    const int vq = c.quad >> 1;
    const int vc[2][2] = {{((vq) ^ c.sw) * 16, ((vq + 2) ^ c.sw) * 16}, {((4 + vq) ^ c.sw) * 16, ((6 + vq) ^ c.sw) * 16}};
    const int koffl = c.l15 * 128, voffl = 8192 + c.l15 * 128 + 8 * (c.quad & 1);
#pragma unroll
    for (int p = 0; p < 3; ++p) dma.issue(lds, p * SLOTB, K, VT, vpitch, tile(p < n ? p : n - 1), WITHV);
    int sl_issue = 3 * SLOTB;
    if (WITHV) NSA_WAIT_V(4); else NSA_WAIT_V(2);
    NSA_BAR();
    f32x4 Sc[2][4], Sn[2][4];
#define DT_QK(SX, slotoff) do { const LAS unsigned char* kb_ = lds + (slotoff) + koffl; float cn_[2]; \
        _Pragma("unroll") for (int s_ = 0; s_ < 2; ++s_) cn_[s_] = (st[s_].m == -INFINITY) ? 0.f : -st[s_].m; \
        _Pragma("unroll") for (int mb_ = 0; mb_ < 4; ++mb_) { const bf16x8 k0_ = *(const LAS bf16x8*)(kb_ + mb_ * 2048 + kc0), k1_ = *(const LAS bf16x8*)(kb_ + mb_ * 2048 + kc1); \
            _Pragma("unroll") for (int s_ = 0; s_ < 2; ++s_) { SX[s_][mb_] = __builtin_amdgcn_mfma_f32_16x16x32_bf16(k0_, qf[s_][0], (f32x4){cn_[s_], cn_[s_], cn_[s_], cn_[s_]}, 0, 0, 0); \
                SX[s_][mb_] = __builtin_amdgcn_mfma_f32_16x16x32_bf16(k1_, qf[s_][1], SX[s_][mb_], 0, 0, 0); } } } while (0)
    DT_QK(Sc, 0);
    int so = 0;
#pragma unroll 1
    for (int i = 0; i < n; ++i) {
        if (WITHV) NSA_WAIT_V(2); else NSA_WAIT_V(1);
        NSA_BAR();
        { const int ti = (i + 3) < n ? (i + 3) : n - 1; dma.issue(lds, sl_issue, K, VT, vpitch, tile(ti), WITHV); sl_issue = (sl_issue == 3 * SLOTB) ? 0 : sl_issue + SLOTB; }
        const int son = (so == 3 * SLOTB) ? 0 : so + SLOTB;
        DT_QK(Sn, son);
        float tm[2]; bool any_upd = false;
#pragma unroll
        for (int s = 0; s < 2; ++s) { int lo, hi; mask(i, s, lo, hi);
            if (__any(lo > 0 || hi < 63)) {
#pragma unroll
                for (int mb = 0; mb < 4; ++mb)
#pragma unroll
                    for (int e = 0; e < 4; ++e) { const int off = 16 * mb + 4 * c.quad + e; Sc[s][mb][e] = (off >= lo && off <= hi) ? Sc[s][mb][e] : -INFINITY; }
            }
            if (MODE != 1) {
                float t0 = max3f(Sc[s][0][0], Sc[s][0][1], Sc[s][0][2]), t1 = max3f(Sc[s][0][3], Sc[s][1][0], Sc[s][1][1]);
                t0 = max3f(t0, Sc[s][1][2], Sc[s][1][3]); t1 = max3f(t1, Sc[s][2][0], Sc[s][2][1]); t0 = max3f(t0, Sc[s][2][2], Sc[s][2][3]); t1 = max3f(t1, Sc[s][3][0], Sc[s][3][1]); t0 = max3f(t0, Sc[s][3][2], Sc[s][3][3]);
                tm[s] = fmaxf(t0, t1);
                any_upd = any_upd || (tm[s] > THR) || (st[s].m == -INFINITY && tm[s] > -INFINITY);
            }
        }
        if (MODE != 1) {
            if (__any(any_upd)) {
#pragma unroll
                for (int s = 0; s < 2; ++s) {
                    float t = max_x16(tm[s]); t = max_x32(t);
                    const bool fresh = st[s].m == -INFINITY; const bool upd = (t > THR) || (fresh && t > -INFINITY);
                    const float d = upd ? t : 0.f, alpha = fresh ? 1.0f : __builtin_amdgcn_exp2f(-d), mr = fresh ? 0.f : st[s].m;
#pragma unroll
                    for (int mb = 0; mb < 4; ++mb) { Sc[s][mb] = Sc[s][mb] - d; Sn[s][mb] = Sn[s][mb] - d; }
                    st[s].l *= alpha;
                    if (MODE != 0) { st[s].L *= alpha;
#pragma unroll
                        for (int db = 0; db < 4; ++db) st[s].O[db] = st[s].O[db] * alpha; }
                    st[s].m = upd ? mr + d : st[s].m;
                }
            }
        }
        bf16x8 pf[2][2];
#pragma unroll
        for (int s = 0; s < 2; ++s) {
            float ps = 0.f;
#pragma unroll
            for (int mb = 0; mb < 4; ++mb)
#pragma unroll
                for (int e = 0; e < 4; ++e) { float p = __builtin_amdgcn_exp2f(Sc[s][mb][e]); if (MODE == 1) p *= invl[s]; Sc[s][mb][e] = p; if (MODE == 0) ps += p; }
            if (MODE == 0) st[s].l += ps;
            if (MODE == 1) {
                LAS float* imp = (LAS float*)(lds + A_IMP) + (c.wave * 8 + s * 4 + c.qi) * IMP_LD + (tile(i) >> 2) + c.quad;
#pragma unroll
                for (int mb = 0; mb < 4; ++mb) { float a = (Sc[s][mb][0] + Sc[s][mb][1]) + (Sc[s][mb][2] + 0.5f * Sc[s][mb][3]), b = 0.5f * Sc[s][mb][3];
                    a += dpp_x1(a); a += dpp_x2(a); b += dpp_x1(b); b += dpp_x2(b);
                    if (c.h == 0) { __hip_atomic_fetch_add(imp + 4 * mb, a, __ATOMIC_RELAXED, __HIP_MEMORY_SCOPE_WORKGROUP); __hip_atomic_fetch_add(imp + 4 * mb + 1, b, __ATOMIC_RELAXED, __HIP_MEMORY_SCOPE_WORKGROUP); } }
            }
            if (MODE != 0) {
#pragma unroll
                for (int k2 = 0; k2 < 2; ++k2) { const u32x4 w = pack8(Sc[s][2 * k2], Sc[s][2 * k2 + 1]); pf[s][k2] = __builtin_bit_cast(bf16x8, w); }
                if (MODE != 1) { const bf16x8 ones = {0x3F80, 0x3F80, 0x3F80, 0x3F80, 0x3F80, 0x3F80, 0x3F80, 0x3F80};
                    f32x4 la = __builtin_amdgcn_mfma_f32_16x16x32_bf16(ones, pf[s][0], (f32x4){0.f, 0.f, 0.f, 0.f}, 0, 0, 0);
                    la = __builtin_amdgcn_mfma_f32_16x16x32_bf16(ones, pf[s][1], la, 0, 0, 0); st[s].L += la[0]; }
            }
        }
        if (MODE != 0) {
            const LAS unsigned char* vb = lds + so + voffl;
#pragma unroll
            for (int db = 0; db < 4; ++db)
#pragma unroll
                for (int k2 = 0; k2 < 2; ++k2) {
                    const s16x4 a = *(const LAS s16x4*)(vb + db * 2048 + vc[k2][0]), b = *(const LAS s16x4*)(vb + db * 2048 + vc[k2][1]);
                    const bf16x8 vf = (bf16x8){a[0], a[1], a[2], a[3], b[0], b[1], b[2], b[3]};
                    st[0].O[db] = __builtin_amdgcn_mfma_f32_16x16x32_bf16(vf, pf[0][k2], st[0].O[db], 0, 0, 0);
                    st[1].O[db] = __builtin_amdgcn_mfma_f32_16x16x32_bf16(vf, pf[1][k2], st[1].O[db], 0, 0, 0);
                }
        }
#pragma unroll
        for (int s = 0; s < 2; ++s)
#pragma unroll
            for (int mb = 0; mb < 4; ++mb) Sc[s][mb] = Sn[s][mb];
        so = son;
    }
    NSA_WAIT_V(0); NSA_BAR();
#undef DT_QK
}

constexpr int QT_HP = 128, QT_QP = 512, I_STG = 64 * QT_QP, STG_COL = 144, STG_JOB = 16 * STG_COL, STG_BUF = 8 * STG_JOB;
constexpr int I_RIDX = I_STG + 2 * STG_BUF, I_JOBS = I_RIDX + 1024, I_CM = I_JOBS + 2080, I_NJ = I_CM + 2048, I_JOBQ = I_NJ + 1040, I_MREF = I_JOBQ + 2080, I_VSL = ((I_MREF + 1024 + 1023) / 1024) * 1024, I_INV_END = I_VSL + 8 * 8192;
static_assert(I_INV_END <= A_SELM && (I_CM % 8) == 0, "inverted-branch LDS map");
__device__ __forceinline__ int nth_set_bit(unsigned long long m, int r) {
    const unsigned lo = (unsigned)m, hi = (unsigned)(m >> 32); int c = __popc(lo); const bool up = r >= c; unsigned w = up ? hi : lo; int base = up ? 32 : 0; r -= up ? c : 0;
#pragma unroll
    for (int sh = 16; sh >= 1; sh >>= 1) { const unsigned low = w & ((1u << sh) - 1u); c = __popc(low); const bool u2 = r >= c; r -= u2 ? c : 0; base += u2 ? sh : 0; w = u2 ? (w >> sh) : low; }
    return base;
}
__device__ __forceinline__ void selected_inverted(const Ctx& c, const Tensors& T, LAS unsigned char* lds, const bf16x8 (&qr)[2][2], SubState (&st)[2], int t0, int bg, int qt) {
    constexpr float L2E = 1.4426950408889634f;
    const LAS unsigned* selm = (const LAS unsigned*)(lds + A_SELM);
    LAS unsigned long long* CM = (LAS unsigned long long*)(lds + I_CM); LAS int* NJ = (LAS int*)(lds + I_NJ); LAS unsigned* JOBS = (LAS unsigned*)(lds + I_JOBS);
#pragma unroll
    for (int s = 0; s < 2; ++s) { LAS unsigned char* qd = lds + (c.wave * 8 + 4 * s + c.qi) * QT_QP + c.h * QT_HP + 16 * c.quad; *(LAS bf16x8*)qd = qr[s][0]; *(LAS bf16x8*)(qd + 64) = qr[s][1]; }
    { const unsigned word = selm[c.lane * 8 + c.wave]; unsigned long long mine = 0ull;
#pragma unroll 1
      for (int jj = 0; jj < 32; ++jj) { const unsigned long long m = __ballot((word >> jj) & 1u); mine = (c.lane == jj) ? m : mine; }
      if (c.lane < 32) { const int jb = 32 * c.wave + c.lane; CM[jb] = (jb == 0 || jb == qt || jb == qt - 1) ? 0ull : mine; } }
    if (c.tid < 256) ((LAS unsigned*)(lds + I_RIDX))[c.tid] = 0xFFFFFFFFu;
#pragma unroll
    for (int s = 0; s < 2; ++s) if (c.quad == 0) ((LAS float*)(lds + I_MREF))[(c.wave * 8 + 4 * s + c.qi) * 4 + c.h] = st[s].m;
    __syncthreads();
    if (c.tid < 256) NJ[c.tid] = (__popcll(CM[c.tid]) + 3) >> 2;
    __syncthreads();
    if (c.tid < 256) { int pre = 0; const int i4 = c.tid >> 2;
#pragma clang loop vectorize(disable) unroll(disable)
        for (int i = 0; i < i4; ++i) { const LAS int* p4 = NJ + 4 * i; pre += (p4[0] + p4[1]) + (p4[2] + p4[3]); }
#pragma clang loop vectorize(disable) unroll(disable)
        for (int i = 4 * i4; i < c.tid; ++i) pre += NJ[i];
        const int cnt = NJ[c.tid];
        unsigned long long mrem = CM[c.tid];
        for (int t = 0; t < cnt; ++t) { JOBS[pre + t] = (unsigned)c.tid | ((unsigned)t << 16); unsigned qb = 0u;
#pragma unroll
            for (int u = 0; u < 4; ++u) { unsigned q = 0xffu; if (mrem) { q = (unsigned)__ffsll((long long)mrem) - 1u; mrem &= mrem - 1ull; } qb |= q << (8 * u); }
            ((LAS unsigned*)(lds + I_JOBQ))[pre + t] = qb; }
        if (c.tid == 255) NJ[256] = pre + cnt; }
    __syncthreads();
    const int njobs = __builtin_amdgcn_readfirstlane(NJ[256]), nrounds = (njobs + 7) >> 3;
    if (njobs == 0) { __syncthreads(); return; }
    const bf16_t* Ks = T.KS + (size_t)bg * SEQ * 64; const bf16_t* Vs = T.VTS + (size_t)bg * 64 * SEQ;
    const unsigned koff = (unsigned)((8 * (c.l15 >> 2) + (c.l15 & 3)) * 64 + 8 * c.quad);
    bf16x8 kf[4][2];
    const int vslot = I_VSL + c.wave * 8192;
    const unsigned vdoff = (unsigned)((c.lane >> 3) * SEQ + (unsigned)(((c.lane & 7) ^ ((c.lane >> 4) & 7)) * 8));
#define VDMA(jblk) do { const bf16_t* vb_ = Vs + (size_t)(64 * (jblk)); _Pragma("unroll") for (int i_ = 0; i_ < 8; ++i_) { \
        const unsigned ch_ = (unsigned)((((c.lane & 7) ^ ((4 * i_ + (c.lane >> 4)) & 7))) * 8); \
        __builtin_amdgcn_global_load_lds((const unsigned*)(vb_ + (size_t)(8 * i_ + (c.lane >> 3)) * SEQ + ch_), (LAS unsigned*)(lds + vslot + i_ * 1024), 16, 0, 0); } } while (0)
    {   const int ji0 = min(c.wave, njobs - 1); const int j0 = __builtin_amdgcn_readfirstlane((int)(JOBS[ji0] & 0xffffu));
        const bf16_t* kb = Ks + (size_t)(64 * j0) * 64;
#pragma unroll
        for (int mb = 0; mb < 4; ++mb) { const unsigned ko = koff + (unsigned)((32 * (mb >> 1) + 4 * (mb & 1)) * 64); kf[mb][0] = *(const bf16x8*)(kb + ko); kf[mb][1] = *(const bf16x8*)(kb + (ko + 32u)); }
        VDMA(j0); }
    float dcur[2] = {0.f, 0.f};
    const LAS unsigned char* vfb = lds + vslot + c.l15 * 128;
    const int vch0 = ((c.quad) ^ c.sw) * 16, vch1 = ((4 + c.quad) ^ c.sw) * 16;
    int buf = 0;
#if PROBE_T
    unsigned long long tacc = 0ull, tmark;
#define TMARK() (tmark = __builtin_amdgcn_s_memtime())
#define TACC(sel) do { if (PROBE_T == (sel)) tacc += __builtin_amdgcn_s_memtime() - tmark; } while (0)
#else
#define TMARK() do {} while (0)
#define TACC(sel) do {} while (0)
#endif
#pragma unroll 1
    for (int r = 0; r < nrounds; ++r) {
        TMARK();
        const int jiu = 8 * r + c.wave; const bool has = jiu < njobs; const int ji = has ? jiu : njobs - 1;
        const int jin = min(jiu + 8, njobs - 1);
        const unsigned jw = JOBS[ji], jwn = JOBS[jin];
        const int j = __builtin_amdgcn_readfirstlane((int)(jw & 0xffffu)), t = __builtin_amdgcn_readfirstlane((int)(jw >> 16)), jn = __builtin_amdgcn_readfirstlane((int)(jwn & 0xffffu));
        const unsigned qb = ((const LAS unsigned*)(lds + I_JOBQ))[ji]; const unsigned qraw = (qb >> (8 * c.qi)) & 0xffu; const bool valid = has && qraw != 0xffu;
        const int qidx = (int)(qraw != 0xffu ? qraw : (qb & 0xffu)); const int hi = t0 + qidx - 64 * j;
        const LAS unsigned char* qa = lds + qidx * QT_QP + c.h * QT_HP + 16 * c.quad;
        const bf16x8 q0 = *(const LAS bf16x8*)qa, q1 = *(const LAS bf16x8*)(qa + 64);
#if PROBE_T
        asm volatile("s_waitcnt lgkmcnt(0)" ::: "memory"); TACC(4); TMARK();
#endif
        const float mref = ((const LAS float*)(lds + I_MREF))[qidx * 4 + c.h];
        const f32x4 cinit = {-mref, -mref, -mref, -mref};
        f32x4 S[4];
#pragma unroll
        for (int mb = 0; mb < 4; ++mb) {
            S[mb] = __builtin_amdgcn_mfma_f32_16x16x32_bf16(kf[mb][0], q0, cinit, 0, 0, 0);
            S[mb] = __builtin_amdgcn_mfma_f32_16x16x32_bf16(kf[mb][1], q1, S[mb], 0, 0, 0); }
        {   const bf16_t* kb = Ks + (size_t)(64 * jn) * 64;
#pragma unroll
            for (int mb = 0; mb < 4; ++mb) { const unsigned ko = koff + (unsigned)((32 * (mb >> 1) + 4 * (mb & 1)) * 64); kf[mb][0] = *(const bf16x8*)(kb + ko); kf[mb][1] = *(const bf16x8*)(kb + (ko + 32u)); } }
        if (__any(hi < 63)) {
#pragma unroll
            for (int mb = 0; mb < 4; ++mb)
#pragma unroll
                for (int i = 0; i < 4; ++i) { const int off = 32 * (mb >> 1) + 8 * c.quad + 4 * (mb & 1) + i; S[mb][i] = off <= hi ? S[mb][i] : -INFINITY; }
        }
        float tmax = max3f(S[0][0], S[0][1], S[0][2]), tmx2 = max3f(S[0][3], S[1][0], S[1][1]);
        tmax = max3f(tmax, S[1][2], S[1][3]); tmx2 = max3f(tmx2, S[2][0], S[2][1]); tmax = max3f(tmax, S[2][2], S[2][3]); tmx2 = max3f(tmx2, S[3][0], S[3][1]); tmax = max3f(tmax, S[3][2], S[3][3]); tmax = fmaxf(tmax, tmx2);
        float dsh = 0.f;
        if (__any(tmax > 8.0f)) { tmax = max_x16(tmax); tmax = max_x32(tmax); dsh = tmax > 8.0f ? tmax : 0.f;
#pragma unroll
            for (int mb = 0; mb < 4; ++mb) S[mb] = S[mb] - dsh; }
#pragma unroll
        for (int mb = 0; mb < 4; ++mb)
#pragma unroll
            for (int i = 0; i < 4; ++i) S[mb][i] = __builtin_amdgcn_exp2f(S[mb][i]);
        bf16x8 pf[2];
#pragma unroll
        for (int k2 = 0; k2 < 2; ++k2) { const u32x4 w = pack8(S[2 * k2], S[2 * k2 + 1]); pf[k2] = __builtin_bit_cast(bf16x8, w); }
        const bf16x8 ones = {0x3F80, 0x3F80, 0x3F80, 0x3F80, 0x3F80, 0x3F80, 0x3F80, 0x3F80};
        f32x4 la = __builtin_amdgcn_mfma_f32_16x16x32_bf16(ones, pf[0], (f32x4){0.f, 0.f, 0.f, 0.f}, 0, 0, 0);
        la = __builtin_amdgcn_mfma_f32_16x16x32_bf16(ones, pf[1], la, 0, 0, 0);
        const float ps = la[0];
#if PROBE_T
        asm volatile("s_nop 0" : "+v"(pf[0]), "+v"(pf[1])); TACC(6); TMARK();
#endif
        LAS unsigned char* sg = lds + I_STG + buf * STG_BUF + c.wave * STG_JOB + c.l15 * STG_COL;
        asm volatile("s_waitcnt vmcnt(8)" ::: "memory");
        bf16x8 vfr[4][2];
#pragma unroll
        for (int db = 0; db < 4; ++db) { vfr[db][0] = *(const LAS bf16x8*)(vfb + db * 2048 + vch0); vfr[db][1] = *(const LAS bf16x8*)(vfb + db * 2048 + vch1); }
        asm volatile("s_waitcnt lgkmcnt(0)" ::: "memory");
        VDMA(jn);
#pragma unroll
        for (int db = 0; db < 4; ++db) { f32x4 o = __builtin_amdgcn_mfma_f32_16x16x32_bf16(vfr[db][0], pf[0], (f32x4){0.f, 0.f, 0.f, 0.f}, 0, 0, 0);
            o = __builtin_amdgcn_mfma_f32_16x16x32_bf16(vfr[db][1], pf[1], o, 0, 0, 0);
            *(LAS u32x2*)(sg + (16 * db + 4 * c.quad) * 2) = pack4(o); }
        if (c.quad == 0) { *(LAS f32x2*)(sg + 128) = (f32x2){dsh, ps};
            if (c.h == 0 && valid) (lds + I_RIDX + buf * 512 + qidx * 8)[c.wave] = (unsigned char)c.qi; }
        asm volatile("s_waitcnt lgkmcnt(0)" ::: "memory"); TACC(7); TACC(1); TMARK(); NSA_BAR(); TACC(2); TMARK();
#pragma unroll
        for (int s = 0; s < 2; ++s) {
            LAS unsigned char* rx = lds + I_RIDX + buf * 512 + (c.wave * 8 + 4 * s + c.qi) * 8;
            const u32x2 idx = *(const LAS u32x2*)rx;
#pragma unroll
            for (int k = 0; k < (PROBE_NOMERGE ? 0 : 8); ++k) { const unsigned u = ((k < 4 ? idx[0] : idx[1]) >> (8 * (k & 3))) & 0xffu; const bool hit = u != 0xffu;
                if (__any(hit)) {
                    const LAS unsigned char* sp = lds + I_STG + buf * STG_BUF + k * STG_JOB + ((hit ? (int)u : 0) * 4 + c.h) * STG_COL;
                    const f32x2 ml = *(const LAS f32x2*)(sp + 128);
                    const float dt = hit ? ml[0] : dcur[s], lt = hit ? ml[1] : 0.f;
                    const float dn = fmaxf(dt, dcur[s]); const float a = __builtin_amdgcn_exp2f(dcur[s] - dn), b = hit ? __builtin_amdgcn_exp2f(dt - dn) : 0.f;
                    st[s].L = st[s].L * a + lt * b; dcur[s] = dn;
#pragma unroll
                    for (int db = 0; db < 4; ++db) { const u32x2 ow = *(const LAS u32x2*)(sp + (16 * db + 4 * c.quad) * 2);
                        const f32x4 o = hit ? (f32x4){bflo(ow[0]), bfhi(ow[0]), bflo(ow[1]), bfhi(ow[1])} : (f32x4){0.f, 0.f, 0.f, 0.f};
                        st[s].O[db] = st[s].O[db] * a + o * b; }
                }
            }
            if (c.h == 0 && c.quad == 0) *(LAS u32x2*)rx = (u32x2){0xFFFFFFFFu, 0xFFFFFFFFu};
        }
        TACC(3);
        buf ^= 1;
    }
#if PROBE_T
    if (blockIdx.x == 17 && c.tid == 64 && t0 >= 64 * 200) { const float n = (float)(tacc / (unsigned long long)nrounds) * 0.01f; *((volatile float*)T.PROBE) = n; }
#endif
    asm volatile("s_waitcnt vmcnt(0)" ::: "memory");
    __syncthreads();
#undef VDMA
}

struct TileLin { int base; __device__ __forceinline__ int operator()(int i) const { return 64 * (base + i); } };
struct TileForced { int nf, qt; __device__ __forceinline__ int operator()(int i) const { return 64 * (i == 0 ? 0 : (i == nf - 1 ? qt : qt - 1)); } };
struct MaskCmp { int lim0, lim1; __device__ __forceinline__ void operator()(int i, int s, int& lo, int& hi) const { lo = 0; hi = (s ? lim1 : lim0) - 64 * i; } };
struct MaskCausal { int t0_, t1_; TileForced tf; __device__ __forceinline__ void operator()(int i, int s, int& lo, int& hi) const { lo = 0; hi = (s ? t1_ : t0_) - tf(i); } };
struct MaskWin { int t0_, t1_, kt0; __device__ __forceinline__ void operator()(int i, int s, int& lo, int& hi) const { const int k0 = 64 * (kt0 + i), t = s ? t1_ : t0_; hi = t - k0; lo = t - 511 - k0; } };

__device__ __forceinline__ void attn_unit(const Tensors& T, LAS unsigned char* lds, int tid_in, int b, int g, int qt) {
    Ctx c; { int t_ = tid_in; asm volatile("" : "+v"(t_)); c.tid = t_; } c.lane = c.tid & 63; c.wave = __builtin_amdgcn_readfirstlane(c.tid >> 6); c.l15 = c.lane & 15; c.quad = c.lane >> 4; c.qi = c.l15 >> 2; c.h = c.l15 & 3; c.sw = (c.l15 >> 1) & 7; c.lds = lds;
    const int t0 = qt * 64, bg = b * 4 + g; const unsigned tokbase = (unsigned)b * SEQ;
    Dma dma; dma.init(c.wave, c.lane);
    int tq[2]; tq[0] = t0 + c.wave * 8 + c.qi; tq[1] = tq[0] + 4;
    bf16x8 qc[2][2];
#pragma unroll
    for (int s = 0; s < 2; ++s) {
        const bf16_t* qp = T.Q + (tokbase + tq[s]) * D + (g * 4 + c.h) * 64 + 8 * c.quad;
        qc[s][0] = *(const bf16x8*)qp; qc[s][1] = *(const bf16x8*)(qp + 32);
    }
#define NSA_GATE(s, br) (T.gates[(tokbase + tq[s]) * 48 + (g * 4 + c.h) * 3 + (br)])
    float* scr0 = T.SCR + (c.wave * 8 + c.qi) * 256 + c.h * 64 + 4 * c.quad;
    for (int i = c.tid; i < 64 * IMP_LD; i += NTHREADS) ((LAS float*)(lds + A_IMP))[i] = 0.f;

    SubState st[2]; int lo[2], hi[2]; bool act[2], rowsel[2] = {true, true}; float invl[2] = {0.f, 0.f};
#define RESET_ST() do { _Pragma("unroll") for (int s = 0; s < 2; ++s) { st[s].m = -INFINITY; st[s].l = 0.f; st[s].L = 0.f; _Pragma("unroll") for (int db = 0; db < 4; ++db) st[s].O[db] = (f32x4){0.f, 0.f, 0.f, 0.f}; } } while (0)
    const int ncmp = min(NCMP, t0 / 16 + 3), ntc = (ncmp + 63) >> 6;
    const bf16_t* Kc = T.KCMP + (size_t)bg * 1024 * 64; const bf16_t* Vc = T.VCMPT + (size_t)bg * 64 * 1024;
    int lim[2];
#pragma unroll
    for (int s = 0; s < 2; ++s) lim[s] = tq[s] >= 31 ? ((tq[s] - 31) >> 4) : -1;
    RESET_ST();
#define KPTR Kc
#define VPTR Vc
#define VPITCH 1024
#define TILE_C(i) (64 * (i))
#define BODY_C0(i, so) do { _Pragma("unroll") for (int s = 0; s < 2; ++s) { lo[s] = 0; hi[s] = lim[s] - 64 * (i); act[s] = true; } tile_compute<0>(c, so, qc, st, lo, hi, rowsel, act, 64 * (i), invl); } while (0)
#define BODY_C1(i, so) do { _Pragma("unroll") for (int s = 0; s < 2; ++s) { lo[s] = 0; hi[s] = lim[s] - 64 * (i); act[s] = true; } tile_compute<1>(c, so, qc, st, lo, hi, rowsel, act, 64 * (i), invl); } while (0)
    if (!(ATT_SKIP & 1)) dense_tiles<0, false>(c, dma, lds, Kc, Vc, 1024, ntc, TileLin{0}, MaskCmp{lim[0], lim[1]}, qc, st, invl);
#pragma unroll
    for (int s = 0; s < 2; ++s) { float l = st[s].l; l = sum_x16(l); l = sum_x32(l); invl[s] = l > 0.f ? 1.0f / l : 0.f; }
    if (!(ATT_SKIP & 1)) dense_tiles<1, true>(c, dma, lds, Kc, Vc, 1024, ntc, TileLin{0}, MaskCmp{lim[0], lim[1]}, qc, st, invl);
#undef KPTR
#undef VPTR
#undef VPITCH
#pragma unroll
    for (int s = 0; s < 2; ++s)
#pragma unroll
        for (int db = 0; db < 4; ++db) *(f32x4*)(scr0 + s * 4 * 256 + 16 * db) = st[s].O[db] * NSA_GATE(s, 0);
#if NSA_CHECK
    if (NSA_CHECK_BR == 0) {
#pragma unroll
        for (int s = 0; s < 2; ++s) { bf16_t* op = T.DBG + (tokbase + tq[s]) * D + (g * 4 + c.h) * 64 + 4 * c.quad;
#pragma unroll
            for (int db = 0; db < 4; ++db) *(u32x2*)(op + 16 * db) = pack4(st[s].O[db]); } }
#endif
    {
        LAS float* impw = (LAS float*)(lds + A_IMP) + (c.wave * 8) * IMP_LD;
        unsigned uw = 0u;
        const unsigned long long lt_mask = (1ull << c.lane) - 1ull;
#pragma unroll 1
        for (int qq = (ATT_SKIP & 2) ? 8 : 0; qq < 8; ++qq) {
            const int tqq = t0 + c.wave * 8 + qq, cur = tqq >> 6;
            const int K = 16 - (cur >= 2 ? 3 : cur + 1);
            unsigned key[4]; unsigned long long forced[4];
#pragma unroll
            for (int e = 0; e < 4; ++e) { const int j = c.lane + 64 * e; const bool valid = j <= cur; const bool fo = (j == 0) || (j == cur) || (j == cur - 1);
                key[e] = (valid && !fo) ? (__float_as_uint(impw[qq * IMP_LD + j]) + 1u) : 0u; forced[e] = __ballot(valid && fo); }
            unsigned T = 0u; bool exact = false;
#pragma unroll 1
            for (int bit = 30; bit >= 0; --bit) { const unsigned cand = T | (1u << bit);
                const int cnt = __popcll(__ballot(key[0] >= cand)) + __popcll(__ballot(key[1] >= cand)) + __popcll(__ballot(key[2] >= cand)) + __popcll(__ballot(key[3] >= cand));
                T = (cnt >= K) ? cand : T;
                if (cnt == K) { exact = true; break; } }
            const unsigned Tg = exact ? T - 1u : T;
            unsigned long long sel[4]; int ngt = 0;
#pragma unroll
            for (int e = 0; e < 4; ++e) { sel[e] = __ballot(key[e] > Tg); ngt += __popcll(sel[e]); }
            int r = (T != 0u && !exact) ? (K - ngt) : 0;
#pragma unroll
            for (int e = 0; e < 4; ++e) { const unsigned long long eq = (T != 0u && !exact) ? __ballot(key[e] == T) : 0ull;
                const bool take = ((eq >> c.lane) & 1ull) && (__popcll(eq & lt_mask) < r);
                sel[e] |= __ballot(take) | forced[e]; r -= min(r, (int)__popcll(eq)); }
            unsigned myword = 0u;
#pragma unroll
            for (int e = 0; e < 4; ++e) { myword = (c.lane == 2 * e) ? (unsigned)sel[e] : myword; myword = (c.lane == 2 * e + 1) ? (unsigned)(sel[e] >> 32) : myword; }
            if (c.lane < 8) ((LAS unsigned*)(lds + A_SELM))[(c.wave * 8 + qq) * 8 + c.lane] = myword;
            uw |= myword;
        }
        if (c.lane < 8) ((LAS unsigned*)(lds + A_UW))[c.wave * 8 + c.lane] = uw;
        __syncthreads();
        if (c.tid < 8) { unsigned u = 0u;
#pragma unroll
            for (int w = 0; w < 8; ++w) u |= ((LAS unsigned*)(lds + A_UW))[w * 8 + c.tid];
            ((LAS unsigned*)(lds + A_UB))[c.tid] = u; }
        __syncthreads();
        if (c.tid < 256) { const LAS unsigned* ub = (const LAS unsigned*)(lds + A_UB); const int wj = c.tid >> 5, bj = c.tid & 31; int pos = 0;
#pragma unroll
            for (int w = 0; w < 8; ++w) { const unsigned x = ub[w]; pos += (w < wj) ? __popc(x) : 0; }
            const unsigned xw = ub[wj]; pos += __popc(xw & ((1u << bj) - 1u));
            if ((xw >> bj) & 1u) ((LAS int*)(lds + A_TL))[pos] = c.tid; }
        __syncthreads();
    }
    bf16x8 qr[2][2];
#pragma unroll
    for (int s = 0; s < 2; ++s) {
        const bf16_t* qp = T.Q + (tokbase + tq[s]) * D + (g * 4 + c.h) * 64 + 8 * c.quad;
        const bf16x8 q0 = *(const bf16x8*)qp, q1 = *(const bf16x8*)(qp + 32);
        const f32x4* rp = (const f32x4*)(T.rope + (tokbase + tq[s]) * 32 + 8 * c.quad);
        u32x4 w0, w1;
#pragma unroll
        for (int p = 0; p < 4; ++p) { const f32x4 cs = rp[p];
            const float a0 = bf2f((unsigned short)q0[2 * p]), a1 = bf2f((unsigned short)q0[2 * p + 1]), b0 = bf2f((unsigned short)q1[2 * p]), b1 = bf2f((unsigned short)q1[2 * p + 1]);
            w0[p] = pk2(a0 * cs[0] - b0 * cs[1], a1 * cs[2] - b1 * cs[3]); w1[p] = pk2(b0 * cs[0] + a0 * cs[1], b1 * cs[2] + a1 * cs[3]); }
        qr[s][0] = __builtin_bit_cast(bf16x8, w0); qr[s][1] = __builtin_bit_cast(bf16x8, w1);
    }
    {
        const LAS unsigned* ub = (const LAS unsigned*)(lds + A_UB); int nsel = 0;
#pragma unroll
        for (int w = 0; w < 8; ++w) nsel += __popc(ub[w]);
        nsel = __builtin_amdgcn_readfirstlane(nsel);
        const LAS int* TL = (const LAS int*)(lds + A_TL); const LAS unsigned* selm = (const LAS unsigned*)(lds + A_SELM);
        const bf16_t* Ks = T.KS + (size_t)bg * SEQ * 64; const bf16_t* Vs = T.VTS + (size_t)bg * 64 * SEQ;
        RESET_ST();
#define KPTR Ks
#define VPTR Vs
#define VPITCH SEQ
#define TILE_S(i) (64 * __builtin_amdgcn_readfirstlane(TL[(i)]))
#define BODY_S(i, so) do { const int j = __builtin_amdgcn_readfirstlane(TL[(i)]); \
        _Pragma("unroll") for (int s = 0; s < 2; ++s) { const unsigned w = selm[(c.wave * 8 + 4 * s + c.qi) * 8 + (j >> 5)]; const bool sel = (w >> (j & 31)) & 1u; \
            lo[s] = 0; hi[s] = tq[s] - 64 * j; rowsel[s] = sel; act[s] = __any(sel ? 1 : 0) != 0; } \
        tile_compute<2>(c, so, qr, st, lo, hi, rowsel, act, 64 * j, invl); } while (0)
#if SEL_INVERTED
        if (!(ATT_SKIP & 4)) {
            const int nforced = qt >= 2 ? 3 : qt + 1;
#define TILE_F(i) (64 * ((i) == 0 ? 0 : ((i) == nforced - 1 ? qt : qt - 1)))
#define BODY_F(i, so) do { const int j = ((i) == 0 ? 0 : ((i) == nforced - 1 ? qt : qt - 1)); \
        _Pragma("unroll") for (int s = 0; s < 2; ++s) { lo[s] = 0; hi[s] = tq[s] - 64 * j; rowsel[s] = true; act[s] = true; } \
        tile_compute<2>(c, so, qr, st, lo, hi, rowsel, act, 64 * j, invl); } while (0)
            { const TileForced tf{nforced, qt}; dense_tiles<2, true>(c, dma, lds, Ks, Vs, SEQ, nforced, tf, MaskCausal{tq[0], tq[1], tf}, qr, st, invl); }
            selected_inverted(c, T, lds, qr, st, t0, bg, qt);
        }
#else
        if (!(ATT_SKIP & 4)) NSA_RING_B4(nsel, TILE_S, BODY_S);
#endif
#undef KPTR
#undef VPTR
#pragma unroll
        for (int s = 0; s < 2; ++s) { const float l = st[s].L; const float fn = (l > 0.f ? 1.0f / l : 0.f), f = fn * NSA_GATE(s, 1);
#if NSA_CHECK
            if (NSA_CHECK_BR == 1) { bf16_t* op = T.DBG + (tokbase + tq[s]) * D + (g * 4 + c.h) * 64 + 4 * c.quad;
#pragma unroll
                for (int db = 0; db < 4; ++db) *(u32x2*)(op + 16 * db) = pack4(st[s].O[db] * fn); }
#endif
#pragma unroll
            for (int db = 0; db < 4; ++db) { f32x4* p = (f32x4*)(scr0 + s * 4 * 256 + 16 * db); *p = *p + st[s].O[db] * f; } }
    }
    {
        const bf16_t* Kw = T.KW + (size_t)bg * SEQ * 64; const bf16_t* Vw = T.VTW + (size_t)bg * 64 * SEQ;
        const int kt1 = qt, kt0 = max(0, qt - 8), nw = kt1 - kt0 + 1;
        RESET_ST();
#define KPTR Kw
#define VPTR Vw
#define TILE_W(i) (64 * (kt0 + (i)))
#define BODY_W(i, so) do { const int k0 = 64 * (kt0 + (i)); \
        _Pragma("unroll") for (int s = 0; s < 2; ++s) { hi[s] = tq[s] - k0; lo[s] = tq[s] - 511 - k0; act[s] = true; } \
        tile_compute<3>(c, so, qr, st, lo, hi, rowsel, act, k0, invl); } while (0)
        if (!(ATT_SKIP & 8)) dense_tiles<3, true>(c, dma, lds, Kw, Vw, SEQ, nw, TileLin{kt0}, MaskWin{tq[0], tq[1], kt0}, qr, st, invl);
#undef KPTR
#undef VPTR
#undef VPITCH
#pragma unroll
        for (int s = 0; s < 2; ++s) { const float l = st[s].L; const float fn = (l > 0.f ? 1.0f / l : 0.f), f = fn * NSA_GATE(s, 2);
#if NSA_CHECK
            if (NSA_CHECK_BR == 2) { bf16_t* op = T.DBG + (tokbase + tq[s]) * D + (g * 4 + c.h) * 64 + 4 * c.quad;
#pragma unroll
                for (int db = 0; db < 4; ++db) *(u32x2*)(op + 16 * db) = pack4(st[s].O[db] * fn); }
#endif
            bf16_t* op = T.O + (tokbase + tq[s]) * D + (g * 4 + c.h) * 64 + 4 * c.quad;
#pragma unroll
            for (int db = 0; db < 4; ++db) { const f32x4 v = *(const f32x4*)(scr0 + s * 4 * 256 + 16 * db) + st[s].O[db] * f; *(u32x2*)(op + 16 * db) = pack4(v); } }
    }
#undef RESET_ST
#undef NSA_GATE
}
}


#if NSA_CHECK
namespace chk {
__constant__ int tlist[24] = {0, 1, 30, 31, 32, 47, 63, 64, 65, 79, 127, 128, 510, 511, 512, 513, 1023, 1024, 1025, 1087, 4095, 4096, 8191, 16383};
__device__ __forceinline__ float blk_max(float v, LAS float* red, int tid) {
#pragma unroll
    for (int o = 1; o < 64; o <<= 1) v = fmaxf(v, __shfl_xor(v, o));
    __syncthreads(); if ((tid & 63) == 0) red[tid >> 6] = v; __syncthreads();
    float r = red[0]; for (int w = 1; w < 8; ++w) r = fmaxf(r, red[w]); __syncthreads(); return r; }
__device__ __forceinline__ float blk_sum(float v, LAS float* red, int tid) {
#pragma unroll
    for (int o = 1; o < 64; o <<= 1) v += __shfl_xor(v, o);
    __syncthreads(); if ((tid & 63) == 0) red[tid >> 6] = v; __syncthreads();
    float r = 0.f; for (int w = 0; w < 8; ++w) r += red[w]; __syncthreads(); return r; }

__device__ __forceinline__ void check_sample(const nsa::Tensors& T, LAS unsigned char* lds, int tid, int b, int g, int t, unsigned* flag) {
    LAS float* sc = (LAS float*)lds;
    LAS float* qf = sc + 4096;
    LAS float* oacc = qf + 512;
    LAS float* score = oacc + 768;
    LAS int* sel = (LAS int*)(score + 256);
    LAS float* red = (LAS float*)(sel + 16);
    const int bg = b * 4 + g; const size_t tok = (size_t)b * SEQ + t;
    if (tid < 256) { const int h = tid >> 6, d = tid & 63;
        const float q = bf2f(T.Q[tok * D + (g * 4 + h) * 64 + d]);
        const int dd = d & 31; const f32x2 cs = T.rope[tok * 32 + dd]; const float qo = bf2f(T.Q[tok * D + (g * 4 + h) * 64 + (d < 32 ? d + 32 : d - 32)]);
        const float r = d < 32 ? q * cs[0] - qo * cs[1] : q * cs[0] + qo * cs[1];
        qf[h * 64 + d] = q; qf[256 + h * 64 + d] = bf2f((unsigned short)f2bf(r)); }
    __syncthreads();
    const bf16_t* Kc = T.KCMP + (size_t)bg * 1024 * 64; const bf16_t* Vc = T.VCMPT + (size_t)bg * 64 * 1024;
    for (int i = tid; i < 4096; i += 512) { const int h = i >> 10, c = i & 1023; float s = -INFINITY;
        if (c < 1023 && 16 * c + 31 <= t) { s = 0.f; for (int d = 0; d < 64; ++d) s += qf[h * 64 + d] * bf2f(Kc[(size_t)c * 64 + d]); }
        sc[i] = s; }
    __syncthreads();
    for (int h = 0; h < 4; ++h) {
        float m = -INFINITY; for (int c = tid; c < 1024; c += 512) m = fmaxf(m, sc[h * 1024 + c]);
        m = blk_max(m, red, tid); if (m == -INFINITY) m = 0.f;
        float l = 0.f; for (int c = tid; c < 1024; c += 512) l += exp2f(sc[h * 1024 + c] - m);
        l = blk_sum(l, red, tid); l = fmaxf(l, 1e-30f);
        for (int c = tid; c < 1024; c += 512) sc[h * 1024 + c] = exp2f(sc[h * 1024 + c] - m) / l;
        __syncthreads();
    }
    if (tid < 256) { const int h = tid >> 6, d = tid & 63; float o = 0.f;
        for (int c = 0; c < 1023; ++c) o += bf2f((unsigned short)f2bf(sc[h * 1024 + c])) * bf2f(Vc[(size_t)d * 1024 + c]);
        oacc[h * 64 + d] = o; }
    if (tid < 256) { const int j = tid; float im = 0.f;
        for (int h = 0; h < 4; ++h) for (int c = 4 * j - 1; c <= 4 * j + 3; ++c) if (c >= 0 && c < 1023) {
            const int c0 = 16 * c, j0 = 64 * j; int ov = min(c0 + 32, j0 + 64) - max(c0, j0); if (ov < 0) ov = 0;
            im += sc[h * 1024 + c] * ((float)ov / 32.0f); }
        const int cur = t >> 6; const bool valid = 64 * j <= t, forced = (j == 0) || (j == cur) || (j == cur - 1);
        score[j] = valid ? im + (forced ? 1000.0f : 0.0f) : -1.0f; }
    __syncthreads();
    if (tid == 0) { for (int n = 0; n < 16; ++n) { int bi = 0; float bv = -INFINITY; for (int j = 0; j < 256; ++j) if (score[j] > bv) { bv = score[j]; bi = j; } sel[n] = bi; score[bi] = -INFINITY; } }
    __syncthreads();
    const bf16_t* Ks = T.KS + (size_t)bg * SEQ * 64; const bf16_t* Vs = T.VTS + (size_t)bg * 64 * SEQ;
    for (int i = tid; i < 4096; i += 512) { const int h = i >> 10, n = (i >> 6) & 15, k = i & 63; const int kpos = sel[n] * 64 + k; float s = -INFINITY;
        if (kpos <= t) { s = 0.f; for (int d = 0; d < 64; ++d) s += qf[256 + h * 64 + d] * bf2f(Ks[(size_t)kpos * 64 + d]); }
        sc[i] = s; }
    __syncthreads();
    for (int h = 0; h < 4; ++h) {
        float m = -INFINITY; for (int c = tid; c < 1024; c += 512) m = fmaxf(m, sc[h * 1024 + c]);
        m = blk_max(m, red, tid); if (m == -INFINITY) m = 0.f;
        float l = 0.f; for (int c = tid; c < 1024; c += 512) l += exp2f(sc[h * 1024 + c] - m);
        l = blk_sum(l, red, tid); l = fmaxf(l, 1e-30f);
        for (int c = tid; c < 1024; c += 512) sc[h * 1024 + c] = exp2f(sc[h * 1024 + c] - m) / l;
        __syncthreads();
    }
    if (tid < 256) { const int h = tid >> 6, d = tid & 63; float o = 0.f;
        for (int i = 0; i < 1024; ++i) { const float p = sc[h * 1024 + i]; if (p != 0.f) { const int kpos = sel[i >> 6] * 64 + (i & 63); o += bf2f((unsigned short)f2bf(p)) * bf2f(Vs[(size_t)d * SEQ + kpos]); } }
        oacc[256 + h * 64 + d] = o; }
    __syncthreads();
    const bf16_t* Kw = T.KW + (size_t)bg * SEQ * 64; const bf16_t* Vw = T.VTW + (size_t)bg * 64 * SEQ;
    for (int i = tid; i < 4096; i += 512) { const int h = i >> 10, k = i & 1023; const int kpos = t - 511 + k; float s = -INFINITY;
        if (k < 512 && kpos >= 0) { s = 0.f; for (int d = 0; d < 64; ++d) s += qf[256 + h * 64 + d] * bf2f(Kw[(size_t)kpos * 64 + d]); }
        sc[i] = s; }
    __syncthreads();
    for (int h = 0; h < 4; ++h) {
        float m = -INFINITY; for (int c = tid; c < 1024; c += 512) m = fmaxf(m, sc[h * 1024 + c]);
        m = blk_max(m, red, tid); if (m == -INFINITY) m = 0.f;
        float l = 0.f; for (int c = tid; c < 1024; c += 512) l += exp2f(sc[h * 1024 + c] - m);
        l = blk_sum(l, red, tid); l = fmaxf(l, 1e-30f);
        for (int c = tid; c < 1024; c += 512) sc[h * 1024 + c] = exp2f(sc[h * 1024 + c] - m) / l;
        __syncthreads();
    }
    if (tid < 256) { const int h = tid >> 6, d = tid & 63; float o = 0.f;
        for (int k = 0; k < 512; ++k) { const float p = sc[h * 1024 + k]; if (p != 0.f) o += bf2f((unsigned short)f2bf(p)) * bf2f(Vw[(size_t)d * SEQ + (t - 511 + k)]); }
        oacc[512 + h * 64 + d] = o; }
    __syncthreads();
    if (tid == 0) red[0] = 0.f;
    __syncthreads();
    if (tid < 256) { const int h = tid >> 6, d = tid & 63; const float* gt = T.gates + tok * 48 + (g * 4 + h) * 3;
        float ref = gt[0] * oacc[h * 64 + d] + gt[1] * oacc[256 + h * 64 + d] + gt[2] * oacc[512 + h * 64 + d];
        float got = bf2f(T.O[tok * D + (g * 4 + h) * 64 + d]);
        if (NSA_CHECK_BR >= 0) { ref = oacc[NSA_CHECK_BR * 256 + h * 64 + d]; got = bf2f(T.DBG[tok * D + (g * 4 + h) * 64 + d]); }
        sc[tid] = ref * ref; sc[256 + tid] = got; sc[512 + tid] = ref; }
    __syncthreads();
    if (tid < 256) { const int h = tid >> 6; float ms = 0.f; for (int d2 = 0; d2 < 64; ++d2) ms += sc[h * 64 + d2]; const float rms = sqrtf(ms * (1.0f / 64.0f));
        const float got = sc[256 + tid], ref = sc[512 + tid];
        const float tol = NSA_CHECK_ABS * rms + NSA_CHECK_REL * fabsf(ref);
        if (!(fabsf(got - ref) <= tol)) red[0] = 1.0f; }
    __syncthreads();
    if (tid == 0 && red[0] != 0.f) atomicAdd(flag, 1u);
    __syncthreads();
}

__device__ __forceinline__ bool near(float got, float ref, float rms) { return fabsf(got - ref) <= 0.02f * rms + 0.015f * fabsf(ref); }
__device__ __forceinline__ void check_proj(const Args& a, const nsa::Tensors& T, unsigned char* ws, const float* X, LAS unsigned char* lds, int tid, int smp, unsigned* flag) {
    LAS float* hk = (LAS float*)lds;
    LAS float* hq = hk + 1024;
    LAS float* val = hq + 1024;
    LAS float* red = val + 512;
    LAS float* hid = red + 8;
    LAS float* blk = hid + 256;
    unsigned hsh = (unsigned)smp * 2654435761u + 12345u; hsh ^= hsh >> 15; hsh *= 2246822519u; hsh ^= hsh >> 13;
    const int tok = (int)(hsh % NT), b = tok >> 14, sp = tok & (SEQ - 1), g = (hsh >> 17) & 3, hh = (hsh >> 19) & 15;
    if (tid == 0) red[0] = 0.f;
    float ss = 0.f; for (int k = tid; k < 1024; k += 512) { const float v = X[(size_t)tok * D + k]; ss += v * v; }
    ss = blk_sum(ss, red + 1, tid); const float r = 1.0f / sqrtf(ss * (1.0f / D) + RMS_EPS);
    for (int k = tid; k < 1024; k += 512) { const float v = X[(size_t)tok * D + k] * r; hk[k] = v * a.in[I_NKV][k]; hq[k] = v * a.in[I_NMIX][D + k]; }
    __syncthreads();
    const float pos = (float)((const int*)a.in[I_POS])[tok];
    bool bad = false;
    for (int slot = 0; slot < 6; ++slot) {
        if (tid < 64) { float s_ = 0.f; const float* w = a.in[I_WKV] + slot * 256 + g * 64 + tid; for (int k = 0; k < 1024; ++k) s_ += hk[k] * w[(size_t)k * 1536]; val[tid] = s_; }
        __syncthreads();
        if (tid < 64) { float v = val[tid];
            if (slot == 2 || slot == 4) { const int i = tid & 31; const float ang = pos * a.inv_freq[i]; float sn, cs; sincosf(ang, &sn, &cs); const float t1 = val[i], t2 = val[i + 32]; v = tid < 32 ? t1 * cs - t2 * sn : t2 * cs + t1 * sn; }
            float got; const size_t bg = (size_t)(b * 4 + g);
            if (slot == 3 || slot == 5) got = bf2f(((const bf16_t*)(ws + WS_RD + (size_t)slot * KVSTRIDE))[(bg * 64 + tid) * SEQ + sp]);
            else got = bf2f(((const bf16_t*)(ws + WS_RD + (size_t)slot * KVSTRIDE))[(bg * SEQ + sp) * 64 + tid]);
            if (!near(got, v, 1.0f)) bad = true; }
        __syncthreads();
    }
    if (tid < 112) { const int col = tid < 64 ? hh * 64 + tid : 1024 + (tid - 64); float s_ = 0.f; const float* w = a.in[I_AWIN] + col; for (int k = 0; k < 1024; ++k) s_ += hq[k] * w[(size_t)k * 1072];
        if (tid < 64) { if (!near(bf2f(T.Q[(size_t)tok * D + hh * 64 + tid]), s_ * (0.125f * 1.4426950408889634f), 0.18f)) bad = true; }
        else { const float gt = 1.0f / (1.0f + expf(-s_)); if (!near(T.gates[(size_t)tok * 48 + (tid - 64)], gt, 0.25f)) bad = true; } }
    const int c = (int)((hsh >> 8) % 1023);
    for (int kv = 0; kv < 2; ++kv) {
        const bf16_t* src = (const bf16_t*)(ws + WS_RD + (kv ? RD_VC : RD_KC)) + ((size_t)(b * 4 + g) * SEQ + 16 * c) * 64; const float* pe = a.in[kv ? I_CPV : I_CPK];
        for (int i = tid; i < 2048; i += 512) blk[i] = bf2f(src[i]) + pe[i];
        __syncthreads();
        if (tid < 256) { float s_ = 0.f; const float* w1 = a.in[kv ? I_CW1V : I_CW1K] + tid; for (int i = 0; i < 2048; ++i) s_ += blk[i] * w1[(size_t)i * 256];
            const float y = 0.7978845608028654f * (s_ + 0.044715f * s_ * s_ * s_); hid[tid] = 0.5f * s_ * (1.0f + tanhf(y)); }
        __syncthreads();
        if (tid < 64) { float s_ = 0.f; const float* w2 = a.in[kv ? I_CW2V : I_CW2K] + tid; for (int n = 0; n < 256; ++n) s_ += hid[n] * w2[n * 64];
            const float got = kv ? bf2f(T.VCMPT[((size_t)(b * 4 + g) * 64 + tid) * 1024 + c]) : bf2f(T.KCMP[((size_t)(b * 4 + g) * 1024 + c) * 64 + tid]);
            if (!near(got, s_, 0.5f)) bad = true; }
        __syncthreads();
    }
    if (bad) red[0] = 1.0f;
    __syncthreads();
    if (tid == 0 && red[0] != 0.f) atomicAdd(flag, 1u);
    __syncthreads();
}
}
#endif

#define XB_TMO      128
#define XB_XCNT(j)  (256  + 64 * (j))
#define XB_XSUB(j)  (1280 + 64 * (j))
#define XB_XGEN(j)  (2304 + 64 * (j))
#define XB_TOP      3328
#define XB_TOPGEN   3392
#define XCD_BAR_WORDS 3456
#define XB_SPIN_CAP (1u << 22)
__device__ __forceinline__ unsigned xb_ld(unsigned* p)              { return __hip_atomic_load(p, __ATOMIC_RELAXED, __HIP_MEMORY_SCOPE_AGENT); }
__device__ __forceinline__ unsigned xb_add(unsigned* p, unsigned v) { return __hip_atomic_fetch_add(p, v, __ATOMIC_RELAXED, __HIP_MEMORY_SCOPE_AGENT); }
__device__ __forceinline__ unsigned xb_xcc_id() { return (unsigned)__builtin_amdgcn_s_getreg((3 << 11) | 20) & 0xFu; }
#define XB_SPIN(cond, bar) do { unsigned _sp = 0; while (cond) { __builtin_amdgcn_s_sleep(1); \
    if ((++_sp & 255u) == 0u) { if (xb_ld(&(bar)[XB_TMO])) break; if (_sp > XB_SPIN_CAP) { atomicAdd(&(bar)[XB_TMO], 1u); break; } } } } while (0)
struct XcdBarrier { unsigned* bar; unsigned x; volatile LAS unsigned* st; };
__device__ __forceinline__ XcdBarrier xcd_barrier_post(unsigned* bar, volatile LAS unsigned* st, bool t0) {
    XcdBarrier b; b.bar = bar; b.x = xb_xcc_id(); b.st = st;
    if (t0) (void)xb_add(&bar[XB_XCNT(b.x)], 1u);
    return b;
}
__device__ __forceinline__ void xcd_barrier_complete(unsigned* bar, unsigned x, unsigned& nloc, unsigned& nx) {
    const unsigned G = gridDim.x;
    unsigned sum, cnt, mine, sp = 0u;
    for (;;) {
        sum = 0u; cnt = 0u; mine = 0u;
#pragma unroll
        for (unsigned j = 0; j < 16; ++j) { const unsigned c = xb_ld(&bar[XB_XCNT(j)]); sum += c; cnt += (c > 0u) ? 1u : 0u; mine = (j == x) ? c : mine; }
        if (sum == G) break;
        __builtin_amdgcn_s_sleep(1);
        if ((++sp & 255u) == 0u) { if (xb_ld(&bar[XB_TMO])) break; if (sp > XB_SPIN_CAP) { atomicAdd(&bar[XB_TMO], 1u); break; } }
    }
    nloc = mine > 0u ? mine : 1u; nx = cnt > 0u ? cnt : 1u;
}
__device__ __forceinline__ void xcd_barrier(const XcdBarrier& b, bool t0) {
    asm volatile("s_waitcnt vmcnt(0)" ::: "memory");
    __syncthreads();
    if (t0) {
        unsigned* bar = b.bar;
        __builtin_amdgcn_s_waitcnt(0);
        unsigned nloc = b.st[0], nx = b.st[1];
        if (nloc == 0u) { xcd_barrier_complete(bar, b.x, nloc, nx); b.st[0] = nloc; b.st[1] = nx; }
        const unsigned old = xb_add(&bar[XB_XSUB(b.x)], 1u);
        const unsigned gen = old / nloc;
        if (old + 1u == (gen + 1u) * nloc) {
            __builtin_amdgcn_fence(__ATOMIC_RELEASE, "agent");
            asm volatile("s_waitcnt vmcnt(0)" ::: "memory");
            const unsigned og = xb_add(&bar[XB_TOP], 1u);
            const unsigned tg = og / nx;
            if (og + 1u == (tg + 1u) * nx) xb_add(&bar[XB_TOPGEN], 1u);
            else XB_SPIN(xb_ld(&bar[XB_TOPGEN]) == tg, bar);
            __builtin_amdgcn_fence(__ATOMIC_ACQUIRE, "agent");
            xb_add(&bar[XB_XGEN(b.x)], 1u);
            asm volatile("s_waitcnt vmcnt(0)" ::: "memory");
        } else {
            XB_SPIN(xb_ld(&bar[XB_XGEN(b.x)]) == gen, bar);
            __builtin_amdgcn_fence(__ATOMIC_ACQUIRE, "agent");
            asm volatile("s_waitcnt vmcnt(0)" ::: "memory");
        }
    }
    __syncthreads();
}

__device__ __forceinline__ MoeTab moe_tables(const Frame& F0, int layer) {
    const Frame F = refresh(F0);
    MoeTab T; T.tstart = (volatile LAS int*)(F.lds + MISC_OFF); T.cnt = T.tstart + 64;
    const unsigned* gcnt = (const unsigned*)(F.ws + WS_CTL) + CW_CNT + layer * 32;
    __syncthreads();
    if (F.tid < 32) T.cnt[F.tid] = (int)__hip_atomic_load(gcnt + F.tid, __ATOMIC_RELAXED, __HIP_MEMORY_SCOPE_AGENT);
    __syncthreads();
    if (F.tid == 0) { int acc = 0; for (int e = 0; e < 32; ++e) { T.tstart[e] = acc; acc += (T.cnt[e] + 255) >> 8; } T.tstart[32] = acc; }
    __syncthreads();
    return T;
}

constexpr int N_PHASES = 17;
__global__ void __launch_bounds__(NTHREADS, 2) nsa_fwd(Args args) {
    extern __shared__ __attribute__((aligned(16))) unsigned char lds_raw[];
    cg::grid_group grid = cg::this_grid();
    Frame F; F.lds = (LAS unsigned char*)lds_raw; F.ws = args.ws;
    { const int t = threadIdx.x; F.wave = __builtin_amdgcn_readfirstlane(t >> 6); F.tid = t; F.lane = t & 63; }
    F.G = gridDim.x; { const int bx = blockIdx.x; F.vcu = (F.G % 8 == 0) ? (bx % 8) * (F.G / 8) + bx / 8 : bx; }
    unsigned char* ws = args.ws;
    float* X = args.out;
    const int lo = args.ph_lo, hi = args.ph_hi;
    volatile LAS unsigned* bst = (volatile LAS unsigned*)(F.lds + MISC_OFF + 1024);
    if (F.tid < 2) bst[F.tid] = 0u;
    __syncthreads();
    XcdBarrier xb; xb.bar = (unsigned*)(ws + WS_CTL) + CW_BAR; xb.x = 0; xb.st = bst;
    if (hi - lo > 1) xb = xcd_barrier_post((unsigned*)(ws + WS_CTL) + CW_BAR, bst, F.tid == 0);
#ifndef PH_MASK
#define PH_MASK 0x1ffff
#endif
#ifndef REPEAT_MASK
#define REPEAT_MASK 0
#endif
#define REPS(k) (1 + ((REPEAT_MASK >> (k)) & 1))
#define IN(k) (((PH_MASK >> (k)) & 1) && lo <= (k) && (k) < hi)
#if PROBE_PHASE >= 0
    unsigned long long ph_t0 = __builtin_amdgcn_s_memrealtime(), ph_dur = 0ull;
#define PH_STAMP(k) do { const unsigned long long now_ = __builtin_amdgcn_s_memrealtime(); if ((k) == PROBE_PHASE) ph_dur = now_ - ph_t0; ph_t0 = now_; } while (0)
#else
#define PH_STAMP(k) do {} while (0)
#endif
#define SEAM(k) do { if (IN(k) && IN((k) + 1)) { if ((k) == 0) grid.sync(); else xcd_barrier(xb, mytid(F) == 0); } PH_STAMP(k); } while (0)
    LAS unsigned char* ring = F.lds;

    if (IN(0)) for (int rep_ = 0; rep_ < REPS(0); ++rep_) { phase_prep(args, F); } SEAM(0);
    if (IN(1)) for (int rep_ = 0; rep_ < REPS(1); ++rep_) {
        DenseOrder S; S.init(ws + WS_RA, ws + WS_WIN, NT, 3 * D, D, D, F.G, (int)blockIdx.x);
        EpiInProj E{(const float*)(ws + WS_R0), (bf16_t*)(ws + WS_RB), (bf16_t*)(ws + WS_RC)};
        pg8::gemm_phase<EpiInProj, DenseOrder, false>(ring, mytid(F), pg8::Gemm{D, D}, S, E);
    } SEAM(1);
#ifdef EXTRA_BARS
    for (int eb_ = 0; eb_ < EXTRA_BARS; ++eb_) xcd_barrier(xb, mytid(F) == 0);
#endif
    if (IN(2)) for (int rep_ = 0; rep_ < REPS(2); ++rep_) { phase_conv(args, F); } SEAM(2);
    if (IN(3)) for (int rep_ = 0; rep_ < REPS(3); ++rep_) {
        DenseOrder S; S.init(ws + WS_RA, ws + WS_WOUT, NT, D, D, D, F.G, (int)blockIdx.x);
        EpiResid E{args.in[I_X], X};
        pg8::gemm_phase<EpiResid, DenseOrder, false>(ring, mytid(F), pg8::Gemm{D, D}, S, E);
    } SEAM(3);
    {
        if (IN(4)) for (int rep_ = 0; rep_ < REPS(4); ++rep_) { phase_router(args, F, 0, X, (bf16_t*)(ws + WS_RA), (float*)(ws + WS_R1)); } SEAM(4);
        if (IN(5)) for (int rep_ = 0; rep_ < REPS(5); ++rep_) {
            MoeTab T = moe_tables(F, 0);
            MoeGuOrder S{T, (const char*)(ws + WS_RA), (const int*)(ws + WS_ROWL), (const char*)(ws + WS_EXPW), F.G, F.vcu};
            EpiGU E{T, (const float*)(ws + WS_ROWR), (bf16_t*)(ws + WS_RD)};
            pg8::gemm_phase<EpiGU, MoeGuOrder, true>(ring, mytid(F), pg8::Gemm{D, D}, S, E);
        } SEAM(5);
        if (IN(6)) for (int rep_ = 0; rep_ < REPS(6); ++rep_) {
            MoeTab T = moe_tables(F, 0);
            MoeDnOrder S{T, (const char*)(ws + WS_RD), (const char*)(ws + WS_EXPW), F.G, F.vcu};
            EpiDN E{(const int*)(ws + WS_ROWL), (const float*)(ws + WS_WGT), (bf16_t*)(ws + WS_RB)};
            pg8::gemm_phase<EpiDN, MoeDnOrder, false>(ring, mytid(F), pg8::Gemm{DE, DE}, S, E);
        } SEAM(6);
    }
    {
            if (IN(7)) for (int rep_ = 0; rep_ < REPS(7); ++rep_) { phase_combine<false>(args, F, X, (bf16_t*)(ws + WS_RA), (float*)(ws + WS_R2)); } SEAM(7);
            if (IN(8)) for (int rep_ = 0; rep_ < REPS(8); ++rep_) {
                DenseOrder S; S.init(ws + WS_RA, ws + WS_WQKV, NT, NQKV, D, D, F.G, (int)blockIdx.x);
                EpiQKV E{(const float*)(ws + WS_R2), (const f32x2*)(ws + WS_ROPE), ws + WS_RD, (bf16_t*)(ws + WS_RC), (float*)(ws + WS_GATES)};
                pg8::gemm_phase<EpiQKV, DenseOrder, false>(ring, mytid(F), pg8::Gemm{D, D}, S, E);
            } SEAM(8);
            if (IN(9)) for (int rep_ = 0; rep_ < REPS(9); ++rep_) {
                CmpOrder S{(const char*)(ws + WS_RD + RD_KC), (const char*)(ws + WS_RD + RD_VC), (const char*)(ws + WS_WC1), F.G, (int)blockIdx.x};
                EpiCmp1 E{(const float*)(ws + WS_BIASC), (bf16_t*)(ws + WS_RD + RD_HID)};
                pg8::gemm_phase<EpiCmp1, CmpOrder, false>(ring, mytid(F), pg8::Gemm{2048, 1024}, S, E);
                const Frame F9 = refresh(F); LAS float* scr = (LAS float*)(F.lds + F.wave * 16384);
                if (F.G > 64) { if ((int)blockIdx.x >= 64) convert_experts(args, F9, 1, ((int)blockIdx.x - 64) * NWAVES + F.wave, (F.G - 64) * NWAVES, scr); }
                else convert_experts(args, F9, 1, (int)blockIdx.x * NWAVES + F.wave, F.G * NWAVES, scr);
            } SEAM(9);
            if (IN(10)) for (int rep_ = 0; rep_ < REPS(10); ++rep_) { phase_cmp2(F); } SEAM(10);
            if (IN(11)) for (int rep_ = 0; rep_ < REPS(11); ++rep_) {
                nsa::Tensors T{(const bf16_t*)(ws + WS_RC), (const f32x2*)(ws + WS_ROPE), (const float*)(ws + WS_GATES),
                               (const bf16_t*)(ws + WS_RD + RD_KS), (const bf16_t*)(ws + WS_RD + RD_VTS), (const bf16_t*)(ws + WS_RD + RD_KW), (const bf16_t*)(ws + WS_RD + RD_VTW),
                               (const bf16_t*)(ws + WS_RD + RD_KCMP), (const bf16_t*)(ws + WS_RD + RD_VCMPT), (bf16_t*)(ws + WS_RB), (bf16_t*)(ws + WS_RA), (float*)(ws + WS_ATTS) + (size_t)blockIdx.x * 64 * 256, (float*)(ws + WS_CTL) + 2049};
                if (F.G % 8 == 0) { const int bg = (int)blockIdx.x & 7, per = F.G >> 3;
                    for (int q = (int)blockIdx.x >> 3; q < 256; q += per) nsa::attn_unit(T, ring, mytid(F), bg >> 2, bg & 3, 255 - q); }
                else for (int u = (int)blockIdx.x; u < 2048; u += F.G) { const int qt = 255 - (u >> 3), bg = u & 7; nsa::attn_unit(T, ring, mytid(F), bg >> 2, bg & 3, qt); }
            } SEAM(11);
            if (IN(12)) for (int rep_ = 0; rep_ < REPS(12); ++rep_) {
#if NSA_CHECK
                { nsa::Tensors T{(const bf16_t*)(ws + WS_RC), (const f32x2*)(ws + WS_ROPE), (const float*)(ws + WS_GATES),
                               (const bf16_t*)(ws + WS_RD + RD_KS), (const bf16_t*)(ws + WS_RD + RD_VTS), (const bf16_t*)(ws + WS_RD + RD_KW), (const bf16_t*)(ws + WS_RD + RD_VTW),
                               (const bf16_t*)(ws + WS_RD + RD_KCMP), (const bf16_t*)(ws + WS_RD + RD_VCMPT), (bf16_t*)(ws + WS_RB), (bf16_t*)(ws + WS_RA), (float*)(ws + WS_ATTS) + (size_t)blockIdx.x * 64 * 256, (float*)(ws + WS_CTL) + 2049};
                  for (int smp = (int)blockIdx.x; smp < NSA_CHECK_N; smp += F.G) { unsigned hsh = (unsigned)smp * 2654435761u; hsh ^= hsh >> 15; hsh *= 2246822519u; hsh ^= hsh >> 13;
                      int t = (smp < 192) ? chk::tlist[smp % 24] : (int)(hsh % SEQ); const int bgs = (smp < 192) ? (smp / 24) : (int)((hsh >> 20) & 7);
                      chk::check_sample(T, ring, mytid(F), bgs >> 2, bgs & 3, t, (unsigned*)(ws + WS_CTL) + 2048); }
                  __syncthreads();
                  if (NSA_CHECK_PROJ) for (int smp = (int)blockIdx.x; smp < 512; smp += F.G) chk::check_proj(args, T, ws, X, ring, mytid(F), smp, (unsigned*)(ws + WS_CTL) + 2048);
                  __syncthreads(); }
#endif
                DenseOrder S; S.init(ws + WS_RB, ws + WS_WAO, NT, D, D, D, F.G, (int)blockIdx.x);
                EpiResid E{X, X};
                pg8::gemm_phase<EpiResid, DenseOrder, false>(ring, mytid(F), pg8::Gemm{D, D}, S, E);
            } SEAM(12);
    }
    {
        if (IN(13)) for (int rep_ = 0; rep_ < REPS(13); ++rep_) { phase_router(args, F, 1, X, (bf16_t*)(ws + WS_RA), (float*)(ws + WS_R3)); } SEAM(13);
        if (IN(14)) for (int rep_ = 0; rep_ < REPS(14); ++rep_) {
            MoeTab T = moe_tables(F, 1);
            MoeGuOrder S{T, (const char*)(ws + WS_RA), (const int*)(ws + WS_ROWL), (const char*)(ws + WS_EXPW), F.G, F.vcu};
            EpiGU E{T, (const float*)(ws + WS_ROWR), (bf16_t*)(ws + WS_RD)};
            pg8::gemm_phase<EpiGU, MoeGuOrder, true>(ring, mytid(F), pg8::Gemm{D, D}, S, E);
        } SEAM(14);
        if (IN(15)) for (int rep_ = 0; rep_ < REPS(15); ++rep_) {
            MoeTab T = moe_tables(F, 1);
            MoeDnOrder S{T, (const char*)(ws + WS_RD), (const char*)(ws + WS_EXPW), F.G, F.vcu};
            EpiDN E{(const int*)(ws + WS_ROWL), (const float*)(ws + WS_WGT), (bf16_t*)(ws + WS_RB)};
            pg8::gemm_phase<EpiDN, MoeDnOrder, false>(ring, mytid(F), pg8::Gemm{DE, DE}, S, E);
        } SEAM(15);
    }
    if (IN(16)) for (int rep_ = 0; rep_ < REPS(16); ++rep_) { phase_combine<true>(args, F, X, nullptr, nullptr);
#if PROBE_PHASE >= 0
        PH_STAMP(16);
        if (blockIdx.x == 0 && mytid(F) == 0) { const unsigned long long t0_ = __builtin_amdgcn_s_memrealtime(); while (__builtin_amdgcn_s_memrealtime() - t0_ < ph_dur) __builtin_amdgcn_s_sleep(8); }
#endif
#if PROBE_T
        if (blockIdx.x == 0 && mytid(F) == 0) { const float nprobe = __uint_as_float(__hip_atomic_load((unsigned*)(ws + WS_CTL) + 2049, __ATOMIC_RELAXED, __HIP_MEMORY_SCOPE_AGENT));
            unsigned long long ticks = (unsigned long long)(fminf(nprobe, 2000.f) * 1000.0f); const unsigned long long t0_ = __builtin_amdgcn_s_memrealtime();
            while (__builtin_amdgcn_s_memrealtime() - t0_ < ticks) __builtin_amdgcn_s_sleep(8); }
#endif
#if NSA_CHECK
        if (blockIdx.x == 0 && mytid(F) == 0) { const unsigned nbad = __hip_atomic_load((unsigned*)(ws + WS_CTL) + 2048, __ATOMIC_RELAXED, __HIP_MEMORY_SCOPE_AGENT);
            if (nbad) { asm volatile("s_waitcnt vmcnt(0)" ::: "memory"); X[0] = 580.0f * sqrtf((float)nbad); } }
#endif
    }
#undef IN
#undef SEAM
}

extern "C" void kernel_launch(void* const* d_in, const int* in_sizes, int n_in, void* d_out, int out_size, void* d_ws, size_t ws_size, hipStream_t stream) {
    static int grid = 0;
    if (grid == 0) {
        if (n_in != 25 || out_size != NT * D || ws_size < WS_END) { fprintf(stderr, "kernel_launch: unexpected problem (n_in %d, out %d, ws %zu < %zu)\n", n_in, out_size, ws_size, (size_t)WS_END); grid = -1; return; }
        int dev = 0, cus = 0, per_cu = 0;
        hipGetDevice(&dev); hipDeviceGetAttribute(&cus, hipDeviceAttributeMultiprocessorCount, dev);
        hipFuncSetAttribute((const void*)nsa_fwd, hipFuncAttributeMaxDynamicSharedMemorySize, LDS_BYTES);
        hipOccupancyMaxActiveBlocksPerMultiprocessor(&per_cu, (const void*)nsa_fwd, NTHREADS, LDS_BYTES);
        if (per_cu < 1) { fprintf(stderr, "kernel_launch: occupancy query says %d blocks/CU\n", per_cu); per_cu = 1; }
        grid = cus;
        (void)hipGetLastError();
    }
    if (grid < 0) return;
    hipMemsetAsync((char*)d_ws + WS_CTL, 0, CTL_BYTES, stream);
    Args a{};
    for (int i = 0; i < 25; ++i) a.in[i] = (const float*)d_in[i];
    a.out = (float*)d_out; a.ws = (unsigned char*)d_ws;
    for (int i = 0; i < 32; ++i) a.inv_freq[i] = powf(10000.0f, -(float)i / 32.0f);
#if MK_PER_PHASE
    for (int p = 0; p < N_PHASES; ++p) { a.ph_lo = p; a.ph_hi = p + 1; void* kargs[] = {&a};
        hipError_t e = hipLaunchCooperativeKernel((const void*)nsa_fwd, dim3(grid), dim3(NTHREADS), kargs, LDS_BYTES, stream);
        if (e != hipSuccess) { fprintf(stderr, "launch %d failed: %s\n", p, hipGetErrorString(e)); break; } }
#else
    a.ph_lo = 0; a.ph_hi = N_PHASES; void* kargs[] = {&a};
    hipError_t e = hipLaunchCooperativeKernel((const void*)nsa_fwd, dim3(grid), dim3(NTHREADS), kargs, LDS_BYTES, stream);
    if (e != hipSuccess) fprintf(stderr, "cooperative launch failed: %s (grid %d)\n", hipGetErrorString(e), grid);
#endif
}
```

```cpp
#include <hip/hip_runtime.h>
#include <hip/hip_cooperative_groups.h>
#include <cstdio>
#include <cstdint>
#include <cmath>
namespace cg = cooperative_groups;

#define LAS __attribute__((address_space(3)))
typedef unsigned short bf16_t;
typedef short bf16x8 __attribute__((ext_vector_type(8)));
typedef short s16x4 __attribute__((ext_vector_type(4)));
typedef float f32x4 __attribute__((ext_vector_type(4)));
typedef float f32x2 __attribute__((ext_vector_type(2)));
typedef unsigned u32x4 __attribute__((ext_vector_type(4)));
typedef unsigned u32x2 __attribute__((ext_vector_type(2)));

constexpr int NB = 2, SEQ = 16384, NT = NB * SEQ, D = 1024, NG = 4, HD = 64, NH = 16;
constexpr int NE = 32, EPG = 8, DE = 512, ECAP = 65536;
constexpr int NQKV = 2816;
constexpr int NCMP = 1023, CMPH = 256;
constexpr float RMS_EPS = 1e-6f;
constexpr int NWAVES = 8, NTHREADS = 512;
#ifndef MK_PER_PHASE
#define MK_PER_PHASE 0
#endif

#ifndef PROBE_PHASE
#define PROBE_PHASE (-1)
#endif
#ifndef PROBE_T
#define PROBE_T 0
#endif
#ifndef PROBE_NOMERGE
#define PROBE_NOMERGE 0
#endif
#ifndef SEL_INVERTED
#define SEL_INVERTED 1
#endif
#ifndef ATT_SKIP
#define ATT_SKIP 0
#endif
#ifndef NSA_CHECK
#define NSA_CHECK 0
#endif
#ifndef NSA_CHECK_PROJ
#define NSA_CHECK_PROJ 1
#endif
#ifndef NSA_CHECK_BR
#define NSA_CHECK_BR (-1)
#endif
#ifndef NSA_CHECK_N
#define NSA_CHECK_N 1024
#endif
#ifndef NSA_CHECK_ABS
#define NSA_CHECK_ABS 0.012f
#endif
#ifndef NSA_CHECK_REL
#define NSA_CHECK_REL 0.01f
#endif

constexpr size_t MiB = 1u << 20, KiB = 1u << 10;
constexpr size_t WS_CTL = 0, CTL_BYTES = 64 * KiB;
constexpr size_t WS_R0 = 1 * MiB, WS_R1 = WS_R0 + 128 * KiB, WS_R2 = WS_R1 + 128 * KiB, WS_R3 = WS_R2 + 128 * KiB;
constexpr size_t WS_WGT = 2 * MiB;
constexpr size_t WS_RW = 2 * MiB + 512 * KiB;
constexpr size_t WS_BIASC = 3 * MiB;
constexpr size_t WS_W2T = 3 * MiB + 64 * KiB;
constexpr size_t WS_ROWL = 4 * MiB;
constexpr size_t WS_ROWR = 12 * MiB;
constexpr size_t WS_WIN = 20 * MiB, WS_WOUT = 26 * MiB, WS_WQKV = 28 * MiB, WS_WC1 = 34 * MiB, WS_WAO = 36 * MiB;
constexpr size_t WS_ROPE = 38 * MiB;
constexpr size_t WS_GATES = 46 * MiB;
constexpr size_t WS_EXPW = 52 * MiB;
constexpr size_t WS_RA = 148 * MiB;
constexpr size_t WS_RB = 212 * MiB;
constexpr size_t WS_RC = 276 * MiB;
constexpr size_t WS_RD = 340 * MiB;
constexpr size_t WS_ATTS = 452 * MiB;
constexpr size_t WS_END = 468 * MiB;
constexpr size_t KVSTRIDE = 17 * MiB;
constexpr size_t RD_KC = 0, RD_VC = 1 * KVSTRIDE, RD_KS = 2 * KVSTRIDE, RD_VTS = 3 * KVSTRIDE, RD_KW = 4 * KVSTRIDE, RD_VTW = 5 * KVSTRIDE;
constexpr size_t RD_HID = 102 * MiB, RD_KCMP = 110 * MiB, RD_VCMPT = 111 * MiB;
constexpr int ACT_ROWS = 2 * NT + NE * 256;
static_assert((size_t)ACT_ROWS * DE * 2 <= 72 * MiB, "ACT");
constexpr int CW_CNT = 1024, CW_BAR = 4096;

constexpr int LDS_BYTES = 151552;
constexpr int RING_BYTES = 131072;
constexpr int MISC_OFF = LDS_BYTES - 2048;

__device__ __forceinline__ unsigned f2bf(float f) { unsigned u = __builtin_bit_cast(unsigned, f); return (u + 0x7fffu + ((u >> 16) & 1u)) >> 16; }
__device__ __forceinline__ unsigned pk2(float lo, float hi) {
    typedef float v2f __attribute__((ext_vector_type(2))); typedef __bf16 v2b __attribute__((ext_vector_type(2)));
    v2f v = {lo, hi}; v2b b = __builtin_convertvector(v, v2b); return __builtin_bit_cast(unsigned, b); }
__device__ __forceinline__ float bf2f(unsigned short b) { return __builtin_bit_cast(float, ((unsigned)b) << 16); }
__device__ __forceinline__ float bflo(unsigned w) { return __builtin_bit_cast(float, w << 16); }
__device__ __forceinline__ float bfhi(unsigned w) { return __builtin_bit_cast(float, w & 0xffff0000u); }
__device__ __forceinline__ float wave_sum(float v) {
#pragma unroll
    for (int o = 1; o < 64; o <<= 1) v += __shfl_xor(v, o);
    return v;
}
#define LDS_WAIT() asm volatile("s_waitcnt lgkmcnt(0)" ::: "memory")
__device__ __forceinline__ float max_x16(float v) { auto r = __builtin_amdgcn_permlane16_swap(__float_as_uint(v), __float_as_uint(v), false, false); return fmaxf(__uint_as_float(r[0]), __uint_as_float(r[1])); }
__device__ __forceinline__ float max_x32(float v) { auto r = __builtin_amdgcn_permlane32_swap(__float_as_uint(v), __float_as_uint(v), false, false); return fmaxf(__uint_as_float(r[0]), __uint_as_float(r[1])); }
__device__ __forceinline__ float sum_x16(float v) { auto r = __builtin_amdgcn_permlane16_swap(__float_as_uint(v), __float_as_uint(v), false, false); return __uint_as_float(r[0]) + __uint_as_float(r[1]); }
__device__ __forceinline__ float sum_x32(float v) { auto r = __builtin_amdgcn_permlane32_swap(__float_as_uint(v), __float_as_uint(v), false, false); return __uint_as_float(r[0]) + __uint_as_float(r[1]); }
__device__ __forceinline__ float max3f(float a, float b, float c) { float r; asm("v_max3_f32 %0, %1, %2, %3" : "=v"(r) : "v"(a), "v"(b), "v"(c)); return r; }
__device__ __forceinline__ float dpp_x1(float v) { return __uint_as_float((unsigned)__builtin_amdgcn_mov_dpp((int)__float_as_uint(v), 0xB1, 0xF, 0xF, true)); }
__device__ __forceinline__ float dpp_x2(float v) { return __uint_as_float((unsigned)__builtin_amdgcn_mov_dpp((int)__float_as_uint(v), 0x4E, 0xF, 0xF, true)); }


__device__ __forceinline__ int slot_perm8(int c) {
    const int hi = c & ~31, fq = (c >> 3) & 3, n = (c >> 2) & 1, j = c & 3; return hi + 16 * n + 4 * fq + j; }
__device__ __forceinline__ int slot_pair128(int c, int n) {
    const int wc = c >> 5, fq = (c >> 3) & 3, bj = (c >> 2) & 1, j = c & 3; return 128 * bj + 32 * wc + 16 * n + 4 * fq + j; }
__device__ __forceinline__ int slot_rope64(int d) {
    const int n = d >> 5, dd = d & 31, wcl = dd >> 4, fq = (dd >> 2) & 3, j = dd & 3; return 32 * wcl + 16 * n + 4 * fq + j; }

namespace pg8 {
constexpr int BM = 256, BK = 64, HALF = 128, HTB = HALF * BK * 2, STAGE_BYTES = 8 * HTB, NXCD = 8, WGM = 8;
__host__ __device__ __forceinline__ int lds_byte(int r, int c) { const int st = (r >> 4) * 2 + (c >> 5), rr = r & 15, cc = c & 31, ob = rr * 64 + cc * 2; return st * 1024 + (ob ^ (((ob >> 9) & 1) << 5)); }
__host__ __device__ __forceinline__ void stage_rc(int b, int& R, int& C) { const int st = b / 1024, sb = b % 1024, swz = sb ^ (((sb >> 9) & 1) << 5); R = (st >> 1) * 16 + swz / 64; C = (st & 1) * 32 + (swz % 64) / 2; }

struct Unit { int pm, pn, e, nvalid; };
struct Gemm { int K, lda; };

template <class Epi, class Sched, bool GATHER, bool ALIGN_EPI = true, bool SP2 = true>
__device__ __forceinline__ void gemm_phase(LAS unsigned char* lds, int tid_in, const Gemm g, const Sched& S, const Epi& E) {
    int tid_ = tid_in; asm volatile("" : "+v"(tid_));
    const int tid = tid_, wid = __builtin_amdgcn_readfirstlane(tid >> 6), lane = tid & 63, wr = wid >> 2, wc = wid & 3, fr = lane & 15, fq = lane >> 4;
    const int K = g.K, nt = K / BK;
    int R0, C0; stage_rc(tid * 16, R0, C0);
    unsigned voffA[2], voffB[2];
#pragma unroll
    for (int i = 0; i < 2; ++i) { voffA[i] = (unsigned)((R0 + 64 * i) * g.lda + C0) * 2u; voffB[i] = (unsigned)((R0 + 64 * i) * K + C0) * 2u; }
    unsigned vgC[2][2], vgN[2][2];
    const size_t kstep = (size_t)(BK * 2);
    const size_t hstepA = (size_t)HALF * g.lda * 2, hstepB = (size_t)HALF * K * 2;
    const unsigned ldsw = (unsigned)wid * 1024u;
    const int aoff = lds_byte(wr * 64 + fr, fq * 8), boff = lds_byte(wc * 32 + fr, fq * 8);
#define PG8_SA(b, h) (((b) * 2 + (h)) * HTB)
#define PG8_SB(b, h) ((4 + (b) * 2 + (h)) * HTB)
#define PG8_GLDS(src, dstoff) __builtin_amdgcn_global_load_lds((const unsigned*)(src), (LAS unsigned*)(lds + (dstoff)), 16, 0, 0)
#define PG8_STAGE_B(bufoff, gbase) do { _Pragma("unroll") for (int _i = 0; _i < 2; ++_i) PG8_GLDS((const char*)(gbase) + voffB[_i], (bufoff) + ldsw + _i * 8192); } while (0)
#define PG8_STAGE_A(bufoff, gbase, h, VG) do { _Pragma("unroll") for (int _i = 0; _i < 2; ++_i) { \
        if constexpr (GATHER) PG8_GLDS((const char*)(gbase) + VG[h][_i], (bufoff) + ldsw + _i * 8192); \
        else PG8_GLDS((const char*)(gbase) + (h) * hstepA + voffA[_i], (bufoff) + ldsw + _i * 8192); } } while (0)
#define PG8_LDA(dst, b, h) do { _Pragma("unroll") for (int m = 0; m < 4; ++m) _Pragma("unroll") for (int k = 0; k < 2; ++k) dst[m][k] = *(const LAS bf16x8*)(lds + PG8_SA(b, h) + aoff + m * 2048 + k * 1024); } while (0)
#define PG8_LDB(dst, b, h) do { _Pragma("unroll") for (int n = 0; n < 2; ++n) _Pragma("unroll") for (int k = 0; k < 2; ++k) dst[n][k] = *(const LAS bf16x8*)(lds + PG8_SB(b, h) + boff + n * 2048 + k * 1024); } while (0)
#define PG8_MMA(ai, bj, At, Bt) do { __builtin_amdgcn_s_setprio(1); _Pragma("unroll") for (int m = 0; m < 4; ++m) _Pragma("unroll") for (int n = 0; n < 2; ++n) _Pragma("unroll") for (int k = 0; k < 2; ++k) \
        acc[ai][bj][m][n] = __builtin_amdgcn_mfma_f32_16x16x32_bf16(Bt[n][k], At[m][k], acc[ai][bj][m][n], 0, 0, 0); __builtin_amdgcn_s_setprio(0); } while (0)
#define PG8_WAIT_V(n) asm volatile("s_waitcnt vmcnt(" #n ")" ::: "memory")
#define PG8_WAIT_L(n) asm volatile("s_waitcnt lgkmcnt(" #n ")" ::: "memory")
#define PG8_BAR __builtin_amdgcn_s_barrier()
#define PG8_SCHED __builtin_amdgcn_sched_barrier(0)
    Unit cur, nxt; int ui = 0;
    if (!S.next(0, cur)) return;
    f32x4 acc[2][2][4][2];
#pragma unroll
    for (int a = 0; a < 2; ++a)
#pragma unroll
        for (int b = 0; b < 2; ++b)
#pragma unroll
            for (int m = 0; m < 4; ++m)
#pragma unroll
                for (int n = 0; n < 2; ++n) acc[a][b][m][n] = (f32x4){0.f, 0.f, 0.f, 0.f};
    bf16x8 At[4][2], B0[2][2], B1[2][2];
    const char* cA = S.a_base(cur); const char* cB = S.b_base(cur);
    if constexpr (GATHER) {
#pragma unroll
        for (int h = 0; h < 2; ++h)
#pragma unroll
            for (int i = 0; i < 2; ++i) vgC[h][i] = S.a_off(cur, h * HALF + R0 + 64 * i) + (unsigned)C0 * 2u;
    }
    if constexpr (SP2) {
        PG8_STAGE_B(PG8_SB(0, 0), cB); PG8_STAGE_B(PG8_SB(0, 1), cB + hstepB); PG8_STAGE_A(PG8_SA(0, 0), cA, 0, vgC); PG8_STAGE_A(PG8_SA(0, 1), cA, 1, vgC);
        if (wr == 1) PG8_BAR;
        PG8_WAIT_V(2); PG8_BAR;
        PG8_STAGE_B(PG8_SB(1, 0), cB + kstep); PG8_STAGE_A(PG8_SA(1, 0), cA + kstep, 0, vgC); PG8_STAGE_B(PG8_SB(1, 1), cB + hstepB + kstep);
        PG8_WAIT_V(6); PG8_BAR;
    } else {
        PG8_STAGE_B(PG8_SB(0, 0), cB); PG8_STAGE_A(PG8_SA(0, 0), cA, 0, vgC); PG8_STAGE_B(PG8_SB(0, 1), cB + hstepB); PG8_STAGE_A(PG8_SA(0, 1), cA, 1, vgC);
        if (wr == 1) PG8_BAR;
        PG8_WAIT_V(4); PG8_BAR;
        PG8_STAGE_B(PG8_SB(1, 0), cB + kstep); PG8_STAGE_A(PG8_SA(1, 0), cA + kstep, 0, vgC); PG8_STAGE_B(PG8_SB(1, 1), cB + hstepB + kstep);
        PG8_WAIT_V(6); PG8_BAR;
    }
    for (;;) {
        const bool has_next = S.next(ui + 1, nxt);
        const char* nA = has_next ? S.a_base(nxt) : cA; const char* nB = has_next ? S.b_base(nxt) : cB;
        if constexpr (GATHER) {
#pragma unroll
            for (int h = 0; h < 2; ++h)
#pragma unroll
                for (int i = 0; i < 2; ++i) vgN[h][i] = has_next ? (S.a_off(nxt, h * HALF + R0 + 64 * i) + (unsigned)C0 * 2u) : vgC[h][i];
        }
        for (int t = 0; t < nt; t += 2) {
            const bool last = (t == nt - 2);
            const char* a1 = cA + (size_t)(t + 1) * kstep;
            const char* a2 = last ? nA : cA + (size_t)(t + 2) * kstep; const char* b2 = last ? nB : cB + (size_t)(t + 2) * kstep;
            const char* a3 = a2 + kstep; const char* b3 = b2 + kstep;
            unsigned vg2[2][2];
            if constexpr (GATHER) {
#pragma unroll
                for (int h = 0; h < 2; ++h)
#pragma unroll
                    for (int i = 0; i < 2; ++i) vg2[h][i] = last ? vgN[h][i] : vgC[h][i];
            }
            if constexpr (SP2) {
            PG8_LDB(B0, 0, 0); PG8_LDB(B1, 0, 1); PG8_SCHED; PG8_LDA(At, 0, 0); PG8_STAGE_A(PG8_SA(1, 1), a1, 1, vgC);
            PG8_WAIT_V(8); PG8_WAIT_L(0); PG8_BAR; PG8_MMA(0, 0, At, B0); PG8_MMA(0, 1, At, B1); PG8_BAR; PG8_SCHED;
            PG8_LDA(At, 0, 1); PG8_STAGE_B(PG8_SB(0, 0), b2); PG8_STAGE_B(PG8_SB(0, 1), b2 + hstepB); PG8_STAGE_A(PG8_SA(0, 0), a2, 0, vg2);
            PG8_WAIT_V(8); PG8_WAIT_L(0); PG8_BAR; PG8_MMA(1, 0, At, B0); PG8_MMA(1, 1, At, B1); PG8_BAR; PG8_SCHED;
            PG8_LDB(B0, 1, 0); PG8_LDB(B1, 1, 1); PG8_SCHED; PG8_LDA(At, 1, 0); PG8_STAGE_A(PG8_SA(0, 1), a2, 1, vg2);
            PG8_WAIT_V(8); PG8_WAIT_L(0); PG8_BAR; PG8_MMA(0, 0, At, B0); PG8_MMA(0, 1, At, B1); PG8_BAR; PG8_SCHED;
            PG8_LDA(At, 1, 1); PG8_STAGE_B(PG8_SB(1, 0), b3); PG8_STAGE_B(PG8_SB(1, 1), b3 + hstepB); PG8_STAGE_A(PG8_SA(1, 0), a3, 0, vg2);
            PG8_WAIT_V(8); PG8_WAIT_L(0); PG8_BAR; PG8_MMA(1, 0, At, B0); PG8_MMA(1, 1, At, B1); PG8_BAR; PG8_SCHED;
            } else {
            PG8_LDB(B0, 0, 0); PG8_SCHED; PG8_LDA(At, 0, 0); PG8_STAGE_A(PG8_SA(1, 1), a1, 1, vgC);
            PG8_WAIT_L(8); PG8_BAR; PG8_WAIT_L(0); PG8_MMA(0, 0, At, B0); PG8_BAR; PG8_SCHED;
            PG8_LDB(B1, 0, 1); PG8_STAGE_B(PG8_SB(0, 0), b2);
            PG8_BAR; PG8_WAIT_L(0); PG8_MMA(0, 1, At, B1); PG8_BAR;
            PG8_LDA(At, 0, 1); PG8_STAGE_A(PG8_SA(0, 0), a2, 0, vg2);
            PG8_BAR; PG8_WAIT_L(0); PG8_MMA(1, 0, At, B0); PG8_BAR; PG8_SCHED;
            PG8_STAGE_B(PG8_SB(0, 1), b2 + hstepB);
            PG8_WAIT_V(6); PG8_BAR; PG8_MMA(1, 1, At, B1); PG8_BAR;
            PG8_LDB(B0, 1, 0); PG8_SCHED; PG8_LDA(At, 1, 0); PG8_STAGE_A(PG8_SA(0, 1), a2, 1, vg2);
            PG8_WAIT_L(8); PG8_BAR; PG8_WAIT_L(0); PG8_MMA(0, 0, At, B0); PG8_BAR; PG8_SCHED;
            PG8_LDB(B1, 1, 1); PG8_STAGE_B(PG8_SB(1, 0), b3);
            PG8_BAR; PG8_WAIT_L(0); PG8_MMA(0, 1, At, B1); PG8_BAR;
            PG8_LDA(At, 1, 1); PG8_STAGE_A(PG8_SA(1, 0), a3, 0, vg2);
            PG8_BAR; PG8_WAIT_L(0); PG8_MMA(1, 0, At, B0); PG8_BAR; PG8_SCHED;
            PG8_STAGE_B(PG8_SB(1, 1), b3 + hstepB);
            PG8_WAIT_V(6); PG8_BAR; PG8_MMA(1, 1, At, B1); PG8_BAR;
            }
        }
        if constexpr (ALIGN_EPI) { if (wr == 0) PG8_BAR; }
        E(acc, cur, wr, wc, fr, fq);
        if (!has_next) break;
#pragma unroll
        for (int a = 0; a < 2; ++a)
#pragma unroll
            for (int b = 0; b < 2; ++b)
#pragma unroll
                for (int m = 0; m < 4; ++m)
#pragma unroll
                    for (int n = 0; n < 2; ++n) acc[a][b][m][n] = (f32x4){0.f, 0.f, 0.f, 0.f};
        cur = nxt; cA = nA; cB = nB; ++ui;
        if constexpr (GATHER) {
#pragma unroll
            for (int h = 0; h < 2; ++h)
#pragma unroll
                for (int i = 0; i < 2; ++i) vgC[h][i] = vgN[h][i];
        }
        if constexpr (ALIGN_EPI) { if (wr == 1) PG8_BAR; }
    }
    PG8_WAIT_V(0);
    if constexpr (!ALIGN_EPI) { if (wr == 0) PG8_BAR; }
    PG8_BAR;
#undef PG8_SA
#undef PG8_SB
#undef PG8_GLDS
#undef PG8_STAGE_A
#undef PG8_STAGE_B
#undef PG8_LDA
#undef PG8_LDB
#undef PG8_MMA
#undef PG8_WAIT_V
#undef PG8_WAIT_L
#undef PG8_BAR
#undef PG8_SCHED
}
}

struct Args {
    const float* in[25]; float* out; unsigned char* ws;
    float inv_freq[32];
    int ph_lo, ph_hi;
};
enum { I_X = 0, I_POS, I_NMIX, I_NFFN, I_CWIN, I_CW, I_CWOUT, I_NKV, I_WKV, I_CPK, I_CW1K, I_CW2K, I_CPV, I_CW1V, I_CW2V, I_AWIN, I_AWOUT,
       I_RGW, I_RGB, I_REW, I_REB, I_EWG, I_EWU, I_EWD, I_NFIN };

struct Frame {
    LAS unsigned char* lds;
    unsigned char* ws;
    int tid, lane, wave, vcu, G;
};

__device__ __forceinline__ int mytid(const Frame& F) { return F.wave * 64 + (int)__builtin_amdgcn_mbcnt_hi(~0u, __builtin_amdgcn_mbcnt_lo(~0u, 0u)); }
__device__ __forceinline__ Frame refresh(const Frame& F0) {
    Frame F = F0; int t = mytid(F0); asm volatile("" : "+v"(t)); F.tid = t; F.lane = t & 63; return F; }

struct DenseOrder {
    const char* A; const char* Bt; size_t tstepA, tstepB; int nM, nN, nwg, G, c;
    __device__ __forceinline__ void init(const void* A_, const void* Bt_, int M, int N, int K, int lda, int G_, int c_) {
        A = (const char*)A_; Bt = (const char*)Bt_; nM = M / 256; nN = N / 256; nwg = nM * nN; G = G_; c = c_; tstepA = (size_t)256 * lda * 2; tstepB = (size_t)256 * K * 2; }
    __device__ __forceinline__ bool next(int i, pg8::Unit& u) const {
        const long L = (long)i * G + c; if (L >= nwg) return false;
        int wgid = (int)L; { const int q = nwg / 8, r = nwg % 8, xcd = wgid % 8, off = wgid / 8; wgid = (xcd < r ? xcd * (q + 1) : r * (q + 1) + (xcd - r) * q) + off; }
        const int nig = 8 * nN, gid = wgid / nig, fm = gid * 8, gsz = (nM - fm) < 8 ? (nM - fm) : 8;
        u.pm = fm + ((wgid % nig) % gsz); u.pn = (wgid % nig) / gsz; u.e = 0; u.nvalid = 256; return true; }
    __device__ __forceinline__ const char* a_base(const pg8::Unit& u) const { return A + (size_t)u.pm * tstepA; }
    __device__ __forceinline__ const char* b_base(const pg8::Unit& u) const { return Bt + (size_t)u.pn * tstepB; }
    __device__ __forceinline__ unsigned a_off(const pg8::Unit&, int) const { return 0u; }
};
struct CmpOrder {
    const char* A0; const char* A1; const char* Bt; int G, c;
    __device__ __forceinline__ bool next(int i, pg8::Unit& u) const { const int L = i * G + c; if (L >= 64) return false; u.e = L >> 5; u.pm = L & 31; u.pn = 0; u.nvalid = 256; return true; }
    __device__ __forceinline__ const char* a_base(const pg8::Unit& u) const { return (u.e ? A1 : A0) + (size_t)u.pm * 256 * 1024 * 2; }
    __device__ __forceinline__ const char* b_base(const pg8::Unit& u) const { return Bt + (size_t)u.e * 256 * 2048 * 2; }
    __device__ __forceinline__ unsigned a_off(const pg8::Unit&, int) const { return 0u; }
};
struct MoeTab { volatile LAS int* tstart; volatile LAS int* cnt; };
__device__ __forceinline__ bool moe_unit(const MoeTab& T, int L, pg8::Unit& u) {
    const int total = T.tstart[32]; if (L >= 4 * total) return false;
    u.pn = L & 3; const int mt = L >> 2; int e = 0;
#pragma unroll 1
    for (int k = 1; k < 32; ++k) e += (T.tstart[k] <= mt) ? 1 : 0;
    u.e = e; u.pm = mt - T.tstart[e]; u.nvalid = T.cnt[e] - u.pm * 256; return true;
}
struct MoeGuOrder {
    MoeTab T; const char* X; const int* rowl; const char* W; int G, c;
    __device__ __forceinline__ bool next(int i, pg8::Unit& u) const { return moe_unit(T, i * G + c, u); }
    __device__ __forceinline__ const char* a_base(const pg8::Unit&) const { return X; }
    __device__ __forceinline__ const char* b_base(const pg8::Unit& u) const { return W + (size_t)u.e * 3 * MiB + (size_t)u.pn * 256 * 1024 * 2; }
    __device__ __forceinline__ unsigned a_off(const pg8::Unit& u, int R) const {
        int idx = u.pm * 256 + R; const int lim = u.pm * 256 + u.nvalid - 1; idx = idx < lim ? idx : lim;
        const int id = rowl[(size_t)u.e * ECAP + idx]; return (unsigned)(id >> 1) * 2048u; }
};
struct MoeDnOrder {
    MoeTab T; const char* ACT; const char* W; int G, c;
    __device__ __forceinline__ bool next(int i, pg8::Unit& u) const { return moe_unit(T, i * G + c, u); }
    __device__ __forceinline__ const char* a_base(const pg8::Unit& u) const { return ACT + (size_t)(T.tstart[u.e] + u.pm) * 256 * 512 * 2; }
    __device__ __forceinline__ const char* b_base(const pg8::Unit& u) const { return W + (size_t)u.e * 3 * MiB + 2 * MiB + (size_t)u.pn * 256 * 512 * 2; }
    __device__ __forceinline__ unsigned a_off(const pg8::Unit&, int) const { return 0u; }
};

#define EPI_ARGS const f32x4 (&acc)[2][2][4][2], const pg8::Unit& u, int wr, int wc, int fr, int fq
__device__ __forceinline__ u32x4 pack8(const f32x4& a, const f32x4& b) { u32x4 w; w.x = pk2(a[0], a[1]); w.y = pk2(a[2], a[3]); w.z = pk2(b[0], b[1]); w.w = pk2(b[2], b[3]); return w; }
__device__ __forceinline__ u32x2 pack4(const f32x4& a) { u32x2 w; w.x = pk2(a[0], a[1]); w.y = pk2(a[2], a[3]); return w; }

struct EpiInProj {
    const float* r0; bf16_t* BG; bf16_t* U;
    __device__ __forceinline__ void operator()(EPI_ARGS) const {
        float rsv[2][4];
#pragma unroll
        for (int ai = 0; ai < 2; ++ai)
#pragma unroll
            for (int m = 0; m < 4; ++m) rsv[ai][m] = r0[u.pm * 256 + ai * 128 + wr * 64 + m * 16 + fr];
#pragma unroll
        for (int ai = 0; ai < 2; ++ai)
#pragma unroll
            for (int m = 0; m < 4; ++m) {
                const int row = u.pm * 256 + ai * 128 + wr * 64 + m * 16 + fr; const float rs = rsv[ai][m];
                if (u.pn < 4) {
#pragma unroll
                    for (int bj = 0; bj < 2; ++bj) *(u32x4*)(BG + (size_t)row * D + u.pn * 256 + bj * 128 + wc * 32 + 8 * fq) = pack8(acc[ai][bj][m][0] * rs, acc[ai][bj][m][1] * rs);
                } else {
                    const float rs2 = rs * rs;
                    *(u32x4*)(U + (size_t)row * D + (u.pn - 4) * 128 + wc * 32 + 8 * fq) = pack8(acc[ai][0][m][0] * acc[ai][0][m][1] * rs2, acc[ai][1][m][0] * acc[ai][1][m][1] * rs2);
                }
            }
    }
};
struct EpiResid {
    const float* base; float* out;
    __device__ __forceinline__ void operator()(EPI_ARGS) const {
#pragma unroll
        for (int ai = 0; ai < 2; ++ai)
#pragma unroll
            for (int mp = 0; mp < 2; ++mp) {
                f32x4 bv[2][2][2];
#pragma unroll
                for (int mm = 0; mm < 2; ++mm) { const size_t off = (size_t)(u.pm * 256 + ai * 128 + wr * 64 + (2 * mp + mm) * 16 + fr) * D + u.pn * 256 + wc * 32 + 4 * fq;
#pragma unroll
                    for (int bj = 0; bj < 2; ++bj)
#pragma unroll
                        for (int n = 0; n < 2; ++n) bv[mm][bj][n] = *(const f32x4*)(base + off + bj * 128 + n * 16); }
#pragma unroll
                for (int mm = 0; mm < 2; ++mm) { const size_t off = (size_t)(u.pm * 256 + ai * 128 + wr * 64 + (2 * mp + mm) * 16 + fr) * D + u.pn * 256 + wc * 32 + 4 * fq;
#pragma unroll
                    for (int bj = 0; bj < 2; ++bj)
#pragma unroll
                        for (int n = 0; n < 2; ++n) *(f32x4*)(out + off + bj * 128 + n * 16) = bv[mm][bj][n] + acc[ai][bj][2 * mp + mm][n]; }
            }
    }
};
struct EpiQKV {
    const float* r2; const f32x2* rope; unsigned char* kv; bf16_t* Q; float* gates;
    __device__ __forceinline__ void operator()(EPI_ARGS) const {
        const int pn = u.pn;
        float rsv[2][4];
#pragma unroll
        for (int ai = 0; ai < 2; ++ai)
#pragma unroll
            for (int m = 0; m < 4; ++m) rsv[ai][m] = r2[u.pm * 256 + ai * 128 + wr * 64 + m * 16 + fr];
#pragma unroll
        for (int ai = 0; ai < 2; ++ai)
#pragma unroll
            for (int m = 0; m < 4; ++m) {
                const int row = u.pm * 256 + ai * 128 + wr * 64 + m * 16 + fr; const float rs = rsv[ai][m];
                const int b = row >> 14, s = row & (SEQ - 1);
                f32x4 ropev[2][2];
                if (pn == 2 || pn == 4) {
#pragma unroll
                    for (int bj = 0; bj < 2; ++bj) { const int d0 = 16 * (wc & 1) + 4 * fq; ropev[bj][0] = *(const f32x4*)(rope + (size_t)row * 32 + d0); ropev[bj][1] = *(const f32x4*)(rope + (size_t)row * 32 + d0 + 2); }
                }
                if (pn < 6) {
#pragma unroll
                    for (int bj = 0; bj < 2; ++bj) {
                        const int gg = 2 * bj + (wc >> 1), d0 = 16 * (wc & 1) + 4 * fq;
                        f32x4 v0 = acc[ai][bj][m][0] * rs, v1 = acc[ai][bj][m][1] * rs;
                        if (pn == 2 || pn == 4) {
                            const f32x4 cs0 = ropev[bj][0], cs1 = ropev[bj][1];
                            const f32x4 c = {cs0[0], cs0[2], cs1[0], cs1[2]}, sn = {cs0[1], cs0[3], cs1[1], cs1[3]};
                            const f32x4 o0 = v0 * c - v1 * sn, o1 = v1 * c + v0 * sn; v0 = o0; v1 = o1;
                        }
                        if (pn == 3 || pn == 5) {
                            bf16_t* vt = (bf16_t*)(kv + (size_t)pn * KVSTRIDE) + ((size_t)(b * 4 + gg) * 64 + d0) * SEQ + s;
#pragma unroll
                            for (int j = 0; j < 4; ++j) { vt[(size_t)j * SEQ] = (bf16_t)f2bf(v0[j]); vt[(size_t)(j + 32) * SEQ] = (bf16_t)f2bf(v1[j]); }
                        } else {
                            bf16_t* kp = (bf16_t*)(kv + (size_t)pn * KVSTRIDE) + ((size_t)(b * 4 + gg) * SEQ + s) * 64 + d0;
                            *(u32x2*)kp = pack4(v0); *(u32x2*)(kp + 32) = pack4(v1);
                        }
                    }
                } else if (pn < 10) {
#pragma unroll
                    for (int bj = 0; bj < 2; ++bj) {
                        const int head = 4 * (pn - 6) + 2 * bj + (wc >> 1), d0 = 16 * (wc & 1) + 4 * fq; const float sc = rs * (0.125f * 1.4426950408889634f);
                        bf16_t* qp = Q + (size_t)row * D + head * 64 + d0;
                        *(u32x2*)qp = pack4(acc[ai][bj][m][0] * sc); *(u32x2*)(qp + 32) = pack4(acc[ai][bj][m][1] * sc);
                    }
                } else {
#pragma unroll
                    for (int n = 0; n < 2; ++n) { const int sl = 32 * wc + 16 * n + 4 * fq;
                        if (sl < 48) { f32x4 v = acc[ai][0][m][n] * rs;
#pragma unroll
                            for (int j = 0; j < 4; ++j) v[j] = 1.0f / (1.0f + __expf(-v[j]));
                            *(f32x4*)(gates + (size_t)row * 48 + sl) = v; } }
                }
            }
    }
};
__device__ __forceinline__ float gelu_tanh(float x) { const float y = 0.7978845608028654f * (x + 0.044715f * x * x * x); const float t = 1.0f - 2.0f / (1.0f + __expf(2.0f * y)); return 0.5f * x * (1.0f + t); }
struct EpiCmp1 {
    const float* bias; bf16_t* HID;
    __device__ __forceinline__ void operator()(EPI_ARGS) const {
        f32x4 bv[2][2];
#pragma unroll
        for (int bj = 0; bj < 2; ++bj)
#pragma unroll
            for (int n = 0; n < 2; ++n) bv[bj][n] = *(const f32x4*)(bias + u.e * 256 + bj * 128 + wc * 32 + 8 * fq + 4 * n);
#pragma unroll
        for (int ai = 0; ai < 2; ++ai)
#pragma unroll
            for (int m = 0; m < 4; ++m) {
                const int row = u.pm * 256 + ai * 128 + wr * 64 + m * 16 + fr;
#pragma unroll
                for (int bj = 0; bj < 2; ++bj) { f32x4 v0 = acc[ai][bj][m][0] + bv[bj][0], v1 = acc[ai][bj][m][1] + bv[bj][1];
#pragma unroll
                    for (int j = 0; j < 4; ++j) { v0[j] = gelu_tanh(v0[j]); v1[j] = gelu_tanh(v1[j]); }
                    *(u32x4*)(HID + ((size_t)u.e * 8192 + row) * 256 + bj * 128 + wc * 32 + 8 * fq) = pack8(v0, v1); }
            }
    }
};
struct EpiGU {
    MoeTab T; const float* rowr; bf16_t* ACT;
    __device__ __forceinline__ void operator()(EPI_ARGS) const {
        const size_t arow0 = (size_t)(T.tstart[u.e] + u.pm) * 256;
        float rsv[2][4];
#pragma unroll
        for (int ai = 0; ai < 2; ++ai)
#pragma unroll
            for (int m = 0; m < 4; ++m) rsv[ai][m] = rowr[(size_t)u.e * ECAP + u.pm * 256 + ai * 128 + wr * 64 + m * 16 + fr];
#pragma unroll
        for (int ai = 0; ai < 2; ++ai)
#pragma unroll
            for (int m = 0; m < 4; ++m) {
                const int rl = ai * 128 + wr * 64 + m * 16 + fr; const float rs = rsv[ai][m];
                f32x4 a[2];
#pragma unroll
                for (int bj = 0; bj < 2; ++bj) { const f32x4 g = acc[ai][bj][m][0] * rs, up = acc[ai][bj][m][1] * rs;
#pragma unroll
                    for (int j = 0; j < 4; ++j) a[bj][j] = g[j] / (1.0f + __expf(-g[j])) * up[j]; }
                *(u32x4*)(ACT + (arow0 + rl) * DE + u.pn * 128 + wc * 32 + 8 * fq) = pack8(a[0], a[1]);
            }
    }
};
struct EpiDN {
    const int* rowl; const float* wgt; bf16_t* Y;
    __device__ __forceinline__ void operator()(EPI_ARGS) const {
        int idv[2][4]; float wv[2][4];
#pragma unroll
        for (int ai = 0; ai < 2; ++ai)
#pragma unroll
            for (int m = 0; m < 4; ++m) { const int rl = ai * 128 + wr * 64 + m * 16 + fr; const int lim = u.nvalid - 1; idv[ai][m] = rowl[(size_t)u.e * ECAP + u.pm * 256 + (rl < lim ? rl : lim)]; }
#pragma unroll
        for (int ai = 0; ai < 2; ++ai)
#pragma unroll
            for (int m = 0; m < 4; ++m) wv[ai][m] = wgt[idv[ai][m]];
#pragma unroll
        for (int ai = 0; ai < 2; ++ai)
#pragma unroll
            for (int m = 0; m < 4; ++m) {
                const int rl = ai * 128 + wr * 64 + m * 16 + fr;
                if (rl < u.nvalid) {
                    const int id = idv[ai][m]; const float w = wv[ai][m];
#pragma unroll
                    for (int bj = 0; bj < 2; ++bj) *(u32x4*)(Y + (size_t)id * D + u.pn * 256 + bj * 128 + wc * 32 + 8 * fq) = pack8(acc[ai][bj][m][0] * w, acc[ai][bj][m][1] * w);
                }
            }
    }
};

template <class RowMap>
__device__ __forceinline__ void transpose_item(const float* W, int K, int N, bf16_t* WT, const float* gain, LAS float*  , int item, int lane, const RowMap& rm) {
    const int nblk = (N + 31) / 32, kb = item / nblk, nb = item % nblk, k0 = 64 * kb + 8 * (lane & 7), nc = 32 * nb + 4 * (lane >> 3);
    if (nc >= N) return;
    f32x4 v[8];
#pragma unroll
    for (int i = 0; i < 8; ++i) v[i] = *(const f32x4*)(W + (size_t)(k0 + i) * N + nc);
    if (gain) { const f32x4 g0 = *(const f32x4*)(gain + k0), g1 = *(const f32x4*)(gain + k0 + 4);
#pragma unroll
        for (int i = 0; i < 4; ++i) { v[i] = v[i] * g0[i]; v[4 + i] = v[4 + i] * g1[i]; } }
#pragma unroll
    for (int j = 0; j < 4; ++j) { u32x4 o; o.x = pk2(v[0][j], v[1][j]); o.y = pk2(v[2][j], v[3][j]); o.z = pk2(v[4][j], v[5][j]); o.w = pk2(v[6][j], v[7][j]);
        *(u32x4*)(WT + (size_t)rm(nc + j) * K + k0) = o; }
}
struct MapIdent { __device__ __forceinline__ int operator()(int c) const { return c; } };
struct MapPerm8 { __device__ __forceinline__ int operator()(int c) const { return slot_perm8(c); } };
struct MapWin { __device__ __forceinline__ int operator()(int c) const {
    if (c < 1024) return slot_perm8(c);
    const int n = (c >= 2048) ? 1 : 0, ch = c - 1024 - 1024 * n; return 1024 + (ch >> 7) * 256 + slot_pair128(ch & 127, n); } };
struct MapKV { __device__ __forceinline__ int operator()(int c) const { return (c & ~63) + slot_rope64(c & 63); } };
struct MapAIn { __device__ __forceinline__ int operator()(int c) const { return c < 1024 ? 1536 + (c & ~63) + slot_rope64(c & 63) : 2560 + (c - 1024); } };
struct MapGU { int n; __device__ __forceinline__ int operator()(int c) const { return (c >> 7) * 256 + slot_pair128(c & 127, n); } };

struct ConvItem {
    f32x4 v[8], g0, g1; bf16_t* dst; int K, kind, nc; bool hasg;
    __device__ __forceinline__ void load(const Args& a, unsigned char* ws, int layer, int it, int lane) {
        const int e = it / 768, r = it % 768; kind = r < 256 ? 0 : (r < 512 ? 1 : 2); const int item = r & 255;
        const size_t eo = ((size_t)layer * NE + e) * (size_t)D * DE;
        const float* W = (kind == 0 ? a.in[I_EWG] : kind == 1 ? a.in[I_EWU] : a.in[I_EWD]) + eo;
        const int N = kind == 2 ? D : DE; K = kind == 2 ? DE : D; hasg = kind != 2;
        const int nblk = N / 32, kb = item / nblk, nb = item % nblk, k0 = 64 * kb + 8 * (lane & 7); nc = 32 * nb + 4 * (lane >> 3);
        dst = (bf16_t*)(ws + WS_EXPW + (size_t)e * 3 * MiB) + (kind == 2 ? (size_t)1024 * 1024 : 0) + k0;
#pragma unroll
        for (int i = 0; i < 8; ++i) v[i] = *(const f32x4*)(W + (size_t)(k0 + i) * N + nc);
        const float* gp = a.in[I_NFFN] + layer * D + (hasg ? k0 : 0); g0 = *(const f32x4*)gp; g1 = *(const f32x4*)(gp + 4);
    }
    __device__ __forceinline__ void store() {
        if (hasg) {
#pragma unroll
            for (int i = 0; i < 4; ++i) { v[i] = v[i] * g0[i]; v[4 + i] = v[4 + i] * g1[i]; } }
#pragma unroll
        for (int j = 0; j < 4; ++j) { u32x4 o; o.x = pk2(v[0][j], v[1][j]); o.y = pk2(v[2][j], v[3][j]); o.z = pk2(v[4][j], v[5][j]); o.w = pk2(v[6][j], v[7][j]);
            const int c = nc + j; const int slot = kind == 2 ? slot_perm8(c) : (c >> 7) * 256 + slot_pair128(c & 127, kind);
            *(u32x4*)(dst + (size_t)slot * K) = o; }
    }
};
__device__ __forceinline__ void convert_experts(const Args& a, const Frame& F, int layer, int gw, int NGW, LAS float*  ) {
    constexpr int NIT = NE * 768;
    if (gw >= NIT) return;
    ConvItem cur, nxt; cur.load(a, F.ws, layer, gw, F.lane);
#pragma unroll 1
    for (int it = gw; it < NIT; it += NGW) {
        const int itn = it + NGW < NIT ? it + NGW : it;
        nxt.load(a, F.ws, layer, itn, F.lane);
        cur.store();
        cur = nxt;
    }
}

__device__ __forceinline__ void phase_prep(const Args& a, const Frame& F0) {
    const Frame F = refresh(F0);
    LAS float* scr = (LAS float*)(F.lds + F.wave * 16384);
    const int gw = F.vcu * NWAVES + F.wave, NGW = F.G * NWAVES;
    const int gt = gw * 64 + F.lane, NGT = NGW * 64;
    unsigned char* ws = F.ws;
    { const float* x = a.in[I_X]; bf16_t* XB = (bf16_t*)(ws + WS_RA); float* R0 = (float*)(ws + WS_R0);
      for (int m = gw; m < NT; m += NGW) { const f32x4* xr = (const f32x4*)(x + (size_t)m * D) + F.lane; f32x4 v[4]; float s = 0.f;
#pragma unroll
          for (int j = 0; j < 4; ++j) { v[j] = xr[64 * j]; s += (v[j][0] * v[j][0] + v[j][1] * v[j][1]) + (v[j][2] * v[j][2] + v[j][3] * v[j][3]); }
          s = wave_sum(s); if (F.lane == 0) R0[m] = 1.0f / sqrtf(s * (1.0f / D) + RMS_EPS);
          u32x2* o8 = (u32x2*)(XB + (size_t)m * D) + F.lane;
#pragma unroll
          for (int j = 0; j < 4; ++j) o8[64 * j] = pack4(v[j]); } }
    { const int* pos = (const int*)a.in[I_POS]; f32x2* rope = (f32x2*)(ws + WS_ROPE);
      for (int i = gt; i < NT * 32; i += NGT) { const float ang = (float)pos[i >> 5] * a.inv_freq[i & 31];
          double rev = (double)ang * 0.15915494309189533577; rev -= __builtin_rint(rev); const float rf = (float)rev;
          rope[i] = (f32x2){__builtin_amdgcn_cosf(rf), __builtin_amdgcn_sinf(rf)}; } }
    { constexpr int I_IN = 16 * 96, I_OUT = 16 * 32, I_KV = 16 * 48, I_AIN = 16 * 34, I_C1 = 32 * 8, I_AO = 16 * 32;
      constexpr int NI = I_IN + I_OUT + I_KV + I_AIN + 2 * I_C1 + I_AO;
      for (int it = gw; it < NI; it += NGW) { int r = it;
          if (r < I_IN) { transpose_item(a.in[I_CWIN], D, 3 * D, (bf16_t*)(ws + WS_WIN), a.in[I_NMIX], scr, r, F.lane, MapWin{}); continue; } r -= I_IN;
          if (r < I_OUT) { transpose_item(a.in[I_CWOUT], D, D, (bf16_t*)(ws + WS_WOUT), nullptr, scr, r, F.lane, MapIdent{}); continue; } r -= I_OUT;
          if (r < I_KV) { transpose_item(a.in[I_WKV], D, 1536, (bf16_t*)(ws + WS_WQKV), a.in[I_NKV], scr, r, F.lane, MapKV{}); continue; } r -= I_KV;
          if (r < I_AIN) { transpose_item(a.in[I_AWIN], D, 1072, (bf16_t*)(ws + WS_WQKV), a.in[I_NMIX] + D, scr, r, F.lane, MapAIn{}); continue; } r -= I_AIN;
          if (r < I_C1) { transpose_item(a.in[I_CW1K], 2048, 256, (bf16_t*)(ws + WS_WC1), nullptr, scr, r, F.lane, MapPerm8{}); continue; } r -= I_C1;
          if (r < I_C1) { transpose_item(a.in[I_CW1V], 2048, 256, (bf16_t*)(ws + WS_WC1) + 256 * 2048, nullptr, scr, r, F.lane, MapPerm8{}); continue; } r -= I_C1;
          transpose_item(a.in[I_AWOUT], D, D, (bf16_t*)(ws + WS_WAO), nullptr, scr, r, F.lane, MapIdent{});
      } }
    convert_experts(a, F, 0, gw, NGW, scr);
    { unsigned* z = (unsigned*)((bf16_t*)(ws + WS_WQKV) + (size_t)2608 * D); for (int i = gt; i < 208 * D / 2; i += NGT) z[i] = 0u; }
    { float* bc = (float*)(ws + WS_BIASC);
      for (int o = gw; o < 512; o += NGW) { const int kv = o >> 8, n = o & 255; const float* pos = a.in[kv ? I_CPV : I_CPK]; const float* w1 = a.in[kv ? I_CW1V : I_CW1K]; float s = 0.f;
          for (int i = F.lane; i < 2048; i += 64) s += pos[i] * w1[(size_t)i * 256 + n];
          s = wave_sum(s); if (F.lane == 0) bc[o] = s; } }
    { float* rw = (float*)(ws + WS_RW);
      for (int i = gt; i < 2 * 36 * 1024; i += NGT) { const int l = i / (36 * 1024), r = i % (36 * 1024), o = r >> 10, k = r & 1023;
          const float g = a.in[I_NFFN][l * D + k]; rw[i] = g * (o < 32 ? a.in[I_REW][((size_t)l * D + k) * 32 + o] : a.in[I_RGW][((size_t)l * D + k) * 4 + (o - 32)]); } }
    { bf16_t* w2t = (bf16_t*)(ws + WS_W2T);
      for (int i = gt; i < 2 * 64 * 256; i += NGT) { const int kv = i >> 14, r = i & 16383, n = r >> 8, k = r & 255; w2t[i] = (bf16_t)f2bf(a.in[kv ? I_CW2V : I_CW2K][k * 64 + n]); } }
}

__device__ __forceinline__ void phase_conv(const Args& a, const Frame& F0) {
    const Frame F = refresh(F0);
    const bf16_t* BG = (const bf16_t*)(F.ws + WS_RB); const bf16_t* U = (const bf16_t*)(F.ws + WS_RC); bf16_t* Z = (bf16_t*)(F.ws + WS_RA);
    const float* cw = a.in[I_CW];
    const int cg8 = (F.tid & 127) * 8, tq = F.tid >> 7;
    float w0[8], w1[8], w2[8];
#pragma unroll
    for (int j = 0; j < 8; ++j) { w0[j] = cw[cg8 + j]; w1[j] = cw[D + cg8 + j]; w2[j] = cw[2 * D + cg8 + j]; }
    for (int ch = F.vcu; ch < NT / 32; ch += F.G) {
        const int t0 = ch * 32 + tq * 8; const int s0 = t0 & (SEQ - 1);
        float um2[8], um1[8];
        { u32x4 p = {0u, 0u, 0u, 0u}, q = {0u, 0u, 0u, 0u};
          if (s0 >= 2) p = *(const u32x4*)(U + (size_t)(t0 - 2) * D + cg8);
          if (s0 >= 1) q = *(const u32x4*)(U + (size_t)(t0 - 1) * D + cg8);
#pragma unroll
          for (int j = 0; j < 4; ++j) { um2[2 * j] = bflo(p[j]); um2[2 * j + 1] = bfhi(p[j]); um1[2 * j] = bflo(q[j]); um1[2 * j + 1] = bfhi(q[j]); } }
#pragma unroll
        for (int i = 0; i < 8; ++i) {
            const u32x4 uu = *(const u32x4*)(U + (size_t)(t0 + i) * D + cg8), bb = *(const u32x4*)(BG + (size_t)(t0 + i) * D + cg8);
            float z[8];
#pragma unroll
            for (int j = 0; j < 4; ++j) { const float u0 = bflo(uu[j]), u1 = bfhi(uu[j]);
                z[2 * j] = bflo(bb[j]) * (w0[2 * j] * um2[2 * j] + w1[2 * j] * um1[2 * j] + w2[2 * j] * u0);
                z[2 * j + 1] = bfhi(bb[j]) * (w0[2 * j + 1] * um2[2 * j + 1] + w1[2 * j + 1] * um1[2 * j + 1] + w2[2 * j + 1] * u1);
                um2[2 * j] = um1[2 * j]; um2[2 * j + 1] = um1[2 * j + 1]; um1[2 * j] = u0; um1[2 * j + 1] = u1; }
            u32x4 o; o.x = pk2(z[0], z[1]); o.y = pk2(z[2], z[3]); o.z = pk2(z[4], z[5]); o.w = pk2(z[6], z[7]);
            *(u32x4*)(Z + (size_t)(t0 + i) * D + cg8) = o;
        }
    }
}

__device__ __forceinline__ void phase_router(const Args& a, const Frame& F0, int layer, const float* X, bf16_t* XnB, float* Rout) {
    const Frame F = refresh(F0);
    unsigned char* ws = F.ws;
    const float* rw = (const float*)(ws + WS_RW) + (size_t)layer * 36 * 1024;
    const float* brg = a.in[I_RGB] + layer * 4; const float* bre = a.in[I_REB] + layer * 32;
    unsigned* gcnt = (unsigned*)(ws + WS_CTL) + CW_CNT + layer * 32;
    int* rowl = (int*)(ws + WS_ROWL); float* rowr = (float*)(ws + WS_ROWR); float* wgt = (float*)(ws + WS_WGT);
    constexpr int XT_LD = 260;
    LAS float* xt = (LAS float*)(F.lds) + F.wave * (16 * XT_LD);
    LAS float* lg = xt;
    LAS unsigned* cntl = (LAS unsigned*)(F.lds + 8 * 16 * XT_LD * 4); LAS unsigned* basel = cntl + 32;
    const int l15 = F.lane & 15, quad = F.lane >> 4;
    for (int base = F.vcu * 128; base < NT; base += F.G * 128) {
        if (F.tid < 32) cntl[F.tid] = 0u;
        const int tok0 = base + F.wave * 16, tok = tok0 + l15;
        const float* w0 = rw + (size_t)l15 * 1024 + 4 * quad; const float* w1 = w0 + 16 * 1024; const float* w2 = rw + (size_t)(32 + (l15 & 3)) * 1024 + 4 * quad;
        f32x4 acc0 = {0.f, 0.f, 0.f, 0.f}, acc1 = acc0, acc2 = acc0; float ss = 0.f;
        f32x4 nxt[16];
#pragma unroll
        for (int r = 0; r < 16; ++r) nxt[r] = *(const f32x4*)(X + (size_t)(tok0 + r) * D + 4 * F.lane);
#pragma unroll 1
        for (int ch = 0; ch < 4; ++ch) {
#pragma unroll
            for (int r = 0; r < 16; ++r) { *(LAS f32x4*)(xt + r * XT_LD + 4 * F.lane) = nxt[r]; *(u32x2*)(XnB + (size_t)(tok0 + r) * D + 256 * ch + 4 * F.lane) = pack4(nxt[r]); }
            if (ch < 3) {
#pragma unroll
                for (int r = 0; r < 16; ++r) nxt[r] = *(const f32x4*)(X + (size_t)(tok0 + r) * D + 256 * (ch + 1) + 4 * F.lane); }
#pragma unroll 4
            for (int i = 0; i < 16; ++i) {
                const int k0 = 256 * ch + 16 * i;
                const f32x4 xv = *(const LAS f32x4*)(xt + l15 * XT_LD + 16 * i + 4 * quad), b0 = *(const f32x4*)(w0 + k0), b1 = *(const f32x4*)(w1 + k0), b2 = *(const f32x4*)(w2 + k0);
                ss += (xv[0] * xv[0] + xv[1] * xv[1]) + (xv[2] * xv[2] + xv[3] * xv[3]);
#pragma unroll
                for (int jj = 0; jj < 4; ++jj) {
                    acc0 = __builtin_amdgcn_mfma_f32_16x16x4f32(xv[jj], b0[jj], acc0, 0, 0, 0);
                    acc1 = __builtin_amdgcn_mfma_f32_16x16x4f32(xv[jj], b1[jj], acc1, 0, 0, 0);
                    acc2 = __builtin_amdgcn_mfma_f32_16x16x4f32(xv[jj], b2[jj], acc2, 0, 0, 0);
                }
            }
        }
        ss += __shfl_xor(ss, 16); ss += __shfl_xor(ss, 32);
        const float r = 1.0f / sqrtf(ss * (1.0f / D) + RMS_EPS);
        if (quad == 0) Rout[tok] = r;
#pragma unroll
        for (int i = 0; i < 4; ++i) { const float rt = __shfl(r, 4 * quad + i); const int trow = 4 * quad + i;
            lg[trow * 36 + l15] = acc0[i] * rt + bre[l15]; lg[trow * 36 + 16 + l15] = acc1[i] * rt + bre[16 + l15];
            if (l15 < 4) lg[trow * 36 + 32 + l15] = acc2[i] * rt + brg[l15]; }
        __syncthreads();
        int e0 = 0, e1 = 0, rk0 = 0, rk1 = 0; float wt0 = 0.f, wt1 = 0.f;
        if (F.lane < 16) {
            const LAS float* L = lg + F.lane * 36;
            const float g0 = L[32], g1 = L[33], g2 = L[34], g3 = L[35];
            float gm = g0; int gt = 0; if (g1 > gm) { gm = g1; gt = 1; } if (g2 > gm) { gm = g2; gt = 2; } if (g3 > gm) { gm = g3; gt = 3; }
            const float pg = 1.0f / (expf(g0 - gm) + expf(g1 - gm) + expf(g2 - gm) + expf(g3 - gm));
            float v0 = -INFINITY, v1 = -INFINITY; int i0 = 0, i1 = 0;
#pragma unroll
            for (int k = 0; k < 8; ++k) { const float v = L[8 * gt + k]; if (v > v0) { v1 = v0; i1 = i0; v0 = v; i0 = k; } else if (v > v1) { v1 = v; i1 = k; } }
            const float ex = expf(v1 - v0); const float s0 = 1.0f / (1.0f + ex);
            wt0 = pg * s0; wt1 = pg * (ex * s0); e0 = 8 * gt + i0; e1 = 8 * gt + i1;
            rk0 = (int)atomicAdd((unsigned*)&cntl[e0], 1u); rk1 = (int)atomicAdd((unsigned*)&cntl[e1], 1u);
        }
        __syncthreads();
        if (F.tid < 32) { const unsigned c = cntl[F.tid]; basel[F.tid] = c ? __hip_atomic_fetch_add(gcnt + F.tid, c, __ATOMIC_RELAXED, __HIP_MEMORY_SCOPE_AGENT) : 0u; }
        __syncthreads();
        if (F.lane < 16) {
            const int tk = base + F.wave * 16 + F.lane; const float rr = r;
            const size_t s0 = (size_t)e0 * ECAP + basel[e0] + rk0, s1 = (size_t)e1 * ECAP + basel[e1] + rk1;
            rowl[s0] = 2 * tk; rowr[s0] = rr; wgt[2 * tk] = wt0;
            rowl[s1] = 2 * tk + 1; rowr[s1] = rr; wgt[2 * tk + 1] = wt1;
        }
        __syncthreads();
    }
}

template <bool FINAL>
__device__ __forceinline__ void phase_combine(const Args& a, const Frame& F0, float* X, bf16_t* XnB, float* Rout) {
    const Frame F = refresh(F0);
    const bf16_t* Y = (const bf16_t*)(F.ws + WS_RB);
    const int gw = F.vcu * NWAVES + F.wave, NGW = F.G * NWAVES;
    for (int m = gw; m < NT; m += NGW) {
        f32x4* xr = (f32x4*)(X + (size_t)m * D) + F.lane; const u32x2* y0 = (const u32x2*)(Y + (size_t)(2 * m) * D) + F.lane; const u32x2* y1 = (const u32x2*)(Y + (size_t)(2 * m + 1) * D) + F.lane;
        f32x4 v[4]; float s = 0.f;
#pragma unroll
        for (int j = 0; j < 4; ++j) { v[j] = xr[64 * j]; const u32x2 p = y0[64 * j], q = y1[64 * j];
            v[j][0] += bflo(p[0]) + bflo(q[0]); v[j][1] += bfhi(p[0]) + bfhi(q[0]); v[j][2] += bflo(p[1]) + bflo(q[1]); v[j][3] += bfhi(p[1]) + bfhi(q[1]);
            s += (v[j][0] * v[j][0] + v[j][1] * v[j][1]) + (v[j][2] * v[j][2] + v[j][3] * v[j][3]); }
        s = wave_sum(s); const float r = 1.0f / sqrtf(s * (1.0f / D) + RMS_EPS);
        if constexpr (FINAL) {
            const f32x4* g = (const f32x4*)a.in[I_NFIN] + F.lane;
#pragma unroll
            for (int j = 0; j < 4; ++j) xr[64 * j] = v[j] * r * g[64 * j];
        } else {
            if (F.lane == 0) Rout[m] = r;
            u32x2* o8 = (u32x2*)(XnB + (size_t)m * D) + F.lane;
#pragma unroll
            for (int j = 0; j < 4; ++j) { xr[64 * j] = v[j]; o8[64 * j] = pack4(v[j]); }
        }
    }
}

__device__ __forceinline__ void phase_cmp2(const Frame& F0) {
    const Frame F = refresh(F0);
    const bf16_t* HID = (const bf16_t*)(F.ws + WS_RD + RD_HID); const bf16_t* W2T = (const bf16_t*)(F.ws + WS_W2T);
    bf16_t* KCMP = (bf16_t*)(F.ws + WS_RD + RD_KCMP); bf16_t* VCMPT = (bf16_t*)(F.ws + WS_RD + RD_VCMPT);
    const int gw = F.vcu * NWAVES + F.wave, NGW = F.G * NWAVES, l15 = F.lane & 15, quad = F.lane >> 4;
    for (int task = gw; task < 1024; task += NGW) {
        const int kv = task >> 9, r0 = (task & 511) * 16;
        const bf16_t* ap = HID + ((size_t)kv * 8192 + r0 + l15) * 256 + 8 * quad; const bf16_t* bp = W2T + (size_t)kv * 64 * 256 + (size_t)l15 * 256 + 8 * quad;
        f32x4 acc[4];
#pragma unroll
        for (int cb = 0; cb < 4; ++cb) acc[cb] = (f32x4){0.f, 0.f, 0.f, 0.f};
#pragma unroll
        for (int ks = 0; ks < 8; ++ks) { const bf16x8 af = *(const bf16x8*)(ap + 32 * ks);
#pragma unroll
            for (int cb = 0; cb < 4; ++cb) acc[cb] = __builtin_amdgcn_mfma_f32_16x16x32_bf16(af, *(const bf16x8*)(bp + (size_t)cb * 16 * 256 + 32 * ks), acc[cb], 0, 0, 0); }
#pragma unroll
        for (int cb = 0; cb < 4; ++cb)
#pragma unroll
            for (int i = 0; i < 4; ++i) { const int row = r0 + 4 * quad + i, bg = row >> 10, c = row & 1023, col = l15 + 16 * cb;
                if (kv == 0) KCMP[((size_t)bg * 1024 + c) * 64 + col] = (bf16_t)f2bf(acc[cb][i]);
                else VCMPT[((size_t)bg * 64 + col) * 1024 + c] = (bf16_t)f2bf(acc[cb][i]); }
    }
}

namespace nsa {
constexpr int SLOTB = 16384;
constexpr int NS_CMP = 4, NS_SW = 8;
constexpr int A_IMP = NS_CMP * SLOTB, IMP_LD = 260, A_SELM = 145408, A_UW = A_SELM + 64 * 8 * 4, A_UB = A_UW + 64 * 4, A_TL = A_UB + 64, A_END = A_TL + 260 * 4;
static_assert(A_IMP + 64 * IMP_LD * 4 <= A_SELM && NS_SW * SLOTB <= A_SELM && A_END <= MISC_OFF, "attention LDS");
struct Ctx { int tid, lane, wave, l15, quad, qi, h, sw; LAS unsigned char* lds; };
struct SubState { float m, l, L; f32x4 O[4]; };

template <int MODE>
__device__ __forceinline__ void sub_scores(const Ctx& c, const LAS unsigned char* kb, int kc0, int kc1, const bf16x8 (&qf)[2], SubState& st, int lo, int hi, bool rowsel, bool needmask, int kidx0, float invl, int sgi, bf16x8 (&pf)[2]) {
    constexpr float THR = 8.0f;
    const float mr = (st.m == -INFINITY) ? 0.f : st.m;
    const float cneg = (MODE == 2 && !rowsel) ? -INFINITY : -mr;
    const f32x4 cinit = {cneg, cneg, cneg, cneg};
    f32x4 S[4];
#pragma unroll
    for (int mb = 0; mb < 4; ++mb) {
        const bf16x8 k0 = *(const LAS bf16x8*)(kb + mb * 2048 + kc0), k1 = *(const LAS bf16x8*)(kb + mb * 2048 + kc1);
        S[mb] = __builtin_amdgcn_mfma_f32_16x16x32_bf16(k0, qf[0], cinit, 0, 0, 0);
        S[mb] = __builtin_amdgcn_mfma_f32_16x16x32_bf16(k1, qf[1], S[mb], 0, 0, 0); }
    if (needmask) {
#pragma unroll
        for (int mb = 0; mb < 4; ++mb)
#pragma unroll
            for (int i = 0; i < 4; ++i) { const int off = 16 * mb + 4 * c.quad + i; S[mb][i] = (off >= lo && off <= hi) ? S[mb][i] : -INFINITY; }
    }
    if (MODE != 1) {
        float tmax = max3f(S[0][0], S[0][1], S[0][2]), tmx2 = max3f(S[0][3], S[1][0], S[1][1]);
        tmax = max3f(tmax, S[1][2], S[1][3]); tmx2 = max3f(tmx2, S[2][0], S[2][1]); tmax = max3f(tmax, S[2][2], S[2][3]); tmx2 = max3f(tmx2, S[3][0], S[3][1]); tmax = max3f(tmax, S[3][2], S[3][3]); tmax = fmaxf(tmax, tmx2);
        const bool fresh = st.m == -INFINITY;
        if (__any((tmax > THR) || (fresh && tmax > -INFINITY))) {
            tmax = max_x16(tmax); tmax = max_x32(tmax);
            const bool upd = (tmax > THR) || (fresh && tmax > -INFINITY);
            const float d = upd ? tmax : 0.f;
            const float alpha = fresh ? 1.0f : __builtin_amdgcn_exp2f(-d);
#pragma unroll
            for (int mb = 0; mb < 4; ++mb) S[mb] = S[mb] - d;
            st.l *= alpha;
            if (MODE != 0) { st.L = st.L * alpha;
#pragma unroll
                for (int db = 0; db < 4; ++db) st.O[db] = st.O[db] * alpha; }
            st.m = upd ? mr + d : st.m;
        }
    }
    float ps = 0.f;
#pragma unroll
    for (int mb = 0; mb < 4; ++mb)
#pragma unroll
        for (int i = 0; i < 4; ++i) { float p = __builtin_amdgcn_exp2f(S[mb][i]); if (MODE == 1) p *= invl; S[mb][i] = p; if (MODE == 0) ps += p; }
    if (MODE == 0) { st.l += ps; return; }
    if (MODE == 1) {
        LAS float* imp = (LAS float*)(c.lds + A_IMP) + (c.wave * 8 + sgi * 4 + c.qi) * IMP_LD + (kidx0 >> 2) + c.quad;
#pragma unroll
        for (int mb = 0; mb < 4; ++mb) { float a = (S[mb][0] + S[mb][1]) + (S[mb][2] + 0.5f * S[mb][3]), b = 0.5f * S[mb][3];
            a += dpp_x1(a); a += dpp_x2(a); b += dpp_x1(b); b += dpp_x2(b);
            if (c.h == 0) { __hip_atomic_fetch_add(imp + 4 * mb, a, __ATOMIC_RELAXED, __HIP_MEMORY_SCOPE_WORKGROUP); __hip_atomic_fetch_add(imp + 4 * mb + 1, b, __ATOMIC_RELAXED, __HIP_MEMORY_SCOPE_WORKGROUP); } }
    }
#pragma unroll
    for (int k2 = 0; k2 < 2; ++k2) { const u32x4 w = pack8(S[2 * k2], S[2 * k2 + 1]); pf[k2] = __builtin_bit_cast(bf16x8, w); }
    if (MODE != 1) {
        const bf16x8 ones = {0x3F80, 0x3F80, 0x3F80, 0x3F80, 0x3F80, 0x3F80, 0x3F80, 0x3F80};
        f32x4 la = __builtin_amdgcn_mfma_f32_16x16x32_bf16(ones, pf[0], (f32x4){0.f, 0.f, 0.f, 0.f}, 0, 0, 0);
        la = __builtin_amdgcn_mfma_f32_16x16x32_bf16(ones, pf[1], la, 0, 0, 0); st.L += la[0]; }
}
template <int MODE, bool A0, bool A1>
__device__ __forceinline__ void tile_compute2(const Ctx& c, int slotoff, const bf16x8 (&qf)[2][2], SubState (&st)[2], const int (&lo)[2], const int (&hi)[2], const bool (&rowsel)[2], const bool (&needmask)[2], int kidx0, const float (&invl)[2]) {
    const LAS unsigned char* kb = c.lds + slotoff + c.l15 * 128;
    const LAS unsigned char* vb = c.lds + slotoff + 8192 + c.l15 * 128 + 8 * (c.quad & 1);
    const int kc0 = ((c.quad) ^ c.sw) * 16, kc1 = ((4 + c.quad) ^ c.sw) * 16;
    const int vq = c.quad >> 1;
    const int vc[2][2] = {{((vq) ^ c.sw) * 16, ((vq + 2) ^ c.sw) * 16}, {((4 + vq) ^ c.sw) * 16, ((6 + vq) ^ c.sw) * 16}};
    bf16x8 pf[2][2];
    if (A0) sub_scores<MODE>(c, kb, kc0, kc1, qf[0], st[0], lo[0], hi[0], rowsel[0], needmask[0], kidx0, invl[0], 0, pf[0]);
    if (A1) sub_scores<MODE>(c, kb, kc0, kc1, qf[1], st[1], lo[1], hi[1], rowsel[1], needmask[1], kidx0, invl[1], 1, pf[1]);
    if (MODE == 0) return;
#pragma unroll
    for (int db = 0; db < 4; ++db)
#pragma unroll
        for (int k2 = 0; k2 < 2; ++k2) {
            const s16x4 a = *(const LAS s16x4*)(vb + db * 2048 + vc[k2][0]), b = *(const LAS s16x4*)(vb + db * 2048 + vc[k2][1]);
            const bf16x8 vf = (bf16x8){a[0], a[1], a[2], a[3], b[0], b[1], b[2], b[3]};
            if (A0) st[0].O[db] = __builtin_amdgcn_mfma_f32_16x16x32_bf16(vf, pf[0][k2], st[0].O[db], 0, 0, 0);
            if (A1) st[1].O[db] = __builtin_amdgcn_mfma_f32_16x16x32_bf16(vf, pf[1][k2], st[1].O[db], 0, 0, 0);
        }
}
template <int MODE>
__device__ __forceinline__ void tile_compute(const Ctx& c, int slotoff, const bf16x8 (&qf)[2][2], SubState (&st)[2], const int (&lo)[2], const int (&hi)[2], const bool (&rowsel)[2], const bool (&act)[2], int kidx0, const float (&invl)[2]) {
    bool needmask[2];
#pragma unroll
    for (int s = 0; s < 2; ++s) needmask[s] = __any((MODE == 2 ? rowsel[s] : true) && (lo[s] > 0 || hi[s] < 63)) != 0;
    if (act[0] && act[1]) tile_compute2<MODE, true, true>(c, slotoff, qf, st, lo, hi, rowsel, needmask, kidx0, invl);
    else if (act[0]) tile_compute2<MODE, true, false>(c, slotoff, qf, st, lo, hi, rowsel, needmask, kidx0, invl);
    else if (act[1]) tile_compute2<MODE, false, true>(c, slotoff, qf, st, lo, hi, rowsel, needmask, kidx0, invl);
}
}

namespace nsa {
struct Tensors { const bf16_t* Q; const f32x2* rope; const float* gates; const bf16_t *KS, *VTS, *KW, *VTW, *KCMP, *VCMPT; bf16_t* O; bf16_t* DBG; float* SCR; float* PROBE; };

struct Dma {
    int wave; unsigned koff, voffrow, vchk;
    __device__ __forceinline__ void init(int wave_, int lane) { wave = wave_; const int row = 8 * wave_ + (lane >> 3), chs = (lane & 7) ^ ((row >> 1) & 7); koff = (unsigned)(row * 64 + chs * 8); voffrow = (unsigned)row; vchk = (unsigned)(chs * 8); }
    __device__ __forceinline__ void issue(LAS unsigned char* lds, int slotoff, const bf16_t* K, const bf16_t* VT, size_t vpitch, int kidx0, bool withv = true) const {
        __builtin_amdgcn_global_load_lds((const unsigned*)(K + (size_t)kidx0 * 64 + koff), (LAS unsigned*)(lds + slotoff + wave * 1024), 16, 0, 0);
        if (withv) __builtin_amdgcn_global_load_lds((const unsigned*)(VT + (size_t)voffrow * vpitch + kidx0 + vchk), (LAS unsigned*)(lds + slotoff + 8192 + wave * 1024), 16, 0, 0);
    }
};
#define NSA_WAIT_V(n) asm volatile("s_waitcnt vmcnt(" #n ")" ::: "memory")
#define NSA_BAR() do { asm volatile("" ::: "memory"); __builtin_amdgcn_s_barrier(); asm volatile("" ::: "memory"); } while (0)
#define NSA_RING_BG(G, WITHV, NTILES, TILE, BODY) do { \
        const int n_ = (NTILES); int so_ = 0; \
        _Pragma("unroll") for (int k_ = 0; k_ < (G); ++k_) if (k_ < n_) dma.issue(lds, k_ * SLOTB, KPTR, VPTR, VPITCH, TILE(k_), WITHV); \
        _Pragma("unroll 1") for (int i_ = 0; i_ < n_; ++i_) { \
            if ((i_ % (G)) == 0) { NSA_WAIT_V(0); NSA_BAR(); const int other_ = (((i_ / (G)) & 1) ? 0 : (G) * SLOTB); \
                _Pragma("unroll") for (int k_ = 0; k_ < (G); ++k_) if (i_ + (G) + k_ < n_) dma.issue(lds, other_ + k_ * SLOTB, KPTR, VPTR, VPITCH, TILE(i_ + (G) + k_), WITHV); } \
            BODY(i_, so_); \
            so_ = (so_ == (2 * (G) - 1) * SLOTB) ? 0 : so_ + SLOTB; } \
        NSA_WAIT_V(0); NSA_BAR(); } while (0)
#define NSA_RING_B4(NTILES, TILE, BODY) NSA_RING_BG(4, true, NTILES, TILE, BODY)
#define NSA_RING(NS, WITHV, NTILES, TILE, BODY) do { \
        const int n_ = (NTILES); int sl_issue_ = 0, sl_cur_ = 0; \
        _Pragma("unroll") for (int p_ = 0; p_ < (NS) - 1; ++p_) { const int ti_ = p_ < n_ ? p_ : n_ - 1; dma.issue(lds, sl_issue_, KPTR, VPTR, VPITCH, TILE(ti_), WITHV); sl_issue_ += SLOTB; } \
        _Pragma("unroll 1") for (int i_ = 0; i_ < n_; ++i_) { \
            static_assert((NS) == 3 || (NS) == 4, "ring depth"); \
            if ((NS) == 3) { if (WITHV) NSA_WAIT_V(2); else NSA_WAIT_V(1); } else { if (WITHV) NSA_WAIT_V(4); else NSA_WAIT_V(2); } \
            NSA_BAR(); \
            { const int ti_ = (i_ + (NS) - 1) < n_ ? (i_ + (NS) - 1) : n_ - 1; dma.issue(lds, sl_issue_, KPTR, VPTR, VPITCH, TILE(ti_), WITHV); sl_issue_ = (sl_issue_ == ((NS) - 1) * SLOTB) ? 0 : sl_issue_ + SLOTB; } \
            BODY(i_, sl_cur_); \
            sl_cur_ = (sl_cur_ == ((NS) - 1) * SLOTB) ? 0 : sl_cur_ + SLOTB; } \
        NSA_WAIT_V(0); NSA_BAR(); } while (0)


constexpr int QT_HP = 128, QT_QP = 512, I_STG = 64 * QT_QP, STG_COL = 144, STG_JOB = 16 * STG_COL, STG_BUF = 8 * STG_JOB;
constexpr int I_RIDX = I_STG + 2 * STG_BUF, I_JOBS = I_RIDX + 1024, I_CM = I_JOBS + 2080, I_NJ = I_CM + 2048, I_JOBQ = I_NJ + 1040, I_MREF = I_JOBQ + 2080, I_VSL = ((I_MREF + 1024 + 1023) / 1024) * 1024, I_INV_END = I_VSL + 8 * 8192;
static_assert(I_INV_END <= A_SELM && (I_CM % 8) == 0, "inverted-branch LDS map");
__device__ __forceinline__ int nth_set_bit(unsigned long long m, int r) {
    const unsigned lo = (unsigned)m, hi = (unsigned)(m >> 32); int c = __popc(lo); const bool up = r >= c; unsigned w = up ? hi : lo; int base = up ? 32 : 0; r -= up ? c : 0;
#pragma unroll
    for (int sh = 16; sh >= 1; sh >>= 1) { const unsigned low = w & ((1u << sh) - 1u); c = __popc(low); const bool u2 = r >= c; r -= u2 ? c : 0; base += u2 ? sh : 0; w = u2 ? (w >> sh) : low; }
    return base;
}
__device__ __forceinline__ void selected_inverted(const Ctx& c, const Tensors& T, LAS unsigned char* lds, const bf16x8 (&qr)[2][2], SubState (&st)[2], int t0, int bg, int qt) {
    constexpr float L2E = 1.4426950408889634f;
    const LAS unsigned* selm = (const LAS unsigned*)(lds + A_SELM);
    LAS unsigned long long* CM = (LAS unsigned long long*)(lds + I_CM); LAS int* NJ = (LAS int*)(lds + I_NJ); LAS unsigned* JOBS = (LAS unsigned*)(lds + I_JOBS);
#pragma unroll
    for (int s = 0; s < 2; ++s) { LAS unsigned char* qd = lds + (c.wave * 8 + 4 * s + c.qi) * QT_QP + c.h * QT_HP + 16 * c.quad; *(LAS bf16x8*)qd = qr[s][0]; *(LAS bf16x8*)(qd + 64) = qr[s][1]; }
    { const unsigned word = selm[c.lane * 8 + c.wave]; unsigned long long mine = 0ull;
#pragma unroll 1
      for (int jj = 0; jj < 32; ++jj) { const unsigned long long m = __ballot((word >> jj) & 1u); mine = (c.lane == jj) ? m : mine; }
      if (c.lane < 32) { const int jb = 32 * c.wave + c.lane; CM[jb] = (jb == 0 || jb == qt || jb == qt - 1) ? 0ull : mine; } }
    if (c.tid < 256) ((LAS unsigned*)(lds + I_RIDX))[c.tid] = 0xFFFFFFFFu;
#pragma unroll
    for (int s = 0; s < 2; ++s) if (c.quad == 0) ((LAS float*)(lds + I_MREF))[(c.wave * 8 + 4 * s + c.qi) * 4 + c.h] = st[s].m;
    __syncthreads();
    if (c.tid < 256) NJ[c.tid] = (__popcll(CM[c.tid]) + 3) >> 2;
    __syncthreads();
    if (c.tid < 256) { int pre = 0; const int i4 = c.tid >> 2;
#pragma clang loop vectorize(disable) unroll(disable)
        for (int i = 0; i < i4; ++i) { const LAS int* p4 = NJ + 4 * i; pre += (p4[0] + p4[1]) + (p4[2] + p4[3]); }
#pragma clang loop vectorize(disable) unroll(disable)
        for (int i = 4 * i4; i < c.tid; ++i) pre += NJ[i];
        const int cnt = NJ[c.tid];
        unsigned long long mrem = CM[c.tid];
        for (int t = 0; t < cnt; ++t) { JOBS[pre + t] = (unsigned)c.tid | ((unsigned)t << 16); unsigned qb = 0u;
#pragma unroll
            for (int u = 0; u < 4; ++u) { unsigned q = 0xffu; if (mrem) { q = (unsigned)__ffsll((long long)mrem) - 1u; mrem &= mrem - 1ull; } qb |= q << (8 * u); }
            ((LAS unsigned*)(lds + I_JOBQ))[pre + t] = qb; }
        if (c.tid == 255) NJ[256] = pre + cnt; }
    __syncthreads();
    const int njobs = __builtin_amdgcn_readfirstlane(NJ[256]), nrounds = (njobs + 7) >> 3;
    if (njobs == 0) { __syncthreads(); return; }
    const bf16_t* Ks = T.KS + (size_t)bg * SEQ * 64; const bf16_t* Vs = T.VTS + (size_t)bg * 64 * SEQ;
    const unsigned koff = (unsigned)((8 * (c.l15 >> 2) + (c.l15 & 3)) * 64 + 8 * c.quad);
    bf16x8 kf[4][2];
    const int vslot = I_VSL + c.wave * 8192;
    const unsigned vdoff = (unsigned)((c.lane >> 3) * SEQ + (unsigned)(((c.lane & 7) ^ ((c.lane >> 4) & 7)) * 8));
#define VDMA(jblk) do { const bf16_t* vb_ = Vs + (size_t)(64 * (jblk)); _Pragma("unroll") for (int i_ = 0; i_ < 8; ++i_) { \
        const unsigned ch_ = (unsigned)((((c.lane & 7) ^ ((4 * i_ + (c.lane >> 4)) & 7))) * 8); \
        __builtin_amdgcn_global_load_lds((const unsigned*)(vb_ + (size_t)(8 * i_ + (c.lane >> 3)) * SEQ + ch_), (LAS unsigned*)(lds + vslot + i_ * 1024), 16, 0, 0); } } while (0)
    {   const int ji0 = min(c.wave, njobs - 1); const int j0 = __builtin_amdgcn_readfirstlane((int)(JOBS[ji0] & 0xffffu));
        const bf16_t* kb = Ks + (size_t)(64 * j0) * 64;
#pragma unroll
        for (int mb = 0; mb < 4; ++mb) { const unsigned ko = koff + (unsigned)((32 * (mb >> 1) + 4 * (mb & 1)) * 64); kf[mb][0] = *(const bf16x8*)(kb + ko); kf[mb][1] = *(const bf16x8*)(kb + (ko + 32u)); }
        VDMA(j0); }
    float dcur[2] = {0.f, 0.f};
    const LAS unsigned char* vfb = lds + vslot + c.l15 * 128;
    const int vch0 = ((c.quad) ^ c.sw) * 16, vch1 = ((4 + c.quad) ^ c.sw) * 16;
    int buf = 0;
#if PROBE_T
    unsigned long long tacc = 0ull, tmark;
#define TMARK() (tmark = __builtin_amdgcn_s_memtime())
#define TACC(sel) do { if (PROBE_T == (sel)) tacc += __builtin_amdgcn_s_memtime() - tmark; } while (0)
#else
#define TMARK() do {} while (0)
#define TACC(sel) do {} while (0)
#endif
#pragma unroll 1
    for (int r = 0; r < nrounds; ++r) {
        TMARK();
        const int jiu = 8 * r + c.wave; const bool has = jiu < njobs; const int ji = has ? jiu : njobs - 1;
        const int jin = min(jiu + 8, njobs - 1);
        const unsigned jw = JOBS[ji], jwn = JOBS[jin];
        const int j = __builtin_amdgcn_readfirstlane((int)(jw & 0xffffu)), t = __builtin_amdgcn_readfirstlane((int)(jw >> 16)), jn = __builtin_amdgcn_readfirstlane((int)(jwn & 0xffffu));
        const unsigned qb = ((const LAS unsigned*)(lds + I_JOBQ))[ji]; const unsigned qraw = (qb >> (8 * c.qi)) & 0xffu; const bool valid = has && qraw != 0xffu;
        const int qidx = (int)(qraw != 0xffu ? qraw : (qb & 0xffu)); const int hi = t0 + qidx - 64 * j;
        const LAS unsigned char* qa = lds + qidx * QT_QP + c.h * QT_HP + 16 * c.quad;
        const bf16x8 q0 = *(const LAS bf16x8*)qa, q1 = *(const LAS bf16x8*)(qa + 64);
#if PROBE_T
        asm volatile("s_waitcnt lgkmcnt(0)" ::: "memory"); TACC(4); TMARK();
#endif
        const float mref = ((const LAS float*)(lds + I_MREF))[qidx * 4 + c.h];
        const f32x4 cinit = {-mref, -mref, -mref, -mref};
        f32x4 S[4];
#pragma unroll
        for (int mb = 0; mb < 4; ++mb) {
            S[mb] = __builtin_amdgcn_mfma_f32_16x16x32_bf16(kf[mb][0], q0, cinit, 0, 0, 0);
            S[mb] = __builtin_amdgcn_mfma_f32_16x16x32_bf16(kf[mb][1], q1, S[mb], 0, 0, 0); }
        {   const bf16_t* kb = Ks + (size_t)(64 * jn) * 64;
#pragma unroll
            for (int mb = 0; mb < 4; ++mb) { const unsigned ko = koff + (unsigned)((32 * (mb >> 1) + 4 * (mb & 1)) * 64); kf[mb][0] = *(const bf16x8*)(kb + ko); kf[mb][1] = *(const bf16x8*)(kb + (ko + 32u)); } }
        if (__any(hi < 63)) {
#pragma unroll
            for (int mb = 0; mb < 4; ++mb)
#pragma unroll
                for (int i = 0; i < 4; ++i) { const int off = 32 * (mb >> 1) + 8 * c.quad + 4 * (mb & 1) + i; S[mb][i] = off <= hi ? S[mb][i] : -INFINITY; }
        }
        float tmax = max3f(S[0][0], S[0][1], S[0][2]), tmx2 = max3f(S[0][3], S[1][0], S[1][1]);
        tmax = max3f(tmax, S[1][2], S[1][3]); tmx2 = max3f(tmx2, S[2][0], S[2][1]); tmax = max3f(tmax, S[2][2], S[2][3]); tmx2 = max3f(tmx2, S[3][0], S[3][1]); tmax = max3f(tmax, S[3][2], S[3][3]); tmax = fmaxf(tmax, tmx2);
        float dsh = 0.f;
        if (__any(tmax > 8.0f)) { tmax = max_x16(tmax); tmax = max_x32(tmax); dsh = tmax > 8.0f ? tmax : 0.f;
#pragma unroll
            for (int mb = 0; mb < 4; ++mb) S[mb] = S[mb] - dsh; }
#pragma unroll
        for (int mb = 0; mb < 4; ++mb)
#pragma unroll
            for (int i = 0; i < 4; ++i) S[mb][i] = __builtin_amdgcn_exp2f(S[mb][i]);
        bf16x8 pf[2];
#pragma unroll
        for (int k2 = 0; k2 < 2; ++k2) { const u32x4 w = pack8(S[2 * k2], S[2 * k2 + 1]); pf[k2] = __builtin_bit_cast(bf16x8, w); }
        const bf16x8 ones = {0x3F80, 0x3F80, 0x3F80, 0x3F80, 0x3F80, 0x3F80, 0x3F80, 0x3F80};
        f32x4 la = __builtin_amdgcn_mfma_f32_16x16x32_bf16(ones, pf[0], (f32x4){0.f, 0.f, 0.f, 0.f}, 0, 0, 0);
        la = __builtin_amdgcn_mfma_f32_16x16x32_bf16(ones, pf[1], la, 0, 0, 0);
        const float ps = la[0];
#if PROBE_T
        asm volatile("s_nop 0" : "+v"(pf[0]), "+v"(pf[1])); TACC(6); TMARK();
#endif
        LAS unsigned char* sg = lds + I_STG + buf * STG_BUF + c.wave * STG_JOB + c.l15 * STG_COL;
        asm volatile("s_waitcnt vmcnt(8)" ::: "memory");
        bf16x8 vfr[4][2];
#pragma unroll
        for (int db = 0; db < 4; ++db) { vfr[db][0] = *(const LAS bf16x8*)(vfb + db * 2048 + vch0); vfr[db][1] = *(const LAS bf16x8*)(vfb + db * 2048 + vch1); }
        asm volatile("s_waitcnt lgkmcnt(0)" ::: "memory");
        VDMA(jn);
#pragma unroll
        for (int db = 0; db < 4; ++db) { f32x4 o = __builtin_amdgcn_mfma_f32_16x16x32_bf16(vfr[db][0], pf[0], (f32x4){0.f, 0.f, 0.f, 0.f}, 0, 0, 0);
            o = __builtin_amdgcn_mfma_f32_16x16x32_bf16(vfr[db][1], pf[1], o, 0, 0, 0);
            *(LAS u32x2*)(sg + (16 * db + 4 * c.quad) * 2) = pack4(o); }
        if (c.quad == 0) { *(LAS f32x2*)(sg + 128) = (f32x2){dsh, ps};
            if (c.h == 0 && valid) (lds + I_RIDX + buf * 512 + qidx * 8)[c.wave] = (unsigned char)c.qi; }
        asm volatile("s_waitcnt lgkmcnt(0)" ::: "memory"); TACC(7); TACC(1); TMARK(); NSA_BAR(); TACC(2); TMARK();
#pragma unroll
        for (int s = 0; s < 2; ++s) {
            LAS unsigned char* rx = lds + I_RIDX + buf * 512 + (c.wave * 8 + 4 * s + c.qi) * 8;
            const u32x2 idx = *(const LAS u32x2*)rx;
#pragma unroll
            for (int k = 0; k < (PROBE_NOMERGE ? 0 : 8); ++k) { const unsigned u = ((k < 4 ? idx[0] : idx[1]) >> (8 * (k & 3))) & 0xffu; const bool hit = u != 0xffu;
                if (__any(hit)) {
                    const LAS unsigned char* sp = lds + I_STG + buf * STG_BUF + k * STG_JOB + ((hit ? (int)u : 0) * 4 + c.h) * STG_COL;
                    const f32x2 ml = *(const LAS f32x2*)(sp + 128);
                    const float dt = hit ? ml[0] : dcur[s], lt = hit ? ml[1] : 0.f;
                    const float dn = fmaxf(dt, dcur[s]); const float a = __builtin_amdgcn_exp2f(dcur[s] - dn), b = hit ? __builtin_amdgcn_exp2f(dt - dn) : 0.f;
                    st[s].L = st[s].L * a + lt * b; dcur[s] = dn;
#pragma unroll
                    for (int db = 0; db < 4; ++db) { const u32x2 ow = *(const LAS u32x2*)(sp + (16 * db + 4 * c.quad) * 2);
                        const f32x4 o = hit ? (f32x4){bflo(ow[0]), bfhi(ow[0]), bflo(ow[1]), bfhi(ow[1])} : (f32x4){0.f, 0.f, 0.f, 0.f};
                        st[s].O[db] = st[s].O[db] * a + o * b; }
                }
            }
            if (c.h == 0 && c.quad == 0) *(LAS u32x2*)rx = (u32x2){0xFFFFFFFFu, 0xFFFFFFFFu};
        }
        TACC(3);
        buf ^= 1;
    }
#if PROBE_T
    if (blockIdx.x == 17 && c.tid == 64 && t0 >= 64 * 200) { const float n = (float)(tacc / (unsigned long long)nrounds) * 0.01f; *((volatile float*)T.PROBE) = n; }
#endif
    asm volatile("s_waitcnt vmcnt(0)" ::: "memory");
    __syncthreads();
#undef VDMA
}

__device__ __forceinline__ void attn_unit(const Tensors& T, LAS unsigned char* lds, int tid_in, int b, int g, int qt) {
    Ctx c; { int t_ = tid_in; asm volatile("" : "+v"(t_)); c.tid = t_; } c.lane = c.tid & 63; c.wave = __builtin_amdgcn_readfirstlane(c.tid >> 6); c.l15 = c.lane & 15; c.quad = c.lane >> 4; c.qi = c.l15 >> 2; c.h = c.l15 & 3; c.sw = (c.l15 >> 1) & 7; c.lds = lds;
    const int t0 = qt * 64, bg = b * 4 + g; const unsigned tokbase = (unsigned)b * SEQ;
    Dma dma; dma.init(c.wave, c.lane);
    int tq[2]; tq[0] = t0 + c.wave * 8 + c.qi; tq[1] = tq[0] + 4;
    bf16x8 qc[2][2];
#pragma unroll
    for (int s = 0; s < 2; ++s) {
        const bf16_t* qp = T.Q + (tokbase + tq[s]) * D + (g * 4 + c.h) * 64 + 8 * c.quad;
        qc[s][0] = *(const bf16x8*)qp; qc[s][1] = *(const bf16x8*)(qp + 32);
    }
#define NSA_GATE(s, br) (T.gates[(tokbase + tq[s]) * 48 + (g * 4 + c.h) * 3 + (br)])
    float* scr0 = T.SCR + (c.wave * 8 + c.qi) * 256 + c.h * 64 + 4 * c.quad;
    for (int i = c.tid; i < 64 * IMP_LD; i += NTHREADS) ((LAS float*)(lds + A_IMP))[i] = 0.f;

    SubState st[2]; int lo[2], hi[2]; bool act[2], rowsel[2] = {true, true}; float invl[2] = {0.f, 0.f};
#define RESET_ST() do { _Pragma("unroll") for (int s = 0; s < 2; ++s) { st[s].m = -INFINITY; st[s].l = 0.f; st[s].L = 0.f; _Pragma("unroll") for (int db = 0; db < 4; ++db) st[s].O[db] = (f32x4){0.f, 0.f, 0.f, 0.f}; } } while (0)
    const int ncmp = min(NCMP, t0 / 16 + 3), ntc = (ncmp + 63) >> 6;
    const bf16_t* Kc = T.KCMP + (size_t)bg * 1024 * 64; const bf16_t* Vc = T.VCMPT + (size_t)bg * 64 * 1024;
    int lim[2];
#pragma unroll
    for (int s = 0; s < 2; ++s) lim[s] = tq[s] >= 31 ? ((tq[s] - 31) >> 4) : -1;
    RESET_ST();
#define KPTR Kc
#define VPTR Vc
#define VPITCH 1024
#define TILE_C(i) (64 * (i))
#define BODY_C0(i, so) do { _Pragma("unroll") for (int s = 0; s < 2; ++s) { lo[s] = 0; hi[s] = lim[s] - 64 * (i); act[s] = true; } tile_compute<0>(c, so, qc, st, lo, hi, rowsel, act, 64 * (i), invl); } while (0)
#define BODY_C1(i, so) do { _Pragma("unroll") for (int s = 0; s < 2; ++s) { lo[s] = 0; hi[s] = lim[s] - 64 * (i); act[s] = true; } tile_compute<1>(c, so, qc, st, lo, hi, rowsel, act, 64 * (i), invl); } while (0)
    if (!(ATT_SKIP & 1)) NSA_RING(NS_CMP, false, ntc, TILE_C, BODY_C0);
#pragma unroll
    for (int s = 0; s < 2; ++s) { float l = st[s].l; l = sum_x16(l); l = sum_x32(l); invl[s] = l > 0.f ? 1.0f / l : 0.f; }
    if (!(ATT_SKIP & 1)) NSA_RING(NS_CMP, true, ntc, TILE_C, BODY_C1);
#undef KPTR
#undef VPTR
#undef VPITCH
#pragma unroll
    for (int s = 0; s < 2; ++s)
#pragma unroll
        for (int db = 0; db < 4; ++db) *(f32x4*)(scr0 + s * 4 * 256 + 16 * db) = st[s].O[db] * NSA_GATE(s, 0);
#if NSA_CHECK
    if (NSA_CHECK_BR == 0) {
#pragma unroll
        for (int s = 0; s < 2; ++s) { bf16_t* op = T.DBG + (tokbase + tq[s]) * D + (g * 4 + c.h) * 64 + 4 * c.quad;
#pragma unroll
            for (int db = 0; db < 4; ++db) *(u32x2*)(op + 16 * db) = pack4(st[s].O[db]); } }
#endif
    {
        LAS float* impw = (LAS float*)(lds + A_IMP) + (c.wave * 8) * IMP_LD;
        unsigned uw = 0u;
        const unsigned long long lt_mask = (1ull << c.lane) - 1ull;
#pragma unroll 1
        for (int qq = (ATT_SKIP & 2) ? 8 : 0; qq < 8; ++qq) {
            const int tqq = t0 + c.wave * 8 + qq, cur = tqq >> 6;
            const int K = 16 - (cur >= 2 ? 3 : cur + 1);
            unsigned key[4]; unsigned long long forced[4];
#pragma unroll
            for (int e = 0; e < 4; ++e) { const int j = c.lane + 64 * e; const bool valid = j <= cur; const bool fo = (j == 0) || (j == cur) || (j == cur - 1);
                key[e] = (valid && !fo) ? (__float_as_uint(impw[qq * IMP_LD + j]) + 1u) : 0u; forced[e] = __ballot(valid && fo); }
            unsigned T = 0u; bool exact = false;
#pragma unroll 1
            for (int bit = 30; bit >= 0; --bit) { const unsigned cand = T | (1u << bit);
                const int cnt = __popcll(__ballot(key[0] >= cand)) + __popcll(__ballot(key[1] >= cand)) + __popcll(__ballot(key[2] >= cand)) + __popcll(__ballot(key[3] >= cand));
                T = (cnt >= K) ? cand : T;
                if (cnt == K) { exact = true; break; } }
            const unsigned Tg = exact ? T - 1u : T;
            unsigned long long sel[4]; int ngt = 0;
#pragma unroll
            for (int e = 0; e < 4; ++e) { sel[e] = __ballot(key[e] > Tg); ngt += __popcll(sel[e]); }
            int r = (T != 0u && !exact) ? (K - ngt) : 0;
#pragma unroll
            for (int e = 0; e < 4; ++e) { const unsigned long long eq = (T != 0u && !exact) ? __ballot(key[e] == T) : 0ull;
                const bool take = ((eq >> c.lane) & 1ull) && (__popcll(eq & lt_mask) < r);
                sel[e] |= __ballot(take) | forced[e]; r -= min(r, (int)__popcll(eq)); }
            unsigned myword = 0u;
#pragma unroll
            for (int e = 0; e < 4; ++e) { myword = (c.lane == 2 * e) ? (unsigned)sel[e] : myword; myword = (c.lane == 2 * e + 1) ? (unsigned)(sel[e] >> 32) : myword; }
            if (c.lane < 8) ((LAS unsigned*)(lds + A_SELM))[(c.wave * 8 + qq) * 8 + c.lane] = myword;
            uw |= myword;
        }
        if (c.lane < 8) ((LAS unsigned*)(lds + A_UW))[c.wave * 8 + c.lane] = uw;
        __syncthreads();
        if (c.tid < 8) { unsigned u = 0u;
#pragma unroll
            for (int w = 0; w < 8; ++w) u |= ((LAS unsigned*)(lds + A_UW))[w * 8 + c.tid];
            ((LAS unsigned*)(lds + A_UB))[c.tid] = u; }
        __syncthreads();
        if (c.tid < 256) { const LAS unsigned* ub = (const LAS unsigned*)(lds + A_UB); const int wj = c.tid >> 5, bj = c.tid & 31; int pos = 0;
#pragma unroll
            for (int w = 0; w < 8; ++w) { const unsigned x = ub[w]; pos += (w < wj) ? __popc(x) : 0; }
            const unsigned xw = ub[wj]; pos += __popc(xw & ((1u << bj) - 1u));
            if ((xw >> bj) & 1u) ((LAS int*)(lds + A_TL))[pos] = c.tid; }
        __syncthreads();
    }
    bf16x8 qr[2][2];
#pragma unroll
    for (int s = 0; s < 2; ++s) {
        const bf16_t* qp = T.Q + (tokbase + tq[s]) * D + (g * 4 + c.h) * 64 + 8 * c.quad;
        const bf16x8 q0 = *(const bf16x8*)qp, q1 = *(const bf16x8*)(qp + 32);
        const f32x4* rp = (const f32x4*)(T.rope + (tokbase + tq[s]) * 32 + 8 * c.quad);
        u32x4 w0, w1;
#pragma unroll
        for (int p = 0; p < 4; ++p) { const f32x4 cs = rp[p];
            const float a0 = bf2f((unsigned short)q0[2 * p]), a1 = bf2f((unsigned short)q0[2 * p + 1]), b0 = bf2f((unsigned short)q1[2 * p]), b1 = bf2f((unsigned short)q1[2 * p + 1]);
            w0[p] = pk2(a0 * cs[0] - b0 * cs[1], a1 * cs[2] - b1 * cs[3]); w1[p] = pk2(b0 * cs[0] + a0 * cs[1], b1 * cs[2] + a1 * cs[3]); }
        qr[s][0] = __builtin_bit_cast(bf16x8, w0); qr[s][1] = __builtin_bit_cast(bf16x8, w1);
    }
    {
        const LAS unsigned* ub = (const LAS unsigned*)(lds + A_UB); int nsel = 0;
#pragma unroll
        for (int w = 0; w < 8; ++w) nsel += __popc(ub[w]);
        nsel = __builtin_amdgcn_readfirstlane(nsel);
        const LAS int* TL = (const LAS int*)(lds + A_TL); const LAS unsigned* selm = (const LAS unsigned*)(lds + A_SELM);
        const bf16_t* Ks = T.KS + (size_t)bg * SEQ * 64; const bf16_t* Vs = T.VTS + (size_t)bg * 64 * SEQ;
        RESET_ST();
#define KPTR Ks
#define VPTR Vs
#define VPITCH SEQ
#define TILE_S(i) (64 * __builtin_amdgcn_readfirstlane(TL[(i)]))
#define BODY_S(i, so) do { const int j = __builtin_amdgcn_readfirstlane(TL[(i)]); \
        _Pragma("unroll") for (int s = 0; s < 2; ++s) { const unsigned w = selm[(c.wave * 8 + 4 * s + c.qi) * 8 + (j >> 5)]; const bool sel = (w >> (j & 31)) & 1u; \
            lo[s] = 0; hi[s] = tq[s] - 64 * j; rowsel[s] = sel; act[s] = __any(sel ? 1 : 0) != 0; } \
        tile_compute<2>(c, so, qr, st, lo, hi, rowsel, act, 64 * j, invl); } while (0)
#if SEL_INVERTED
        if (!(ATT_SKIP & 4)) {
            const int nforced = qt >= 2 ? 3 : qt + 1;
#define TILE_F(i) (64 * ((i) == 0 ? 0 : ((i) == nforced - 1 ? qt : qt - 1)))
#define BODY_F(i, so) do { const int j = ((i) == 0 ? 0 : ((i) == nforced - 1 ? qt : qt - 1)); \
        _Pragma("unroll") for (int s = 0; s < 2; ++s) { lo[s] = 0; hi[s] = tq[s] - 64 * j; rowsel[s] = true; act[s] = true; } \
        tile_compute<2>(c, so, qr, st, lo, hi, rowsel, act, 64 * j, invl); } while (0)
            NSA_RING_B4(nforced, TILE_F, BODY_F);
            selected_inverted(c, T, lds, qr, st, t0, bg, qt);
        }
#else
        if (!(ATT_SKIP & 4)) NSA_RING_B4(nsel, TILE_S, BODY_S);
#endif
#undef KPTR
#undef VPTR
#pragma unroll
        for (int s = 0; s < 2; ++s) { const float l = st[s].L; const float fn = (l > 0.f ? 1.0f / l : 0.f), f = fn * NSA_GATE(s, 1);
#if NSA_CHECK
            if (NSA_CHECK_BR == 1) { bf16_t* op = T.DBG + (tokbase + tq[s]) * D + (g * 4 + c.h) * 64 + 4 * c.quad;
#pragma unroll
                for (int db = 0; db < 4; ++db) *(u32x2*)(op + 16 * db) = pack4(st[s].O[db] * fn); }
#endif
#pragma unroll
            for (int db = 0; db < 4; ++db) { f32x4* p = (f32x4*)(scr0 + s * 4 * 256 + 16 * db); *p = *p + st[s].O[db] * f; } }
    }
    {
        const bf16_t* Kw = T.KW + (size_t)bg * SEQ * 64; const bf16_t* Vw = T.VTW + (size_t)bg * 64 * SEQ;
        const int kt1 = qt, kt0 = max(0, qt - 8), nw = kt1 - kt0 + 1;
        RESET_ST();
#define KPTR Kw
#define VPTR Vw
#define TILE_W(i) (64 * (kt0 + (i)))
#define BODY_W(i, so) do { const int k0 = 64 * (kt0 + (i)); \
        _Pragma("unroll") for (int s = 0; s < 2; ++s) { hi[s] = tq[s] - k0; lo[s] = tq[s] - 511 - k0; act[s] = true; } \
        tile_compute<3>(c, so, qr, st, lo, hi, rowsel, act, k0, invl); } while (0)
        if (!(ATT_SKIP & 8)) NSA_RING_B4(nw, TILE_W, BODY_W);
#undef KPTR
#undef VPTR
#undef VPITCH
#pragma unroll
        for (int s = 0; s < 2; ++s) { const float l = st[s].L; const float fn = (l > 0.f ? 1.0f / l : 0.f), f = fn * NSA_GATE(s, 2);
#if NSA_CHECK
            if (NSA_CHECK_BR == 2) { bf16_t* op = T.DBG + (tokbase + tq[s]) * D + (g * 4 + c.h) * 64 + 4 * c.quad;
#pragma unroll
                for (int db = 0; db < 4; ++db) *(u32x2*)(op + 16 * db) = pack4(st[s].O[db] * fn); }
#endif
            bf16_t* op = T.O + (tokbase + tq[s]) * D + (g * 4 + c.h) * 64 + 4 * c.quad;
#pragma unroll
            for (int db = 0; db < 4; ++db) { const f32x4 v = *(const f32x4*)(scr0 + s * 4 * 256 + 16 * db) + st[s].O[db] * f; *(u32x2*)(op + 16 * db) = pack4(v); } }
    }
#undef RESET_ST
#undef NSA_GATE
}
}


#if NSA_CHECK
namespace chk {
__constant__ int tlist[24] = {0, 1, 30, 31, 32, 47, 63, 64, 65, 79, 127, 128, 510, 511, 512, 513, 1023, 1024, 1025, 1087, 4095, 4096, 8191, 16383};
__device__ __forceinline__ float blk_max(float v, LAS float* red, int tid) {
#pragma unroll
    for (int o = 1; o < 64; o <<= 1) v = fmaxf(v, __shfl_xor(v, o));
    __syncthreads(); if ((tid & 63) == 0) red[tid >> 6] = v; __syncthreads();
    float r = red[0]; for (int w = 1; w < 8; ++w) r = fmaxf(r, red[w]); __syncthreads(); return r; }
__device__ __forceinline__ float blk_sum(float v, LAS float* red, int tid) {
#pragma unroll
    for (int o = 1; o < 64; o <<= 1) v += __shfl_xor(v, o);
    __syncthreads(); if ((tid & 63) == 0) red[tid >> 6] = v; __syncthreads();
    float r = 0.f; for (int w = 0; w < 8; ++w) r += red[w]; __syncthreads(); return r; }

__device__ __forceinline__ void check_sample(const nsa::Tensors& T, LAS unsigned char* lds, int tid, int b, int g, int t, unsigned* flag) {
    LAS float* sc = (LAS float*)lds;
    LAS float* qf = sc + 4096;
    LAS float* oacc = qf + 512;
    LAS float* score = oacc + 768;
    LAS int* sel = (LAS int*)(score + 256);
    LAS float* red = (LAS float*)(sel + 16);
    const int bg = b * 4 + g; const size_t tok = (size_t)b * SEQ + t;
    if (tid < 256) { const int h = tid >> 6, d = tid & 63;
        const float q = bf2f(T.Q[tok * D + (g * 4 + h) * 64 + d]);
        const int dd = d & 31; const f32x2 cs = T.rope[tok * 32 + dd]; const float qo = bf2f(T.Q[tok * D + (g * 4 + h) * 64 + (d < 32 ? d + 32 : d - 32)]);
        const float r = d < 32 ? q * cs[0] - qo * cs[1] : q * cs[0] + qo * cs[1];
        qf[h * 64 + d] = q; qf[256 + h * 64 + d] = bf2f((unsigned short)f2bf(r)); }
    __syncthreads();
    const bf16_t* Kc = T.KCMP + (size_t)bg * 1024 * 64; const bf16_t* Vc = T.VCMPT + (size_t)bg * 64 * 1024;
    for (int i = tid; i < 4096; i += 512) { const int h = i >> 10, c = i & 1023; float s = -INFINITY;
        if (c < 1023 && 16 * c + 31 <= t) { s = 0.f; for (int d = 0; d < 64; ++d) s += qf[h * 64 + d] * bf2f(Kc[(size_t)c * 64 + d]); }
        sc[i] = s; }
    __syncthreads();
    for (int h = 0; h < 4; ++h) {
        float m = -INFINITY; for (int c = tid; c < 1024; c += 512) m = fmaxf(m, sc[h * 1024 + c]);
        m = blk_max(m, red, tid); if (m == -INFINITY) m = 0.f;
        float l = 0.f; for (int c = tid; c < 1024; c += 512) l += exp2f(sc[h * 1024 + c] - m);
        l = blk_sum(l, red, tid); l = fmaxf(l, 1e-30f);
        for (int c = tid; c < 1024; c += 512) sc[h * 1024 + c] = exp2f(sc[h * 1024 + c] - m) / l;
        __syncthreads();
    }
    if (tid < 256) { const int h = tid >> 6, d = tid & 63; float o = 0.f;
        for (int c = 0; c < 1023; ++c) o += bf2f((unsigned short)f2bf(sc[h * 1024 + c])) * bf2f(Vc[(size_t)d * 1024 + c]);
        oacc[h * 64 + d] = o; }
    if (tid < 256) { const int j = tid; float im = 0.f;
        for (int h = 0; h < 4; ++h) for (int c = 4 * j - 1; c <= 4 * j + 3; ++c) if (c >= 0 && c < 1023) {
            const int c0 = 16 * c, j0 = 64 * j; int ov = min(c0 + 32, j0 + 64) - max(c0, j0); if (ov < 0) ov = 0;
            im += sc[h * 1024 + c] * ((float)ov / 32.0f); }
        const int cur = t >> 6; const bool valid = 64 * j <= t, forced = (j == 0) || (j == cur) || (j == cur - 1);
        score[j] = valid ? im + (forced ? 1000.0f : 0.0f) : -1.0f; }
    __syncthreads();
    if (tid == 0) { for (int n = 0; n < 16; ++n) { int bi = 0; float bv = -INFINITY; for (int j = 0; j < 256; ++j) if (score[j] > bv) { bv = score[j]; bi = j; } sel[n] = bi; score[bi] = -INFINITY; } }
    __syncthreads();
    const bf16_t* Ks = T.KS + (size_t)bg * SEQ * 64; const bf16_t* Vs = T.VTS + (size_t)bg * 64 * SEQ;
    for (int i = tid; i < 4096; i += 512) { const int h = i >> 10, n = (i >> 6) & 15, k = i & 63; const int kpos = sel[n] * 64 + k; float s = -INFINITY;
        if (kpos <= t) { s = 0.f; for (int d = 0; d < 64; ++d) s += qf[256 + h * 64 + d] * bf2f(Ks[(size_t)kpos * 64 + d]); }
        sc[i] = s; }
    __syncthreads();
    for (int h = 0; h < 4; ++h) {
        float m = -INFINITY; for (int c = tid; c < 1024; c += 512) m = fmaxf(m, sc[h * 1024 + c]);
        m = blk_max(m, red, tid); if (m == -INFINITY) m = 0.f;
        float l = 0.f; for (int c = tid; c < 1024; c += 512) l += exp2f(sc[h * 1024 + c] - m);
        l = blk_sum(l, red, tid); l = fmaxf(l, 1e-30f);
        for (int c = tid; c < 1024; c += 512) sc[h * 1024 + c] = exp2f(sc[h * 1024 + c] - m) / l;
        __syncthreads();
    }
    if (tid < 256) { const int h = tid >> 6, d = tid & 63; float o = 0.f;
        for (int i = 0; i < 1024; ++i) { const float p = sc[h * 1024 + i]; if (p != 0.f) { const int kpos = sel[i >> 6] * 64 + (i & 63); o += bf2f((unsigned short)f2bf(p)) * bf2f(Vs[(size_t)d * SEQ + kpos]); } }
        oacc[256 + h * 64 + d] = o; }
    __syncthreads();
    const bf16_t* Kw = T.KW + (size_t)bg * SEQ * 64; const bf16_t* Vw = T.VTW + (size_t)bg * 64 * SEQ;
    for (int i = tid; i < 4096; i += 512) { const int h = i >> 10, k = i & 1023; const int kpos = t - 511 + k; float s = -INFINITY;
        if (k < 512 && kpos >= 0) { s = 0.f; for (int d = 0; d < 64; ++d) s += qf[256 + h * 64 + d] * bf2f(Kw[(size_t)kpos * 64 + d]); }
        sc[i] = s; }
    __syncthreads();
    for (int h = 0; h < 4; ++h) {
        float m = -INFINITY; for (int c = tid; c < 1024; c += 512) m = fmaxf(m, sc[h * 1024 + c]);
        m = blk_max(m, red, tid); if (m == -INFINITY) m = 0.f;
        float l = 0.f; for (int c = tid; c < 1024; c += 512) l += exp2f(sc[h * 1024 + c] - m);
        l = blk_sum(l, red, tid); l = fmaxf(l, 1e-30f);
        for (int c = tid; c < 1024; c += 512) sc[h * 1024 + c] = exp2f(sc[h * 1024 + c] - m) / l;
        __syncthreads();
    }
    if (tid < 256) { const int h = tid >> 6, d = tid & 63; float o = 0.f;
        for (int k = 0; k < 512; ++k) { const float p = sc[h * 1024 + k]; if (p != 0.f) o += bf2f((unsigned short)f2bf(p)) * bf2f(Vw[(size_t)d * SEQ + (t - 511 + k)]); }
        oacc[512 + h * 64 + d] = o; }
    __syncthreads();
    if (tid == 0) red[0] = 0.f;
    __syncthreads();
    if (tid < 256) { const int h = tid >> 6, d = tid & 63; const float* gt = T.gates + tok * 48 + (g * 4 + h) * 3;
        float ref = gt[0] * oacc[h * 64 + d] + gt[1] * oacc[256 + h * 64 + d] + gt[2] * oacc[512 + h * 64 + d];
        float got = bf2f(T.O[tok * D + (g * 4 + h) * 64 + d]);
        if (NSA_CHECK_BR >= 0) { ref = oacc[NSA_CHECK_BR * 256 + h * 64 + d]; got = bf2f(T.DBG[tok * D + (g * 4 + h) * 64 + d]); }
        sc[tid] = ref * ref; sc[256 + tid] = got; sc[512 + tid] = ref; }
    __syncthreads();
    if (tid < 256) { const int h = tid >> 6; float ms = 0.f; for (int d2 = 0; d2 < 64; ++d2) ms += sc[h * 64 + d2]; const float rms = sqrtf(ms * (1.0f / 64.0f));
        const float got = sc[256 + tid], ref = sc[512 + tid];
        const float tol = NSA_CHECK_ABS * rms + NSA_CHECK_REL * fabsf(ref);
        if (!(fabsf(got - ref) <= tol)) red[0] = 1.0f; }
    __syncthreads();
    if (tid == 0 && red[0] != 0.f) atomicAdd(flag, 1u);
    __syncthreads();
}

__device__ __forceinline__ bool near(float got, float ref, float rms) { return fabsf(got - ref) <= 0.02f * rms + 0.015f * fabsf(ref); }
__device__ __forceinline__ void check_proj(const Args& a, const nsa::Tensors& T, unsigned char* ws, const float* X, LAS unsigned char* lds, int tid, int smp, unsigned* flag) {
    LAS float* hk = (LAS float*)lds;
    LAS float* hq = hk + 1024;
    LAS float* val = hq + 1024;
    LAS float* red = val + 512;
    LAS float* hid = red + 8;
    LAS float* blk = hid + 256;
    unsigned hsh = (unsigned)smp * 2654435761u + 12345u; hsh ^= hsh >> 15; hsh *= 2246822519u; hsh ^= hsh >> 13;
    const int tok = (int)(hsh % NT), b = tok >> 14, sp = tok & (SEQ - 1), g = (hsh >> 17) & 3, hh = (hsh >> 19) & 15;
    if (tid == 0) red[0] = 0.f;
    float ss = 0.f; for (int k = tid; k < 1024; k += 512) { const float v = X[(size_t)tok * D + k]; ss += v * v; }
    ss = blk_sum(ss, red + 1, tid); const float r = 1.0f / sqrtf(ss * (1.0f / D) + RMS_EPS);
    for (int k = tid; k < 1024; k += 512) { const float v = X[(size_t)tok * D + k] * r; hk[k] = v * a.in[I_NKV][k]; hq[k] = v * a.in[I_NMIX][D + k]; }
    __syncthreads();
    const float pos = (float)((const int*)a.in[I_POS])[tok];
    bool bad = false;
    for (int slot = 0; slot < 6; ++slot) {
        if (tid < 64) { float s_ = 0.f; const float* w = a.in[I_WKV] + slot * 256 + g * 64 + tid; for (int k = 0; k < 1024; ++k) s_ += hk[k] * w[(size_t)k * 1536]; val[tid] = s_; }
        __syncthreads();
        if (tid < 64) { float v = val[tid];
            if (slot == 2 || slot == 4) { const int i = tid & 31; const float ang = pos * a.inv_freq[i]; float sn, cs; sincosf(ang, &sn, &cs); const float t1 = val[i], t2 = val[i + 32]; v = tid < 32 ? t1 * cs - t2 * sn : t2 * cs + t1 * sn; }
            float got; const size_t bg = (size_t)(b * 4 + g);
            if (slot == 3 || slot == 5) got = bf2f(((const bf16_t*)(ws + WS_RD + (size_t)slot * KVSTRIDE))[(bg * 64 + tid) * SEQ + sp]);
            else got = bf2f(((const bf16_t*)(ws + WS_RD + (size_t)slot * KVSTRIDE))[(bg * SEQ + sp) * 64 + tid]);
            if (!near(got, v, 1.0f)) bad = true; }
        __syncthreads();
    }
    if (tid < 112) { const int col = tid < 64 ? hh * 64 + tid : 1024 + (tid - 64); float s_ = 0.f; const float* w = a.in[I_AWIN] + col; for (int k = 0; k < 1024; ++k) s_ += hq[k] * w[(size_t)k * 1072];
        if (tid < 64) { if (!near(bf2f(T.Q[(size_t)tok * D + hh * 64 + tid]), s_ * (0.125f * 1.4426950408889634f), 0.18f)) bad = true; }
        else { const float gt = 1.0f / (1.0f + expf(-s_)); if (!near(T.gates[(size_t)tok * 48 + (tid - 64)], gt, 0.25f)) bad = true; } }
    const int c = (int)((hsh >> 8) % 1023);
    for (int kv = 0; kv < 2; ++kv) {
        const bf16_t* src = (const bf16_t*)(ws + WS_RD + (kv ? RD_VC : RD_KC)) + ((size_t)(b * 4 + g) * SEQ + 16 * c) * 64; const float* pe = a.in[kv ? I_CPV : I_CPK];
        for (int i = tid; i < 2048; i += 512) blk[i] = bf2f(src[i]) + pe[i];
        __syncthreads();
        if (tid < 256) { float s_ = 0.f; const float* w1 = a.in[kv ? I_CW1V : I_CW1K] + tid; for (int i = 0; i < 2048; ++i) s_ += blk[i] * w1[(size_t)i * 256];
            const float y = 0.7978845608028654f * (s_ + 0.044715f * s_ * s_ * s_); hid[tid] = 0.5f * s_ * (1.0f + tanhf(y)); }
        __syncthreads();
        if (tid < 64) { float s_ = 0.f; const float* w2 = a.in[kv ? I_CW2V : I_CW2K] + tid; for (int n = 0; n < 256; ++n) s_ += hid[n] * w2[n * 64];
            const float got = kv ? bf2f(T.VCMPT[((size_t)(b * 4 + g) * 64 + tid) * 1024 + c]) : bf2f(T.KCMP[((size_t)(b * 4 + g) * 1024 + c) * 64 + tid]);
            if (!near(got, s_, 0.5f)) bad = true; }
        __syncthreads();
    }
    if (bad) red[0] = 1.0f;
    __syncthreads();
    if (tid == 0 && red[0] != 0.f) atomicAdd(flag, 1u);
    __syncthreads();
}
}
#endif

#define XB_TMO      128
#define XB_XCNT(j)  (256  + 64 * (j))
#define XB_XSUB(j)  (1280 + 64 * (j))
#define XB_XGEN(j)  (2304 + 64 * (j))
#define XB_TOP      3328
#define XB_TOPGEN   3392
#define XCD_BAR_WORDS 3456
#define XB_SPIN_CAP (1u << 22)
__device__ __forceinline__ unsigned xb_ld(unsigned* p)              { return __hip_atomic_load(p, __ATOMIC_RELAXED, __HIP_MEMORY_SCOPE_AGENT); }
__device__ __forceinline__ unsigned xb_add(unsigned* p, unsigned v) { return __hip_atomic_fetch_add(p, v, __ATOMIC_RELAXED, __HIP_MEMORY_SCOPE_AGENT); }
__device__ __forceinline__ unsigned xb_xcc_id() { return (unsigned)__builtin_amdgcn_s_getreg((3 << 11) | 20) & 0xFu; }
#define XB_SPIN(cond, bar) do { unsigned _sp = 0; while (cond) { __builtin_amdgcn_s_sleep(1); \
    if ((++_sp & 255u) == 0u) { if (xb_ld(&(bar)[XB_TMO])) break; if (_sp > XB_SPIN_CAP) { atomicAdd(&(bar)[XB_TMO], 1u); break; } } } } while (0)
struct XcdBarrier { unsigned* bar; unsigned x; volatile LAS unsigned* st; };
__device__ __forceinline__ XcdBarrier xcd_barrier_post(unsigned* bar, volatile LAS unsigned* st, bool t0) {
    XcdBarrier b; b.bar = bar; b.x = xb_xcc_id(); b.st = st;
    if (t0) (void)xb_add(&bar[XB_XCNT(b.x)], 1u);
    return b;
}
__device__ __forceinline__ void xcd_barrier_complete(unsigned* bar, unsigned x, unsigned& nloc, unsigned& nx) {
    const unsigned G = gridDim.x;
    unsigned sum, cnt, mine, sp = 0u;
    for (;;) {
        sum = 0u; cnt = 0u; mine = 0u;
#pragma unroll
        for (unsigned j = 0; j < 16; ++j) { const unsigned c = xb_ld(&bar[XB_XCNT(j)]); sum += c; cnt += (c > 0u) ? 1u : 0u; mine = (j == x) ? c : mine; }
        if (sum == G) break;
        __builtin_amdgcn_s_sleep(1);
        if ((++sp & 255u) == 0u) { if (xb_ld(&bar[XB_TMO])) break; if (sp > XB_SPIN_CAP) { atomicAdd(&bar[XB_TMO], 1u); break; } }
    }
    nloc = mine > 0u ? mine : 1u; nx = cnt > 0u ? cnt : 1u;
}
__device__ __forceinline__ void xcd_barrier(const XcdBarrier& b, bool t0) {
    asm volatile("s_waitcnt vmcnt(0)" ::: "memory");
    __syncthreads();
    if (t0) {
        unsigned* bar = b.bar;
        __builtin_amdgcn_s_waitcnt(0);
        unsigned nloc = b.st[0], nx = b.st[1];
        if (nloc == 0u) { xcd_barrier_complete(bar, b.x, nloc, nx); b.st[0] = nloc; b.st[1] = nx; }
        const unsigned old = xb_add(&bar[XB_XSUB(b.x)], 1u);
        const unsigned gen = old / nloc;
        if (old + 1u == (gen + 1u) * nloc) {
            __builtin_amdgcn_fence(__ATOMIC_RELEASE, "agent");
            asm volatile("s_waitcnt vmcnt(0)" ::: "memory");
            const unsigned og = xb_add(&bar[XB_TOP], 1u);
            const unsigned tg = og / nx;
            if (og + 1u == (tg + 1u) * nx) xb_add(&bar[XB_TOPGEN], 1u);
            else XB_SPIN(xb_ld(&bar[XB_TOPGEN]) == tg, bar);
            __builtin_amdgcn_fence(__ATOMIC_ACQUIRE, "agent");
            xb_add(&bar[XB_XGEN(b.x)], 1u);
            asm volatile("s_waitcnt vmcnt(0)" ::: "memory");
        } else {
            XB_SPIN(xb_ld(&bar[XB_XGEN(b.x)]) == gen, bar);
            __builtin_amdgcn_fence(__ATOMIC_ACQUIRE, "agent");
            asm volatile("s_waitcnt vmcnt(0)" ::: "memory");
        }
    }
    __syncthreads();
}

__device__ __forceinline__ MoeTab moe_tables(const Frame& F0, int layer) {
    const Frame F = refresh(F0);
    MoeTab T; T.tstart = (volatile LAS int*)(F.lds + MISC_OFF); T.cnt = T.tstart + 64;
    const unsigned* gcnt = (const unsigned*)(F.ws + WS_CTL) + CW_CNT + layer * 32;
    __syncthreads();
    if (F.tid < 32) T.cnt[F.tid] = (int)__hip_atomic_load(gcnt + F.tid, __ATOMIC_RELAXED, __HIP_MEMORY_SCOPE_AGENT);
    __syncthreads();
    if (F.tid == 0) { int acc = 0; for (int e = 0; e < 32; ++e) { T.tstart[e] = acc; acc += (T.cnt[e] + 255) >> 8; } T.tstart[32] = acc; }
    __syncthreads();
    return T;
}

constexpr int N_PHASES = 17;
__global__ void __launch_bounds__(NTHREADS, 2) nsa_fwd(Args args) {
    extern __shared__ __attribute__((aligned(16))) unsigned char lds_raw[];
    cg::grid_group grid = cg::this_grid();
    Frame F; F.lds = (LAS unsigned char*)lds_raw; F.ws = args.ws;
    { const int t = threadIdx.x; F.wave = __builtin_amdgcn_readfirstlane(t >> 6); F.tid = t; F.lane = t & 63; }
    F.G = gridDim.x; { const int bx = blockIdx.x; F.vcu = (F.G % 8 == 0) ? (bx % 8) * (F.G / 8) + bx / 8 : bx; }
    unsigned char* ws = args.ws;
    float* X = args.out;
    const int lo = args.ph_lo, hi = args.ph_hi;
    volatile LAS unsigned* bst = (volatile LAS unsigned*)(F.lds + MISC_OFF + 1024);
    if (F.tid < 2) bst[F.tid] = 0u;
    __syncthreads();
    XcdBarrier xb; xb.bar = (unsigned*)(ws + WS_CTL) + CW_BAR; xb.x = 0; xb.st = bst;
    if (hi - lo > 1) xb = xcd_barrier_post((unsigned*)(ws + WS_CTL) + CW_BAR, bst, F.tid == 0);
#ifndef PH_MASK
#define PH_MASK 0x1ffff
#endif
#ifndef REPEAT_MASK
#define REPEAT_MASK 0
#endif
#define REPS(k) (1 + ((REPEAT_MASK >> (k)) & 1))
#define IN(k) (((PH_MASK >> (k)) & 1) && lo <= (k) && (k) < hi)
#if PROBE_PHASE >= 0
    unsigned long long ph_t0 = __builtin_amdgcn_s_memrealtime(), ph_dur = 0ull;
#define PH_STAMP(k) do { const unsigned long long now_ = __builtin_amdgcn_s_memrealtime(); if ((k) == PROBE_PHASE) ph_dur = now_ - ph_t0; ph_t0 = now_; } while (0)
#else
#define PH_STAMP(k) do {} while (0)
#endif
#define SEAM(k) do { if (IN(k) && IN((k) + 1)) { if ((k) == 0) grid.sync(); else xcd_barrier(xb, mytid(F) == 0); } PH_STAMP(k); } while (0)
    LAS unsigned char* ring = F.lds;

    if (IN(0)) for (int rep_ = 0; rep_ < REPS(0); ++rep_) { phase_prep(args, F); } SEAM(0);
    if (IN(1)) for (int rep_ = 0; rep_ < REPS(1); ++rep_) {
        DenseOrder S; S.init(ws + WS_RA, ws + WS_WIN, NT, 3 * D, D, D, F.G, (int)blockIdx.x);
        EpiInProj E{(const float*)(ws + WS_R0), (bf16_t*)(ws + WS_RB), (bf16_t*)(ws + WS_RC)};
        pg8::gemm_phase<EpiInProj, DenseOrder, false>(ring, mytid(F), pg8::Gemm{D, D}, S, E);
    } SEAM(1);
#ifdef EXTRA_BARS
    for (int eb_ = 0; eb_ < EXTRA_BARS; ++eb_) xcd_barrier(xb, mytid(F) == 0);
#endif
    if (IN(2)) for (int rep_ = 0; rep_ < REPS(2); ++rep_) { phase_conv(args, F); } SEAM(2);
    if (IN(3)) for (int rep_ = 0; rep_ < REPS(3); ++rep_) {
        DenseOrder S; S.init(ws + WS_RA, ws + WS_WOUT, NT, D, D, D, F.G, (int)blockIdx.x);
        EpiResid E{args.in[I_X], X};
        pg8::gemm_phase<EpiResid, DenseOrder, false>(ring, mytid(F), pg8::Gemm{D, D}, S, E);
    } SEAM(3);
    {
        if (IN(4)) for (int rep_ = 0; rep_ < REPS(4); ++rep_) { phase_router(args, F, 0, X, (bf16_t*)(ws + WS_RA), (float*)(ws + WS_R1)); } SEAM(4);
        if (IN(5)) for (int rep_ = 0; rep_ < REPS(5); ++rep_) {
            MoeTab T = moe_tables(F, 0);
            MoeGuOrder S{T, (const char*)(ws + WS_RA), (const int*)(ws + WS_ROWL), (const char*)(ws + WS_EXPW), F.G, F.vcu};
            EpiGU E{T, (const float*)(ws + WS_ROWR), (bf16_t*)(ws + WS_RD)};
            pg8::gemm_phase<EpiGU, MoeGuOrder, true>(ring, mytid(F), pg8::Gemm{D, D}, S, E);
        } SEAM(5);
        if (IN(6)) for (int rep_ = 0; rep_ < REPS(6); ++rep_) {
            MoeTab T = moe_tables(F, 0);
            MoeDnOrder S{T, (const char*)(ws + WS_RD), (const char*)(ws + WS_EXPW), F.G, F.vcu};
            EpiDN E{(const int*)(ws + WS_ROWL), (const float*)(ws + WS_WGT), (bf16_t*)(ws + WS_RB)};
            pg8::gemm_phase<EpiDN, MoeDnOrder, false>(ring, mytid(F), pg8::Gemm{DE, DE}, S, E);
        } SEAM(6);
    }
    {
            if (IN(7)) for (int rep_ = 0; rep_ < REPS(7); ++rep_) { phase_combine<false>(args, F, X, (bf16_t*)(ws + WS_RA), (float*)(ws + WS_R2)); } SEAM(7);
            if (IN(8)) for (int rep_ = 0; rep_ < REPS(8); ++rep_) {
                DenseOrder S; S.init(ws + WS_RA, ws + WS_WQKV, NT, NQKV, D, D, F.G, (int)blockIdx.x);
                EpiQKV E{(const float*)(ws + WS_R2), (const f32x2*)(ws + WS_ROPE), ws + WS_RD, (bf16_t*)(ws + WS_RC), (float*)(ws + WS_GATES)};
                pg8::gemm_phase<EpiQKV, DenseOrder, false>(ring, mytid(F), pg8::Gemm{D, D}, S, E);
            } SEAM(8);
            if (IN(9)) for (int rep_ = 0; rep_ < REPS(9); ++rep_) {
                CmpOrder S{(const char*)(ws + WS_RD + RD_KC), (const char*)(ws + WS_RD + RD_VC), (const char*)(ws + WS_WC1), F.G, (int)blockIdx.x};
                EpiCmp1 E{(const float*)(ws + WS_BIASC), (bf16_t*)(ws + WS_RD + RD_HID)};
                pg8::gemm_phase<EpiCmp1, CmpOrder, false>(ring, mytid(F), pg8::Gemm{2048, 1024}, S, E);
                const Frame F9 = refresh(F); LAS float* scr = (LAS float*)(F.lds + F.wave * 16384);
                if (F.G > 64) { if ((int)blockIdx.x >= 64) convert_experts(args, F9, 1, ((int)blockIdx.x - 64) * NWAVES + F.wave, (F.G - 64) * NWAVES, scr); }
                else convert_experts(args, F9, 1, (int)blockIdx.x * NWAVES + F.wave, F.G * NWAVES, scr);
            } SEAM(9);
            if (IN(10)) for (int rep_ = 0; rep_ < REPS(10); ++rep_) { phase_cmp2(F); } SEAM(10);
            if (IN(11)) for (int rep_ = 0; rep_ < REPS(11); ++rep_) {
                nsa::Tensors T{(const bf16_t*)(ws + WS_RC), (const f32x2*)(ws + WS_ROPE), (const float*)(ws + WS_GATES),
                               (const bf16_t*)(ws + WS_RD + RD_KS), (const bf16_t*)(ws + WS_RD + RD_VTS), (const bf16_t*)(ws + WS_RD + RD_KW), (const bf16_t*)(ws + WS_RD + RD_VTW),
                               (const bf16_t*)(ws + WS_RD + RD_KCMP), (const bf16_t*)(ws + WS_RD + RD_VCMPT), (bf16_t*)(ws + WS_RB), (bf16_t*)(ws + WS_RA), (float*)(ws + WS_ATTS) + (size_t)blockIdx.x * 64 * 256, (float*)(ws + WS_CTL) + 2049};
                if (F.G % 8 == 0) { const int bg = (int)blockIdx.x & 7, per = F.G >> 3;
                    const int r = (int)blockIdx.x >> 3;
                    for (int i = 0; i * per < 256; ++i) { const int q = i * per + ((i & 1) ? (per - 1 - r) : r); if (q < 256) nsa::attn_unit(T, ring, mytid(F), bg >> 2, bg & 3, 255 - q); } }
                else for (int u = (int)blockIdx.x; u < 2048; u += F.G) { const int qt = 255 - (u >> 3), bg = u & 7; nsa::attn_unit(T, ring, mytid(F), bg >> 2, bg & 3, qt); }
            } SEAM(11);
            if (IN(12)) for (int rep_ = 0; rep_ < REPS(12); ++rep_) {
#if NSA_CHECK
                { nsa::Tensors T{(const bf16_t*)(ws + WS_RC), (const f32x2*)(ws + WS_ROPE), (const float*)(ws + WS_GATES),
                               (const bf16_t*)(ws + WS_RD + RD_KS), (const bf16_t*)(ws + WS_RD + RD_VTS), (const bf16_t*)(ws + WS_RD + RD_KW), (const bf16_t*)(ws + WS_RD + RD_VTW),
                               (const bf16_t*)(ws + WS_RD + RD_KCMP), (const bf16_t*)(ws + WS_RD + RD_VCMPT), (bf16_t*)(ws + WS_RB), (bf16_t*)(ws + WS_RA), (float*)(ws + WS_ATTS) + (size_t)blockIdx.x * 64 * 256, (float*)(ws + WS_CTL) + 2049};
                  for (int smp = (int)blockIdx.x; smp < NSA_CHECK_N; smp += F.G) { unsigned hsh = (unsigned)smp * 2654435761u; hsh ^= hsh >> 15; hsh *= 2246822519u; hsh ^= hsh >> 13;
                      int t = (smp < 192) ? chk::tlist[smp % 24] : (int)(hsh % SEQ); const int bgs = (smp < 192) ? (smp / 24) : (int)((hsh >> 20) & 7);
                      chk::check_sample(T, ring, mytid(F), bgs >> 2, bgs & 3, t, (unsigned*)(ws + WS_CTL) + 2048); }
                  __syncthreads();
                  if (NSA_CHECK_PROJ) for (int smp = (int)blockIdx.x; smp < 512; smp += F.G) chk::check_proj(args, T, ws, X, ring, mytid(F), smp, (unsigned*)(ws + WS_CTL) + 2048);
                  __syncthreads(); }
#endif
                DenseOrder S; S.init(ws + WS_RB, ws + WS_WAO, NT, D, D, D, F.G, (int)blockIdx.x);
                EpiResid E{X, X};
                pg8::gemm_phase<EpiResid, DenseOrder, false>(ring, mytid(F), pg8::Gemm{D, D}, S, E);
            } SEAM(12);
    }
    {
        if (IN(13)) for (int rep_ = 0; rep_ < REPS(13); ++rep_) { phase_router(args, F, 1, X, (bf16_t*)(ws + WS_RA), (float*)(ws + WS_R3)); } SEAM(13);
        if (IN(14)) for (int rep_ = 0; rep_ < REPS(14); ++rep_) {
            MoeTab T = moe_tables(F, 1);
            MoeGuOrder S{T, (const char*)(ws + WS_RA), (const int*)(ws + WS_ROWL), (const char*)(ws + WS_EXPW), F.G, F.vcu};
            EpiGU E{T, (const float*)(ws + WS_ROWR), (bf16_t*)(ws + WS_RD)};
            pg8::gemm_phase<EpiGU, MoeGuOrder, true>(ring, mytid(F), pg8::Gemm{D, D}, S, E);
        } SEAM(14);
        if (IN(15)) for (int rep_ = 0; rep_ < REPS(15); ++rep_) {
            MoeTab T = moe_tables(F, 1);
            MoeDnOrder S{T, (const char*)(ws + WS_RD), (const char*)(ws + WS_EXPW), F.G, F.vcu};
            EpiDN E{(const int*)(ws + WS_ROWL), (const float*)(ws + WS_WGT), (bf16_t*)(ws + WS_RB)};
            pg8::gemm_phase<EpiDN, MoeDnOrder, false>(ring, mytid(F), pg8::Gemm{DE, DE}, S, E);
        } SEAM(15);
    }
    if (IN(16)) for (int rep_ = 0; rep_ < REPS(16); ++rep_) { phase_combine<true>(args, F, X, nullptr, nullptr);
#if PROBE_PHASE >= 0
        PH_STAMP(16);
        if (blockIdx.x == 0 && mytid(F) == 0) { const unsigned long long t0_ = __builtin_amdgcn_s_memrealtime(); while (__builtin_amdgcn_s_memrealtime() - t0_ < ph_dur) __builtin_amdgcn_s_sleep(8); }
#endif
#if PROBE_T
        if (blockIdx.x == 0 && mytid(F) == 0) { const float nprobe = __uint_as_float(__hip_atomic_load((unsigned*)(ws + WS_CTL) + 2049, __ATOMIC_RELAXED, __HIP_MEMORY_SCOPE_AGENT));
            unsigned long long ticks = (unsigned long long)(fminf(nprobe, 2000.f) * 1000.0f); const unsigned long long t0_ = __builtin_amdgcn_s_memrealtime();
            while (__builtin_amdgcn_s_memrealtime() - t0_ < ticks) __builtin_amdgcn_s_sleep(8); }
#endif
#if NSA_CHECK
        if (blockIdx.x == 0 && mytid(F) == 0) { const unsigned nbad = __hip_atomic_load((unsigned*)(ws + WS_CTL) + 2048, __ATOMIC_RELAXED, __HIP_MEMORY_SCOPE_AGENT);
            if (nbad) { asm volatile("s_waitcnt vmcnt(0)" ::: "memory"); X[0] = 580.0f * sqrtf((float)nbad); } }
#endif
    }
#undef IN
#undef SEAM
}

extern "C" void kernel_launch(void* const* d_in, const int* in_sizes, int n_in, void* d_out, int out_size, void* d_ws, size_t ws_size, hipStream_t stream) {
    static int grid = 0;
    if (grid == 0) {
        if (n_in != 25 || out_size != NT * D || ws_size < WS_END) { fprintf(stderr, "kernel_launch: unexpected problem (n_in %d, out %d, ws %zu < %zu)\n", n_in, out_size, ws_size, (size_t)WS_END); grid = -1; return; }
        int dev = 0, cus = 0, per_cu = 0;
        hipGetDevice(&dev); hipDeviceGetAttribute(&cus, hipDeviceAttributeMultiprocessorCount, dev);
        hipFuncSetAttribute((const void*)nsa_fwd, hipFuncAttributeMaxDynamicSharedMemorySize, LDS_BYTES);
        hipOccupancyMaxActiveBlocksPerMultiprocessor(&per_cu, (const void*)nsa_fwd, NTHREADS, LDS_BYTES);
        if (per_cu < 1) { fprintf(stderr, "kernel_launch: occupancy query says %d blocks/CU\n", per_cu); per_cu = 1; }
        grid = cus;
        (void)hipGetLastError();
    }
    if (grid < 0) return;
    hipMemsetAsync((char*)d_ws + WS_CTL, 0, CTL_BYTES, stream);
    Args a{};
    for (int i = 0; i < 25; ++i) a.in[i] = (const float*)d_in[i];
    a.out = (float*)d_out; a.ws = (unsigned char*)d_ws;
    for (int i = 0; i < 32; ++i) a.inv_freq[i] = powf(10000.0f, -(float)i / 32.0f);
#if MK_PER_PHASE
    for (int p = 0; p < N_PHASES; ++p) { a.ph_lo = p; a.ph_hi = p + 1; void* kargs[] = {&a};
        hipError_t e = hipLaunchCooperativeKernel((const void*)nsa_fwd, dim3(grid), dim3(NTHREADS), kargs, LDS_BYTES, stream);
        if (e != hipSuccess) { fprintf(stderr, "launch %d failed: %s\n", p, hipGetErrorString(e)); break; } }
#else
    a.ph_lo = 0; a.ph_hi = N_PHASES; void* kargs[] = {&a};
    hipError_t e = hipLaunchCooperativeKernel((const void*)nsa_fwd, dim3(grid), dim3(NTHREADS), kargs, LDS_BYTES, stream);
    if (e != hipSuccess) fprintf(stderr, "cooperative launch failed: %s (grid %d)\n", hipGetErrorString(e), grid);
#endif
}
```

```cpp
#include <hip/hip_runtime.h>
#include <hip/hip_cooperative_groups.h>
#include <cstdio>
#include <cstdint>
#include <cmath>
namespace cg = cooperative_groups;

#define LAS __attribute__((address_space(3)))
typedef unsigned short bf16_t;
typedef short bf16x8 __attribute__((ext_vector_type(8)));
typedef short s16x4 __attribute__((ext_vector_type(4)));
typedef float f32x4 __attribute__((ext_vector_type(4)));
typedef float f32x2 __attribute__((ext_vector_type(2)));
typedef unsigned u32x4 __attribute__((ext_vector_type(4)));
typedef unsigned u32x2 __attribute__((ext_vector_type(2)));

constexpr int NB = 2, SEQ = 16384, NT = NB * SEQ, D = 1024, NG = 4, HD = 64, NH = 16;
constexpr int NE = 32, EPG = 8, DE = 512, ECAP = 65536;
constexpr int NQKV = 2816;
constexpr int NCMP = 1023, CMPH = 256;
constexpr float RMS_EPS = 1e-6f;
constexpr int NWAVES = 8, NTHREADS = 512;
#ifndef MK_PER_PHASE
#define MK_PER_PHASE 0
#endif

#ifndef PROBE_PHASE
#define PROBE_PHASE (-1)
#endif
#ifndef PROBE_T
#define PROBE_T 0
#endif
#ifndef PROBE_NOMERGE
#define PROBE_NOMERGE 0
#endif
#ifndef SEL_INVERTED
#define SEL_INVERTED 1
#endif
#ifndef ATT_SKIP
#define ATT_SKIP 0
#endif
#ifndef NSA_CHECK
#define NSA_CHECK 0
#endif
#ifndef NSA_CHECK_PROJ
#define NSA_CHECK_PROJ 1
#endif
#ifndef NSA_CHECK_BR
#define NSA_CHECK_BR (-1)
#endif
#ifndef NSA_CHECK_N
#define NSA_CHECK_N 1024
#endif
#ifndef NSA_CHECK_ABS
#define NSA_CHECK_ABS 0.012f
#endif
#ifndef NSA_CHECK_REL
#define NSA_CHECK_REL 0.01f
#endif

constexpr size_t MiB = 1u << 20, KiB = 1u << 10;
constexpr size_t WS_CTL = 0, CTL_BYTES = 64 * KiB;
constexpr size_t WS_R0 = 1 * MiB, WS_R1 = WS_R0 + 128 * KiB, WS_R2 = WS_R1 + 128 * KiB, WS_R3 = WS_R2 + 128 * KiB;
constexpr size_t WS_WGT = 2 * MiB;
constexpr size_t WS_RW = 2 * MiB + 512 * KiB;
constexpr size_t WS_BIASC = 3 * MiB;
constexpr size_t WS_W2T = 3 * MiB + 64 * KiB;
constexpr size_t WS_ROWL = 4 * MiB;
constexpr size_t WS_ROWR = 12 * MiB;
constexpr size_t WS_WIN = 20 * MiB, WS_WOUT = 26 * MiB, WS_WQKV = 28 * MiB, WS_WC1 = 34 * MiB, WS_WAO = 36 * MiB;
constexpr size_t WS_ROPE = 38 * MiB;
constexpr size_t WS_GATES = 46 * MiB;
constexpr size_t WS_EXPW = 52 * MiB;
constexpr size_t WS_RA = 148 * MiB;
constexpr size_t WS_RB = 212 * MiB;
constexpr size_t WS_RC = 276 * MiB;
constexpr size_t WS_RD = 340 * MiB;
constexpr size_t WS_ATTS = 452 * MiB;
constexpr size_t WS_END = 468 * MiB;
constexpr size_t KVSTRIDE = 17 * MiB;
constexpr size_t RD_KC = 0, RD_VC = 1 * KVSTRIDE, RD_KS = 2 * KVSTRIDE, RD_VTS = 3 * KVSTRIDE, RD_KW = 4 * KVSTRIDE, RD_VTW = 5 * KVSTRIDE;
constexpr size_t RD_HID = 102 * MiB, RD_KCMP = 110 * MiB, RD_VCMPT = 111 * MiB;
constexpr int ACT_ROWS = 2 * NT + NE * 256;
static_assert((size_t)ACT_ROWS * DE * 2 <= 72 * MiB, "ACT");
constexpr int CW_CNT = 1024, CW_BAR = 4096;

constexpr int LDS_BYTES = 151552;
constexpr int RING_BYTES = 131072;
constexpr int MISC_OFF = LDS_BYTES - 2048;

__device__ __forceinline__ unsigned f2bf(float f) { unsigned u = __builtin_bit_cast(unsigned, f); return (u + 0x7fffu + ((u >> 16) & 1u)) >> 16; }
__device__ __forceinline__ unsigned pk2(float lo, float hi) {
    typedef float v2f __attribute__((ext_vector_type(2))); typedef __bf16 v2b __attribute__((ext_vector_type(2)));
    v2f v = {lo, hi}; v2b b = __builtin_convertvector(v, v2b); return __builtin_bit_cast(unsigned, b); }
__device__ __forceinline__ float bf2f(unsigned short b) { return __builtin_bit_cast(float, ((unsigned)b) << 16); }
__device__ __forceinline__ float bflo(unsigned w) { return __builtin_bit_cast(float, w << 16); }
__device__ __forceinline__ float bfhi(unsigned w) { return __builtin_bit_cast(float, w & 0xffff0000u); }
__device__ __forceinline__ float wave_sum(float v) {
#pragma unroll
    for (int o = 1; o < 64; o <<= 1) v += __shfl_xor(v, o);
    return v;
}
#define LDS_WAIT() asm volatile("s_waitcnt lgkmcnt(0)" ::: "memory")
__device__ __forceinline__ float max_x16(float v) { auto r = __builtin_amdgcn_permlane16_swap(__float_as_uint(v), __float_as_uint(v), false, false); return fmaxf(__uint_as_float(r[0]), __uint_as_float(r[1])); }
__device__ __forceinline__ float max_x32(float v) { auto r = __builtin_amdgcn_permlane32_swap(__float_as_uint(v), __float_as_uint(v), false, false); return fmaxf(__uint_as_float(r[0]), __uint_as_float(r[1])); }
__device__ __forceinline__ float sum_x16(float v) { auto r = __builtin_amdgcn_permlane16_swap(__float_as_uint(v), __float_as_uint(v), false, false); return __uint_as_float(r[0]) + __uint_as_float(r[1]); }
__device__ __forceinline__ float sum_x32(float v) { auto r = __builtin_amdgcn_permlane32_swap(__float_as_uint(v), __float_as_uint(v), false, false); return __uint_as_float(r[0]) + __uint_as_float(r[1]); }
__device__ __forceinline__ float max3f(float a, float b, float c) { float r; asm("v_max3_f32 %0, %1, %2, %3" : "=v"(r) : "v"(a), "v"(b), "v"(c)); return r; }
__device__ __forceinline__ float dpp_x1(float v) { return __uint_as_float((unsigned)__builtin_amdgcn_mov_dpp((int)__float_as_uint(v), 0xB1, 0xF, 0xF, true)); }
__device__ __forceinline__ float dpp_x2(float v) { return __uint_as_float((unsigned)__builtin_amdgcn_mov_dpp((int)__float_as_uint(v), 0x4E, 0xF, 0xF, true)); }


__device__ __forceinline__ int slot_perm8(int c) {
    const int hi = c & ~31, fq = (c >> 3) & 3, n = (c >> 2) & 1, j = c & 3; return hi + 16 * n + 4 * fq + j; }
__device__ __forceinline__ int slot_pair128(int c, int n) {
    const int wc = c >> 5, fq = (c >> 3) & 3, bj = (c >> 2) & 1, j = c & 3; return 128 * bj + 32 * wc + 16 * n + 4 * fq + j; }
__device__ __forceinline__ int slot_rope64(int d) {
    const int n = d >> 5, dd = d & 31, wcl = dd >> 4, fq = (dd >> 2) & 3, j = dd & 3; return 32 * wcl + 16 * n + 4 * fq + j; }

namespace pg8 {
constexpr int BM = 256, BK = 64, HALF = 128, HTB = HALF * BK * 2, STAGE_BYTES = 8 * HTB, NXCD = 8, WGM = 8;
__host__ __device__ __forceinline__ int lds_byte(int r, int c) { const int st = (r >> 4) * 2 + (c >> 5), rr = r & 15, cc = c & 31, ob = rr * 64 + cc * 2; return st * 1024 + (ob ^ (((ob >> 9) & 1) << 5)); }
__host__ __device__ __forceinline__ void stage_rc(int b, int& R, int& C) { const int st = b / 1024, sb = b % 1024, swz = sb ^ (((sb >> 9) & 1) << 5); R = (st >> 1) * 16 + swz / 64; C = (st & 1) * 32 + (swz % 64) / 2; }

struct Unit { int pm, pn, e, nvalid; };
struct Gemm { int K, lda; };

template <class Epi, class Sched, bool GATHER, bool ALIGN_EPI = true, bool SP2 = true>
__device__ __forceinline__ void gemm_phase(LAS unsigned char* lds, int tid_in, const Gemm g, const Sched& S, const Epi& E) {
    int tid_ = tid_in; asm volatile("" : "+v"(tid_));
    const int tid = tid_, wid = __builtin_amdgcn_readfirstlane(tid >> 6), lane = tid & 63, wr = wid >> 2, wc = wid & 3, fr = lane & 15, fq = lane >> 4;
    const int K = g.K, nt = K / BK;
    int R0, C0; stage_rc(tid * 16, R0, C0);
    unsigned voffA[2], voffB[2];
#pragma unroll
    for (int i = 0; i < 2; ++i) { voffA[i] = (unsigned)((R0 + 64 * i) * g.lda + C0) * 2u; voffB[i] = (unsigned)((R0 + 64 * i) * K + C0) * 2u; }
    unsigned vgC[2][2], vgN[2][2];
    const size_t kstep = (size_t)(BK * 2);
    const size_t hstepA = (size_t)HALF * g.lda * 2, hstepB = (size_t)HALF * K * 2;
    const unsigned ldsw = (unsigned)wid * 1024u;
    const int aoff = lds_byte(wr * 64 + fr, fq * 8), boff = lds_byte(wc * 32 + fr, fq * 8);
#define PG8_SA(b, h) (((b) * 2 + (h)) * HTB)
#define PG8_SB(b, h) ((4 + (b) * 2 + (h)) * HTB)
#define PG8_GLDS(src, dstoff) __builtin_amdgcn_global_load_lds((const unsigned*)(src), (LAS unsigned*)(lds + (dstoff)), 16, 0, 0)
#define PG8_STAGE_B(bufoff, gbase) do { _Pragma("unroll") for (int _i = 0; _i < 2; ++_i) PG8_GLDS((const char*)(gbase) + voffB[_i], (bufoff) + ldsw + _i * 8192); } while (0)
#define PG8_STAGE_A(bufoff, gbase, h, VG) do { _Pragma("unroll") for (int _i = 0; _i < 2; ++_i) { \
        if constexpr (GATHER) PG8_GLDS((const char*)(gbase) + VG[h][_i], (bufoff) + ldsw + _i * 8192); \
        else PG8_GLDS((const char*)(gbase) + (h) * hstepA + voffA[_i], (bufoff) + ldsw + _i * 8192); } } while (0)
#define PG8_LDA(dst, b, h) do { _Pragma("unroll") for (int m = 0; m < 4; ++m) _Pragma("unroll") for (int k = 0; k < 2; ++k) dst[m][k] = *(const LAS bf16x8*)(lds + PG8_SA(b, h) + aoff + m * 2048 + k * 1024); } while (0)
#define PG8_LDB(dst, b, h) do { _Pragma("unroll") for (int n = 0; n < 2; ++n) _Pragma("unroll") for (int k = 0; k < 2; ++k) dst[n][k] = *(const LAS bf16x8*)(lds + PG8_SB(b, h) + boff + n * 2048 + k * 1024); } while (0)
#define PG8_MMA(ai, bj, At, Bt) do { __builtin_amdgcn_s_setprio(1); _Pragma("unroll") for (int m = 0; m < 4; ++m) _Pragma("unroll") for (int n = 0; n < 2; ++n) _Pragma("unroll") for (int k = 0; k < 2; ++k) \
        acc[ai][bj][m][n] = __builtin_amdgcn_mfma_f32_16x16x32_bf16(Bt[n][k], At[m][k], acc[ai][bj][m][n], 0, 0, 0); __builtin_amdgcn_s_setprio(0); } while (0)
#define PG8_WAIT_V(n) asm volatile("s_waitcnt vmcnt(" #n ")" ::: "memory")
#define PG8_WAIT_L(n) asm volatile("s_waitcnt lgkmcnt(" #n ")" ::: "memory")
#define PG8_BAR __builtin_amdgcn_s_barrier()
#define PG8_SCHED __builtin_amdgcn_sched_barrier(0)
    Unit cur, nxt; int ui = 0;
    if (!S.next(0, cur)) return;
    f32x4 acc[2][2][4][2];
#pragma unroll
    for (int a = 0; a < 2; ++a)
#pragma unroll
        for (int b = 0; b < 2; ++b)
#pragma unroll
            for (int m = 0; m < 4; ++m)
#pragma unroll
                for (int n = 0; n < 2; ++n) acc[a][b][m][n] = (f32x4){0.f, 0.f, 0.f, 0.f};
    bf16x8 At[4][2], B0[2][2], B1[2][2];
    const char* cA = S.a_base(cur); const char* cB = S.b_base(cur);
    if constexpr (GATHER) {
#pragma unroll
        for (int h = 0; h < 2; ++h)
#pragma unroll
            for (int i = 0; i < 2; ++i) vgC[h][i] = S.a_off(cur, h * HALF + R0 + 64 * i) + (unsigned)C0 * 2u;
    }
    if constexpr (SP2) {
        PG8_STAGE_B(PG8_SB(0, 0), cB); PG8_STAGE_B(PG8_SB(0, 1), cB + hstepB); PG8_STAGE_A(PG8_SA(0, 0), cA, 0, vgC); PG8_STAGE_A(PG8_SA(0, 1), cA, 1, vgC);
        if (wr == 1) PG8_BAR;
        PG8_WAIT_V(2); PG8_BAR;
        PG8_STAGE_B(PG8_SB(1, 0), cB + kstep); PG8_STAGE_A(PG8_SA(1, 0), cA + kstep, 0, vgC); PG8_STAGE_B(PG8_SB(1, 1), cB + hstepB + kstep);
        PG8_WAIT_V(6); PG8_BAR;
    } else {
        PG8_STAGE_B(PG8_SB(0, 0), cB); PG8_STAGE_A(PG8_SA(0, 0), cA, 0, vgC); PG8_STAGE_B(PG8_SB(0, 1), cB + hstepB); PG8_STAGE_A(PG8_SA(0, 1), cA, 1, vgC);
        if (wr == 1) PG8_BAR;
        PG8_WAIT_V(4); PG8_BAR;
        PG8_STAGE_B(PG8_SB(1, 0), cB + kstep); PG8_STAGE_A(PG8_SA(1, 0), cA + kstep, 0, vgC); PG8_STAGE_B(PG8_SB(1, 1), cB + hstepB + kstep);
        PG8_WAIT_V(6); PG8_BAR;
    }
    for (;;) {
        const bool has_next = S.next(ui + 1, nxt);
        const char* nA = has_next ? S.a_base(nxt) : cA; const char* nB = has_next ? S.b_base(nxt) : cB;
        if constexpr (GATHER) {
#pragma unroll
            for (int h = 0; h < 2; ++h)
#pragma unroll
                for (int i = 0; i < 2; ++i) vgN[h][i] = has_next ? (S.a_off(nxt, h * HALF + R0 + 64 * i) + (unsigned)C0 * 2u) : vgC[h][i];
        }
        for (int t = 0; t < nt; t += 2) {
            const bool last = (t == nt - 2);
            const char* a1 = cA + (size_t)(t + 1) * kstep;
            const char* a2 = last ? nA : cA + (size_t)(t + 2) * kstep; const char* b2 = last ? nB : cB + (size_t)(t + 2) * kstep;
            const char* a3 = a2 + kstep; const char* b3 = b2 + kstep;
            unsigned vg2[2][2];
            if constexpr (GATHER) {
#pragma unroll
                for (int h = 0; h < 2; ++h)
#pragma unroll
                    for (int i = 0; i < 2; ++i) vg2[h][i] = last ? vgN[h][i] : vgC[h][i];
            }
            if constexpr (SP2) {
            PG8_LDB(B0, 0, 0); PG8_LDB(B1, 0, 1); PG8_SCHED; PG8_LDA(At, 0, 0); PG8_STAGE_A(PG8_SA(1, 1), a1, 1, vgC);
            PG8_WAIT_V(8); PG8_WAIT_L(0); PG8_BAR; PG8_MMA(0, 0, At, B0); PG8_MMA(0, 1, At, B1); PG8_BAR; PG8_SCHED;
            PG8_LDA(At, 0, 1); PG8_STAGE_B(PG8_SB(0, 0), b2); PG8_STAGE_B(PG8_SB(0, 1), b2 + hstepB); PG8_STAGE_A(PG8_SA(0, 0), a2, 0, vg2);
            PG8_WAIT_V(8); PG8_WAIT_L(0); PG8_BAR; PG8_MMA(1, 0, At, B0); PG8_MMA(1, 1, At, B1); PG8_BAR; PG8_SCHED;
            PG8_LDB(B0, 1, 0); PG8_LDB(B1, 1, 1); PG8_SCHED; PG8_LDA(At, 1, 0); PG8_STAGE_A(PG8_SA(0, 1), a2, 1, vg2);
            PG8_WAIT_V(8); PG8_WAIT_L(0); PG8_BAR; PG8_MMA(0, 0, At, B0); PG8_MMA(0, 1, At, B1); PG8_BAR; PG8_SCHED;
            PG8_LDA(At, 1, 1); PG8_STAGE_B(PG8_SB(1, 0), b3); PG8_STAGE_B(PG8_SB(1, 1), b3 + hstepB); PG8_STAGE_A(PG8_SA(1, 0), a3, 0, vg2);
            PG8_WAIT_V(8); PG8_WAIT_L(0); PG8_BAR; PG8_MMA(1, 0, At, B0); PG8_MMA(1, 1, At, B1); PG8_BAR; PG8_SCHED;
            } else {
            PG8_LDB(B0, 0, 0); PG8_SCHED; PG8_LDA(At, 0, 0); PG8_STAGE_A(PG8_SA(1, 1), a1, 1, vgC);
            PG8_WAIT_L(8); PG8_BAR; PG8_WAIT_L(0); PG8_MMA(0, 0, At, B0); PG8_BAR; PG8_SCHED;
            PG8_LDB(B1, 0, 1); PG8_STAGE_B(PG8_SB(0, 0), b2);
            PG8_BAR; PG8_WAIT_L(0); PG8_MMA(0, 1, At, B1); PG8_BAR;
            PG8_LDA(At, 0, 1); PG8_STAGE_A(PG8_SA(0, 0), a2, 0, vg2);
            PG8_BAR; PG8_WAIT_L(0); PG8_MMA(1, 0, At, B0); PG8_BAR; PG8_SCHED;
            PG8_STAGE_B(PG8_SB(0, 1), b2 + hstepB);
            PG8_WAIT_V(6); PG8_BAR; PG8_MMA(1, 1, At, B1); PG8_BAR;
            PG8_LDB(B0, 1, 0); PG8_SCHED; PG8_LDA(At, 1, 0); PG8_STAGE_A(PG8_SA(0, 1), a2, 1, vg2);
            PG8_WAIT_L(8); PG8_BAR; PG8_WAIT_L(0); PG8_MMA(0, 0, At, B0); PG8_BAR; PG8_SCHED;
            PG8_LDB(B1, 1, 1); PG8_STAGE_B(PG8_SB(1, 0), b3);
            PG8_BAR; PG8_WAIT_L(0); PG8_MMA(0, 1, At, B1); PG8_BAR;
            PG8_LDA(At, 1, 1); PG8_STAGE_A(PG8_SA(1, 0), a3, 0, vg2);
            PG8_BAR; PG8_WAIT_L(0); PG8_MMA(1, 0, At, B0); PG8_BAR; PG8_SCHED;
            PG8_STAGE_B(PG8_SB(1, 1), b3 + hstepB);
            PG8_WAIT_V(6); PG8_BAR; PG8_MMA(1, 1, At, B1); PG8_BAR;
            }
        }
        if constexpr (ALIGN_EPI) { if (wr == 0) PG8_BAR; }
        E(acc, cur, wr, wc, fr, fq);
        if (!has_next) break;
#pragma unroll
        for (int a = 0; a < 2; ++a)
#pragma unroll
            for (int b = 0; b < 2; ++b)
#pragma unroll
                for (int m = 0; m < 4; ++m)
#pragma unroll
                    for (int n = 0; n < 2; ++n) acc[a][b][m][n] = (f32x4){0.f, 0.f, 0.f, 0.f};
        cur = nxt; cA = nA; cB = nB; ++ui;
        if constexpr (GATHER) {
#pragma unroll
            for (int h = 0; h < 2; ++h)
#pragma unroll
                for (int i = 0; i < 2; ++i) vgC[h][i] = vgN[h][i];
        }
        if constexpr (ALIGN_EPI) { if (wr == 1) PG8_BAR; }
    }
    PG8_WAIT_V(0);
    if constexpr (!ALIGN_EPI) { if (wr == 0) PG8_BAR; }
    PG8_BAR;
#undef PG8_SA
#undef PG8_SB
#undef PG8_GLDS
#undef PG8_STAGE_A
#undef PG8_STAGE_B
#undef PG8_LDA
#undef PG8_LDB
#undef PG8_MMA
#undef PG8_WAIT_V
#undef PG8_WAIT_L
#undef PG8_BAR
#undef PG8_SCHED
}
}

struct Args {
    const float* in[25]; float* out; unsigned char* ws;
    float inv_freq[32];
    int ph_lo, ph_hi;
};
enum { I_X = 0, I_POS, I_NMIX, I_NFFN, I_CWIN, I_CW, I_CWOUT, I_NKV, I_WKV, I_CPK, I_CW1K, I_CW2K, I_CPV, I_CW1V, I_CW2V, I_AWIN, I_AWOUT,
       I_RGW, I_RGB, I_REW, I_REB, I_EWG, I_EWU, I_EWD, I_NFIN };

struct Frame {
    LAS unsigned char* lds;
    unsigned char* ws;
    int tid, lane, wave, vcu, G;
};

__device__ __forceinline__ int mytid(const Frame& F) { return F.wave * 64 + (int)__builtin_amdgcn_mbcnt_hi(~0u, __builtin_amdgcn_mbcnt_lo(~0u, 0u)); }
__device__ __forceinline__ Frame refresh(const Frame& F0) {
    Frame F = F0; int t = mytid(F0); asm volatile("" : "+v"(t)); F.tid = t; F.lane = t & 63; return F; }

struct DenseOrder {
    const char* A; const char* Bt; size_t tstepA, tstepB; int nM, nN, nwg, G, c;
    __device__ __forceinline__ void init(const void* A_, const void* Bt_, int M, int N, int K, int lda, int G_, int c_) {
        A = (const char*)A_; Bt = (const char*)Bt_; nM = M / 256; nN = N / 256; nwg = nM * nN; G = G_; c = c_; tstepA = (size_t)256 * lda * 2; tstepB = (size_t)256 * K * 2; }
    __device__ __forceinline__ bool next(int i, pg8::Unit& u) const {
        const long L = (long)i * G + c; if (L >= nwg) return false;
        int wgid = (int)L; { const int q = nwg / 8, r = nwg % 8, xcd = wgid % 8, off = wgid / 8; wgid = (xcd < r ? xcd * (q + 1) : r * (q + 1) + (xcd - r) * q) + off; }
        const int nig = 8 * nN, gid = wgid / nig, fm = gid * 8, gsz = (nM - fm) < 8 ? (nM - fm) : 8;
        u.pm = fm + ((wgid % nig) % gsz); u.pn = (wgid % nig) / gsz; u.e = 0; u.nvalid = 256; return true; }
    __device__ __forceinline__ const char* a_base(const pg8::Unit& u) const { return A + (size_t)u.pm * tstepA; }
    __device__ __forceinline__ const char* b_base(const pg8::Unit& u) const { return Bt + (size_t)u.pn * tstepB; }
    __device__ __forceinline__ unsigned a_off(const pg8::Unit&, int) const { return 0u; }
};
struct CmpOrder {
    const char* A0; const char* A1; const char* Bt; int G, c;
    __device__ __forceinline__ bool next(int i, pg8::Unit& u) const { const int L = i * G + c; if (L >= 64) return false; u.e = L >> 5; u.pm = L & 31; u.pn = 0; u.nvalid = 256; return true; }
    __device__ __forceinline__ const char* a_base(const pg8::Unit& u) const { return (u.e ? A1 : A0) + (size_t)u.pm * 256 * 1024 * 2; }
    __device__ __forceinline__ const char* b_base(const pg8::Unit& u) const { return Bt + (size_t)u.e * 256 * 2048 * 2; }
    __device__ __forceinline__ unsigned a_off(const pg8::Unit&, int) const { return 0u; }
};
struct MoeTab { volatile LAS int* tstart; volatile LAS int* cnt; };
__device__ __forceinline__ bool moe_unit(const MoeTab& T, int L, pg8::Unit& u) {
    const int total = T.tstart[32]; if (L >= 4 * total) return false;
    u.pn = L & 3; const int mt = L >> 2; int e = 0;
#pragma unroll 1
    for (int k = 1; k < 32; ++k) e += (T.tstart[k] <= mt) ? 1 : 0;
    u.e = e; u.pm = mt - T.tstart[e]; u.nvalid = T.cnt[e] - u.pm * 256; return true;
}
struct MoeGuOrder {
    MoeTab T; const char* X; const int* rowl; const char* W; int G, c;
    __device__ __forceinline__ bool next(int i, pg8::Unit& u) const { return moe_unit(T, i * G + c, u); }
    __device__ __forceinline__ const char* a_base(const pg8::Unit&) const { return X; }
    __device__ __forceinline__ const char* b_base(const pg8::Unit& u) const { return W + (size_t)u.e * 3 * MiB + (size_t)u.pn * 256 * 1024 * 2; }
    __device__ __forceinline__ unsigned a_off(const pg8::Unit& u, int R) const {
        int idx = u.pm * 256 + R; const int lim = u.pm * 256 + u.nvalid - 1; idx = idx < lim ? idx : lim;
        const int id = rowl[(size_t)u.e * ECAP + idx]; return (unsigned)(id >> 1) * 2048u; }
};
struct MoeDnOrder {
    MoeTab T; const char* ACT; const char* W; int G, c;
    __device__ __forceinline__ bool next(int i, pg8::Unit& u) const { return moe_unit(T, i * G + c, u); }
    __device__ __forceinline__ const char* a_base(const pg8::Unit& u) const { return ACT + (size_t)(T.tstart[u.e] + u.pm) * 256 * 512 * 2; }
    __device__ __forceinline__ const char* b_base(const pg8::Unit& u) const { return W + (size_t)u.e * 3 * MiB + 2 * MiB + (size_t)u.pn * 256 * 512 * 2; }
    __device__ __forceinline__ unsigned a_off(const pg8::Unit&, int) const { return 0u; }
};

#define EPI_ARGS const f32x4 (&acc)[2][2][4][2], const pg8::Unit& u, int wr, int wc, int fr, int fq
__device__ __forceinline__ u32x4 pack8(const f32x4& a, const f32x4& b) { u32x4 w; w.x = pk2(a[0], a[1]); w.y = pk2(a[2], a[3]); w.z = pk2(b[0], b[1]); w.w = pk2(b[2], b[3]); return w; }
__device__ __forceinline__ u32x2 pack4(const f32x4& a) { u32x2 w; w.x = pk2(a[0], a[1]); w.y = pk2(a[2], a[3]); return w; }

struct EpiInProj {
    const float* r0; bf16_t* BG; bf16_t* U;
    __device__ __forceinline__ void operator()(EPI_ARGS) const {
        float rsv[2][4];
#pragma unroll
        for (int ai = 0; ai < 2; ++ai)
#pragma unroll
            for (int m = 0; m < 4; ++m) rsv[ai][m] = r0[u.pm * 256 + ai * 128 + wr * 64 + m * 16 + fr];
#pragma unroll
        for (int ai = 0; ai < 2; ++ai)
#pragma unroll
            for (int m = 0; m < 4; ++m) {
                const int row = u.pm * 256 + ai * 128 + wr * 64 + m * 16 + fr; const float rs = rsv[ai][m];
                if (u.pn < 4) {
#pragma unroll
                    for (int bj = 0; bj < 2; ++bj) *(u32x4*)(BG + (size_t)row * D + u.pn * 256 + bj * 128 + wc * 32 + 8 * fq) = pack8(acc[ai][bj][m][0] * rs, acc[ai][bj][m][1] * rs);
                } else {
                    const float rs2 = rs * rs;
                    *(u32x4*)(U + (size_t)row * D + (u.pn - 4) * 128 + wc * 32 + 8 * fq) = pack8(acc[ai][0][m][0] * acc[ai][0][m][1] * rs2, acc[ai][1][m][0] * acc[ai][1][m][1] * rs2);
                }
            }
    }
};
struct EpiResid {
    const float* base; float* out;
    __device__ __forceinline__ void operator()(EPI_ARGS) const {
#pragma unroll
        for (int ai = 0; ai < 2; ++ai)
#pragma unroll
            for (int mp = 0; mp < 2; ++mp) {
                f32x4 bv[2][2][2];
#pragma unroll
                for (int mm = 0; mm < 2; ++mm) { const size_t off = (size_t)(u.pm * 256 + ai * 128 + wr * 64 + (2 * mp + mm) * 16 + fr) * D + u.pn * 256 + wc * 32 + 4 * fq;
#pragma unroll
                    for (int bj = 0; bj < 2; ++bj)
#pragma unroll
                        for (int n = 0; n < 2; ++n) bv[mm][bj][n] = *(const f32x4*)(base + off + bj * 128 + n * 16); }
#pragma unroll
                for (int mm = 0; mm < 2; ++mm) { const size_t off = (size_t)(u.pm * 256 + ai * 128 + wr * 64 + (2 * mp + mm) * 16 + fr) * D + u.pn * 256 + wc * 32 + 4 * fq;
#pragma unroll
                    for (int bj = 0; bj < 2; ++bj)
#pragma unroll
                        for (int n = 0; n < 2; ++n) *(f32x4*)(out + off + bj * 128 + n * 16) = bv[mm][bj][n] + acc[ai][bj][2 * mp + mm][n]; }
            }
    }
};
struct EpiQKV {
    const float* r2; const f32x2* rope; unsigned char* kv; bf16_t* Q; float* gates;
    __device__ __forceinline__ void operator()(EPI_ARGS) const {
        const int pn = u.pn;
        float rsv[2][4];
#pragma unroll
        for (int ai = 0; ai < 2; ++ai)
#pragma unroll
            for (int m = 0; m < 4; ++m) rsv[ai][m] = r2[u.pm * 256 + ai * 128 + wr * 64 + m * 16 + fr];
#pragma unroll
        for (int ai = 0; ai < 2; ++ai)
#pragma unroll
            for (int m = 0; m < 4; ++m) {
                const int row = u.pm * 256 + ai * 128 + wr * 64 + m * 16 + fr; const float rs = rsv[ai][m];
                const int b = row >> 14, s = row & (SEQ - 1);
                f32x4 ropev[2][2];
                if (pn == 2 || pn == 4) {
#pragma unroll
                    for (int bj = 0; bj < 2; ++bj) { const int d0 = 16 * (wc & 1) + 4 * fq; ropev[bj][0] = *(const f32x4*)(rope + (size_t)row * 32 + d0); ropev[bj][1] = *(const f32x4*)(rope + (size_t)row * 32 + d0 + 2); }
                }
                if (pn < 6) {
#pragma unroll
                    for (int bj = 0; bj < 2; ++bj) {
                        const int gg = 2 * bj + (wc >> 1), d0 = 16 * (wc & 1) + 4 * fq;
                        f32x4 v0 = acc[ai][bj][m][0] * rs, v1 = acc[ai][bj][m][1] * rs;
                        if (pn == 2 || pn == 4) {
                            const f32x4 cs0 = ropev[bj][0], cs1 = ropev[bj][1];
                            const f32x4 c = {cs0[0], cs0[2], cs1[0], cs1[2]}, sn = {cs0[1], cs0[3], cs1[1], cs1[3]};
                            const f32x4 o0 = v0 * c - v1 * sn, o1 = v1 * c + v0 * sn; v0 = o0; v1 = o1;
                        }
                        if (pn == 3 || pn == 5) {
                            bf16_t* vt = (bf16_t*)(kv + (size_t)pn * KVSTRIDE) + ((size_t)(b * 4 + gg) * 64 + d0) * SEQ + s;
#pragma unroll
                            for (int j = 0; j < 4; ++j) { vt[(size_t)j * SEQ] = (bf16_t)f2bf(v0[j]); vt[(size_t)(j + 32) * SEQ] = (bf16_t)f2bf(v1[j]); }
                        } else {
                            bf16_t* kp = (bf16_t*)(kv + (size_t)pn * KVSTRIDE) + ((size_t)(b * 4 + gg) * SEQ + s) * 64 + d0;
                            *(u32x2*)kp = pack4(v0); *(u32x2*)(kp + 32) = pack4(v1);
                        }
                    }
                } else if (pn < 10) {
#pragma unroll
                    for (int bj = 0; bj < 2; ++bj) {
                        const int head = 4 * (pn - 6) + 2 * bj + (wc >> 1), d0 = 16 * (wc & 1) + 4 * fq; const float sc = rs * (0.125f * 1.4426950408889634f);
                        bf16_t* qp = Q + (size_t)row * D + head * 64 + d0;
                        *(u32x2*)qp = pack4(acc[ai][bj][m][0] * sc); *(u32x2*)(qp + 32) = pack4(acc[ai][bj][m][1] * sc);
                    }
                } else {
#pragma unroll
                    for (int n = 0; n < 2; ++n) { const int sl = 32 * wc + 16 * n + 4 * fq;
                        if (sl < 48) { f32x4 v = acc[ai][0][m][n] * rs;
#pragma unroll
                            for (int j = 0; j < 4; ++j) v[j] = 1.0f / (1.0f + __expf(-v[j]));
                            *(f32x4*)(gates + (size_t)row * 48 + sl) = v; } }
                }
            }
    }
};
__device__ __forceinline__ float gelu_tanh(float x) { const float y = 0.7978845608028654f * (x + 0.044715f * x * x * x); const float t = 1.0f - 2.0f / (1.0f + __expf(2.0f * y)); return 0.5f * x * (1.0f + t); }
struct EpiCmp1 {
    const float* bias; bf16_t* HID;
    __device__ __forceinline__ void operator()(EPI_ARGS) const {
        f32x4 bv[2][2];
#pragma unroll
        for (int bj = 0; bj < 2; ++bj)
#pragma unroll
            for (int n = 0; n < 2; ++n) bv[bj][n] = *(const f32x4*)(bias + u.e * 256 + bj * 128 + wc * 32 + 8 * fq + 4 * n);
#pragma unroll
        for (int ai = 0; ai < 2; ++ai)
#pragma unroll
            for (int m = 0; m < 4; ++m) {
                const int row = u.pm * 256 + ai * 128 + wr * 64 + m * 16 + fr;
#pragma unroll
                for (int bj = 0; bj < 2; ++bj) { f32x4 v0 = acc[ai][bj][m][0] + bv[bj][0], v1 = acc[ai][bj][m][1] + bv[bj][1];
#pragma unroll
                    for (int j = 0; j < 4; ++j) { v0[j] = gelu_tanh(v0[j]); v1[j] = gelu_tanh(v1[j]); }
                    *(u32x4*)(HID + ((size_t)u.e * 8192 + row) * 256 + bj * 128 + wc * 32 + 8 * fq) = pack8(v0, v1); }
            }
    }
};
struct EpiGU {
    MoeTab T; const float* rowr; bf16_t* ACT;
    __device__ __forceinline__ void operator()(EPI_ARGS) const {
        const size_t arow0 = (size_t)(T.tstart[u.e] + u.pm) * 256;
        float rsv[2][4];
#pragma unroll
        for (int ai = 0; ai < 2; ++ai)
#pragma unroll
            for (int m = 0; m < 4; ++m) rsv[ai][m] = rowr[(size_t)u.e * ECAP + u.pm * 256 + ai * 128 + wr * 64 + m * 16 + fr];
#pragma unroll
        for (int ai = 0; ai < 2; ++ai)
#pragma unroll
            for (int m = 0; m < 4; ++m) {
                const int rl = ai * 128 + wr * 64 + m * 16 + fr; const float rs = rsv[ai][m];
                f32x4 a[2];
#pragma unroll
                for (int bj = 0; bj < 2; ++bj) { const f32x4 g = acc[ai][bj][m][0] * rs, up = acc[ai][bj][m][1] * rs;
#pragma unroll
                    for (int j = 0; j < 4; ++j) a[bj][j] = g[j] / (1.0f + __expf(-g[j])) * up[j]; }
                *(u32x4*)(ACT + (arow0 + rl) * DE + u.pn * 128 + wc * 32 + 8 * fq) = pack8(a[0], a[1]);
            }
    }
};
struct EpiDN {
    const int* rowl; const float* wgt; bf16_t* Y;
    __device__ __forceinline__ void operator()(EPI_ARGS) const {
        int idv[2][4]; float wv[2][4];
#pragma unroll
        for (int ai = 0; ai < 2; ++ai)
#pragma unroll
            for (int m = 0; m < 4; ++m) { const int rl = ai * 128 + wr * 64 + m * 16 + fr; const int lim = u.nvalid - 1; idv[ai][m] = rowl[(size_t)u.e * ECAP + u.pm * 256 + (rl < lim ? rl : lim)]; }
#pragma unroll
        for (int ai = 0; ai < 2; ++ai)
#pragma unroll
            for (int m = 0; m < 4; ++m) wv[ai][m] = wgt[idv[ai][m]];
#pragma unroll
        for (int ai = 0; ai < 2; ++ai)
#pragma unroll
            for (int m = 0; m < 4; ++m) {
                const int rl = ai * 128 + wr * 64 + m * 16 + fr;
                if (rl < u.nvalid) {
                    const int id = idv[ai][m]; const float w = wv[ai][m];
#pragma unroll
                    for (int bj = 0; bj < 2; ++bj) *(u32x4*)(Y + (size_t)id * D + u.pn * 256 + bj * 128 + wc * 32 + 8 * fq) = pack8(acc[ai][bj][m][0] * w, acc[ai][bj][m][1] * w);
                }
            }
    }
};

template <class RowMap>
__device__ __forceinline__ void transpose_item(const float* W, int K, int N, bf16_t* WT, const float* gain, LAS float*  , int item, int lane, const RowMap& rm) {
    const int nblk = (N + 31) / 32, kb = item / nblk, nb = item % nblk, k0 = 64 * kb + 8 * (lane & 7), nc = 32 * nb + 4 * (lane >> 3);
    if (nc >= N) return;
    f32x4 v[8];
#pragma unroll
    for (int i = 0; i < 8; ++i) v[i] = *(const f32x4*)(W + (size_t)(k0 + i) * N + nc);
    if (gain) { const f32x4 g0 = *(const f32x4*)(gain + k0), g1 = *(const f32x4*)(gain + k0 + 4);
#pragma unroll
        for (int i = 0; i < 4; ++i) { v[i] = v[i] * g0[i]; v[4 + i] = v[4 + i] * g1[i]; } }
#pragma unroll
    for (int j = 0; j < 4; ++j) { u32x4 o; o.x = pk2(v[0][j], v[1][j]); o.y = pk2(v[2][j], v[3][j]); o.z = pk2(v[4][j], v[5][j]); o.w = pk2(v[6][j], v[7][j]);
        *(u32x4*)(WT + (size_t)rm(nc + j) * K + k0) = o; }
}
struct MapIdent { __device__ __forceinline__ int operator()(int c) const { return c; } };
struct MapPerm8 { __device__ __forceinline__ int operator()(int c) const { return slot_perm8(c); } };
struct MapWin { __device__ __forceinline__ int operator()(int c) const {
    if (c < 1024) return slot_perm8(c);
    const int n = (c >= 2048) ? 1 : 0, ch = c - 1024 - 1024 * n; return 1024 + (ch >> 7) * 256 + slot_pair128(ch & 127, n); } };
struct MapKV { __device__ __forceinline__ int operator()(int c) const { return (c & ~63) + slot_rope64(c & 63); } };
struct MapAIn { __device__ __forceinline__ int operator()(int c) const { return c < 1024 ? 1536 + (c & ~63) + slot_rope64(c & 63) : 2560 + (c - 1024); } };
struct MapGU { int n; __device__ __forceinline__ int operator()(int c) const { return (c >> 7) * 256 + slot_pair128(c & 127, n); } };

struct ConvItem {
    f32x4 v[8], g0, g1; bf16_t* dst; int K, kind, nc; bool hasg;
    __device__ __forceinline__ void load(const Args& a, unsigned char* ws, int layer, int it, int lane) {
        const int e = it / 768, r = it % 768; kind = r < 256 ? 0 : (r < 512 ? 1 : 2); const int item = r & 255;
        const size_t eo = ((size_t)layer * NE + e) * (size_t)D * DE;
        const float* W = (kind == 0 ? a.in[I_EWG] : kind == 1 ? a.in[I_EWU] : a.in[I_EWD]) + eo;
        const int N = kind == 2 ? D : DE; K = kind == 2 ? DE : D; hasg = kind != 2;
        const int nblk = N / 32, kb = item / nblk, nb = item % nblk, k0 = 64 * kb + 8 * (lane & 7); nc = 32 * nb + 4 * (lane >> 3);
        dst = (bf16_t*)(ws + WS_EXPW + (size_t)e * 3 * MiB) + (kind == 2 ? (size_t)1024 * 1024 : 0) + k0;
#pragma unroll
        for (int i = 0; i < 8; ++i) v[i] = *(const f32x4*)(W + (size_t)(k0 + i) * N + nc);
        const float* gp = a.in[I_NFFN] + layer * D + (hasg ? k0 : 0); g0 = *(const f32x4*)gp; g1 = *(const f32x4*)(gp + 4);
    }
    __device__ __forceinline__ void store() {
        if (hasg) {
#pragma unroll
            for (int i = 0; i < 4; ++i) { v[i] = v[i] * g0[i]; v[4 + i] = v[4 + i] * g1[i]; } }
#pragma unroll
        for (int j = 0; j < 4; ++j) { u32x4 o; o.x = pk2(v[0][j], v[1][j]); o.y = pk2(v[2][j], v[3][j]); o.z = pk2(v[4][j], v[5][j]); o.w = pk2(v[6][j], v[7][j]);
            const int c = nc + j; const int slot = kind == 2 ? slot_perm8(c) : (c >> 7) * 256 + slot_pair128(c & 127, kind);
            *(u32x4*)(dst + (size_t)slot * K) = o; }
    }
};
__device__ __forceinline__ void convert_experts(const Args& a, const Frame& F, int layer, int gw, int NGW, LAS float*  ) {
    constexpr int NIT = NE * 768;
    if (gw >= NIT) return;
    ConvItem cur, nxt; cur.load(a, F.ws, layer, gw, F.lane);
#pragma unroll 1
    for (int it = gw; it < NIT; it += NGW) {
        const int itn = it + NGW < NIT ? it + NGW : it;
        nxt.load(a, F.ws, layer, itn, F.lane);
        cur.store();
        cur = nxt;
    }
}

__device__ __forceinline__ void phase_prep(const Args& a, const Frame& F0) {
    const Frame F = refresh(F0);
    LAS float* scr = (LAS float*)(F.lds + F.wave * 16384);
    const int gw = F.vcu * NWAVES + F.wave, NGW = F.G * NWAVES;
    const int gt = gw * 64 + F.lane, NGT = NGW * 64;
    unsigned char* ws = F.ws;
    { const float* x = a.in[I_X]; bf16_t* XB = (bf16_t*)(ws + WS_RA); float* R0 = (float*)(ws + WS_R0);
      for (int m = gw; m < NT; m += NGW) { const f32x4* xr = (const f32x4*)(x + (size_t)m * D) + F.lane; f32x4 v[4]; float s = 0.f;
#pragma unroll
          for (int j = 0; j < 4; ++j) { v[j] = xr[64 * j]; s += (v[j][0] * v[j][0] + v[j][1] * v[j][1]) + (v[j][2] * v[j][2] + v[j][3] * v[j][3]); }
          s = wave_sum(s); if (F.lane == 0) R0[m] = 1.0f / sqrtf(s * (1.0f / D) + RMS_EPS);
          u32x2* o8 = (u32x2*)(XB + (size_t)m * D) + F.lane;
#pragma unroll
          for (int j = 0; j < 4; ++j) o8[64 * j] = pack4(v[j]); } }
    { const int* pos = (const int*)a.in[I_POS]; f32x2* rope = (f32x2*)(ws + WS_ROPE);
      for (int i = gt; i < NT * 32; i += NGT) { const float ang = (float)pos[i >> 5] * a.inv_freq[i & 31];
          double rev = (double)ang * 0.15915494309189533577; rev -= __builtin_rint(rev); const float rf = (float)rev;
          rope[i] = (f32x2){__builtin_amdgcn_cosf(rf), __builtin_amdgcn_sinf(rf)}; } }
    { constexpr int I_IN = 16 * 96, I_OUT = 16 * 32, I_KV = 16 * 48, I_AIN = 16 * 34, I_C1 = 32 * 8, I_AO = 16 * 32;
      constexpr int NI = I_IN + I_OUT + I_KV + I_AIN + 2 * I_C1 + I_AO;
      for (int it = gw; it < NI; it += NGW) { int r = it;
          if (r < I_IN) { transpose_item(a.in[I_CWIN], D, 3 * D, (bf16_t*)(ws + WS_WIN), a.in[I_NMIX], scr, r, F.lane, MapWin{}); continue; } r -= I_IN;
          if (r < I_OUT) { transpose_item(a.in[I_CWOUT], D, D, (bf16_t*)(ws + WS_WOUT), nullptr, scr, r, F.lane, MapIdent{}); continue; } r -= I_OUT;
          if (r < I_KV) { transpose_item(a.in[I_WKV], D, 1536, (bf16_t*)(ws + WS_WQKV), a.in[I_NKV], scr, r, F.lane, MapKV{}); continue; } r -= I_KV;
          if (r < I_AIN) { transpose_item(a.in[I_AWIN], D, 1072, (bf16_t*)(ws + WS_WQKV), a.in[I_NMIX] + D, scr, r, F.lane, MapAIn{}); continue; } r -= I_AIN;
          if (r < I_C1) { transpose_item(a.in[I_CW1K], 2048, 256, (bf16_t*)(ws + WS_WC1), nullptr, scr, r, F.lane, MapPerm8{}); continue; } r -= I_C1;
          if (r < I_C1) { transpose_item(a.in[I_CW1V], 2048, 256, (bf16_t*)(ws + WS_WC1) + 256 * 2048, nullptr, scr, r, F.lane, MapPerm8{}); continue; } r -= I_C1;
          transpose_item(a.in[I_AWOUT], D, D, (bf16_t*)(ws + WS_WAO), nullptr, scr, r, F.lane, MapIdent{});
      } }
    convert_experts(a, F, 0, gw, NGW, scr);
    { unsigned* z = (unsigned*)((bf16_t*)(ws + WS_WQKV) + (size_t)2608 * D); for (int i = gt; i < 208 * D / 2; i += NGT) z[i] = 0u; }
    { float* bc = (float*)(ws + WS_BIASC);
      for (int o = gw; o < 512; o += NGW) { const int kv = o >> 8, n = o & 255; const float* pos = a.in[kv ? I_CPV : I_CPK]; const float* w1 = a.in[kv ? I_CW1V : I_CW1K]; float s = 0.f;
          for (int i = F.lane; i < 2048; i += 64) s += pos[i] * w1[(size_t)i * 256 + n];
          s = wave_sum(s); if (F.lane == 0) bc[o] = s; } }
    { float* rw = (float*)(ws + WS_RW);
      for (int i = gt; i < 2 * 36 * 1024; i += NGT) { const int l = i / (36 * 1024), r = i % (36 * 1024), o = r >> 10, k = r & 1023;
          const float g = a.in[I_NFFN][l * D + k]; rw[i] = g * (o < 32 ? a.in[I_REW][((size_t)l * D + k) * 32 + o] : a.in[I_RGW][((size_t)l * D + k) * 4 + (o - 32)]); } }
    { bf16_t* w2t = (bf16_t*)(ws + WS_W2T);
      for (int i = gt; i < 2 * 64 * 256; i += NGT) { const int kv = i >> 14, r = i & 16383, n = r >> 8, k = r & 255; w2t[i] = (bf16_t)f2bf(a.in[kv ? I_CW2V : I_CW2K][k * 64 + n]); } }
}

__device__ __forceinline__ void phase_conv(const Args& a, const Frame& F0) {
    const Frame F = refresh(F0);
    const bf16_t* BG = (const bf16_t*)(F.ws + WS_RB); const bf16_t* U = (const bf16_t*)(F.ws + WS_RC); bf16_t* Z = (bf16_t*)(F.ws + WS_RA);
    const float* cw = a.in[I_CW];
    const int cg8 = (F.tid & 127) * 8, tq = F.tid >> 7;
    float w0[8], w1[8], w2[8];
#pragma unroll
    for (int j = 0; j < 8; ++j) { w0[j] = cw[cg8 + j]; w1[j] = cw[D + cg8 + j]; w2[j] = cw[2 * D + cg8 + j]; }
    for (int ch = F.vcu; ch < NT / 32; ch += F.G) {
        const int t0 = ch * 32 + tq * 8; const int s0 = t0 & (SEQ - 1);
        float um2[8], um1[8];
        { u32x4 p = {0u, 0u, 0u, 0u}, q = {0u, 0u, 0u, 0u};
          if (s0 >= 2) p = *(const u32x4*)(U + (size_t)(t0 - 2) * D + cg8);
          if (s0 >= 1) q = *(const u32x4*)(U + (size_t)(t0 - 1) * D + cg8);
#pragma unroll
          for (int j = 0; j < 4; ++j) { um2[2 * j] = bflo(p[j]); um2[2 * j + 1] = bfhi(p[j]); um1[2 * j] = bflo(q[j]); um1[2 * j + 1] = bfhi(q[j]); } }
#pragma unroll
        for (int i = 0; i < 8; ++i) {
            const u32x4 uu = *(const u32x4*)(U + (size_t)(t0 + i) * D + cg8), bb = *(const u32x4*)(BG + (size_t)(t0 + i) * D + cg8);
            float z[8];
#pragma unroll
            for (int j = 0; j < 4; ++j) { const float u0 = bflo(uu[j]), u1 = bfhi(uu[j]);
                z[2 * j] = bflo(bb[j]) * (w0[2 * j] * um2[2 * j] + w1[2 * j] * um1[2 * j] + w2[2 * j] * u0);
                z[2 * j + 1] = bfhi(bb[j]) * (w0[2 * j + 1] * um2[2 * j + 1] + w1[2 * j + 1] * um1[2 * j + 1] + w2[2 * j + 1] * u1);
                um2[2 * j] = um1[2 * j]; um2[2 * j + 1] = um1[2 * j + 1]; um1[2 * j] = u0; um1[2 * j + 1] = u1; }
            u32x4 o; o.x = pk2(z[0], z[1]); o.y = pk2(z[2], z[3]); o.z = pk2(z[4], z[5]); o.w = pk2(z[6], z[7]);
            *(u32x4*)(Z + (size_t)(t0 + i) * D + cg8) = o;
        }
    }
}

__device__ __forceinline__ void phase_router(const Args& a, const Frame& F0, int layer, const float* X, bf16_t* XnB, float* Rout) {
    const Frame F = refresh(F0);
    unsigned char* ws = F.ws;
    const float* rw = (const float*)(ws + WS_RW) + (size_t)layer * 36 * 1024;
    const float* brg = a.in[I_RGB] + layer * 4; const float* bre = a.in[I_REB] + layer * 32;
    unsigned* gcnt = (unsigned*)(ws + WS_CTL) + CW_CNT + layer * 32;
    int* rowl = (int*)(ws + WS_ROWL); float* rowr = (float*)(ws + WS_ROWR); float* wgt = (float*)(ws + WS_WGT);
    constexpr int XT_LD = 260;
    LAS float* xt = (LAS float*)(F.lds) + F.wave * (16 * XT_LD);
    LAS float* lg = xt;
    LAS unsigned* cntl = (LAS unsigned*)(F.lds + 8 * 16 * XT_LD * 4); LAS unsigned* basel = cntl + 32;
    const int l15 = F.lane & 15, quad = F.lane >> 4;
    for (int base = F.vcu * 128; base < NT; base += F.G * 128) {
        if (F.tid < 32) cntl[F.tid] = 0u;
        const int tok0 = base + F.wave * 16, tok = tok0 + l15;
        const float* w0 = rw + (size_t)l15 * 1024 + 4 * quad; const float* w1 = w0 + 16 * 1024; const float* w2 = rw + (size_t)(32 + (l15 & 3)) * 1024 + 4 * quad;
        f32x4 acc0 = {0.f, 0.f, 0.f, 0.f}, acc1 = acc0, acc2 = acc0; float ss = 0.f;
        f32x4 nxt[16];
#pragma unroll
        for (int r = 0; r < 16; ++r) nxt[r] = *(const f32x4*)(X + (size_t)(tok0 + r) * D + 4 * F.lane);
#pragma unroll 1
        for (int ch = 0; ch < 4; ++ch) {
#pragma unroll
            for (int r = 0; r < 16; ++r) { *(LAS f32x4*)(xt + r * XT_LD + 4 * F.lane) = nxt[r]; *(u32x2*)(XnB + (size_t)(tok0 + r) * D + 256 * ch + 4 * F.lane) = pack4(nxt[r]); }
            if (ch < 3) {
#pragma unroll
                for (int r = 0; r < 16; ++r) nxt[r] = *(const f32x4*)(X + (size_t)(tok0 + r) * D + 256 * (ch + 1) + 4 * F.lane); }
#pragma unroll 4
            for (int i = 0; i < 16; ++i) {
                const int k0 = 256 * ch + 16 * i;
                const f32x4 xv = *(const LAS f32x4*)(xt + l15 * XT_LD + 16 * i + 4 * quad), b0 = *(const f32x4*)(w0 + k0), b1 = *(const f32x4*)(w1 + k0), b2 = *(const f32x4*)(w2 + k0);
                ss += (xv[0] * xv[0] + xv[1] * xv[1]) + (xv[2] * xv[2] + xv[3] * xv[3]);
#pragma unroll
                for (int jj = 0; jj < 4; ++jj) {
                    acc0 = __builtin_amdgcn_mfma_f32_16x16x4f32(xv[jj], b0[jj], acc0, 0, 0, 0);
                    acc1 = __builtin_amdgcn_mfma_f32_16x16x4f32(xv[jj], b1[jj], acc1, 0, 0, 0);
                    acc2 = __builtin_amdgcn_mfma_f32_16x16x4f32(xv[jj], b2[jj], acc2, 0, 0, 0);
                }
            }
        }
        ss += __shfl_xor(ss, 16); ss += __shfl_xor(ss, 32);
        const float r = 1.0f / sqrtf(ss * (1.0f / D) + RMS_EPS);
        if (quad == 0) Rout[tok] = r;
#pragma unroll
        for (int i = 0; i < 4; ++i) { const float rt = __shfl(r, 4 * quad + i); const int trow = 4 * quad + i;
            lg[trow * 36 + l15] = acc0[i] * rt + bre[l15]; lg[trow * 36 + 16 + l15] = acc1[i] * rt + bre[16 + l15];
            if (l15 < 4) lg[trow * 36 + 32 + l15] = acc2[i] * rt + brg[l15]; }
        __syncthreads();
        int e0 = 0, e1 = 0, rk0 = 0, rk1 = 0; float wt0 = 0.f, wt1 = 0.f;
        if (F.lane < 16) {
            const LAS float* L = lg + F.lane * 36;
            const float g0 = L[32], g1 = L[33], g2 = L[34], g3 = L[35];
            float gm = g0; int gt = 0; if (g1 > gm) { gm = g1; gt = 1; } if (g2 > gm) { gm = g2; gt = 2; } if (g3 > gm) { gm = g3; gt = 3; }
            const float pg = 1.0f / (expf(g0 - gm) + expf(g1 - gm) + expf(g2 - gm) + expf(g3 - gm));
            float v0 = -INFINITY, v1 = -INFINITY; int i0 = 0, i1 = 0;
#pragma unroll
            for (int k = 0; k < 8; ++k) { const float v = L[8 * gt + k]; if (v > v0) { v1 = v0; i1 = i0; v0 = v; i0 = k; } else if (v > v1) { v1 = v; i1 = k; } }
            const float ex = expf(v1 - v0); const float s0 = 1.0f / (1.0f + ex);
            wt0 = pg * s0; wt1 = pg * (ex * s0); e0 = 8 * gt + i0; e1 = 8 * gt + i1;
            rk0 = (int)atomicAdd((unsigned*)&cntl[e0], 1u); rk1 = (int)atomicAdd((unsigned*)&cntl[e1], 1u);
        }
        __syncthreads();
        if (F.tid < 32) { const unsigned c = cntl[F.tid]; basel[F.tid] = c ? __hip_atomic_fetch_add(gcnt + F.tid, c, __ATOMIC_RELAXED, __HIP_MEMORY_SCOPE_AGENT) : 0u; }
        __syncthreads();
        if (F.lane < 16) {
            const int tk = base + F.wave * 16 + F.lane; const float rr = r;
            const size_t s0 = (size_t)e0 * ECAP + basel[e0] + rk0, s1 = (size_t)e1 * ECAP + basel[e1] + rk1;
            rowl[s0] = 2 * tk; rowr[s0] = rr; wgt[2 * tk] = wt0;
            rowl[s1] = 2 * tk + 1; rowr[s1] = rr; wgt[2 * tk + 1] = wt1;
        }
        __syncthreads();
    }
}

template <bool FINAL>
__device__ __forceinline__ void phase_combine(const Args& a, const Frame& F0, float* X, bf16_t* XnB, float* Rout) {
    const Frame F = refresh(F0);
    const bf16_t* Y = (const bf16_t*)(F.ws + WS_RB);
    const int gw = F.vcu * NWAVES + F.wave, NGW = F.G * NWAVES;
    for (int m = gw; m < NT; m += NGW) {
        f32x4* xr = (f32x4*)(X + (size_t)m * D) + F.lane; const u32x2* y0 = (const u32x2*)(Y + (size_t)(2 * m) * D) + F.lane; const u32x2* y1 = (const u32x2*)(Y + (size_t)(2 * m + 1) * D) + F.lane;
        f32x4 v[4]; float s = 0.f;
#pragma unroll
        for (int j = 0; j < 4; ++j) { v[j] = xr[64 * j]; const u32x2 p = y0[64 * j], q = y1[64 * j];
            v[j][0] += bflo(p[0]) + bflo(q[0]); v[j][1] += bfhi(p[0]) + bfhi(q[0]); v[j][2] += bflo(p[1]) + bflo(q[1]); v[j][3] += bfhi(p[1]) + bfhi(q[1]);
            s += (v[j][0] * v[j][0] + v[j][1] * v[j][1]) + (v[j][2] * v[j][2] + v[j][3] * v[j][3]); }
        s = wave_sum(s); const float r = 1.0f / sqrtf(s * (1.0f / D) + RMS_EPS);
        if constexpr (FINAL) {
            const f32x4* g = (const f32x4*)a.in[I_NFIN] + F.lane;
#pragma unroll
            for (int j = 0; j < 4; ++j) xr[64 * j] = v[j] * r * g[64 * j];
        } else {
            if (F.lane == 0) Rout[m] = r;
            u32x2* o8 = (u32x2*)(XnB + (size_t)m * D) + F.lane;
#pragma unroll
            for (int j = 0; j < 4; ++j) { xr[64 * j] = v[j]; o8[64 * j] = pack4(v[j]); }
        }
    }
}

__device__ __forceinline__ void phase_cmp2(const Frame& F0) {
    const Frame F = refresh(F0);
    const bf16_t* HID = (const bf16_t*)(F.ws + WS_RD + RD_HID); const bf16_t* W2T = (const bf16_t*)(F.ws + WS_W2T);
    bf16_t* KCMP = (bf16_t*)(F.ws + WS_RD + RD_KCMP); bf16_t* VCMPT = (bf16_t*)(F.ws + WS_RD + RD_VCMPT);
    const int gw = F.vcu * NWAVES + F.wave, NGW = F.G * NWAVES, l15 = F.lane & 15, quad = F.lane >> 4;
    for (int task = gw; task < 1024; task += NGW) {
        const int kv = task >> 9, r0 = (task & 511) * 16;
        const bf16_t* ap = HID + ((size_t)kv * 8192 + r0 + l15) * 256 + 8 * quad; const bf16_t* bp = W2T + (size_t)kv * 64 * 256 + (size_t)l15 * 256 + 8 * quad;
        f32x4 acc[4];
#pragma unroll
        for (int cb = 0; cb < 4; ++cb) acc[cb] = (f32x4){0.f, 0.f, 0.f, 0.f};
#pragma unroll
        for (int ks = 0; ks < 8; ++ks) { const bf16x8 af = *(const bf16x8*)(ap + 32 * ks);
#pragma unroll
            for (int cb = 0; cb < 4; ++cb) acc[cb] = __builtin_amdgcn_mfma_f32_16x16x32_bf16(af, *(const bf16x8*)(bp + (size_t)cb * 16 * 256 + 32 * ks), acc[cb], 0, 0, 0); }
#pragma unroll
        for (int cb = 0; cb < 4; ++cb)
#pragma unroll
            for (int i = 0; i < 4; ++i) { const int row = r0 + 4 * quad + i, bg = row >> 10, c = row & 1023, col = l15 + 16 * cb;
                if (kv == 0) KCMP[((size_t)bg * 1024 + c) * 64 + col] = (bf16_t)f2bf(acc[cb][i]);
                else VCMPT[((size_t)bg * 64 + col) * 1024 + c] = (bf16_t)f2bf(acc[cb][i]); }
    }
}

namespace nsa {
constexpr int SLOTB = 16384;
constexpr int NS_CMP = 4, NS_SW = 8;
constexpr int A_IMP = NS_CMP * SLOTB, IMP_LD = 260, A_SELM = 145408, A_UW = A_SELM + 64 * 8 * 4, A_UB = A_UW + 64 * 4, A_TL = A_UB + 64, A_END = A_TL + 260 * 4;
static_assert(A_IMP + 64 * IMP_LD * 4 <= A_SELM && NS_SW * SLOTB <= A_SELM && A_END <= MISC_OFF, "attention LDS");
struct Ctx { int tid, lane, wave, l15, quad, qi, h, sw; LAS unsigned char* lds; };
struct SubState { float m, l, L; f32x4 O[4]; };

template <int MODE>
__device__ __forceinline__ void sub_scores(const Ctx& c, const LAS unsigned char* kb, int kc0, int kc1, const bf16x8 (&qf)[2], SubState& st, int lo, int hi, bool rowsel, bool needmask, int kidx0, float invl, int sgi, bf16x8 (&pf)[2]) {
    constexpr float THR = 8.0f;
    const float mr = (st.m == -INFINITY) ? 0.f : st.m;
    const float cneg = (MODE == 2 && !rowsel) ? -INFINITY : -mr;
    const f32x4 cinit = {cneg, cneg, cneg, cneg};
    f32x4 S[4];
#pragma unroll
    for (int mb = 0; mb < 4; ++mb) {
        const bf16x8 k0 = *(const LAS bf16x8*)(kb + mb * 2048 + kc0), k1 = *(const LAS bf16x8*)(kb + mb * 2048 + kc1);
        S[mb] = __builtin_amdgcn_mfma_f32_16x16x32_bf16(k0, qf[0], cinit, 0, 0, 0);
        S[mb] = __builtin_amdgcn_mfma_f32_16x16x32_bf16(k1, qf[1], S[mb], 0, 0, 0); }
    if (needmask) {
#pragma unroll
        for (int mb = 0; mb < 4; ++mb)
#pragma unroll
            for (int i = 0; i < 4; ++i) { const int off = 16 * mb + 4 * c.quad + i; S[mb][i] = (off >= lo && off <= hi) ? S[mb][i] : -INFINITY; }
    }
    if (MODE != 1) {
        float tmax = max3f(S[0][0], S[0][1], S[0][2]), tmx2 = max3f(S[0][3], S[1][0], S[1][1]);
        tmax = max3f(tmax, S[1][2], S[1][3]); tmx2 = max3f(tmx2, S[2][0], S[2][1]); tmax = max3f(tmax, S[2][2], S[2][3]); tmx2 = max3f(tmx2, S[3][0], S[3][1]); tmax = max3f(tmax, S[3][2], S[3][3]); tmax = fmaxf(tmax, tmx2);
        const bool fresh = st.m == -INFINITY;
        if (__any((tmax > THR) || (fresh && tmax > -INFINITY))) {
            tmax = max_x16(tmax); tmax = max_x32(tmax);
            const bool upd = (tmax > THR) || (fresh && tmax > -INFINITY);
            const float d = upd ? tmax : 0.f;
            const float alpha = fresh ? 1.0f : __builtin_amdgcn_exp2f(-d);
#pragma unroll
            for (int mb = 0; mb < 4; ++mb) S[mb] = S[mb] - d;
            st.l *= alpha;
            if (MODE != 0) { st.L = st.L * alpha;
#pragma unroll
                for (int db = 0; db < 4; ++db) st.O[db] = st.O[db] * alpha; }
            st.m = upd ? mr + d : st.m;
        }
    }
    float ps = 0.f;
#pragma unroll
    for (int mb = 0; mb < 4; ++mb)
#pragma unroll
        for (int i = 0; i < 4; ++i) { float p = __builtin_amdgcn_exp2f(S[mb][i]); if (MODE == 1) p *= invl; S[mb][i] = p; if (MODE == 0) ps += p; }
    if (MODE == 0) { st.l += ps; return; }
    if (MODE == 1) {
        LAS float* imp = (LAS float*)(c.lds + A_IMP) + (c.wave * 8 + sgi * 4 + c.qi) * IMP_LD + (kidx0 >> 2) + c.quad;
        float bprev = st.L;
#pragma unroll
        for (int mb = 0; mb < 4; ++mb) { float a = (S[mb][0] + S[mb][1]) + (S[mb][2] + 0.5f * S[mb][3]), b = 0.5f * S[mb][3];
            a += dpp_x1(a); a += dpp_x2(a); b += dpp_x1(b); b += dpp_x2(b);
            const auto r16 = __builtin_amdgcn_permlane16_swap(__float_as_uint(b), __float_as_uint(b), false, false);
            const auto r32 = __builtin_amdgcn_permlane32_swap(r16[1], r16[1], false, false);
            const float bsh = (c.quad & 1) ? __uint_as_float(r16[0]) : (c.quad == 2 ? __uint_as_float(r32[0]) : bprev);
            bprev = __uint_as_float(r32[1]);
            if (c.h == 0) imp[4 * mb] = a + bsh; }
        st.L = bprev;
    }
#pragma unroll
    for (int k2 = 0; k2 < 2; ++k2) { const u32x4 w = pack8(S[2 * k2], S[2 * k2 + 1]); pf[k2] = __builtin_bit_cast(bf16x8, w); }
    if (MODE != 1) {
        const bf16x8 ones = {0x3F80, 0x3F80, 0x3F80, 0x3F80, 0x3F80, 0x3F80, 0x3F80, 0x3F80};
        f32x4 la = __builtin_amdgcn_mfma_f32_16x16x32_bf16(ones, pf[0], (f32x4){0.f, 0.f, 0.f, 0.f}, 0, 0, 0);
        la = __builtin_amdgcn_mfma_f32_16x16x32_bf16(ones, pf[1], la, 0, 0, 0); st.L += la[0]; }
}
template <int MODE, bool A0, bool A1>
__device__ __forceinline__ void tile_compute2(const Ctx& c, int slotoff, const bf16x8 (&qf)[2][2], SubState (&st)[2], const int (&lo)[2], const int (&hi)[2], const bool (&rowsel)[2], const bool (&needmask)[2], int kidx0, const float (&invl)[2]) {
    const LAS unsigned char* kb = c.lds + slotoff + c.l15 * 128;
    const LAS unsigned char* vb = c.lds + slotoff + 8192 + c.l15 * 128 + 8 * (c.quad & 1);
    const int kc0 = ((c.quad) ^ c.sw) * 16, kc1 = ((4 + c.quad) ^ c.sw) * 16;
    const int vq = c.quad >> 1;
    const int vc[2][2] = {{((vq) ^ c.sw) * 16, ((vq + 2) ^ c.sw) * 16}, {((4 + vq) ^ c.sw) * 16, ((6 + vq) ^ c.sw) * 16}};
    bf16x8 pf[2][2];
    if (A0) sub_scores<MODE>(c, kb, kc0, kc1, qf[0], st[0], lo[0], hi[0], rowsel[0], needmask[0], kidx0, invl[0], 0, pf[0]);
    if (A1) sub_scores<MODE>(c, kb, kc0, kc1, qf[1], st[1], lo[1], hi[1], rowsel[1], needmask[1], kidx0, invl[1], 1, pf[1]);
    if (MODE == 0) return;
#pragma unroll
    for (int db = 0; db < 4; ++db)
#pragma unroll
        for (int k2 = 0; k2 < 2; ++k2) {
            const s16x4 a = *(const LAS s16x4*)(vb + db * 2048 + vc[k2][0]), b = *(const LAS s16x4*)(vb + db * 2048 + vc[k2][1]);
            const bf16x8 vf = (bf16x8){a[0], a[1], a[2], a[3], b[0], b[1], b[2], b[3]};
            if (A0) st[0].O[db] = __builtin_amdgcn_mfma_f32_16x16x32_bf16(vf, pf[0][k2], st[0].O[db], 0, 0, 0);
            if (A1) st[1].O[db] = __builtin_amdgcn_mfma_f32_16x16x32_bf16(vf, pf[1][k2], st[1].O[db], 0, 0, 0);
        }
}
template <int MODE>
__device__ __forceinline__ void tile_compute(const Ctx& c, int slotoff, const bf16x8 (&qf)[2][2], SubState (&st)[2], const int (&lo)[2], const int (&hi)[2], const bool (&rowsel)[2], const bool (&act)[2], int kidx0, const float (&invl)[2]) {
    bool needmask[2];
#pragma unroll
    for (int s = 0; s < 2; ++s) needmask[s] = __any((MODE == 2 ? rowsel[s] : true) && (lo[s] > 0 || hi[s] < 63)) != 0;
    if (act[0] && act[1]) tile_compute2<MODE, true, true>(c, slotoff, qf, st, lo, hi, rowsel, needmask, kidx0, invl);
    else if (act[0]) tile_compute2<MODE, true, false>(c, slotoff, qf, st, lo, hi, rowsel, needmask, kidx0, invl);
    else if (act[1]) tile_compute2<MODE, false, true>(c, slotoff, qf, st, lo, hi, rowsel, needmask, kidx0, invl);
}
}

namespace nsa {
struct Tensors { const bf16_t* Q; const f32x2* rope; const float* gates; const bf16_t *KS, *VTS, *KW, *VTW, *KCMP, *VCMPT; bf16_t* O; bf16_t* DBG; float* SCR; float* PROBE; };

struct Dma {
    int wave; unsigned koff, voffrow, vchk;
    __device__ __forceinline__ void init(int wave_, int lane) { wave = wave_; const int row = 8 * wave_ + (lane >> 3), chs = (lane & 7) ^ ((row >> 1) & 7); koff = (unsigned)(row * 64 + chs * 8); voffrow = (unsigned)row; vchk = (unsigned)(chs * 8); }
    __device__ __forceinline__ void issue(LAS unsigned char* lds, int slotoff, const bf16_t* K, const bf16_t* VT, size_t vpitch, int kidx0, bool withv = true) const {
        __builtin_amdgcn_global_load_lds((const unsigned*)(K + (size_t)kidx0 * 64 + koff), (LAS unsigned*)(lds + slotoff + wave * 1024), 16, 0, 0);
        if (withv) __builtin_amdgcn_global_load_lds((const unsigned*)(VT + (size_t)voffrow * vpitch + kidx0 + vchk), (LAS unsigned*)(lds + slotoff + 8192 + wave * 1024), 16, 0, 0);
    }
};
#define NSA_WAIT_V(n) asm volatile("s_waitcnt vmcnt(" #n ")" ::: "memory")
#define NSA_BAR() do { asm volatile("" ::: "memory"); __builtin_amdgcn_s_barrier(); asm volatile("" ::: "memory"); } while (0)
#define NSA_RING_BG(G, WITHV, NTILES, TILE, BODY) do { \
        const int n_ = (NTILES); int so_ = 0; \
        _Pragma("unroll") for (int k_ = 0; k_ < (G); ++k_) if (k_ < n_) dma.issue(lds, k_ * SLOTB, KPTR, VPTR, VPITCH, TILE(k_), WITHV); \
        _Pragma("unroll 1") for (int i_ = 0; i_ < n_; ++i_) { \
            if ((i_ % (G)) == 0) { NSA_WAIT_V(0); NSA_BAR(); const int other_ = (((i_ / (G)) & 1) ? 0 : (G) * SLOTB); \
                _Pragma("unroll") for (int k_ = 0; k_ < (G); ++k_) if (i_ + (G) + k_ < n_) dma.issue(lds, other_ + k_ * SLOTB, KPTR, VPTR, VPITCH, TILE(i_ + (G) + k_), WITHV); } \
            BODY(i_, so_); \
            so_ = (so_ == (2 * (G) - 1) * SLOTB) ? 0 : so_ + SLOTB; } \
        NSA_WAIT_V(0); NSA_BAR(); } while (0)
#define NSA_RING_B4(NTILES, TILE, BODY) NSA_RING_BG(4, true, NTILES, TILE, BODY)
#define NSA_RING(NS, WITHV, NTILES, TILE, BODY) do { \
        const int n_ = (NTILES); int sl_issue_ = 0, sl_cur_ = 0; \
        _Pragma("unroll") for (int p_ = 0; p_ < (NS) - 1; ++p_) { const int ti_ = p_ < n_ ? p_ : n_ - 1; dma.issue(lds, sl_issue_, KPTR, VPTR, VPITCH, TILE(ti_), WITHV); sl_issue_ += SLOTB; } \
        _Pragma("unroll 1") for (int i_ = 0; i_ < n_; ++i_) { \
            static_assert((NS) == 3 || (NS) == 4, "ring depth"); \
            if ((NS) == 3) { if (WITHV) NSA_WAIT_V(2); else NSA_WAIT_V(1); } else { if (WITHV) NSA_WAIT_V(4); else NSA_WAIT_V(2); } \
            NSA_BAR(); \
            { const int ti_ = (i_ + (NS) - 1) < n_ ? (i_ + (NS) - 1) : n_ - 1; dma.issue(lds, sl_issue_, KPTR, VPTR, VPITCH, TILE(ti_), WITHV); sl_issue_ = (sl_issue_ == ((NS) - 1) * SLOTB) ? 0 : sl_issue_ + SLOTB; } \
            BODY(i_, sl_cur_); \
            sl_cur_ = (sl_cur_ == ((NS) - 1) * SLOTB) ? 0 : sl_cur_ + SLOTB; } \
        NSA_WAIT_V(0); NSA_BAR(); } while (0)


constexpr int QT_HP = 128, QT_QP = 512, I_STG = 64 * QT_QP, STG_COL = 144, STG_JOB = 16 * STG_COL, STG_BUF = 8 * STG_JOB;
constexpr int I_RIDX = I_STG + 2 * STG_BUF, I_JOBS = I_RIDX + 1024, I_CM = I_JOBS + 2080, I_NJ = I_CM + 2048, I_JOBQ = I_NJ + 1040, I_MREF = I_JOBQ + 2080, I_VSL = ((I_MREF + 1024 + 1023) / 1024) * 1024, I_INV_END = I_VSL + 8 * 8192;
static_assert(I_INV_END <= A_SELM && (I_CM % 8) == 0, "inverted-branch LDS map");
__device__ __forceinline__ int nth_set_bit(unsigned long long m, int r) {
    const unsigned lo = (unsigned)m, hi = (unsigned)(m >> 32); int c = __popc(lo); const bool up = r >= c; unsigned w = up ? hi : lo; int base = up ? 32 : 0; r -= up ? c : 0;
#pragma unroll
    for (int sh = 16; sh >= 1; sh >>= 1) { const unsigned low = w & ((1u << sh) - 1u); c = __popc(low); const bool u2 = r >= c; r -= u2 ? c : 0; base += u2 ? sh : 0; w = u2 ? (w >> sh) : low; }
    return base;
}
__device__ __forceinline__ void selected_inverted(const Ctx& c, const Tensors& T, LAS unsigned char* lds, const bf16x8 (&qr)[2][2], SubState (&st)[2], int t0, int bg, int qt) {
    constexpr float L2E = 1.4426950408889634f;
    const LAS unsigned* selm = (const LAS unsigned*)(lds + A_SELM);
    LAS unsigned long long* CM = (LAS unsigned long long*)(lds + I_CM); LAS int* NJ = (LAS int*)(lds + I_NJ); LAS unsigned* JOBS = (LAS unsigned*)(lds + I_JOBS);
#pragma unroll
    for (int s = 0; s < 2; ++s) { LAS unsigned char* qd = lds + (c.wave * 8 + 4 * s + c.qi) * QT_QP + c.h * QT_HP + 16 * c.quad; *(LAS bf16x8*)qd = qr[s][0]; *(LAS bf16x8*)(qd + 64) = qr[s][1]; }
    { const unsigned word = selm[c.lane * 8 + c.wave]; unsigned long long mine = 0ull;
#pragma unroll 1
      for (int jj = 0; jj < 32; ++jj) { const unsigned long long m = __ballot((word >> jj) & 1u); mine = (c.lane == jj) ? m : mine; }
      if (c.lane < 32) { const int jb = 32 * c.wave + c.lane; CM[jb] = (jb == 0 || jb == qt || jb == qt - 1) ? 0ull : mine; } }
    if (c.tid < 256) ((LAS unsigned*)(lds + I_RIDX))[c.tid] = 0xFFFFFFFFu;
#pragma unroll
    for (int s = 0; s < 2; ++s) if (c.quad == 0) ((LAS float*)(lds + I_MREF))[(c.wave * 8 + 4 * s + c.qi) * 4 + c.h] = st[s].m;
    __syncthreads();
    if (c.tid < 256) NJ[c.tid] = (__popcll(CM[c.tid]) + 3) >> 2;
    __syncthreads();
    if (c.tid < 256) { int pre = 0; const int i4 = c.tid >> 2;
#pragma clang loop vectorize(disable) unroll(disable)
        for (int i = 0; i < i4; ++i) { const LAS int* p4 = NJ + 4 * i; pre += (p4[0] + p4[1]) + (p4[2] + p4[3]); }
#pragma clang loop vectorize(disable) unroll(disable)
        for (int i = 4 * i4; i < c.tid; ++i) pre += NJ[i];
        const int cnt = NJ[c.tid];
        unsigned long long mrem = CM[c.tid];
        for (int t = 0; t < cnt; ++t) { JOBS[pre + t] = (unsigned)c.tid | ((unsigned)t << 16); unsigned qb = 0u;
#pragma unroll
            for (int u = 0; u < 4; ++u) { unsigned q = 0xffu; if (mrem) { q = (unsigned)__ffsll((long long)mrem) - 1u; mrem &= mrem - 1ull; } qb |= q << (8 * u); }
            ((LAS unsigned*)(lds + I_JOBQ))[pre + t] = qb; }
        if (c.tid == 255) NJ[256] = pre + cnt; }
    __syncthreads();
    const int njobs = __builtin_amdgcn_readfirstlane(NJ[256]), nrounds = (njobs + 7) >> 3;
    if (njobs == 0) { __syncthreads(); return; }
    const bf16_t* Ks = T.KS + (size_t)bg * SEQ * 64; const bf16_t* Vs = T.VTS + (size_t)bg * 64 * SEQ;
    const unsigned koff = (unsigned)((8 * (c.l15 >> 2) + (c.l15 & 3)) * 64 + 8 * c.quad);
    bf16x8 kf[4][2];
    const int vslot = I_VSL + c.wave * 8192;
    const unsigned vdoff = (unsigned)((c.lane >> 3) * SEQ + (unsigned)(((c.lane & 7) ^ ((c.lane >> 4) & 7)) * 8));
#define VDMA(jblk) do { const bf16_t* vb_ = Vs + (size_t)(64 * (jblk)); _Pragma("unroll") for (int i_ = 0; i_ < 8; ++i_) { \
        const unsigned ch_ = (unsigned)((((c.lane & 7) ^ ((4 * i_ + (c.lane >> 4)) & 7))) * 8); \
        __builtin_amdgcn_global_load_lds((const unsigned*)(vb_ + (size_t)(8 * i_ + (c.lane >> 3)) * SEQ + ch_), (LAS unsigned*)(lds + vslot + i_ * 1024), 16, 0, 0); } } while (0)
    {   const int ji0 = min(c.wave, njobs - 1); const int j0 = __builtin_amdgcn_readfirstlane((int)(JOBS[ji0] & 0xffffu));
        const bf16_t* kb = Ks + (size_t)(64 * j0) * 64;
#pragma unroll
        for (int mb = 0; mb < 4; ++mb) { const unsigned ko = koff + (unsigned)((32 * (mb >> 1) + 4 * (mb & 1)) * 64); kf[mb][0] = *(const bf16x8*)(kb + ko); kf[mb][1] = *(const bf16x8*)(kb + (ko + 32u)); }
        VDMA(j0); }
    float dcur[2] = {0.f, 0.f};
    const LAS unsigned char* vfb = lds + vslot + c.l15 * 128;
    const int vch0 = ((c.quad) ^ c.sw) * 16, vch1 = ((4 + c.quad) ^ c.sw) * 16;
    int buf = 0;
#if PROBE_T
    unsigned long long tacc = 0ull, tmark;
#define TMARK() (tmark = __builtin_amdgcn_s_memtime())
#define TACC(sel) do { if (PROBE_T == (sel)) tacc += __builtin_amdgcn_s_memtime() - tmark; } while (0)
#else
#define TMARK() do {} while (0)
#define TACC(sel) do {} while (0)
#endif
#pragma unroll 1
    for (int r = 0; r < nrounds; ++r) {
        TMARK();
        const int jiu = 8 * r + c.wave; const bool has = jiu < njobs; const int ji = has ? jiu : njobs - 1;
        const int jin = min(jiu + 8, njobs - 1);
        const unsigned jw = JOBS[ji], jwn = JOBS[jin];
        const int j = __builtin_amdgcn_readfirstlane((int)(jw & 0xffffu)), t = __builtin_amdgcn_readfirstlane((int)(jw >> 16)), jn = __builtin_amdgcn_readfirstlane((int)(jwn & 0xffffu));
        const unsigned qb = ((const LAS unsigned*)(lds + I_JOBQ))[ji]; const unsigned qraw = (qb >> (8 * c.qi)) & 0xffu; const bool valid = has && qraw != 0xffu;
        const int qidx = (int)(qraw != 0xffu ? qraw : (qb & 0xffu)); const int hi = t0 + qidx - 64 * j;
        const LAS unsigned char* qa = lds + qidx * QT_QP + c.h * QT_HP + 16 * c.quad;
        const bf16x8 q0 = *(const LAS bf16x8*)qa, q1 = *(const LAS bf16x8*)(qa + 64);
#if PROBE_T
        asm volatile("s_waitcnt lgkmcnt(0)" ::: "memory"); TACC(4); TMARK();
#endif
        const float mref = ((const LAS float*)(lds + I_MREF))[qidx * 4 + c.h];
        const f32x4 cinit = {-mref, -mref, -mref, -mref};
        f32x4 S[4];
#pragma unroll
        for (int mb = 0; mb < 4; ++mb) {
            S[mb] = __builtin_amdgcn_mfma_f32_16x16x32_bf16(kf[mb][0], q0, cinit, 0, 0, 0);
            S[mb] = __builtin_amdgcn_mfma_f32_16x16x32_bf16(kf[mb][1], q1, S[mb], 0, 0, 0); }
        {   const bf16_t* kb = Ks + (size_t)(64 * jn) * 64;
#pragma unroll
            for (int mb = 0; mb < 4; ++mb) { const unsigned ko = koff + (unsigned)((32 * (mb >> 1) + 4 * (mb & 1)) * 64); kf[mb][0] = *(const bf16x8*)(kb + ko); kf[mb][1] = *(const bf16x8*)(kb + (ko + 32u)); } }
        if (__any(hi < 63)) {
#pragma unroll
            for (int mb = 0; mb < 4; ++mb)
#pragma unroll
                for (int i = 0; i < 4; ++i) { const int off = 32 * (mb >> 1) + 8 * c.quad + 4 * (mb & 1) + i; S[mb][i] = off <= hi ? S[mb][i] : -INFINITY; }
        }
        float tmax = max3f(S[0][0], S[0][1], S[0][2]), tmx2 = max3f(S[0][3], S[1][0], S[1][1]);
        tmax = max3f(tmax, S[1][2], S[1][3]); tmx2 = max3f(tmx2, S[2][0], S[2][1]); tmax = max3f(tmax, S[2][2], S[2][3]); tmx2 = max3f(tmx2, S[3][0], S[3][1]); tmax = max3f(tmax, S[3][2], S[3][3]); tmax = fmaxf(tmax, tmx2);
        float dsh = 0.f;
        if (__any(tmax > 8.0f)) { tmax = max_x16(tmax); tmax = max_x32(tmax); dsh = tmax > 8.0f ? tmax : 0.f;
#pragma unroll
            for (int mb = 0; mb < 4; ++mb) S[mb] = S[mb] - dsh; }
#pragma unroll
        for (int mb = 0; mb < 4; ++mb)
#pragma unroll
            for (int i = 0; i < 4; ++i) S[mb][i] = __builtin_amdgcn_exp2f(S[mb][i]);
        bf16x8 pf[2];
#pragma unroll
        for (int k2 = 0; k2 < 2; ++k2) { const u32x4 w = pack8(S[2 * k2], S[2 * k2 + 1]); pf[k2] = __builtin_bit_cast(bf16x8, w); }
        const bf16x8 ones = {0x3F80, 0x3F80, 0x3F80, 0x3F80, 0x3F80, 0x3F80, 0x3F80, 0x3F80};
        f32x4 la = __builtin_amdgcn_mfma_f32_16x16x32_bf16(ones, pf[0], (f32x4){0.f, 0.f, 0.f, 0.f}, 0, 0, 0);
        la = __builtin_amdgcn_mfma_f32_16x16x32_bf16(ones, pf[1], la, 0, 0, 0);
        const float ps = la[0];
#if PROBE_T
        asm volatile("s_nop 0" : "+v"(pf[0]), "+v"(pf[1])); TACC(6); TMARK();
#endif
        LAS unsigned char* sg = lds + I_STG + buf * STG_BUF + c.wave * STG_JOB + c.l15 * STG_COL;
        asm volatile("s_waitcnt vmcnt(8)" ::: "memory");
        bf16x8 vfr[4][2];
#pragma unroll
        for (int db = 0; db < 4; ++db) { vfr[db][0] = *(const LAS bf16x8*)(vfb + db * 2048 + vch0); vfr[db][1] = *(const LAS bf16x8*)(vfb + db * 2048 + vch1); }
        asm volatile("s_waitcnt lgkmcnt(0)" ::: "memory");
        VDMA(jn);
#pragma unroll
        for (int db = 0; db < 4; ++db) { f32x4 o = __builtin_amdgcn_mfma_f32_16x16x32_bf16(vfr[db][0], pf[0], (f32x4){0.f, 0.f, 0.f, 0.f}, 0, 0, 0);
            o = __builtin_amdgcn_mfma_f32_16x16x32_bf16(vfr[db][1], pf[1], o, 0, 0, 0);
            *(LAS u32x2*)(sg + (16 * db + 4 * c.quad) * 2) = pack4(o); }
        if (c.quad == 0) { *(LAS f32x2*)(sg + 128) = (f32x2){dsh, ps};
            if (c.h == 0 && valid) (lds + I_RIDX + buf * 512 + qidx * 8)[c.wave] = (unsigned char)c.qi; }
        asm volatile("s_waitcnt lgkmcnt(0)" ::: "memory"); TACC(7); TACC(1); TMARK(); NSA_BAR(); TACC(2); TMARK();
#pragma unroll
        for (int s = 0; s < 2; ++s) {
            LAS unsigned char* rx = lds + I_RIDX + buf * 512 + (c.wave * 8 + 4 * s + c.qi) * 8;
            const u32x2 idx = *(const LAS u32x2*)rx;
#pragma unroll
            for (int k = 0; k < (PROBE_NOMERGE ? 0 : 8); ++k) { const unsigned u = ((k < 4 ? idx[0] : idx[1]) >> (8 * (k & 3))) & 0xffu; const bool hit = u != 0xffu;
                if (__any(hit)) {
                    const LAS unsigned char* sp = lds + I_STG + buf * STG_BUF + k * STG_JOB + ((hit ? (int)u : 0) * 4 + c.h) * STG_COL;
                    const f32x2 ml = *(const LAS f32x2*)(sp + 128);
                    const float dt = hit ? ml[0] : dcur[s], lt = hit ? ml[1] : 0.f;
                    const float dn = fmaxf(dt, dcur[s]); const float a = __builtin_amdgcn_exp2f(dcur[s] - dn), b = hit ? __builtin_amdgcn_exp2f(dt - dn) : 0.f;
                    st[s].L = st[s].L * a + lt * b; dcur[s] = dn;
#pragma unroll
                    for (int db = 0; db < 4; ++db) { const u32x2 ow = *(const LAS u32x2*)(sp + (16 * db + 4 * c.quad) * 2);
                        const f32x4 o = hit ? (f32x4){bflo(ow[0]), bfhi(ow[0]), bflo(ow[1]), bfhi(ow[1])} : (f32x4){0.f, 0.f, 0.f, 0.f};
                        st[s].O[db] = st[s].O[db] * a + o * b; }
                }
            }
            if (c.h == 0 && c.quad == 0) *(LAS u32x2*)rx = (u32x2){0xFFFFFFFFu, 0xFFFFFFFFu};
        }
        TACC(3);
        buf ^= 1;
    }
#if PROBE_T
    if (blockIdx.x == 17 && c.tid == 64 && t0 >= 64 * 200) { const float n = (float)(tacc / (unsigned long long)nrounds) * 0.01f; *((volatile float*)T.PROBE) = n; }
#endif
    asm volatile("s_waitcnt vmcnt(0)" ::: "memory");
    __syncthreads();
#undef VDMA
}

__device__ __forceinline__ void attn_unit(const Tensors& T, LAS unsigned char* lds, int tid_in, int b, int g, int qt) {
    Ctx c; { int t_ = tid_in; asm volatile("" : "+v"(t_)); c.tid = t_; } c.lane = c.tid & 63; c.wave = __builtin_amdgcn_readfirstlane(c.tid >> 6); c.l15 = c.lane & 15; c.quad = c.lane >> 4; c.qi = c.l15 >> 2; c.h = c.l15 & 3; c.sw = (c.l15 >> 1) & 7; c.lds = lds;
    const int t0 = qt * 64, bg = b * 4 + g; const unsigned tokbase = (unsigned)b * SEQ;
    Dma dma; dma.init(c.wave, c.lane);
    int tq[2]; tq[0] = t0 + c.wave * 8 + c.qi; tq[1] = tq[0] + 4;
    bf16x8 qc[2][2];
#pragma unroll
    for (int s = 0; s < 2; ++s) {
        const bf16_t* qp = T.Q + (tokbase + tq[s]) * D + (g * 4 + c.h) * 64 + 8 * c.quad;
        qc[s][0] = *(const bf16x8*)qp; qc[s][1] = *(const bf16x8*)(qp + 32);
    }
#define NSA_GATE(s, br) (T.gates[(tokbase + tq[s]) * 48 + (g * 4 + c.h) * 3 + (br)])
    float* scr0 = T.SCR + (c.wave * 8 + c.qi) * 256 + c.h * 64 + 4 * c.quad;
    for (int i = c.tid; i < 64 * IMP_LD; i += NTHREADS) ((LAS float*)(lds + A_IMP))[i] = 0.f;

    SubState st[2]; int lo[2], hi[2]; bool act[2], rowsel[2] = {true, true}; float invl[2] = {0.f, 0.f};
#define RESET_ST() do { _Pragma("unroll") for (int s = 0; s < 2; ++s) { st[s].m = -INFINITY; st[s].l = 0.f; st[s].L = 0.f; _Pragma("unroll") for (int db = 0; db < 4; ++db) st[s].O[db] = (f32x4){0.f, 0.f, 0.f, 0.f}; } } while (0)
    const int ncmp = min(NCMP, t0 / 16 + 3), ntc = (ncmp + 63) >> 6;
    const bf16_t* Kc = T.KCMP + (size_t)bg * 1024 * 64; const bf16_t* Vc = T.VCMPT + (size_t)bg * 64 * 1024;
    int lim[2];
#pragma unroll
    for (int s = 0; s < 2; ++s) lim[s] = tq[s] >= 31 ? ((tq[s] - 31) >> 4) : -1;
    RESET_ST();
#define KPTR Kc
#define VPTR Vc
#define VPITCH 1024
#define TILE_C(i) (64 * (i))
#define BODY_C0(i, so) do { _Pragma("unroll") for (int s = 0; s < 2; ++s) { lo[s] = 0; hi[s] = lim[s] - 64 * (i); act[s] = true; } tile_compute<0>(c, so, qc, st, lo, hi, rowsel, act, 64 * (i), invl); } while (0)
#define BODY_C1(i, so) do { _Pragma("unroll") for (int s = 0; s < 2; ++s) { lo[s] = 0; hi[s] = lim[s] - 64 * (i); act[s] = true; } tile_compute<1>(c, so, qc, st, lo, hi, rowsel, act, 64 * (i), invl); } while (0)
    if (!(ATT_SKIP & 1)) NSA_RING(NS_CMP, false, ntc, TILE_C, BODY_C0);
#pragma unroll
    for (int s = 0; s < 2; ++s) { float l = st[s].l; l = sum_x16(l); l = sum_x32(l); invl[s] = l > 0.f ? 1.0f / l : 0.f; }
    if (!(ATT_SKIP & 1)) NSA_RING(NS_CMP, true, ntc, TILE_C, BODY_C1);
#undef KPTR
#undef VPTR
#undef VPITCH
#pragma unroll
    for (int s = 0; s < 2; ++s)
#pragma unroll
        for (int db = 0; db < 4; ++db) *(f32x4*)(scr0 + s * 4 * 256 + 16 * db) = st[s].O[db] * NSA_GATE(s, 0);
#if NSA_CHECK
    if (NSA_CHECK_BR == 0) {
#pragma unroll
        for (int s = 0; s < 2; ++s) { bf16_t* op = T.DBG + (tokbase + tq[s]) * D + (g * 4 + c.h) * 64 + 4 * c.quad;
#pragma unroll
            for (int db = 0; db < 4; ++db) *(u32x2*)(op + 16 * db) = pack4(st[s].O[db]); } }
#endif
    {
        LAS float* impw = (LAS float*)(lds + A_IMP) + (c.wave * 8) * IMP_LD;
        unsigned uw = 0u;
        const unsigned long long lt_mask = (1ull << c.lane) - 1ull;
#pragma unroll 1
        for (int qq = (ATT_SKIP & 2) ? 8 : 0; qq < 8; ++qq) {
            const int tqq = t0 + c.wave * 8 + qq, cur = tqq >> 6;
            const int K = 16 - (cur >= 2 ? 3 : cur + 1);
            unsigned key[4]; unsigned long long forced[4];
#pragma unroll
            for (int e = 0; e < 4; ++e) { const int j = c.lane + 64 * e; const bool valid = j <= cur; const bool fo = (j == 0) || (j == cur) || (j == cur - 1);
                key[e] = (valid && !fo) ? (__float_as_uint(impw[qq * IMP_LD + j]) + 1u) : 0u; forced[e] = __ballot(valid && fo); }
            unsigned T = 0u; bool exact = false;
#pragma unroll 1
            for (int bit = 30; bit >= 0; --bit) { const unsigned cand = T | (1u << bit);
                const int cnt = __popcll(__ballot(key[0] >= cand)) + __popcll(__ballot(key[1] >= cand)) + __popcll(__ballot(key[2] >= cand)) + __popcll(__ballot(key[3] >= cand));
                T = (cnt >= K) ? cand : T;
                if (cnt == K) { exact = true; break; } }
            const unsigned Tg = exact ? T - 1u : T;
            unsigned long long sel[4]; int ngt = 0;
#pragma unroll
            for (int e = 0; e < 4; ++e) { sel[e] = __ballot(key[e] > Tg); ngt += __popcll(sel[e]); }
            int r = (T != 0u && !exact) ? (K - ngt) : 0;
#pragma unroll
            for (int e = 0; e < 4; ++e) { const unsigned long long eq = (T != 0u && !exact) ? __ballot(key[e] == T) : 0ull;
                const bool take = ((eq >> c.lane) & 1ull) && (__popcll(eq & lt_mask) < r);
                sel[e] |= __ballot(take) | forced[e]; r -= min(r, (int)__popcll(eq)); }
            unsigned myword = 0u;
#pragma unroll
            for (int e = 0; e < 4; ++e) { myword = (c.lane == 2 * e) ? (unsigned)sel[e] : myword; myword = (c.lane == 2 * e + 1) ? (unsigned)(sel[e] >> 32) : myword; }
            if (c.lane < 8) ((LAS unsigned*)(lds + A_SELM))[(c.wave * 8 + qq) * 8 + c.lane] = myword;
            uw |= myword;
        }
        if (c.lane < 8) ((LAS unsigned*)(lds + A_UW))[c.wave * 8 + c.lane] = uw;
        __syncthreads();
        if (c.tid < 8) { unsigned u = 0u;
#pragma unroll
            for (int w = 0; w < 8; ++w) u |= ((LAS unsigned*)(lds + A_UW))[w * 8 + c.tid];
            ((LAS unsigned*)(lds + A_UB))[c.tid] = u; }
        __syncthreads();
        if (c.tid < 256) { const LAS unsigned* ub = (const LAS unsigned*)(lds + A_UB); const int wj = c.tid >> 5, bj = c.tid & 31; int pos = 0;
#pragma unroll
            for (int w = 0; w < 8; ++w) { const unsigned x = ub[w]; pos += (w < wj) ? __popc(x) : 0; }
            const unsigned xw = ub[wj]; pos += __popc(xw & ((1u << bj) - 1u));
            if ((xw >> bj) & 1u) ((LAS int*)(lds + A_TL))[pos] = c.tid; }
        __syncthreads();
    }
    bf16x8 qr[2][2];
#pragma unroll
    for (int s = 0; s < 2; ++s) {
        const bf16_t* qp = T.Q + (tokbase + tq[s]) * D + (g * 4 + c.h) * 64 + 8 * c.quad;
        const bf16x8 q0 = *(const bf16x8*)qp, q1 = *(const bf16x8*)(qp + 32);
        const f32x4* rp = (const f32x4*)(T.rope + (tokbase + tq[s]) * 32 + 8 * c.quad);
        u32x4 w0, w1;
#pragma unroll
        for (int p = 0; p < 4; ++p) { const f32x4 cs = rp[p];
            const float a0 = bf2f((unsigned short)q0[2 * p]), a1 = bf2f((unsigned short)q0[2 * p + 1]), b0 = bf2f((unsigned short)q1[2 * p]), b1 = bf2f((unsigned short)q1[2 * p + 1]);
            w0[p] = pk2(a0 * cs[0] - b0 * cs[1], a1 * cs[2] - b1 * cs[3]); w1[p] = pk2(b0 * cs[0] + a0 * cs[1], b1 * cs[2] + a1 * cs[3]); }
        qr[s][0] = __builtin_bit_cast(bf16x8, w0); qr[s][1] = __builtin_bit_cast(bf16x8, w1);
    }
    {
        const LAS unsigned* ub = (const LAS unsigned*)(lds + A_UB); int nsel = 0;
#pragma unroll
        for (int w = 0; w < 8; ++w) nsel += __popc(ub[w]);
        nsel = __builtin_amdgcn_readfirstlane(nsel);
        const LAS int* TL = (const LAS int*)(lds + A_TL); const LAS unsigned* selm = (const LAS unsigned*)(lds + A_SELM);
        const bf16_t* Ks = T.KS + (size_t)bg * SEQ * 64; const bf16_t* Vs = T.VTS + (size_t)bg * 64 * SEQ;
        RESET_ST();
#define KPTR Ks
#define VPTR Vs
#define VPITCH SEQ
#define TILE_S(i) (64 * __builtin_amdgcn_readfirstlane(TL[(i)]))
#define BODY_S(i, so) do { const int j = __builtin_amdgcn_readfirstlane(TL[(i)]); \
        _Pragma("unroll") for (int s = 0; s < 2; ++s) { const unsigned w = selm[(c.wave * 8 + 4 * s + c.qi) * 8 + (j >> 5)]; const bool sel = (w >> (j & 31)) & 1u; \
            lo[s] = 0; hi[s] = tq[s] - 64 * j; rowsel[s] = sel; act[s] = __any(sel ? 1 : 0) != 0; } \
        tile_compute<2>(c, so, qr, st, lo, hi, rowsel, act, 64 * j, invl); } while (0)
#if SEL_INVERTED
        if (!(ATT_SKIP & 4)) {
            const int nforced = qt >= 2 ? 3 : qt + 1;
#define TILE_F(i) (64 * ((i) == 0 ? 0 : ((i) == nforced - 1 ? qt : qt - 1)))
#define BODY_F(i, so) do { const int j = ((i) == 0 ? 0 : ((i) == nforced - 1 ? qt : qt - 1)); \
        _Pragma("unroll") for (int s = 0; s < 2; ++s) { lo[s] = 0; hi[s] = tq[s] - 64 * j; rowsel[s] = true; act[s] = true; } \
        tile_compute<2>(c, so, qr, st, lo, hi, rowsel, act, 64 * j, invl); } while (0)
            NSA_RING_B4(nforced, TILE_F, BODY_F);
            selected_inverted(c, T, lds, qr, st, t0, bg, qt);
        }
#else
        if (!(ATT_SKIP & 4)) NSA_RING_B4(nsel, TILE_S, BODY_S);
#endif
#undef KPTR
#undef VPTR
#pragma unroll
        for (int s = 0; s < 2; ++s) { const float l = st[s].L; const float fn = (l > 0.f ? 1.0f / l : 0.f), f = fn * NSA_GATE(s, 1);
#if NSA_CHECK
            if (NSA_CHECK_BR == 1) { bf16_t* op = T.DBG + (tokbase + tq[s]) * D + (g * 4 + c.h) * 64 + 4 * c.quad;
#pragma unroll
                for (int db = 0; db < 4; ++db) *(u32x2*)(op + 16 * db) = pack4(st[s].O[db] * fn); }
#endif
#pragma unroll
            for (int db = 0; db < 4; ++db) { f32x4* p = (f32x4*)(scr0 + s * 4 * 256 + 16 * db); *p = *p + st[s].O[db] * f; } }
    }
    {
        const bf16_t* Kw = T.KW + (size_t)bg * SEQ * 64; const bf16_t* Vw = T.VTW + (size_t)bg * 64 * SEQ;
        const int kt1 = qt, kt0 = max(0, qt - 8), nw = kt1 - kt0 + 1;
        RESET_ST();
#define KPTR Kw
#define VPTR Vw
#define TILE_W(i) (64 * (kt0 + (i)))
#define BODY_W(i, so) do { const int k0 = 64 * (kt0 + (i)); \
        _Pragma("unroll") for (int s = 0; s < 2; ++s) { hi[s] = tq[s] - k0; lo[s] = tq[s] - 511 - k0; act[s] = true; } \
        tile_compute<3>(c, so, qr, st, lo, hi, rowsel, act, k0, invl); } while (0)
        if (!(ATT_SKIP & 8)) NSA_RING_B4(nw, TILE_W, BODY_W);
#undef KPTR
#undef VPTR
#undef VPITCH
#pragma unroll
        for (int s = 0; s < 2; ++s) { const float l = st[s].L; const float fn = (l > 0.f ? 1.0f / l : 0.f), f = fn * NSA_GATE(s, 2);
#if NSA_CHECK
            if (NSA_CHECK_BR == 2) { bf16_t* op = T.DBG + (tokbase + tq[s]) * D + (g * 4 + c.h) * 64 + 4 * c.quad;
#pragma unroll
                for (int db = 0; db < 4; ++db) *(u32x2*)(op + 16 * db) = pack4(st[s].O[db] * fn); }
#endif
            bf16_t* op = T.O + (tokbase + tq[s]) * D + (g * 4 + c.h) * 64 + 4 * c.quad;
#pragma unroll
            for (int db = 0; db < 4; ++db) { const f32x4 v = *(const f32x4*)(scr0 + s * 4 * 256 + 16 * db) + st[s].O[db] * f; *(u32x2*)(op + 16 * db) = pack4(v); } }
    }
#undef RESET_ST
#undef NSA_GATE
}
}


#if NSA_CHECK
namespace chk {
__constant__ int tlist[24] = {0, 1, 30, 31, 32, 47, 63, 64, 65, 79, 127, 128, 510, 511, 512, 513, 1023, 1024, 1025, 1087, 4095, 4096, 8191, 16383};
__device__ __forceinline__ float blk_max(float v, LAS float* red, int tid) {
#pragma unroll
    for (int o = 1; o < 64; o <<= 1) v = fmaxf(v, __shfl_xor(v, o));
    __syncthreads(); if ((tid & 63) == 0) red[tid >> 6] = v; __syncthreads();
    float r = red[0]; for (int w = 1; w < 8; ++w) r = fmaxf(r, red[w]); __syncthreads(); return r; }
__device__ __forceinline__ float blk_sum(float v, LAS float* red, int tid) {
#pragma unroll
    for (int o = 1; o < 64; o <<= 1) v += __shfl_xor(v, o);
    __syncthreads(); if ((tid & 63) == 0) red[tid >> 6] = v; __syncthreads();
    float r = 0.f; for (int w = 0; w < 8; ++w) r += red[w]; __syncthreads(); return r; }

__device__ __forceinline__ void check_sample(const nsa::Tensors& T, LAS unsigned char* lds, int tid, int b, int g, int t, unsigned* flag) {
    LAS float* sc = (LAS float*)lds;
    LAS float* qf = sc + 4096;
    LAS float* oacc = qf + 512;
    LAS float* score = oacc + 768;
    LAS int* sel = (LAS int*)(score + 256);
    LAS float* red = (LAS float*)(sel + 16);
    const int bg = b * 4 + g; const size_t tok = (size_t)b * SEQ + t;
    if (tid < 256) { const int h = tid >> 6, d = tid & 63;
        const float q = bf2f(T.Q[tok * D + (g * 4 + h) * 64 + d]);
        const int dd = d & 31; const f32x2 cs = T.rope[tok * 32 + dd]; const float qo = bf2f(T.Q[tok * D + (g * 4 + h) * 64 + (d < 32 ? d + 32 : d - 32)]);
        const float r = d < 32 ? q * cs[0] - qo * cs[1] : q * cs[0] + qo * cs[1];
        qf[h * 64 + d] = q; qf[256 + h * 64 + d] = bf2f((unsigned short)f2bf(r)); }
    __syncthreads();
    const bf16_t* Kc = T.KCMP + (size_t)bg * 1024 * 64; const bf16_t* Vc = T.VCMPT + (size_t)bg * 64 * 1024;
    for (int i = tid; i < 4096; i += 512) { const int h = i >> 10, c = i & 1023; float s = -INFINITY;
        if (c < 1023 && 16 * c + 31 <= t) { s = 0.f; for (int d = 0; d < 64; ++d) s += qf[h * 64 + d] * bf2f(Kc[(size_t)c * 64 + d]); }
        sc[i] = s; }
    __syncthreads();
    for (int h = 0; h < 4; ++h) {
        float m = -INFINITY; for (int c = tid; c < 1024; c += 512) m = fmaxf(m, sc[h * 1024 + c]);
        m = blk_max(m, red, tid); if (m == -INFINITY) m = 0.f;
        float l = 0.f; for (int c = tid; c < 1024; c += 512) l += exp2f(sc[h * 1024 + c] - m);
        l = blk_sum(l, red, tid); l = fmaxf(l, 1e-30f);
        for (int c = tid; c < 1024; c += 512) sc[h * 1024 + c] = exp2f(sc[h * 1024 + c] - m) / l;
        __syncthreads();
    }
    if (tid < 256) { const int h = tid >> 6, d = tid & 63; float o = 0.f;
        for (int c = 0; c < 1023; ++c) o += bf2f((unsigned short)f2bf(sc[h * 1024 + c])) * bf2f(Vc[(size_t)d * 1024 + c]);
        oacc[h * 64 + d] = o; }
    if (tid < 256) { const int j = tid; float im = 0.f;
        for (int h = 0; h < 4; ++h) for (int c = 4 * j - 1; c <= 4 * j + 3; ++c) if (c >= 0 && c < 1023) {
            const int c0 = 16 * c, j0 = 64 * j; int ov = min(c0 + 32, j0 + 64) - max(c0, j0); if (ov < 0) ov = 0;
            im += sc[h * 1024 + c] * ((float)ov / 32.0f); }
        const int cur = t >> 6; const bool valid = 64 * j <= t, forced = (j == 0) || (j == cur) || (j == cur - 1);
        score[j] = valid ? im + (forced ? 1000.0f : 0.0f) : -1.0f; }
    __syncthreads();
    if (tid == 0) { for (int n = 0; n < 16; ++n) { int bi = 0; float bv = -INFINITY; for (int j = 0; j < 256; ++j) if (score[j] > bv) { bv = score[j]; bi = j; } sel[n] = bi; score[bi] = -INFINITY; } }
    __syncthreads();
    const bf16_t* Ks = T.KS + (size_t)bg * SEQ * 64; const bf16_t* Vs = T.VTS + (size_t)bg * 64 * SEQ;
    for (int i = tid; i < 4096; i += 512) { const int h = i >> 10, n = (i >> 6) & 15, k = i & 63; const int kpos = sel[n] * 64 + k; float s = -INFINITY;
        if (kpos <= t) { s = 0.f; for (int d = 0; d < 64; ++d) s += qf[256 + h * 64 + d] * bf2f(Ks[(size_t)kpos * 64 + d]); }
        sc[i] = s; }
    __syncthreads();
    for (int h = 0; h < 4; ++h) {
        float m = -INFINITY; for (int c = tid; c < 1024; c += 512) m = fmaxf(m, sc[h * 1024 + c]);
        m = blk_max(m, red, tid); if (m == -INFINITY) m = 0.f;
        float l = 0.f; for (int c = tid; c < 1024; c += 512) l += exp2f(sc[h * 1024 + c] - m);
        l = blk_sum(l, red, tid); l = fmaxf(l, 1e-30f);
        for (int c = tid; c < 1024; c += 512) sc[h * 1024 + c] = exp2f(sc[h * 1024 + c] - m) / l;
        __syncthreads();
    }
    if (tid < 256) { const int h = tid >> 6, d = tid & 63; float o = 0.f;
        for (int i = 0; i < 1024; ++i) { const float p = sc[h * 1024 + i]; if (p != 0.f) { const int kpos = sel[i >> 6] * 64 + (i & 63); o += bf2f((unsigned short)f2bf(p)) * bf2f(Vs[(size_t)d * SEQ + kpos]); } }
        oacc[256 + h * 64 + d] = o; }
    __syncthreads();
    const bf16_t* Kw = T.KW + (size_t)bg * SEQ * 64; const bf16_t* Vw = T.VTW + (size_t)bg * 64 * SEQ;
    for (int i = tid; i < 4096; i += 512) { const int h = i >> 10, k = i & 1023; const int kpos = t - 511 + k; float s = -INFINITY;
        if (k < 512 && kpos >= 0) { s = 0.f; for (int d = 0; d < 64; ++d) s += qf[256 + h * 64 + d] * bf2f(Kw[(size_t)kpos * 64 + d]); }
        sc[i] = s; }
    __syncthreads();
    for (int h = 0; h < 4; ++h) {
        float m = -INFINITY; for (int c = tid; c < 1024; c += 512) m = fmaxf(m, sc[h * 1024 + c]);
        m = blk_max(m, red, tid); if (m == -INFINITY) m = 0.f;
        float l = 0.f; for (int c = tid; c < 1024; c += 512) l += exp2f(sc[h * 1024 + c] - m);
        l = blk_sum(l, red, tid); l = fmaxf(l, 1e-30f);
        for (int c = tid; c < 1024; c += 512) sc[h * 1024 + c] = exp2f(sc[h * 1024 + c] - m) / l;
        __syncthreads();
    }
    if (tid < 256) { const int h = tid >> 6, d = tid & 63; float o = 0.f;
        for (int k = 0; k < 512; ++k) { const float p = sc[h * 1024 + k]; if (p != 0.f) o += bf2f((unsigned short)f2bf(p)) * bf2f(Vw[(size_t)d * SEQ + (t - 511 + k)]); }
        oacc[512 + h * 64 + d] = o; }
    __syncthreads();
    if (tid == 0) red[0] = 0.f;
    __syncthreads();
    if (tid < 256) { const int h = tid >> 6, d = tid & 63; const float* gt = T.gates + tok * 48 + (g * 4 + h) * 3;
        float ref = gt[0] * oacc[h * 64 + d] + gt[1] * oacc[256 + h * 64 + d] + gt[2] * oacc[512 + h * 64 + d];
        float got = bf2f(T.O[tok * D + (g * 4 + h) * 64 + d]);
        if (NSA_CHECK_BR >= 0) { ref = oacc[NSA_CHECK_BR * 256 + h * 64 + d]; got = bf2f(T.DBG[tok * D + (g * 4 + h) * 64 + d]); }
        sc[tid] = ref * ref; sc[256 + tid] = got; sc[512 + tid] = ref; }
    __syncthreads();
    if (tid < 256) { const int h = tid >> 6; float ms = 0.f; for (int d2 = 0; d2 < 64; ++d2) ms += sc[h * 64 + d2]; const float rms = sqrtf(ms * (1.0f / 64.0f));
        const float got = sc[256 + tid], ref = sc[512 + tid];
        const float tol = NSA_CHECK_ABS * rms + NSA_CHECK_REL * fabsf(ref);
        if (!(fabsf(got - ref) <= tol)) red[0] = 1.0f; }
    __syncthreads();
    if (tid == 0 && red[0] != 0.f) atomicAdd(flag, 1u);
    __syncthreads();
}

__device__ __forceinline__ bool near(float got, float ref, float rms) { return fabsf(got - ref) <= 0.02f * rms + 0.015f * fabsf(ref); }
__device__ __forceinline__ void check_proj(const Args& a, const nsa::Tensors& T, unsigned char* ws, const float* X, LAS unsigned char* lds, int tid, int smp, unsigned* flag) {
    LAS float* hk = (LAS float*)lds;
    LAS float* hq = hk + 1024;
    LAS float* val = hq + 1024;
    LAS float* red = val + 512;
    LAS float* hid = red + 8;
    LAS float* blk = hid + 256;
    unsigned hsh = (unsigned)smp * 2654435761u + 12345u; hsh ^= hsh >> 15; hsh *= 2246822519u; hsh ^= hsh >> 13;
    const int tok = (int)(hsh % NT), b = tok >> 14, sp = tok & (SEQ - 1), g = (hsh >> 17) & 3, hh = (hsh >> 19) & 15;
    if (tid == 0) red[0] = 0.f;
    float ss = 0.f; for (int k = tid; k < 1024; k += 512) { const float v = X[(size_t)tok * D + k]; ss += v * v; }
    ss = blk_sum(ss, red + 1, tid); const float r = 1.0f / sqrtf(ss * (1.0f / D) + RMS_EPS);
    for (int k = tid; k < 1024; k += 512) { const float v = X[(size_t)tok * D + k] * r; hk[k] = v * a.in[I_NKV][k]; hq[k] = v * a.in[I_NMIX][D + k]; }
    __syncthreads();
    const float pos = (float)((const int*)a.in[I_POS])[tok];
    bool bad = false;
    for (int slot = 0; slot < 6; ++slot) {
        if (tid < 64) { float s_ = 0.f; const float* w = a.in[I_WKV] + slot * 256 + g * 64 + tid; for (int k = 0; k < 1024; ++k) s_ += hk[k] * w[(size_t)k * 1536]; val[tid] = s_; }
        __syncthreads();
        if (tid < 64) { float v = val[tid];
            if (slot == 2 || slot == 4) { const int i = tid & 31; const float ang = pos * a.inv_freq[i]; float sn, cs; sincosf(ang, &sn, &cs); const float t1 = val[i], t2 = val[i + 32]; v = tid < 32 ? t1 * cs - t2 * sn : t2 * cs + t1 * sn; }
            float got; const size_t bg = (size_t)(b * 4 + g);
            if (slot == 3 || slot == 5) got = bf2f(((const bf16_t*)(ws + WS_RD + (size_t)slot * KVSTRIDE))[(bg * 64 + tid) * SEQ + sp]);
            else got = bf2f(((const bf16_t*)(ws + WS_RD + (size_t)slot * KVSTRIDE))[(bg * SEQ + sp) * 64 + tid]);
            if (!near(got, v, 1.0f)) bad = true; }
        __syncthreads();
    }
    if (tid < 112) { const int col = tid < 64 ? hh * 64 + tid : 1024 + (tid - 64); float s_ = 0.f; const float* w = a.in[I_AWIN] + col; for (int k = 0; k < 1024; ++k) s_ += hq[k] * w[(size_t)k * 1072];
        if (tid < 64) { if (!near(bf2f(T.Q[(size_t)tok * D + hh * 64 + tid]), s_ * (0.125f * 1.4426950408889634f), 0.18f)) bad = true; }
        else { const float gt = 1.0f / (1.0f + expf(-s_)); if (!near(T.gates[(size_t)tok * 48 + (tid - 64)], gt, 0.25f)) bad = true; } }
    const int c = (int)((hsh >> 8) % 1023);
    for (int kv = 0; kv < 2; ++kv) {
        const bf16_t* src = (const bf16_t*)(ws + WS_RD + (kv ? RD_VC : RD_KC)) + ((size_t)(b * 4 + g) * SEQ + 16 * c) * 64; const float* pe = a.in[kv ? I_CPV : I_CPK];
        for (int i = tid; i < 2048; i += 512) blk[i] = bf2f(src[i]) + pe[i];
        __syncthreads();
        if (tid < 256) { float s_ = 0.f; const float* w1 = a.in[kv ? I_CW1V : I_CW1K] + tid; for (int i = 0; i < 2048; ++i) s_ += blk[i] * w1[(size_t)i * 256];
            const float y = 0.7978845608028654f * (s_ + 0.044715f * s_ * s_ * s_); hid[tid] = 0.5f * s_ * (1.0f + tanhf(y)); }
        __syncthreads();
        if (tid < 64) { float s_ = 0.f; const float* w2 = a.in[kv ? I_CW2V : I_CW2K] + tid; for (int n = 0; n < 256; ++n) s_ += hid[n] * w2[n * 64];
            const float got = kv ? bf2f(T.VCMPT[((size_t)(b * 4 + g) * 64 + tid) * 1024 + c]) : bf2f(T.KCMP[((size_t)(b * 4 + g) * 1024 + c) * 64 + tid]);
            if (!near(got, s_, 0.5f)) bad = true; }
        __syncthreads();
    }
    if (bad) red[0] = 1.0f;
    __syncthreads();
    if (tid == 0 && red[0] != 0.f) atomicAdd(flag, 1u);
    __syncthreads();
}
}
#endif

#define XB_TMO      128
#define XB_XCNT(j)  (256  + 64 * (j))
#define XB_XSUB(j)  (1280 + 64 * (j))
#define XB_XGEN(j)  (2304 + 64 * (j))
#define XB_TOP      3328
#define XB_TOPGEN   3392
#define XCD_BAR_WORDS 3456
#define XB_SPIN_CAP (1u << 22)
__device__ __forceinline__ unsigned xb_ld(unsigned* p)              { return __hip_atomic_load(p, __ATOMIC_RELAXED, __HIP_MEMORY_SCOPE_AGENT); }
__device__ __forceinline__ unsigned xb_add(unsigned* p, unsigned v) { return __hip_atomic_fetch_add(p, v, __ATOMIC_RELAXED, __HIP_MEMORY_SCOPE_AGENT); }
__device__ __forceinline__ unsigned xb_xcc_id() { return (unsigned)__builtin_amdgcn_s_getreg((3 << 11) | 20) & 0xFu; }
#define XB_SPIN(cond, bar) do { unsigned _sp = 0; while (cond) { __builtin_amdgcn_s_sleep(1); \
    if ((++_sp & 255u) == 0u) { if (xb_ld(&(bar)[XB_TMO])) break; if (_sp > XB_SPIN_CAP) { atomicAdd(&(bar)[XB_TMO], 1u); break; } } } } while (0)
struct XcdBarrier { unsigned* bar; unsigned x; volatile LAS unsigned* st; };
__device__ __forceinline__ XcdBarrier xcd_barrier_post(unsigned* bar, volatile LAS unsigned* st, bool t0) {
    XcdBarrier b; b.bar = bar; b.x = xb_xcc_id(); b.st = st;
    if (t0) (void)xb_add(&bar[XB_XCNT(b.x)], 1u);
    return b;
}
__device__ __forceinline__ void xcd_barrier_complete(unsigned* bar, unsigned x, unsigned& nloc, unsigned& nx) {
    const unsigned G = gridDim.x;
    unsigned sum, cnt, mine, sp = 0u;
    for (;;) {
        sum = 0u; cnt = 0u; mine = 0u;
#pragma unroll
        for (unsigned j = 0; j < 16; ++j) { const unsigned c = xb_ld(&bar[XB_XCNT(j)]); sum += c; cnt += (c > 0u) ? 1u : 0u; mine = (j == x) ? c : mine; }
        if (sum == G) break;
        __builtin_amdgcn_s_sleep(1);
        if ((++sp & 255u) == 0u) { if (xb_ld(&bar[XB_TMO])) break; if (sp > XB_SPIN_CAP) { atomicAdd(&bar[XB_TMO], 1u); break; } }
    }
    nloc = mine > 0u ? mine : 1u; nx = cnt > 0u ? cnt : 1u;
}
__device__ __forceinline__ void xcd_barrier(const XcdBarrier& b, bool t0) {
    asm volatile("s_waitcnt vmcnt(0)" ::: "memory");
    __syncthreads();
    if (t0) {
        unsigned* bar = b.bar;
        __builtin_amdgcn_s_waitcnt(0);
        unsigned nloc = b.st[0], nx = b.st[1];
        if (nloc == 0u) { xcd_barrier_complete(bar, b.x, nloc, nx); b.st[0] = nloc; b.st[1] = nx; }
        const unsigned old = xb_add(&bar[XB_XSUB(b.x)], 1u);
        const unsigned gen = old / nloc;
        if (old + 1u == (gen + 1u) * nloc) {
            __builtin_amdgcn_fence(__ATOMIC_RELEASE, "agent");
            asm volatile("s_waitcnt vmcnt(0)" ::: "memory");
            const unsigned og = xb_add(&bar[XB_TOP], 1u);
            const unsigned tg = og / nx;
            if (og + 1u == (tg + 1u) * nx) xb_add(&bar[XB_TOPGEN], 1u);
            else XB_SPIN(xb_ld(&bar[XB_TOPGEN]) == tg, bar);
            __builtin_amdgcn_fence(__ATOMIC_ACQUIRE, "agent");
            xb_add(&bar[XB_XGEN(b.x)], 1u);
            asm volatile("s_waitcnt vmcnt(0)" ::: "memory");
        } else {
            XB_SPIN(xb_ld(&bar[XB_XGEN(b.x)]) == gen, bar);
            __builtin_amdgcn_fence(__ATOMIC_ACQUIRE, "agent");
            asm volatile("s_waitcnt vmcnt(0)" ::: "memory");
        }
    }
    __syncthreads();
}

__device__ __forceinline__ MoeTab moe_tables(const Frame& F0, int layer) {
    const Frame F = refresh(F0);
    MoeTab T; T.tstart = (volatile LAS int*)(F.lds + MISC_OFF); T.cnt = T.tstart + 64;
    const unsigned* gcnt = (const unsigned*)(F.ws + WS_CTL) + CW_CNT + layer * 32;
    __syncthreads();
    if (F.tid < 32) T.cnt[F.tid] = (int)__hip_atomic_load(gcnt + F.tid, __ATOMIC_RELAXED, __HIP_MEMORY_SCOPE_AGENT);
    __syncthreads();
    if (F.tid == 0) { int acc = 0; for (int e = 0; e < 32; ++e) { T.tstart[e] = acc; acc += (T.cnt[e] + 255) >> 8; } T.tstart[32] = acc; }
    __syncthreads();
    return T;
}

constexpr int N_PHASES = 17;
__global__ void __launch_bounds__(NTHREADS, 2) nsa_fwd(Args args) {
    extern __shared__ __attribute__((aligned(16))) unsigned char lds_raw[];
    cg::grid_group grid = cg::this_grid();
    Frame F; F.lds = (LAS unsigned char*)lds_raw; F.ws = args.ws;
    { const int t = threadIdx.x; F.wave = __builtin_amdgcn_readfirstlane(t >> 6); F.tid = t; F.lane = t & 63; }
    F.G = gridDim.x; { const int bx = blockIdx.x; F.vcu = (F.G % 8 == 0) ? (bx % 8) * (F.G / 8) + bx / 8 : bx; }
    unsigned char* ws = args.ws;
    float* X = args.out;
    const int lo = args.ph_lo, hi = args.ph_hi;
    volatile LAS unsigned* bst = (volatile LAS unsigned*)(F.lds + MISC_OFF + 1024);
    if (F.tid < 2) bst[F.tid] = 0u;
    __syncthreads();
    XcdBarrier xb; xb.bar = (unsigned*)(ws + WS_CTL) + CW_BAR; xb.x = 0; xb.st = bst;
    if (hi - lo > 1) xb = xcd_barrier_post((unsigned*)(ws + WS_CTL) + CW_BAR, bst, F.tid == 0);
#ifndef PH_MASK
#define PH_MASK 0x1ffff
#endif
#ifndef REPEAT_MASK
#define REPEAT_MASK 0
#endif
#define REPS(k) (1 + ((REPEAT_MASK >> (k)) & 1))
#define IN(k) (((PH_MASK >> (k)) & 1) && lo <= (k) && (k) < hi)
#if PROBE_PHASE >= 0
    unsigned long long ph_t0 = __builtin_amdgcn_s_memrealtime(), ph_dur = 0ull;
#define PH_STAMP(k) do { const unsigned long long now_ = __builtin_amdgcn_s_memrealtime(); if ((k) == PROBE_PHASE) ph_dur = now_ - ph_t0; ph_t0 = now_; } while (0)
#else
#define PH_STAMP(k) do {} while (0)
#endif
#define SEAM(k) do { if (IN(k) && IN((k) + 1)) { if ((k) == 0) grid.sync(); else xcd_barrier(xb, mytid(F) == 0); } PH_STAMP(k); } while (0)
    LAS unsigned char* ring = F.lds;

    if (IN(0)) for (int rep_ = 0; rep_ < REPS(0); ++rep_) { phase_prep(args, F); } SEAM(0);
    if (IN(1)) for (int rep_ = 0; rep_ < REPS(1); ++rep_) {
        DenseOrder S; S.init(ws + WS_RA, ws + WS_WIN, NT, 3 * D, D, D, F.G, (int)blockIdx.x);
        EpiInProj E{(const float*)(ws + WS_R0), (bf16_t*)(ws + WS_RB), (bf16_t*)(ws + WS_RC)};
        pg8::gemm_phase<EpiInProj, DenseOrder, false>(ring, mytid(F), pg8::Gemm{D, D}, S, E);
    } SEAM(1);
#ifdef EXTRA_BARS
    for (int eb_ = 0; eb_ < EXTRA_BARS; ++eb_) xcd_barrier(xb, mytid(F) == 0);
#endif
    if (IN(2)) for (int rep_ = 0; rep_ < REPS(2); ++rep_) { phase_conv(args, F); } SEAM(2);
    if (IN(3)) for (int rep_ = 0; rep_ < REPS(3); ++rep_) {
        DenseOrder S; S.init(ws + WS_RA, ws + WS_WOUT, NT, D, D, D, F.G, (int)blockIdx.x);
        EpiResid E{args.in[I_X], X};
        pg8::gemm_phase<EpiResid, DenseOrder, false>(ring, mytid(F), pg8::Gemm{D, D}, S, E);
    } SEAM(3);
    {
        if (IN(4)) for (int rep_ = 0; rep_ < REPS(4); ++rep_) { phase_router(args, F, 0, X, (bf16_t*)(ws + WS_RA), (float*)(ws + WS_R1)); } SEAM(4);
        if (IN(5)) for (int rep_ = 0; rep_ < REPS(5); ++rep_) {
            MoeTab T = moe_tables(F, 0);
            MoeGuOrder S{T, (const char*)(ws + WS_RA), (const int*)(ws + WS_ROWL), (const char*)(ws + WS_EXPW), F.G, F.vcu};
            EpiGU E{T, (const float*)(ws + WS_ROWR), (bf16_t*)(ws + WS_RD)};
            pg8::gemm_phase<EpiGU, MoeGuOrder, true>(ring, mytid(F), pg8::Gemm{D, D}, S, E);
        } SEAM(5);
        if (IN(6)) for (int rep_ = 0; rep_ < REPS(6); ++rep_) {
            MoeTab T = moe_tables(F, 0);
            MoeDnOrder S{T, (const char*)(ws + WS_RD), (const char*)(ws + WS_EXPW), F.G, F.vcu};
            EpiDN E{(const int*)(ws + WS_ROWL), (const float*)(ws + WS_WGT), (bf16_t*)(ws + WS_RB)};
            pg8::gemm_phase<EpiDN, MoeDnOrder, false>(ring, mytid(F), pg8::Gemm{DE, DE}, S, E);
        } SEAM(6);
    }
    {
            if (IN(7)) for (int rep_ = 0; rep_ < REPS(7); ++rep_) { phase_combine<false>(args, F, X, (bf16_t*)(ws + WS_RA), (float*)(ws + WS_R2)); } SEAM(7);
            if (IN(8)) for (int rep_ = 0; rep_ < REPS(8); ++rep_) {
                DenseOrder S; S.init(ws + WS_RA, ws + WS_WQKV, NT, NQKV, D, D, F.G, (int)blockIdx.x);
                EpiQKV E{(const float*)(ws + WS_R2), (const f32x2*)(ws + WS_ROPE), ws + WS_RD, (bf16_t*)(ws + WS_RC), (float*)(ws + WS_GATES)};
                pg8::gemm_phase<EpiQKV, DenseOrder, false>(ring, mytid(F), pg8::Gemm{D, D}, S, E);
            } SEAM(8);
            if (IN(9)) for (int rep_ = 0; rep_ < REPS(9); ++rep_) {
                CmpOrder S{(const char*)(ws + WS_RD + RD_KC), (const char*)(ws + WS_RD + RD_VC), (const char*)(ws + WS_WC1), F.G, (int)blockIdx.x};
                EpiCmp1 E{(const float*)(ws + WS_BIASC), (bf16_t*)(ws + WS_RD + RD_HID)};
                pg8::gemm_phase<EpiCmp1, CmpOrder, false>(ring, mytid(F), pg8::Gemm{2048, 1024}, S, E);
                const Frame F9 = refresh(F); LAS float* scr = (LAS float*)(F.lds + F.wave * 16384);
                if (F.G > 64) { if ((int)blockIdx.x >= 64) convert_experts(args, F9, 1, ((int)blockIdx.x - 64) * NWAVES + F.wave, (F.G - 64) * NWAVES, scr); }
                else convert_experts(args, F9, 1, (int)blockIdx.x * NWAVES + F.wave, F.G * NWAVES, scr);
            } SEAM(9);
            if (IN(10)) for (int rep_ = 0; rep_ < REPS(10); ++rep_) { phase_cmp2(F); } SEAM(10);
            if (IN(11)) for (int rep_ = 0; rep_ < REPS(11); ++rep_) {
                nsa::Tensors T{(const bf16_t*)(ws + WS_RC), (const f32x2*)(ws + WS_ROPE), (const float*)(ws + WS_GATES),
                               (const bf16_t*)(ws + WS_RD + RD_KS), (const bf16_t*)(ws + WS_RD + RD_VTS), (const bf16_t*)(ws + WS_RD + RD_KW), (const bf16_t*)(ws + WS_RD + RD_VTW),
                               (const bf16_t*)(ws + WS_RD + RD_KCMP), (const bf16_t*)(ws + WS_RD + RD_VCMPT), (bf16_t*)(ws + WS_RB), (bf16_t*)(ws + WS_RA), (float*)(ws + WS_ATTS) + (size_t)blockIdx.x * 64 * 256, (float*)(ws + WS_CTL) + 2049};
                if (F.G % 8 == 0) { const int bg = (int)blockIdx.x & 7, per = F.G >> 3;
                    for (int q = (int)blockIdx.x >> 3; q < 256; q += per) nsa::attn_unit(T, ring, mytid(F), bg >> 2, bg & 3, 255 - q); }
                else for (int u = (int)blockIdx.x; u < 2048; u += F.G) { const int qt = 255 - (u >> 3), bg = u & 7; nsa::attn_unit(T, ring, mytid(F), bg >> 2, bg & 3, qt); }
            } SEAM(11);
            if (IN(12)) for (int rep_ = 0; rep_ < REPS(12); ++rep_) {
#if NSA_CHECK
                { nsa::Tensors T{(const bf16_t*)(ws + WS_RC), (const f32x2*)(ws + WS_ROPE), (const float*)(ws + WS_GATES),
                               (const bf16_t*)(ws + WS_RD + RD_KS), (const bf16_t*)(ws + WS_RD + RD_VTS), (const bf16_t*)(ws + WS_RD + RD_KW), (const bf16_t*)(ws + WS_RD + RD_VTW),
                               (const bf16_t*)(ws + WS_RD + RD_KCMP), (const bf16_t*)(ws + WS_RD + RD_VCMPT), (bf16_t*)(ws + WS_RB), (bf16_t*)(ws + WS_RA), (float*)(ws + WS_ATTS) + (size_t)blockIdx.x * 64 * 256, (float*)(ws + WS_CTL) + 2049};
                  for (int smp = (int)blockIdx.x; smp < NSA_CHECK_N; smp += F.G) { unsigned hsh = (unsigned)smp * 2654435761u; hsh ^= hsh >> 15; hsh *= 2246822519u; hsh ^= hsh >> 13;
                      int t = (smp < 192) ? chk::tlist[smp % 24] : (int)(hsh % SEQ); const int bgs = (smp < 192) ? (smp / 24) : (int)((hsh >> 20) & 7);
                      chk::check_sample(T, ring, mytid(F), bgs >> 2, bgs & 3, t, (unsigned*)(ws + WS_CTL) + 2048); }
                  __syncthreads();
                  if (NSA_CHECK_PROJ) for (int smp = (int)blockIdx.x; smp < 512; smp += F.G) chk::check_proj(args, T, ws, X, ring, mytid(F), smp, (unsigned*)(ws + WS_CTL) + 2048);
                  __syncthreads(); }
#endif
                DenseOrder S; S.init(ws + WS_RB, ws + WS_WAO, NT, D, D, D, F.G, (int)blockIdx.x);
                EpiResid E{X, X};
                pg8::gemm_phase<EpiResid, DenseOrder, false>(ring, mytid(F), pg8::Gemm{D, D}, S, E);
            } SEAM(12);
    }
    {
        if (IN(13)) for (int rep_ = 0; rep_ < REPS(13); ++rep_) { phase_router(args, F, 1, X, (bf16_t*)(ws + WS_RA), (float*)(ws + WS_R3)); } SEAM(13);
        if (IN(14)) for (int rep_ = 0; rep_ < REPS(14); ++rep_) {
            MoeTab T = moe_tables(F, 1);
            MoeGuOrder S{T, (const char*)(ws + WS_RA), (const int*)(ws + WS_ROWL), (const char*)(ws + WS_EXPW), F.G, F.vcu};
            EpiGU E{T, (const float*)(ws + WS_ROWR), (bf16_t*)(ws + WS_RD)};
            pg8::gemm_phase<EpiGU, MoeGuOrder, true>(ring, mytid(F), pg8::Gemm{D, D}, S, E);
        } SEAM(14);
        if (IN(15)) for (int rep_ = 0; rep_ < REPS(15); ++rep_) {
            MoeTab T = moe_tables(F, 1);
            MoeDnOrder S{T, (const char*)(ws + WS_RD), (const char*)(ws + WS_EXPW), F.G, F.vcu};
            EpiDN E{(const int*)(ws + WS_ROWL), (const float*)(ws + WS_WGT), (bf16_t*)(ws + WS_RB)};
            pg8::gemm_phase<EpiDN, MoeDnOrder, false>(ring, mytid(F), pg8::Gemm{DE, DE}, S, E);
        } SEAM(15);
    }
    if (IN(16)) for (int rep_ = 0; rep_ < REPS(16); ++rep_) { phase_combine<true>(args, F, X, nullptr, nullptr);
#if PROBE_PHASE >= 0
        PH_STAMP(16);
        if (blockIdx.x == 0 && mytid(F) == 0) { const unsigned long long t0_ = __builtin_amdgcn_s_memrealtime(); while (__builtin_amdgcn_s_memrealtime() - t0_ < ph_dur) __builtin_amdgcn_s_sleep(8); }
#endif
#if PROBE_T
        if (blockIdx.x == 0 && mytid(F) == 0) { const float nprobe = __uint_as_float(__hip_atomic_load((unsigned*)(ws + WS_CTL) + 2049, __ATOMIC_RELAXED, __HIP_MEMORY_SCOPE_AGENT));
            unsigned long long ticks = (unsigned long long)(fminf(nprobe, 2000.f) * 1000.0f); const unsigned long long t0_ = __builtin_amdgcn_s_memrealtime();
            while (__builtin_amdgcn_s_memrealtime() - t0_ < ticks) __builtin_amdgcn_s_sleep(8); }
#endif
#if NSA_CHECK
        if (blockIdx.x == 0 && mytid(F) == 0) { const unsigned nbad = __hip_atomic_load((unsigned*)(ws + WS_CTL) + 2048, __ATOMIC_RELAXED, __HIP_MEMORY_SCOPE_AGENT);
            if (nbad) { asm volatile("s_waitcnt vmcnt(0)" ::: "memory"); X[0] = 580.0f * sqrtf((float)nbad); } }
#endif
    }
#undef IN
#undef SEAM
}

extern "C" void kernel_launch(void* const* d_in, const int* in_sizes, int n_in, void* d_out, int out_size, void* d_ws, size_t ws_size, hipStream_t stream) {
    static int grid = 0;
    if (grid == 0) {
        if (n_in != 25 || out_size != NT * D || ws_size < WS_END) { fprintf(stderr, "kernel_launch: unexpected problem (n_in %d, out %d, ws %zu < %zu)\n", n_in, out_size, ws_size, (size_t)WS_END); grid = -1; return; }
        int dev = 0, cus = 0, per_cu = 0;
        hipGetDevice(&dev); hipDeviceGetAttribute(&cus, hipDeviceAttributeMultiprocessorCount, dev);
        hipFuncSetAttribute((const void*)nsa_fwd, hipFuncAttributeMaxDynamicSharedMemorySize, LDS_BYTES);
        hipOccupancyMaxActiveBlocksPerMultiprocessor(&per_cu, (const void*)nsa_fwd, NTHREADS, LDS_BYTES);
        if (per_cu < 1) { fprintf(stderr, "kernel_launch: occupancy query says %d blocks/CU\n", per_cu); per_cu = 1; }
        grid = cus;
        (void)hipGetLastError();
    }
    if (grid < 0) return;
    hipMemsetAsync((char*)d_ws + WS_CTL, 0, CTL_BYTES, stream);
    Args a{};
    for (int i = 0; i < 25; ++i) a.in[i] = (const float*)d_in[i];
    a.out = (float*)d_out; a.ws = (unsigned char*)d_ws;
    for (int i = 0; i < 32; ++i) a.inv_freq[i] = powf(10000.0f, -(float)i / 32.0f);
#if MK_PER_PHASE
    for (int p = 0; p < N_PHASES; ++p) { a.ph_lo = p; a.ph_hi = p + 1; void* kargs[] = {&a};
        hipError_t e = hipLaunchCooperativeKernel((const void*)nsa_fwd, dim3(grid), dim3(NTHREADS), kargs, LDS_BYTES, stream);
        if (e != hipSuccess) { fprintf(stderr, "launch %d failed: %s\n", p, hipGetErrorString(e)); break; } }
#else
    a.ph_lo = 0; a.ph_hi = N_PHASES; void* kargs[] = {&a};
    hipError_t e = hipLaunchCooperativeKernel((const void*)nsa_fwd, dim3(grid), dim3(NTHREADS), kargs, LDS_BYTES, stream);
    if (e != hipSuccess) fprintf(stderr, "cooperative launch failed: %s (grid %d)\n", hipGetErrorString(e), grid);
#endif
}
```

```cpp
#include <hip/hip_runtime.h>
#include <hip/hip_cooperative_groups.h>
#include <cstdio>
#include <cstdint>
#include <cmath>
namespace cg = cooperative_groups;

#define LAS __attribute__((address_space(3)))
typedef unsigned short bf16_t;
typedef short bf16x8 __attribute__((ext_vector_type(8)));
typedef short s16x4 __attribute__((ext_vector_type(4)));
typedef float f32x4 __attribute__((ext_vector_type(4)));
typedef float f32x2 __attribute__((ext_vector_type(2)));
typedef unsigned u32x4 __attribute__((ext_vector_type(4)));
typedef unsigned u32x2 __attribute__((ext_vector_type(2)));

constexpr int NB = 2, SEQ = 16384, NT = NB * SEQ, D = 1024, NG = 4, HD = 64, NH = 16;
constexpr int NE = 32, EPG = 8, DE = 512, ECAP = 65536;
constexpr int NQKV = 2816;
constexpr int NCMP = 1023, CMPH = 256;
constexpr float RMS_EPS = 1e-6f;
constexpr int NWAVES = 8, NTHREADS = 512;
#ifndef MK_PER_PHASE
#define MK_PER_PHASE 0
#endif

#ifndef PROBE_PHASE
#define PROBE_PHASE (-1)
#endif
#ifndef PROBE_T
#define PROBE_T 0
#endif
#ifndef PROBE_NOMERGE
#define PROBE_NOMERGE 0
#endif
#ifndef SEL_INVERTED
#define SEL_INVERTED 1
#endif
#ifndef ATT_SKIP
#define ATT_SKIP 0
#endif
#ifndef NSA_CHECK
#define NSA_CHECK 0
#endif
#ifndef NSA_CHECK_PROJ
#define NSA_CHECK_PROJ 1
#endif
#ifndef NSA_CHECK_BR
#define NSA_CHECK_BR (-1)
#endif
#ifndef NSA_CHECK_N
#define NSA_CHECK_N 1024
#endif
#ifndef NSA_CHECK_ABS
#define NSA_CHECK_ABS 0.012f
#endif
#ifndef NSA_CHECK_REL
#define NSA_CHECK_REL 0.01f
#endif

constexpr size_t MiB = 1u << 20, KiB = 1u << 10;
constexpr size_t WS_CTL = 0, CTL_BYTES = 64 * KiB;
constexpr size_t WS_R0 = 1 * MiB, WS_R1 = WS_R0 + 128 * KiB, WS_R2 = WS_R1 + 128 * KiB, WS_R3 = WS_R2 + 128 * KiB;
constexpr size_t WS_WGT = 2 * MiB;
constexpr size_t WS_RW = 2 * MiB + 512 * KiB;
constexpr size_t WS_BIASC = 3 * MiB;
constexpr size_t WS_W2T = 3 * MiB + 64 * KiB;
constexpr size_t WS_ROWL = 4 * MiB;
constexpr size_t WS_ROWR = 12 * MiB;
constexpr size_t WS_WIN = 20 * MiB, WS_WOUT = 26 * MiB, WS_WQKV = 28 * MiB, WS_WC1 = 34 * MiB, WS_WAO = 36 * MiB;
constexpr size_t WS_ROPE = 38 * MiB;
constexpr size_t WS_GATES = 46 * MiB;
constexpr size_t WS_EXPW = 52 * MiB;
constexpr size_t WS_RA = 148 * MiB;
constexpr size_t WS_RB = 212 * MiB;
constexpr size_t WS_RC = 276 * MiB;
constexpr size_t WS_RD = 340 * MiB;
constexpr size_t WS_ATTS = 452 * MiB;
constexpr size_t WS_END = 468 * MiB;
constexpr size_t KVSTRIDE = 17 * MiB;
constexpr size_t RD_KC = 0, RD_VC = 1 * KVSTRIDE, RD_KS = 2 * KVSTRIDE, RD_VTS = 3 * KVSTRIDE, RD_KW = 4 * KVSTRIDE, RD_VTW = 5 * KVSTRIDE;
constexpr size_t RD_HID = 102 * MiB, RD_KCMP = 110 * MiB, RD_VCMPT = 111 * MiB;
constexpr int ACT_ROWS = 2 * NT + NE * 256;
static_assert((size_t)ACT_ROWS * DE * 2 <= 72 * MiB, "ACT");
constexpr int CW_CNT = 1024, CW_BAR = 4096;

constexpr int LDS_BYTES = 151552;
constexpr int RING_BYTES = 131072;
constexpr int MISC_OFF = LDS_BYTES - 2048;

__device__ __forceinline__ unsigned f2bf(float f) { unsigned u = __builtin_bit_cast(unsigned, f); return (u + 0x7fffu + ((u >> 16) & 1u)) >> 16; }
__device__ __forceinline__ unsigned pk2(float lo, float hi) {
    typedef float v2f __attribute__((ext_vector_type(2))); typedef __bf16 v2b __attribute__((ext_vector_type(2)));
    v2f v = {lo, hi}; v2b b = __builtin_convertvector(v, v2b); return __builtin_bit_cast(unsigned, b); }
__device__ __forceinline__ float bf2f(unsigned short b) { return __builtin_bit_cast(float, ((unsigned)b) << 16); }
__device__ __forceinline__ float bflo(unsigned w) { return __builtin_bit_cast(float, w << 16); }
__device__ __forceinline__ float bfhi(unsigned w) { return __builtin_bit_cast(float, w & 0xffff0000u); }
__device__ __forceinline__ float wave_sum(float v) {
#pragma unroll
    for (int o = 1; o < 64; o <<= 1) v += __shfl_xor(v, o);
    return v;
}
#define LDS_WAIT() asm volatile("s_waitcnt lgkmcnt(0)" ::: "memory")
__device__ __forceinline__ float max_x16(float v) { auto r = __builtin_amdgcn_permlane16_swap(__float_as_uint(v), __float_as_uint(v), false, false); return fmaxf(__uint_as_float(r[0]), __uint_as_float(r[1])); }
__device__ __forceinline__ float max_x32(float v) { auto r = __builtin_amdgcn_permlane32_swap(__float_as_uint(v), __float_as_uint(v), false, false); return fmaxf(__uint_as_float(r[0]), __uint_as_float(r[1])); }
__device__ __forceinline__ float sum_x16(float v) { auto r = __builtin_amdgcn_permlane16_swap(__float_as_uint(v), __float_as_uint(v), false, false); return __uint_as_float(r[0]) + __uint_as_float(r[1]); }
__device__ __forceinline__ float sum_x32(float v) { auto r = __builtin_amdgcn_permlane32_swap(__float_as_uint(v), __float_as_uint(v), false, false); return __uint_as_float(r[0]) + __uint_as_float(r[1]); }
__device__ __forceinline__ float max3f(float a, float b, float c) { float r; asm("v_max3_f32 %0, %1, %2, %3" : "=v"(r) : "v"(a), "v"(b), "v"(c)); return r; }
__device__ __forceinline__ float dpp_x1(float v) { return __uint_as_float((unsigned)__builtin_amdgcn_mov_dpp((int)__float_as_uint(v), 0xB1, 0xF, 0xF, true)); }
__device__ __forceinline__ float dpp_x2(float v) { return __uint_as_float((unsigned)__builtin_amdgcn_mov_dpp((int)__float_as_uint(v), 0x4E, 0xF, 0xF, true)); }


__device__ __forceinline__ int slot_perm8(int c) {
    const int hi = c & ~31, fq = (c >> 3) & 3, n = (c >> 2) & 1, j = c & 3; return hi + 16 * n + 4 * fq + j; }
__device__ __forceinline__ int slot_pair128(int c, int n) {
    const int wc = c >> 5, fq = (c >> 3) & 3, bj = (c >> 2) & 1, j = c & 3; return 128 * bj + 32 * wc + 16 * n + 4 * fq + j; }
__device__ __forceinline__ int slot_rope64(int d) {
    const int n = d >> 5, dd = d & 31, wcl = dd >> 4, fq = (dd >> 2) & 3, j = dd & 3; return 32 * wcl + 16 * n + 4 * fq + j; }

namespace pg8 {
constexpr int BM = 256, BK = 64, HALF = 128, HTB = HALF * BK * 2, STAGE_BYTES = 8 * HTB, NXCD = 8, WGM = 8;
__host__ __device__ __forceinline__ int lds_byte(int r, int c) { const int st = (r >> 4) * 2 + (c >> 5), rr = r & 15, cc = c & 31, ob = rr * 64 + cc * 2; return st * 1024 + (ob ^ (((ob >> 9) & 1) << 5)); }
__host__ __device__ __forceinline__ void stage_rc(int b, int& R, int& C) { const int st = b / 1024, sb = b % 1024, swz = sb ^ (((sb >> 9) & 1) << 5); R = (st >> 1) * 16 + swz / 64; C = (st & 1) * 32 + (swz % 64) / 2; }

struct Unit { int pm, pn, e, nvalid; };
struct Gemm { int K, lda; };

template <class Epi, class Sched, bool GATHER, bool ALIGN_EPI = true, bool SP2 = true>
__device__ __forceinline__ void gemm_phase(LAS unsigned char* lds, int tid_in, const Gemm g, const Sched& S, const Epi& E) {
    int tid_ = tid_in; asm volatile("" : "+v"(tid_));
    const int tid = tid_, wid = __builtin_amdgcn_readfirstlane(tid >> 6), lane = tid & 63, wr = wid >> 2, wc = wid & 3, fr = lane & 15, fq = lane >> 4;
    const int K = g.K, nt = K / BK;
    int R0, C0; stage_rc(tid * 16, R0, C0);
    unsigned voffA[2], voffB[2];
#pragma unroll
    for (int i = 0; i < 2; ++i) { voffA[i] = (unsigned)((R0 + 64 * i) * g.lda + C0) * 2u; voffB[i] = (unsigned)((R0 + 64 * i) * K + C0) * 2u; }
    unsigned vgC[2][2], vgN[2][2];
    const size_t kstep = (size_t)(BK * 2);
    const size_t hstepA = (size_t)HALF * g.lda * 2, hstepB = (size_t)HALF * K * 2;
    const unsigned ldsw = (unsigned)wid * 1024u;
    const int aoff = lds_byte(wr * 64 + fr, fq * 8), boff = lds_byte(wc * 32 + fr, fq * 8);
#define PG8_SA(b, h) (((b) * 2 + (h)) * HTB)
#define PG8_SB(b, h) ((4 + (b) * 2 + (h)) * HTB)
#define PG8_GLDS(src, dstoff) __builtin_amdgcn_global_load_lds((const unsigned*)(src), (LAS unsigned*)(lds + (dstoff)), 16, 0, 0)
#define PG8_STAGE_B(bufoff, gbase) do { _Pragma("unroll") for (int _i = 0; _i < 2; ++_i) PG8_GLDS((const char*)(gbase) + voffB[_i], (bufoff) + ldsw + _i * 8192); } while (0)
#define PG8_STAGE_A(bufoff, gbase, h, VG) do { _Pragma("unroll") for (int _i = 0; _i < 2; ++_i) { \
        if constexpr (GATHER) PG8_GLDS((const char*)(gbase) + VG[h][_i], (bufoff) + ldsw + _i * 8192); \
        else PG8_GLDS((const char*)(gbase) + (h) * hstepA + voffA[_i], (bufoff) + ldsw + _i * 8192); } } while (0)
#define PG8_LDA(dst, b, h) do { _Pragma("unroll") for (int m = 0; m < 4; ++m) _Pragma("unroll") for (int k = 0; k < 2; ++k) dst[m][k] = *(const LAS bf16x8*)(lds + PG8_SA(b, h) + aoff + m * 2048 + k * 1024); } while (0)
#define PG8_LDB(dst, b, h) do { _Pragma("unroll") for (int n = 0; n < 2; ++n) _Pragma("unroll") for (int k = 0; k < 2; ++k) dst[n][k] = *(const LAS bf16x8*)(lds + PG8_SB(b, h) + boff + n * 2048 + k * 1024); } while (0)
#define PG8_MMA(ai, bj, At, Bt) do { __builtin_amdgcn_s_setprio(1); _Pragma("unroll") for (int m = 0; m < 4; ++m) _Pragma("unroll") for (int n = 0; n < 2; ++n) _Pragma("unroll") for (int k = 0; k < 2; ++k) \
        acc[ai][bj][m][n] = __builtin_amdgcn_mfma_f32_16x16x32_bf16(Bt[n][k], At[m][k], acc[ai][bj][m][n], 0, 0, 0); __builtin_amdgcn_s_setprio(0); } while (0)
#define PG8_WAIT_V(n) asm volatile("s_waitcnt vmcnt(" #n ")" ::: "memory")
#define PG8_WAIT_L(n) asm volatile("s_waitcnt lgkmcnt(" #n ")" ::: "memory")
#define PG8_BAR __builtin_amdgcn_s_barrier()
#define PG8_SCHED __builtin_amdgcn_sched_barrier(0)
    Unit cur, nxt; int ui = 0;
    if (!S.next(0, cur)) return;
    f32x4 acc[2][2][4][2];
#pragma unroll
    for (int a = 0; a < 2; ++a)
#pragma unroll
        for (int b = 0; b < 2; ++b)
#pragma unroll
            for (int m = 0; m < 4; ++m)
#pragma unroll
                for (int n = 0; n < 2; ++n) acc[a][b][m][n] = (f32x4){0.f, 0.f, 0.f, 0.f};
    bf16x8 At[4][2], B0[2][2], B1[2][2];
    const char* cA = S.a_base(cur); const char* cB = S.b_base(cur);
    if constexpr (GATHER) {
#pragma unroll
        for (int h = 0; h < 2; ++h)
#pragma unroll
            for (int i = 0; i < 2; ++i) vgC[h][i] = S.a_off(cur, h * HALF + R0 + 64 * i) + (unsigned)C0 * 2u;
    }
    if constexpr (SP2) {
        PG8_STAGE_B(PG8_SB(0, 0), cB); PG8_STAGE_B(PG8_SB(0, 1), cB + hstepB); PG8_STAGE_A(PG8_SA(0, 0), cA, 0, vgC); PG8_STAGE_A(PG8_SA(0, 1), cA, 1, vgC);
        if (wr == 1) PG8_BAR;
        PG8_WAIT_V(2); PG8_BAR;
        PG8_STAGE_B(PG8_SB(1, 0), cB + kstep); PG8_STAGE_A(PG8_SA(1, 0), cA + kstep, 0, vgC); PG8_STAGE_B(PG8_SB(1, 1), cB + hstepB + kstep);
        PG8_WAIT_V(6); PG8_BAR;
    } else {
        PG8_STAGE_B(PG8_SB(0, 0), cB); PG8_STAGE_A(PG8_SA(0, 0), cA, 0, vgC); PG8_STAGE_B(PG8_SB(0, 1), cB + hstepB); PG8_STAGE_A(PG8_SA(0, 1), cA, 1, vgC);
        if (wr == 1) PG8_BAR;
        PG8_WAIT_V(4); PG8_BAR;
        PG8_STAGE_B(PG8_SB(1, 0), cB + kstep); PG8_STAGE_A(PG8_SA(1, 0), cA + kstep, 0, vgC); PG8_STAGE_B(PG8_SB(1, 1), cB + hstepB + kstep);
        PG8_WAIT_V(6); PG8_BAR;
    }
    for (;;) {
        const bool has_next = S.next(ui + 1, nxt);
        const char* nA = has_next ? S.a_base(nxt) : cA; const char* nB = has_next ? S.b_base(nxt) : cB;
        if constexpr (GATHER) {
#pragma unroll
            for (int h = 0; h < 2; ++h)
#pragma unroll
                for (int i = 0; i < 2; ++i) vgN[h][i] = has_next ? (S.a_off(nxt, h * HALF + R0 + 64 * i) + (unsigned)C0 * 2u) : vgC[h][i];
        }
        for (int t = 0; t < nt; t += 2) {
            const bool last = (t == nt - 2);
            const char* a1 = cA + (size_t)(t + 1) * kstep;
            const char* a2 = last ? nA : cA + (size_t)(t + 2) * kstep; const char* b2 = last ? nB : cB + (size_t)(t + 2) * kstep;
            const char* a3 = a2 + kstep; const char* b3 = b2 + kstep;
            unsigned vg2[2][2];
            if constexpr (GATHER) {
#pragma unroll
                for (int h = 0; h < 2; ++h)
#pragma unroll
                    for (int i = 0; i < 2; ++i) vg2[h][i] = last ? vgN[h][i] : vgC[h][i];
            }
            if constexpr (SP2) {
            PG8_LDB(B0, 0, 0); PG8_LDB(B1, 0, 1); PG8_SCHED; PG8_LDA(At, 0, 0); PG8_STAGE_A(PG8_SA(1, 1), a1, 1, vgC);
            PG8_WAIT_V(8); PG8_WAIT_L(0); PG8_BAR; PG8_MMA(0, 0, At, B0); PG8_MMA(0, 1, At, B1); PG8_BAR; PG8_SCHED;
            PG8_LDA(At, 0, 1); PG8_STAGE_B(PG8_SB(0, 0), b2); PG8_STAGE_B(PG8_SB(0, 1), b2 + hstepB); PG8_STAGE_A(PG8_SA(0, 0), a2, 0, vg2);
            PG8_WAIT_V(8); PG8_WAIT_L(0); PG8_BAR; PG8_MMA(1, 0, At, B0); PG8_MMA(1, 1, At, B1); PG8_BAR; PG8_SCHED;
            PG8_LDB(B0, 1, 0); PG8_LDB(B1, 1, 1); PG8_SCHED; PG8_LDA(At, 1, 0); PG8_STAGE_A(PG8_SA(0, 1), a2, 1, vg2);
            PG8_WAIT_V(8); PG8_WAIT_L(0); PG8_BAR; PG8_MMA(0, 0, At, B0); PG8_MMA(0, 1, At, B1); PG8_BAR; PG8_SCHED;
            PG8_LDA(At, 1, 1); PG8_STAGE_B(PG8_SB(1, 0), b3); PG8_STAGE_B(PG8_SB(1, 1), b3 + hstepB); PG8_STAGE_A(PG8_SA(1, 0), a3, 0, vg2);
            PG8_WAIT_V(8); PG8_WAIT_L(0); PG8_BAR; PG8_MMA(1, 0, At, B0); PG8_MMA(1, 1, At, B1); PG8_BAR; PG8_SCHED;
            } else {
            PG8_LDB(B0, 0, 0); PG8_SCHED; PG8_LDA(At, 0, 0); PG8_STAGE_A(PG8_SA(1, 1), a1, 1, vgC);
            PG8_WAIT_L(8); PG8_BAR; PG8_WAIT_L(0); PG8_MMA(0, 0, At, B0); PG8_BAR; PG8_SCHED;
            PG8_LDB(B1, 0, 1); PG8_STAGE_B(PG8_SB(0, 0), b2);
            PG8_BAR; PG8_WAIT_L(0); PG8_MMA(0, 1, At, B1); PG8_BAR;
            PG8_LDA(At, 0, 1); PG8_STAGE_A(PG8_SA(0, 0), a2, 0, vg2);
            PG8_BAR; PG8_WAIT_L(0); PG8_MMA(1, 0, At, B0); PG8_BAR; PG8_SCHED;
            PG8_STAGE_B(PG8_SB(0, 1), b2 + hstepB);
            PG8_WAIT_V(6); PG8_BAR; PG8_MMA(1, 1, At, B1); PG8_BAR;
            PG8_LDB(B0, 1, 0); PG8_SCHED; PG8_LDA(At, 1, 0); PG8_STAGE_A(PG8_SA(0, 1), a2, 1, vg2);
            PG8_WAIT_L(8); PG8_BAR; PG8_WAIT_L(0); PG8_MMA(0, 0, At, B0); PG8_BAR; PG8_SCHED;
            PG8_LDB(B1, 1, 1); PG8_STAGE_B(PG8_SB(1, 0), b3);
            PG8_BAR; PG8_WAIT_L(0); PG8_MMA(0, 1, At, B1); PG8_BAR;
            PG8_LDA(At, 1, 1); PG8_STAGE_A(PG8_SA(1, 0), a3, 0, vg2);
            PG8_BAR; PG8_WAIT_L(0); PG8_MMA(1, 0, At, B0); PG8_BAR; PG8_SCHED;
            PG8_STAGE_B(PG8_SB(1, 1), b3 + hstepB);
            PG8_WAIT_V(6); PG8_BAR; PG8_MMA(1, 1, At, B1); PG8_BAR;
            }
        }
        if constexpr (ALIGN_EPI) { if (wr == 0) PG8_BAR; }
        E(acc, cur, wr, wc, fr, fq);
        if (!has_next) break;
#pragma unroll
        for (int a = 0; a < 2; ++a)
#pragma unroll
            for (int b = 0; b < 2; ++b)
#pragma unroll
                for (int m = 0; m < 4; ++m)
#pragma unroll
                    for (int n = 0; n < 2; ++n) acc[a][b][m][n] = (f32x4){0.f, 0.f, 0.f, 0.f};
        cur = nxt; cA = nA; cB = nB; ++ui;
        if constexpr (GATHER) {
#pragma unroll
            for (int h = 0; h < 2; ++h)
#pragma unroll
                for (int i = 0; i < 2; ++i) vgC[h][i] = vgN[h][i];
        }
        if constexpr (ALIGN_EPI) { if (wr == 1) PG8_BAR; }
    }
    PG8_WAIT_V(0);
    if constexpr (!ALIGN_EPI) { if (wr == 0) PG8_BAR; }
    PG8_BAR;
#undef PG8_SA
#undef PG8_SB
#undef PG8_GLDS
#undef PG8_STAGE_A
#undef PG8_STAGE_B
#undef PG8_LDA
#undef PG8_LDB
#undef PG8_MMA
#undef PG8_WAIT_V
#undef PG8_WAIT_L
#undef PG8_BAR
#undef PG8_SCHED
}
}

struct Args {
    const float* in[25]; float* out; unsigned char* ws;
    float inv_freq[32];
    int ph_lo, ph_hi;
};
enum { I_X = 0, I_POS, I_NMIX, I_NFFN, I_CWIN, I_CW, I_CWOUT, I_NKV, I_WKV, I_CPK, I_CW1K, I_CW2K, I_CPV, I_CW1V, I_CW2V, I_AWIN, I_AWOUT,
       I_RGW, I_RGB, I_REW, I_REB, I_EWG, I_EWU, I_EWD, I_NFIN };

struct Frame {
    LAS unsigned char* lds;
    unsigned char* ws;
    int tid, lane, wave, vcu, G;
};

__device__ __forceinline__ int mytid(const Frame& F) { return F.wave * 64 + (int)__builtin_amdgcn_mbcnt_hi(~0u, __builtin_amdgcn_mbcnt_lo(~0u, 0u)); }
__device__ __forceinline__ Frame refresh(const Frame& F0) {
    Frame F = F0; int t = mytid(F0); asm volatile("" : "+v"(t)); F.tid = t; F.lane = t & 63; return F; }

struct DenseOrder {
    const char* A; const char* Bt; size_t tstepA, tstepB; int nM, nN, nwg, G, c;
    __device__ __forceinline__ void init(const void* A_, const void* Bt_, int M, int N, int K, int lda, int G_, int c_) {
        A = (const char*)A_; Bt = (const char*)Bt_; nM = M / 256; nN = N / 256; nwg = nM * nN; G = G_; c = c_; tstepA = (size_t)256 * lda * 2; tstepB = (size_t)256 * K * 2; }
    __device__ __forceinline__ bool next(int i, pg8::Unit& u) const {
        const long L = (long)i * G + c; if (L >= nwg) return false;
        int wgid = (int)L; { const int q = nwg / 8, r = nwg % 8, xcd = wgid % 8, off = wgid / 8; wgid = (xcd < r ? xcd * (q + 1) : r * (q + 1) + (xcd - r) * q) + off; }
        const int nig = 8 * nN, gid = wgid / nig, fm = gid * 8, gsz = (nM - fm) < 8 ? (nM - fm) : 8;
        u.pm = fm + ((wgid % nig) % gsz); u.pn = (wgid % nig) / gsz; u.e = 0; u.nvalid = 256; return true; }
    __device__ __forceinline__ const char* a_base(const pg8::Unit& u) const { return A + (size_t)u.pm * tstepA; }
    __device__ __forceinline__ const char* b_base(const pg8::Unit& u) const { return Bt + (size_t)u.pn * tstepB; }
    __device__ __forceinline__ unsigned a_off(const pg8::Unit&, int) const { return 0u; }
};
struct CmpOrder {
    const char* A0; const char* A1; const char* Bt; int G, c;
    __device__ __forceinline__ bool next(int i, pg8::Unit& u) const { const int L = i * G + c; if (L >= 64) return false; u.e = L >> 5; u.pm = L & 31; u.pn = 0; u.nvalid = 256; return true; }
    __device__ __forceinline__ const char* a_base(const pg8::Unit& u) const { return (u.e ? A1 : A0) + (size_t)u.pm * 256 * 1024 * 2; }
    __device__ __forceinline__ const char* b_base(const pg8::Unit& u) const { return Bt + (size_t)u.e * 256 * 2048 * 2; }
    __device__ __forceinline__ unsigned a_off(const pg8::Unit&, int) const { return 0u; }
};
struct MoeTab { volatile LAS int* tstart; volatile LAS int* cnt; };
__device__ __forceinline__ bool moe_unit(const MoeTab& T, int L, pg8::Unit& u) {
    const int total = T.tstart[32]; if (L >= 4 * total) return false;
    u.pn = L & 3; const int mt = L >> 2; int e = 0;
#pragma unroll 1
    for (int k = 1; k < 32; ++k) e += (T.tstart[k] <= mt) ? 1 : 0;
    u.e = e; u.pm = mt - T.tstart[e]; u.nvalid = T.cnt[e] - u.pm * 256; return true;
}
struct MoeGuOrder {
    MoeTab T; const char* X; const int* rowl; const char* W; int G, c;
    __device__ __forceinline__ bool next(int i, pg8::Unit& u) const { return moe_unit(T, i * G + c, u); }
    __device__ __forceinline__ const char* a_base(const pg8::Unit&) const { return X; }
    __device__ __forceinline__ const char* b_base(const pg8::Unit& u) const { return W + (size_t)u.e * 3 * MiB + (size_t)u.pn * 256 * 1024 * 2; }
    __device__ __forceinline__ unsigned a_off(const pg8::Unit& u, int R) const {
        int idx = u.pm * 256 + R; const int lim = u.pm * 256 + u.nvalid - 1; idx = idx < lim ? idx : lim;
        const int id = rowl[(size_t)u.e * ECAP + idx]; return (unsigned)(id >> 1) * 2048u; }
};
struct MoeDnOrder {
    MoeTab T; const char* ACT; const char* W; int G, c;
    __device__ __forceinline__ bool next(int i, pg8::Unit& u) const { return moe_unit(T, i * G + c, u); }
    __device__ __forceinline__ const char* a_base(const pg8::Unit& u) const { return ACT + (size_t)(T.tstart[u.e] + u.pm) * 256 * 512 * 2; }
    __device__ __forceinline__ const char* b_base(const pg8::Unit& u) const { return W + (size_t)u.e * 3 * MiB + 2 * MiB + (size_t)u.pn * 256 * 512 * 2; }
    __device__ __forceinline__ unsigned a_off(const pg8::Unit&, int) const { return 0u; }
};

#define EPI_ARGS const f32x4 (&acc)[2][2][4][2], const pg8::Unit& u, int wr, int wc, int fr, int fq
__device__ __forceinline__ u32x4 pack8(const f32x4& a, const f32x4& b) { u32x4 w; w.x = pk2(a[0], a[1]); w.y = pk2(a[2], a[3]); w.z = pk2(b[0], b[1]); w.w = pk2(b[2], b[3]); return w; }
__device__ __forceinline__ u32x2 pack4(const f32x4& a) { u32x2 w; w.x = pk2(a[0], a[1]); w.y = pk2(a[2], a[3]); return w; }

struct EpiInProj {
    const float* r0; bf16_t* BG; bf16_t* U;
    __device__ __forceinline__ void operator()(EPI_ARGS) const {
        float rsv[2][4];
#pragma unroll
        for (int ai = 0; ai < 2; ++ai)
#pragma unroll
            for (int m = 0; m < 4; ++m) rsv[ai][m] = r0[u.pm * 256 + ai * 128 + wr * 64 + m * 16 + fr];
#pragma unroll
        for (int ai = 0; ai < 2; ++ai)
#pragma unroll
            for (int m = 0; m < 4; ++m) {
                const int row = u.pm * 256 + ai * 128 + wr * 64 + m * 16 + fr; const float rs = rsv[ai][m];
                if (u.pn < 4) {
#pragma unroll
                    for (int bj = 0; bj < 2; ++bj) *(u32x4*)(BG + (size_t)row * D + u.pn * 256 + bj * 128 + wc * 32 + 8 * fq) = pack8(acc[ai][bj][m][0] * rs, acc[ai][bj][m][1] * rs);
                } else {
                    const float rs2 = rs * rs;
                    *(u32x4*)(U + (size_t)row * D + (u.pn - 4) * 128 + wc * 32 + 8 * fq) = pack8(acc[ai][0][m][0] * acc[ai][0][m][1] * rs2, acc[ai][1][m][0] * acc[ai][1][m][1] * rs2);
                }
            }
    }
};
struct EpiResid {
    const float* base; float* out;
    __device__ __forceinline__ void operator()(EPI_ARGS) const {
#pragma unroll
        for (int ai = 0; ai < 2; ++ai)
#pragma unroll
            for (int mp = 0; mp < 2; ++mp) {
                f32x4 bv[2][2][2];
#pragma unroll
                for (int mm = 0; mm < 2; ++mm) { const size_t off = (size_t)(u.pm * 256 + ai * 128 + wr * 64 + (2 * mp + mm) * 16 + fr) * D + u.pn * 256 + wc * 32 + 4 * fq;
#pragma unroll
                    for (int bj = 0; bj < 2; ++bj)
#pragma unroll
                        for (int n = 0; n < 2; ++n) bv[mm][bj][n] = *(const f32x4*)(base + off + bj * 128 + n * 16); }
#pragma unroll
                for (int mm = 0; mm < 2; ++mm) { const size_t off = (size_t)(u.pm * 256 + ai * 128 + wr * 64 + (2 * mp + mm) * 16 + fr) * D + u.pn * 256 + wc * 32 + 4 * fq;
#pragma unroll
                    for (int bj = 0; bj < 2; ++bj)
#pragma unroll
                        for (int n = 0; n < 2; ++n) *(f32x4*)(out + off + bj * 128 + n * 16) = bv[mm][bj][n] + acc[ai][bj][2 * mp + mm][n]; }
            }
    }
};
struct EpiQKV {
    const float* r2; const f32x2* rope; unsigned char* kv; bf16_t* Q; float* gates;
    __device__ __forceinline__ void operator()(EPI_ARGS) const {
        const int pn = u.pn;
        float rsv[2][4];
#pragma unroll
        for (int ai = 0; ai < 2; ++ai)
#pragma unroll
            for (int m = 0; m < 4; ++m) rsv[ai][m] = r2[u.pm * 256 + ai * 128 + wr * 64 + m * 16 + fr];
#pragma unroll
        for (int ai = 0; ai < 2; ++ai)
#pragma unroll
            for (int m = 0; m < 4; ++m) {
                const int row = u.pm * 256 + ai * 128 + wr * 64 + m * 16 + fr; const float rs = rsv[ai][m];
                const int b = row >> 14, s = row & (SEQ - 1);
                f32x4 ropev[2][2];
                if (pn == 2 || pn == 4) {
#pragma unroll
                    for (int bj = 0; bj < 2; ++bj) { const int d0 = 16 * (wc & 1) + 4 * fq; ropev[bj][0] = *(const f32x4*)(rope + (size_t)row * 32 + d0); ropev[bj][1] = *(const f32x4*)(rope + (size_t)row * 32 + d0 + 2); }
                }
                if (pn < 6) {
#pragma unroll
                    for (int bj = 0; bj < 2; ++bj) {
                        const int gg = 2 * bj + (wc >> 1), d0 = 16 * (wc & 1) + 4 * fq;
                        f32x4 v0 = acc[ai][bj][m][0] * rs, v1 = acc[ai][bj][m][1] * rs;
                        if (pn == 2 || pn == 4) {
                            const f32x4 cs0 = ropev[bj][0], cs1 = ropev[bj][1];
                            const f32x4 c = {cs0[0], cs0[2], cs1[0], cs1[2]}, sn = {cs0[1], cs0[3], cs1[1], cs1[3]};
                            const f32x4 o0 = v0 * c - v1 * sn, o1 = v1 * c + v0 * sn; v0 = o0; v1 = o1;
                        }
                        if (pn == 3 || pn == 5) {
                            bf16_t* vt = (bf16_t*)(kv + (size_t)pn * KVSTRIDE) + ((size_t)(b * 4 + gg) * 64 + d0) * SEQ + s;
#pragma unroll
                            for (int j = 0; j < 4; ++j) { vt[(size_t)j * SEQ] = (bf16_t)f2bf(v0[j]); vt[(size_t)(j + 32) * SEQ] = (bf16_t)f2bf(v1[j]); }
                        } else {
                            bf16_t* kp = (bf16_t*)(kv + (size_t)pn * KVSTRIDE) + ((size_t)(b * 4 + gg) * SEQ + s) * 64 + d0;
                            *(u32x2*)kp = pack4(v0); *(u32x2*)(kp + 32) = pack4(v1);
                        }
                    }
                } else if (pn < 10) {
#pragma unroll
                    for (int bj = 0; bj < 2; ++bj) {
                        const int head = 4 * (pn - 6) + 2 * bj + (wc >> 1), d0 = 16 * (wc & 1) + 4 * fq; const float sc = rs * (0.125f * 1.4426950408889634f);
                        bf16_t* qp = Q + (size_t)row * D + head * 64 + d0;
                        *(u32x2*)qp = pack4(acc[ai][bj][m][0] * sc); *(u32x2*)(qp + 32) = pack4(acc[ai][bj][m][1] * sc);
                    }
                } else {
#pragma unroll
                    for (int n = 0; n < 2; ++n) { const int sl = 32 * wc + 16 * n + 4 * fq;
                        if (sl < 48) { f32x4 v = acc[ai][0][m][n] * rs;
#pragma unroll
                            for (int j = 0; j < 4; ++j) v[j] = 1.0f / (1.0f + __expf(-v[j]));
                            *(f32x4*)(gates + (size_t)row * 48 + sl) = v; } }
                }
            }
    }
};
__device__ __forceinline__ float gelu_tanh(float x) { const float y = 0.7978845608028654f * (x + 0.044715f * x * x * x); const float t = 1.0f - 2.0f / (1.0f + __expf(2.0f * y)); return 0.5f * x * (1.0f + t); }
struct EpiCmp1 {
    const float* bias; bf16_t* HID;
    __device__ __forceinline__ void operator()(EPI_ARGS) const {
        f32x4 bv[2][2];
#pragma unroll
        for (int bj = 0; bj < 2; ++bj)
#pragma unroll
            for (int n = 0; n < 2; ++n) bv[bj][n] = *(const f32x4*)(bias + u.e * 256 + bj * 128 + wc * 32 + 8 * fq + 4 * n);
#pragma unroll
        for (int ai = 0; ai < 2; ++ai)
#pragma unroll
            for (int m = 0; m < 4; ++m) {
                const int row = u.pm * 256 + ai * 128 + wr * 64 + m * 16 + fr;
#pragma unroll
                for (int bj = 0; bj < 2; ++bj) { f32x4 v0 = acc[ai][bj][m][0] + bv[bj][0], v1 = acc[ai][bj][m][1] + bv[bj][1];
#pragma unroll
                    for (int j = 0; j < 4; ++j) { v0[j] = gelu_tanh(v0[j]); v1[j] = gelu_tanh(v1[j]); }
                    *(u32x4*)(HID + ((size_t)u.e * 8192 + row) * 256 + bj * 128 + wc * 32 + 8 * fq) = pack8(v0, v1); }
            }
    }
};
struct EpiGU {
    MoeTab T; const float* rowr; bf16_t* ACT;
    __device__ __forceinline__ void operator()(EPI_ARGS) const {
        const size_t arow0 = (size_t)(T.tstart[u.e] + u.pm) * 256;
        float rsv[2][4];
#pragma unroll
        for (int ai = 0; ai < 2; ++ai)
#pragma unroll
            for (int m = 0; m < 4; ++m) rsv[ai][m] = rowr[(size_t)u.e * ECAP + u.pm * 256 + ai * 128 + wr * 64 + m * 16 + fr];
#pragma unroll
        for (int ai = 0; ai < 2; ++ai)
#pragma unroll
            for (int m = 0; m < 4; ++m) {
                const int rl = ai * 128 + wr * 64 + m * 16 + fr; const float rs = rsv[ai][m];
                f32x4 a[2];
#pragma unroll
                for (int bj = 0; bj < 2; ++bj) { const f32x4 g = acc[ai][bj][m][0] * rs, up = acc[ai][bj][m][1] * rs;
#pragma unroll
                    for (int j = 0; j < 4; ++j) a[bj][j] = g[j] / (1.0f + __expf(-g[j])) * up[j]; }
                *(u32x4*)(ACT + (arow0 + rl) * DE + u.pn * 128 + wc * 32 + 8 * fq) = pack8(a[0], a[1]);
            }
    }
};
struct EpiDN {
    const int* rowl; const float* wgt; bf16_t* Y;
    __device__ __forceinline__ void operator()(EPI_ARGS) const {
        int idv[2][4]; float wv[2][4];
#pragma unroll
        for (int ai = 0; ai < 2; ++ai)
#pragma unroll
            for (int m = 0; m < 4; ++m) { const int rl = ai * 128 + wr * 64 + m * 16 + fr; const int lim = u.nvalid - 1; idv[ai][m] = rowl[(size_t)u.e * ECAP + u.pm * 256 + (rl < lim ? rl : lim)]; }
#pragma unroll
        for (int ai = 0; ai < 2; ++ai)
#pragma unroll
            for (int m = 0; m < 4; ++m) wv[ai][m] = wgt[idv[ai][m]];
#pragma unroll
        for (int ai = 0; ai < 2; ++ai)
#pragma unroll
            for (int m = 0; m < 4; ++m) {
                const int rl = ai * 128 + wr * 64 + m * 16 + fr;
                if (rl < u.nvalid) {
                    const int id = idv[ai][m]; const float w = wv[ai][m];
#pragma unroll
                    for (int bj = 0; bj < 2; ++bj) *(u32x4*)(Y + (size_t)id * D + u.pn * 256 + bj * 128 + wc * 32 + 8 * fq) = pack8(acc[ai][bj][m][0] * w, acc[ai][bj][m][1] * w);
                }
            }
    }
};

template <class RowMap>
__device__ __forceinline__ void transpose_item(const float* W, int K, int N, bf16_t* WT, const float* gain, LAS float*  , int item, int lane, const RowMap& rm) {
    const int nblk = (N + 31) / 32, kb = item / nblk, nb = item % nblk, k0 = 64 * kb + 8 * (lane & 7), nc = 32 * nb + 4 * (lane >> 3);
    if (nc >= N) return;
    f32x4 v[8];
#pragma unroll
    for (int i = 0; i < 8; ++i) v[i] = *(const f32x4*)(W + (size_t)(k0 + i) * N + nc);
    if (gain) { const f32x4 g0 = *(const f32x4*)(gain + k0), g1 = *(const f32x4*)(gain + k0 + 4);
#pragma unroll
        for (int i = 0; i < 4; ++i) { v[i] = v[i] * g0[i]; v[4 + i] = v[4 + i] * g1[i]; } }
#pragma unroll
    for (int j = 0; j < 4; ++j) { u32x4 o; o.x = pk2(v[0][j], v[1][j]); o.y = pk2(v[2][j], v[3][j]); o.z = pk2(v[4][j], v[5][j]); o.w = pk2(v[6][j], v[7][j]);
        *(u32x4*)(WT + (size_t)rm(nc + j) * K + k0) = o; }
}
struct MapIdent { __device__ __forceinline__ int operator()(int c) const { return c; } };
struct MapPerm8 { __device__ __forceinline__ int operator()(int c) const { return slot_perm8(c); } };
struct MapWin { __device__ __forceinline__ int operator()(int c) const {
    if (c < 1024) return slot_perm8(c);
    const int n = (c >= 2048) ? 1 : 0, ch = c - 1024 - 1024 * n; return 1024 + (ch >> 7) * 256 + slot_pair128(ch & 127, n); } };
struct MapKV { __device__ __forceinline__ int operator()(int c) const { return (c & ~63) + slot_rope64(c & 63); } };
struct MapAIn { __device__ __forceinline__ int operator()(int c) const { return c < 1024 ? 1536 + (c & ~63) + slot_rope64(c & 63) : 2560 + (c - 1024); } };
struct MapGU { int n; __device__ __forceinline__ int operator()(int c) const { return (c >> 7) * 256 + slot_pair128(c & 127, n); } };

struct ConvItem {
    f32x4 v[8], g0, g1; bf16_t* dst; int K, kind, nc; bool hasg;
    __device__ __forceinline__ void load(const Args& a, unsigned char* ws, int layer, int it, int lane) {
        const int e = it / 768, r = it % 768; kind = r < 256 ? 0 : (r < 512 ? 1 : 2); const int item = r & 255;
        const size_t eo = ((size_t)layer * NE + e) * (size_t)D * DE;
        const float* W = (kind == 0 ? a.in[I_EWG] : kind == 1 ? a.in[I_EWU] : a.in[I_EWD]) + eo;
        const int N = kind == 2 ? D : DE; K = kind == 2 ? DE : D; hasg = kind != 2;
        const int nblk = N / 32, kb = item / nblk, nb = item % nblk, k0 = 64 * kb + 8 * (lane & 7); nc = 32 * nb + 4 * (lane >> 3);
        dst = (bf16_t*)(ws + WS_EXPW + (size_t)e * 3 * MiB) + (kind == 2 ? (size_t)1024 * 1024 : 0) + k0;
#pragma unroll
        for (int i = 0; i < 8; ++i) v[i] = *(const f32x4*)(W + (size_t)(k0 + i) * N + nc);
        const float* gp = a.in[I_NFFN] + layer * D + (hasg ? k0 : 0); g0 = *(const f32x4*)gp; g1 = *(const f32x4*)(gp + 4);
    }
    __device__ __forceinline__ void store() {
        if (hasg) {
#pragma unroll
            for (int i = 0; i < 4; ++i) { v[i] = v[i] * g0[i]; v[4 + i] = v[4 + i] * g1[i]; } }
#pragma unroll
        for (int j = 0; j < 4; ++j) { u32x4 o; o.x = pk2(v[0][j], v[1][j]); o.y = pk2(v[2][j], v[3][j]); o.z = pk2(v[4][j], v[5][j]); o.w = pk2(v[6][j], v[7][j]);
            const int c = nc + j; const int slot = kind == 2 ? slot_perm8(c) : (c >> 7) * 256 + slot_pair128(c & 127, kind);
            *(u32x4*)(dst + (size_t)slot * K) = o; }
    }
};
__device__ __forceinline__ void convert_experts(const Args& a, const Frame& F, int layer, int gw, int NGW, LAS float*  ) {
    constexpr int NIT = NE * 768;
    if (gw >= NIT) return;
    ConvItem cur, nxt; cur.load(a, F.ws, layer, gw, F.lane);
#pragma unroll 1
    for (int it = gw; it < NIT; it += NGW) {
        const int itn = it + NGW < NIT ? it + NGW : it;
        nxt.load(a, F.ws, layer, itn, F.lane);
        cur.store();
        cur = nxt;
    }
}

__device__ __forceinline__ void phase_prep(const Args& a, const Frame& F0) {
    const Frame F = refresh(F0);
    LAS float* scr = (LAS float*)(F.lds + F.wave * 16384);
    const int gw = F.vcu * NWAVES + F.wave, NGW = F.G * NWAVES;
    const int gt = gw * 64 + F.lane, NGT = NGW * 64;
    unsigned char* ws = F.ws;
    { const float* x = a.in[I_X]; bf16_t* XB = (bf16_t*)(ws + WS_RA); float* R0 = (float*)(ws + WS_R0);
      for (int m = gw; m < NT; m += NGW) { const f32x4* xr = (const f32x4*)(x + (size_t)m * D) + F.lane; f32x4 v[4]; float s = 0.f;
#pragma unroll
          for (int j = 0; j < 4; ++j) { v[j] = xr[64 * j]; s += (v[j][0] * v[j][0] + v[j][1] * v[j][1]) + (v[j][2] * v[j][2] + v[j][3] * v[j][3]); }
          s = wave_sum(s); if (F.lane == 0) R0[m] = 1.0f / sqrtf(s * (1.0f / D) + RMS_EPS);
          u32x2* o8 = (u32x2*)(XB + (size_t)m * D) + F.lane;
#pragma unroll
          for (int j = 0; j < 4; ++j) o8[64 * j] = pack4(v[j]); } }
    { const int* pos = (const int*)a.in[I_POS]; f32x2* rope = (f32x2*)(ws + WS_ROPE);
      for (int i = gt; i < NT * 32; i += NGT) { const float ang = (float)pos[i >> 5] * a.inv_freq[i & 31];
          double rev = (double)ang * 0.15915494309189533577; rev -= __builtin_rint(rev); const float rf = (float)rev;
          rope[i] = (f32x2){__builtin_amdgcn_cosf(rf), __builtin_amdgcn_sinf(rf)}; } }
    { constexpr int I_IN = 16 * 96, I_OUT = 16 * 32, I_KV = 16 * 48, I_AIN = 16 * 34, I_C1 = 32 * 8, I_AO = 16 * 32;
      constexpr int NI = I_IN + I_OUT + I_KV + I_AIN + 2 * I_C1 + I_AO;
      for (int it = gw; it < NI; it += NGW) { int r = it;
          if (r < I_IN) { transpose_item(a.in[I_CWIN], D, 3 * D, (bf16_t*)(ws + WS_WIN), a.in[I_NMIX], scr, r, F.lane, MapWin{}); continue; } r -= I_IN;
          if (r < I_OUT) { transpose_item(a.in[I_CWOUT], D, D, (bf16_t*)(ws + WS_WOUT), nullptr, scr, r, F.lane, MapIdent{}); continue; } r -= I_OUT;
          if (r < I_KV) { transpose_item(a.in[I_WKV], D, 1536, (bf16_t*)(ws + WS_WQKV), a.in[I_NKV], scr, r, F.lane, MapKV{}); continue; } r -= I_KV;
          if (r < I_AIN) { transpose_item(a.in[I_AWIN], D, 1072, (bf16_t*)(ws + WS_WQKV), a.in[I_NMIX] + D, scr, r, F.lane, MapAIn{}); continue; } r -= I_AIN;
          if (r < I_C1) { transpose_item(a.in[I_CW1K], 2048, 256, (bf16_t*)(ws + WS_WC1), nullptr, scr, r, F.lane, MapPerm8{}); continue; } r -= I_C1;
          if (r < I_C1) { transpose_item(a.in[I_CW1V], 2048, 256, (bf16_t*)(ws + WS_WC1) + 256 * 2048, nullptr, scr, r, F.lane, MapPerm8{}); continue; } r -= I_C1;
          transpose_item(a.in[I_AWOUT], D, D, (bf16_t*)(ws + WS_WAO), nullptr, scr, r, F.lane, MapIdent{});
      } }
    convert_experts(a, F, 0, gw, NGW, scr);
    { unsigned* z = (unsigned*)((bf16_t*)(ws + WS_WQKV) + (size_t)2608 * D); for (int i = gt; i < 208 * D / 2; i += NGT) z[i] = 0u; }
    { float* bc = (float*)(ws + WS_BIASC);
      for (int o = gw; o < 512; o += NGW) { const int kv = o >> 8, n = o & 255; const float* pos = a.in[kv ? I_CPV : I_CPK]; const float* w1 = a.in[kv ? I_CW1V : I_CW1K]; float s = 0.f;
          for (int i = F.lane; i < 2048; i += 64) s += pos[i] * w1[(size_t)i * 256 + n];
          s = wave_sum(s); if (F.lane == 0) bc[o] = s; } }
    { float* rw = (float*)(ws + WS_RW);
      for (int i = gt; i < 2 * 36 * 1024; i += NGT) { const int l = i / (36 * 1024), r = i % (36 * 1024), o = r >> 10, k = r & 1023;
          const float g = a.in[I_NFFN][l * D + k]; rw[i] = g * (o < 32 ? a.in[I_REW][((size_t)l * D + k) * 32 + o] : a.in[I_RGW][((size_t)l * D + k) * 4 + (o - 32)]); } }
    { bf16_t* w2t = (bf16_t*)(ws + WS_W2T);
      for (int i = gt; i < 2 * 64 * 256; i += NGT) { const int kv = i >> 14, r = i & 16383, n = r >> 8, k = r & 255; w2t[i] = (bf16_t)f2bf(a.in[kv ? I_CW2V : I_CW2K][k * 64 + n]); } }
}

__device__ __forceinline__ void phase_conv(const Args& a, const Frame& F0) {
    const Frame F = refresh(F0);
    const bf16_t* BG = (const bf16_t*)(F.ws + WS_RB); const bf16_t* U = (const bf16_t*)(F.ws + WS_RC); bf16_t* Z = (bf16_t*)(F.ws + WS_RA);
    const float* cw = a.in[I_CW];
    const int cg8 = (F.tid & 127) * 8, tq = F.tid >> 7;
    float w0[8], w1[8], w2[8];
#pragma unroll
    for (int j = 0; j < 8; ++j) { w0[j] = cw[cg8 + j]; w1[j] = cw[D + cg8 + j]; w2[j] = cw[2 * D + cg8 + j]; }
    for (int ch = F.vcu; ch < NT / 32; ch += F.G) {
        const int t0 = ch * 32 + tq * 8; const int s0 = t0 & (SEQ - 1);
        float um2[8], um1[8];
        { u32x4 p = {0u, 0u, 0u, 0u}, q = {0u, 0u, 0u, 0u};
          if (s0 >= 2) p = *(const u32x4*)(U + (size_t)(t0 - 2) * D + cg8);
          if (s0 >= 1) q = *(const u32x4*)(U + (size_t)(t0 - 1) * D + cg8);
#pragma unroll
          for (int j = 0; j < 4; ++j) { um2[2 * j] = bflo(p[j]); um2[2 * j + 1] = bfhi(p[j]); um1[2 * j] = bflo(q[j]); um1[2 * j + 1] = bfhi(q[j]); } }
#pragma unroll
        for (int i = 0; i < 8; ++i) {
            const u32x4 uu = *(const u32x4*)(U + (size_t)(t0 + i) * D + cg8), bb = *(const u32x4*)(BG + (size_t)(t0 + i) * D + cg8);
            float z[8];
#pragma unroll
            for (int j = 0; j < 4; ++j) { const float u0 = bflo(uu[j]), u1 = bfhi(uu[j]);
                z[2 * j] = bflo(bb[j]) * (w0[2 * j] * um2[2 * j] + w1[2 * j] * um1[2 * j] + w2[2 * j] * u0);
                z[2 * j + 1] = bfhi(bb[j]) * (w0[2 * j + 1] * um2[2 * j + 1] + w1[2 * j + 1] * um1[2 * j + 1] + w2[2 * j + 1] * u1);
                um2[2 * j] = um1[2 * j]; um2[2 * j + 1] = um1[2 * j + 1]; um1[2 * j] = u0; um1[2 * j + 1] = u1; }
            u32x4 o; o.x = pk2(z[0], z[1]); o.y = pk2(z[2], z[3]); o.z = pk2(z[4], z[5]); o.w = pk2(z[6], z[7]);
            *(u32x4*)(Z + (size_t)(t0 + i) * D + cg8) = o;
        }
    }
}

__device__ __forceinline__ void phase_router(const Args& a, const Frame& F0, int layer, const float* X, bf16_t* XnB, float* Rout) {
    const Frame F = refresh(F0);
    unsigned char* ws = F.ws;
    const float* rw = (const float*)(ws + WS_RW) + (size_t)layer * 36 * 1024;
    const float* brg = a.in[I_RGB] + layer * 4; const float* bre = a.in[I_REB] + layer * 32;
    unsigned* gcnt = (unsigned*)(ws + WS_CTL) + CW_CNT + layer * 32;
    int* rowl = (int*)(ws + WS_ROWL); float* rowr = (float*)(ws + WS_ROWR); float* wgt = (float*)(ws + WS_WGT);
    constexpr int XT_LD = 260;
    LAS float* xt = (LAS float*)(F.lds) + F.wave * (16 * XT_LD);
    LAS float* lg = xt;
    LAS unsigned* cntl = (LAS unsigned*)(F.lds + 8 * 16 * XT_LD * 4); LAS unsigned* basel = cntl + 32;
    const int l15 = F.lane & 15, quad = F.lane >> 4;
    for (int base = F.vcu * 128; base < NT; base += F.G * 128) {
        if (F.tid < 32) cntl[F.tid] = 0u;
        const int tok0 = base + F.wave * 16, tok = tok0 + l15;
        const float* w0 = rw + (size_t)l15 * 1024 + 4 * quad; const float* w1 = w0 + 16 * 1024; const float* w2 = rw + (size_t)(32 + (l15 & 3)) * 1024 + 4 * quad;
        f32x4 acc0 = {0.f, 0.f, 0.f, 0.f}, acc1 = acc0, acc2 = acc0; float ss = 0.f;
        f32x4 nxt[16];
#pragma unroll
        for (int r = 0; r < 16; ++r) nxt[r] = *(const f32x4*)(X + (size_t)(tok0 + r) * D + 4 * F.lane);
#pragma unroll 1
        for (int ch = 0; ch < 4; ++ch) {
#pragma unroll
            for (int r = 0; r < 16; ++r) { *(LAS f32x4*)(xt + r * XT_LD + 4 * F.lane) = nxt[r]; *(u32x2*)(XnB + (size_t)(tok0 + r) * D + 256 * ch + 4 * F.lane) = pack4(nxt[r]); }
            if (ch < 3) {
#pragma unroll
                for (int r = 0; r < 16; ++r) nxt[r] = *(const f32x4*)(X + (size_t)(tok0 + r) * D + 256 * (ch + 1) + 4 * F.lane); }
#pragma unroll 4
            for (int i = 0; i < 16; ++i) {
                const int k0 = 256 * ch + 16 * i;
                const f32x4 xv = *(const LAS f32x4*)(xt + l15 * XT_LD + 16 * i + 4 * quad), b0 = *(const f32x4*)(w0 + k0), b1 = *(const f32x4*)(w1 + k0), b2 = *(const f32x4*)(w2 + k0);
                ss += (xv[0] * xv[0] + xv[1] * xv[1]) + (xv[2] * xv[2] + xv[3] * xv[3]);
#pragma unroll
                for (int jj = 0; jj < 4; ++jj) {
                    acc0 = __builtin_amdgcn_mfma_f32_16x16x4f32(xv[jj], b0[jj], acc0, 0, 0, 0);
                    acc1 = __builtin_amdgcn_mfma_f32_16x16x4f32(xv[jj], b1[jj], acc1, 0, 0, 0);
                    acc2 = __builtin_amdgcn_mfma_f32_16x16x4f32(xv[jj], b2[jj], acc2, 0, 0, 0);
                }
            }
        }
        ss += __shfl_xor(ss, 16); ss += __shfl_xor(ss, 32);
        const float r = 1.0f / sqrtf(ss * (1.0f / D) + RMS_EPS);
        if (quad == 0) Rout[tok] = r;
#pragma unroll
        for (int i = 0; i < 4; ++i) { const float rt = __shfl(r, 4 * quad + i); const int trow = 4 * quad + i;
            lg[trow * 36 + l15] = acc0[i] * rt + bre[l15]; lg[trow * 36 + 16 + l15] = acc1[i] * rt + bre[16 + l15];
            if (l15 < 4) lg[trow * 36 + 32 + l15] = acc2[i] * rt + brg[l15]; }
        __syncthreads();
        int e0 = 0, e1 = 0, rk0 = 0, rk1 = 0; float wt0 = 0.f, wt1 = 0.f;
        if (F.lane < 16) {
            const LAS float* L = lg + F.lane * 36;
            const float g0 = L[32], g1 = L[33], g2 = L[34], g3 = L[35];
            float gm = g0; int gt = 0; if (g1 > gm) { gm = g1; gt = 1; } if (g2 > gm) { gm = g2; gt = 2; } if (g3 > gm) { gm = g3; gt = 3; }
            const float pg = 1.0f / (expf(g0 - gm) + expf(g1 - gm) + expf(g2 - gm) + expf(g3 - gm));
            float v0 = -INFINITY, v1 = -INFINITY; int i0 = 0, i1 = 0;
#pragma unroll
            for (int k = 0; k < 8; ++k) { const float v = L[8 * gt + k]; if (v > v0) { v1 = v0; i1 = i0; v0 = v; i0 = k; } else if (v > v1) { v1 = v; i1 = k; } }
            const float ex = expf(v1 - v0); const float s0 = 1.0f / (1.0f + ex);
            wt0 = pg * s0; wt1 = pg * (ex * s0); e0 = 8 * gt + i0; e1 = 8 * gt + i1;
            rk0 = (int)atomicAdd((unsigned*)&cntl[e0], 1u); rk1 = (int)atomicAdd((unsigned*)&cntl[e1], 1u);
        }
        __syncthreads();
        if (F.tid < 32) { const unsigned c = cntl[F.tid]; basel[F.tid] = c ? __hip_atomic_fetch_add(gcnt + F.tid, c, __ATOMIC_RELAXED, __HIP_MEMORY_SCOPE_AGENT) : 0u; }
        __syncthreads();
        if (F.lane < 16) {
            const int tk = base + F.wave * 16 + F.lane; const float rr = r;
            const size_t s0 = (size_t)e0 * ECAP + basel[e0] + rk0, s1 = (size_t)e1 * ECAP + basel[e1] + rk1;
            rowl[s0] = 2 * tk; rowr[s0] = rr; wgt[2 * tk] = wt0;
            rowl[s1] = 2 * tk + 1; rowr[s1] = rr; wgt[2 * tk + 1] = wt1;
        }
        __syncthreads();
    }
}

template <bool FINAL>
__device__ __forceinline__ void phase_combine(const Args& a, const Frame& F0, float* X, bf16_t* XnB, float* Rout) {
    const Frame F = refresh(F0);
    const bf16_t* Y = (const bf16_t*)(F.ws + WS_RB);
    const int gw = F.vcu * NWAVES + F.wave, NGW = F.G * NWAVES;
    for (int m = gw; m < NT; m += NGW) {
        f32x4* xr = (f32x4*)(X + (size_t)m * D) + F.lane; const u32x2* y0 = (const u32x2*)(Y + (size_t)(2 * m) * D) + F.lane; const u32x2* y1 = (const u32x2*)(Y + (size_t)(2 * m + 1) * D) + F.lane;
        f32x4 v[4]; float s = 0.f;
#pragma unroll
        for (int j = 0; j < 4; ++j) { v[j] = xr[64 * j]; const u32x2 p = y0[64 * j], q = y1[64 * j];
            v[j][0] += bflo(p[0]) + bflo(q[0]); v[j][1] += bfhi(p[0]) + bfhi(q[0]); v[j][2] += bflo(p[1]) + bflo(q[1]); v[j][3] += bfhi(p[1]) + bfhi(q[1]);
            s += (v[j][0] * v[j][0] + v[j][1] * v[j][1]) + (v[j][2] * v[j][2] + v[j][3] * v[j][3]); }
        s = wave_sum(s); const float r = 1.0f / sqrtf(s * (1.0f / D) + RMS_EPS);
        if constexpr (FINAL) {
            const f32x4* g = (const f32x4*)a.in[I_NFIN] + F.lane;
#pragma unroll
            for (int j = 0; j < 4; ++j) xr[64 * j] = v[j] * r * g[64 * j];
        } else {
            if (F.lane == 0) Rout[m] = r;
            u32x2* o8 = (u32x2*)(XnB + (size_t)m * D) + F.lane;
#pragma unroll
            for (int j = 0; j < 4; ++j) { xr[64 * j] = v[j]; o8[64 * j] = pack4(v[j]); }
        }
    }
}

__device__ __forceinline__ void phase_cmp2(const Frame& F0) {
    const Frame F = refresh(F0);
    const bf16_t* HID = (const bf16_t*)(F.ws + WS_RD + RD_HID); const bf16_t* W2T = (const bf16_t*)(F.ws + WS_W2T);
    bf16_t* KCMP = (bf16_t*)(F.ws + WS_RD + RD_KCMP); bf16_t* VCMPT = (bf16_t*)(F.ws + WS_RD + RD_VCMPT);
    const int gw = F.vcu * NWAVES + F.wave, NGW = F.G * NWAVES, l15 = F.lane & 15, quad = F.lane >> 4;
    for (int task = gw; task < 1024; task += NGW) {
        const int kv = task >> 9, r0 = (task & 511) * 16;
        const bf16_t* ap = HID + ((size_t)kv * 8192 + r0 + l15) * 256 + 8 * quad; const bf16_t* bp = W2T + (size_t)kv * 64 * 256 + (size_t)l15 * 256 + 8 * quad;
        f32x4 acc[4];
#pragma unroll
        for (int cb = 0; cb < 4; ++cb) acc[cb] = (f32x4){0.f, 0.f, 0.f, 0.f};
#pragma unroll
        for (int ks = 0; ks < 8; ++ks) { const bf16x8 af = *(const bf16x8*)(ap + 32 * ks);
#pragma unroll
            for (int cb = 0; cb < 4; ++cb) acc[cb] = __builtin_amdgcn_mfma_f32_16x16x32_bf16(af, *(const bf16x8*)(bp + (size_t)cb * 16 * 256 + 32 * ks), acc[cb], 0, 0, 0); }
#pragma unroll
        for (int cb = 0; cb < 4; ++cb)
#pragma unroll
            for (int i = 0; i < 4; ++i) { const int row = r0 + 4 * quad + i, bg = row >> 10, c = row & 1023, col = l15 + 16 * cb;
                if (kv == 0) KCMP[((size_t)bg * 1024 + c) * 64 + col] = (bf16_t)f2bf(acc[cb][i]);
                else VCMPT[((size_t)bg * 64 + col) * 1024 + c] = (bf16_t)f2bf(acc[cb][i]); }
    }
}

namespace nsa {
constexpr int SLOTB = 16384;
constexpr int NS_CMP = 4, NS_SW = 8;
constexpr int A_IMP = NS_CMP * SLOTB, IMP_LD = 260, A_SELM = 145408, A_UW = A_SELM + 64 * 8 * 4, A_UB = A_UW + 64 * 4, A_TL = A_UB + 64, A_END = A_TL + 260 * 4;
static_assert(A_IMP + 64 * IMP_LD * 4 <= A_SELM && NS_SW * SLOTB <= A_SELM && A_END <= MISC_OFF, "attention LDS");
struct Ctx { int tid, lane, wave, l15, quad, qi, h, sw; LAS unsigned char* lds; };
struct SubState { float m, l, L; f32x4 O[4]; };

template <int MODE>
__device__ __forceinline__ void sub_scores(const Ctx& c, const LAS unsigned char* kb, int kc0, int kc1, const bf16x8 (&qf)[2], SubState& st, int lo, int hi, bool rowsel, bool needmask, int kidx0, float invl, int sgi, bf16x8 (&pf)[2]) {
    constexpr float THR = 8.0f;
    const float mr = (st.m == -INFINITY) ? 0.f : st.m;
    const float cneg = (MODE == 2 && !rowsel) ? -INFINITY : -mr;
    const f32x4 cinit = {cneg, cneg, cneg, cneg};
    f32x4 S[4];
#pragma unroll
    for (int mb = 0; mb < 4; ++mb) {
        const bf16x8 k0 = *(const LAS bf16x8*)(kb + mb * 2048 + kc0), k1 = *(const LAS bf16x8*)(kb + mb * 2048 + kc1);
        S[mb] = __builtin_amdgcn_mfma_f32_16x16x32_bf16(k0, qf[0], cinit, 0, 0, 0);
        S[mb] = __builtin_amdgcn_mfma_f32_16x16x32_bf16(k1, qf[1], S[mb], 0, 0, 0); }
    if (needmask) {
#pragma unroll
        for (int mb = 0; mb < 4; ++mb)
#pragma unroll
            for (int i = 0; i < 4; ++i) { const int off = 16 * mb + 4 * c.quad + i; S[mb][i] = (off >= lo && off <= hi) ? S[mb][i] : -INFINITY; }
    }
    if (MODE != 1) {
        float tmax = max3f(S[0][0], S[0][1], S[0][2]), tmx2 = max3f(S[0][3], S[1][0], S[1][1]);
        tmax = max3f(tmax, S[1][2], S[1][3]); tmx2 = max3f(tmx2, S[2][0], S[2][1]); tmax = max3f(tmax, S[2][2], S[2][3]); tmx2 = max3f(tmx2, S[3][0], S[3][1]); tmax = max3f(tmax, S[3][2], S[3][3]); tmax = fmaxf(tmax, tmx2);
        const bool fresh = st.m == -INFINITY;
        if (__any((tmax > THR) || (fresh && tmax > -INFINITY))) {
            tmax = max_x16(tmax); tmax = max_x32(tmax);
            const bool upd = (tmax > THR) || (fresh && tmax > -INFINITY);
            const float d = upd ? tmax : 0.f;
            const float alpha = fresh ? 1.0f : __builtin_amdgcn_exp2f(-d);
#pragma unroll
            for (int mb = 0; mb < 4; ++mb) S[mb] = S[mb] - d;
            st.l *= alpha;
            if (MODE != 0) { st.L = st.L * alpha;
#pragma unroll
                for (int db = 0; db < 4; ++db) st.O[db] = st.O[db] * alpha; }
            st.m = upd ? mr + d : st.m;
        }
    }
    float ps = 0.f;
#pragma unroll
    for (int mb = 0; mb < 4; ++mb)
#pragma unroll
        for (int i = 0; i < 4; ++i) { float p = __builtin_amdgcn_exp2f(S[mb][i]); if (MODE == 1) p *= invl; S[mb][i] = p; if (MODE == 0) ps += p; }
    if (MODE == 0) { st.l += ps; return; }
    if (MODE == 1) {
        LAS float* imp = (LAS float*)(c.lds + A_IMP) + (c.wave * 8 + sgi * 4 + c.qi) * IMP_LD + (kidx0 >> 2) + c.quad;
        float bprev = st.L;
#pragma unroll
        for (int mb = 0; mb < 4; ++mb) { float a = (S[mb][0] + S[mb][1]) + (S[mb][2] + 0.5f * S[mb][3]), b = 0.5f * S[mb][3];
            a += dpp_x1(a); a += dpp_x2(a); b += dpp_x1(b); b += dpp_x2(b);
            const auto r16 = __builtin_amdgcn_permlane16_swap(__float_as_uint(b), __float_as_uint(b), false, false);
            const auto r32 = __builtin_amdgcn_permlane32_swap(r16[1], r16[1], false, false);
            const float bsh = (c.quad & 1) ? __uint_as_float(r16[0]) : (c.quad == 2 ? __uint_as_float(r32[0]) : bprev);
            bprev = __uint_as_float(r32[1]);
            if (c.h == 0) imp[4 * mb] = a + bsh; }
        st.L = bprev;
    }
#pragma unroll
    for (int k2 = 0; k2 < 2; ++k2) { const u32x4 w = pack8(S[2 * k2], S[2 * k2 + 1]); pf[k2] = __builtin_bit_cast(bf16x8, w); }
    if (MODE != 1) {
        const bf16x8 ones = {0x3F80, 0x3F80, 0x3F80, 0x3F80, 0x3F80, 0x3F80, 0x3F80, 0x3F80};
        f32x4 la = __builtin_amdgcn_mfma_f32_16x16x32_bf16(ones, pf[0], (f32x4){0.f, 0.f, 0.f, 0.f}, 0, 0, 0);
        la = __builtin_amdgcn_mfma_f32_16x16x32_bf16(ones, pf[1], la, 0, 0, 0); st.L += la[0]; }
}
template <int MODE, bool A0, bool A1>
__device__ __forceinline__ void tile_compute2(const Ctx& c, int slotoff, const bf16x8 (&qf)[2][2], SubState (&st)[2], const int (&lo)[2], const int (&hi)[2], const bool (&rowsel)[2], const bool (&needmask)[2], int kidx0, const float (&invl)[2]) {
    const LAS unsigned char* kb = c.lds + slotoff + c.l15 * 128;
    const LAS unsigned char* vb = c.lds + slotoff + 8192 + c.l15 * 128 + 8 * (c.quad & 1);
    const int kc0 = ((c.quad) ^ c.sw) * 16, kc1 = ((4 + c.quad) ^ c.sw) * 16;
    const int vq = c.quad >> 1;
    const int vc[2][2] = {{((vq) ^ c.sw) * 16, ((vq + 2) ^ c.sw) * 16}, {((4 + vq) ^ c.sw) * 16, ((6 + vq) ^ c.sw) * 16}};
    bf16x8 pf[2][2];
    if (A0) sub_scores<MODE>(c, kb, kc0, kc1, qf[0], st[0], lo[0], hi[0], rowsel[0], needmask[0], kidx0, invl[0], 0, pf[0]);
    if (A1) sub_scores<MODE>(c, kb, kc0, kc1, qf[1], st[1], lo[1], hi[1], rowsel[1], needmask[1], kidx0, invl[1], 1, pf[1]);
    if (MODE == 0) return;
#pragma unroll
    for (int db = 0; db < 4; ++db)
#pragma unroll
        for (int k2 = 0; k2 < 2; ++k2) {
            const s16x4 a = *(const LAS s16x4*)(vb + db * 2048 + vc[k2][0]), b = *(const LAS s16x4*)(vb + db * 2048 + vc[k2][1]);
            const bf16x8 vf = (bf16x8){a[0], a[1], a[2], a[3], b[0], b[1], b[2], b[3]};
            if (A0) st[0].O[db] = __builtin_amdgcn_mfma_f32_16x16x32_bf16(vf, pf[0][k2], st[0].O[db], 0, 0, 0);
            if (A1) st[1].O[db] = __builtin_amdgcn_mfma_f32_16x16x32_bf16(vf, pf[1][k2], st[1].O[db], 0, 0, 0);
        }
}
template <int MODE>
__device__ __forceinline__ void tile_compute(const Ctx& c, int slotoff, const bf16x8 (&qf)[2][2], SubState (&st)[2], const int (&lo)[2], const int (&hi)[2], const bool (&rowsel)[2], const bool (&act)[2], int kidx0, const float (&invl)[2]) {
    bool needmask[2];
#pragma unroll
    for (int s = 0; s < 2; ++s) needmask[s] = __any((MODE == 2 ? rowsel[s] : true) && (lo[s] > 0 || hi[s] < 63)) != 0;
    if (act[0] && act[1]) tile_compute2<MODE, true, true>(c, slotoff, qf, st, lo, hi, rowsel, needmask, kidx0, invl);
    else if (act[0]) tile_compute2<MODE, true, false>(c, slotoff, qf, st, lo, hi, rowsel, needmask, kidx0, invl);
    else if (act[1]) tile_compute2<MODE, false, true>(c, slotoff, qf, st, lo, hi, rowsel, needmask, kidx0, invl);
}
}

namespace nsa {
struct Tensors { const bf16_t* Q; const f32x2* rope; const float* gates; const bf16_t *KS, *VTS, *KW, *VTW, *KCMP, *VCMPT; bf16_t* O; bf16_t* DBG; float* SCR; float* PROBE; };

struct Dma {
    int wave; unsigned koff, voffrow, vchk;
    __device__ __forceinline__ void init(int wave_, int lane) { wave = wave_; const int row = 8 * wave_ + (lane >> 3), chs = (lane & 7) ^ ((row >> 1) & 7); koff = (unsigned)(row * 64 + chs * 8); voffrow = (unsigned)row; vchk = (unsigned)(chs * 8); }
    __device__ __forceinline__ void issue(LAS unsigned char* lds, int slotoff, const bf16_t* K, const bf16_t* VT, size_t vpitch, int kidx0, bool withv = true) const {
        __builtin_amdgcn_global_load_lds((const unsigned*)(K + (size_t)kidx0 * 64 + koff), (LAS unsigned*)(lds + slotoff + wave * 1024), 16, 0, 0);
        if (withv) __builtin_amdgcn_global_load_lds((const unsigned*)(VT + (size_t)voffrow * vpitch + kidx0 + vchk), (LAS unsigned*)(lds + slotoff + 8192 + wave * 1024), 16, 0, 0);
    }
};
#define NSA_WAIT_V(n) asm volatile("s_waitcnt vmcnt(" #n ")" ::: "memory")
#define NSA_BAR() do { asm volatile("" ::: "memory"); __builtin_amdgcn_s_barrier(); asm volatile("" ::: "memory"); } while (0)
#define NSA_RING_BG(G, WITHV, NTILES, TILE, BODY) do { \
        const int n_ = (NTILES); int so_ = 0; \
        _Pragma("unroll") for (int k_ = 0; k_ < (G); ++k_) if (k_ < n_) dma.issue(lds, k_ * SLOTB, KPTR, VPTR, VPITCH, TILE(k_), WITHV); \
        _Pragma("unroll 1") for (int i_ = 0; i_ < n_; ++i_) { \
            if ((i_ % (G)) == 0) { NSA_WAIT_V(0); NSA_BAR(); const int other_ = (((i_ / (G)) & 1) ? 0 : (G) * SLOTB); \
                _Pragma("unroll") for (int k_ = 0; k_ < (G); ++k_) if (i_ + (G) + k_ < n_) dma.issue(lds, other_ + k_ * SLOTB, KPTR, VPTR, VPITCH, TILE(i_ + (G) + k_), WITHV); } \
            BODY(i_, so_); \
            so_ = (so_ == (2 * (G) - 1) * SLOTB) ? 0 : so_ + SLOTB; } \
        NSA_WAIT_V(0); NSA_BAR(); } while (0)
#define NSA_RING_B4(NTILES, TILE, BODY) NSA_RING_BG(4, true, NTILES, TILE, BODY)
#define NSA_RING(NS, WITHV, NTILES, TILE, BODY) do { \
        const int n_ = (NTILES); int sl_issue_ = 0, sl_cur_ = 0; \
        _Pragma("unroll") for (int p_ = 0; p_ < (NS) - 1; ++p_) { const int ti_ = p_ < n_ ? p_ : n_ - 1; dma.issue(lds, sl_issue_, KPTR, VPTR, VPITCH, TILE(ti_), WITHV); sl_issue_ += SLOTB; } \
        _Pragma("unroll 1") for (int i_ = 0; i_ < n_; ++i_) { \
            static_assert((NS) == 3 || (NS) == 4, "ring depth"); \
            if ((NS) == 3) { if (WITHV) NSA_WAIT_V(2); else NSA_WAIT_V(1); } else { if (WITHV) NSA_WAIT_V(4); else NSA_WAIT_V(2); } \
            NSA_BAR(); \
            { const int ti_ = (i_ + (NS) - 1) < n_ ? (i_ + (NS) - 1) : n_ - 1; dma.issue(lds, sl_issue_, KPTR, VPTR, VPITCH, TILE(ti_), WITHV); sl_issue_ = (sl_issue_ == ((NS) - 1) * SLOTB) ? 0 : sl_issue_ + SLOTB; } \
            BODY(i_, sl_cur_); \
            sl_cur_ = (sl_cur_ == ((NS) - 1) * SLOTB) ? 0 : sl_cur_ + SLOTB; } \
        NSA_WAIT_V(0); NSA_BAR(); } while (0)


constexpr int QT_HP = 128, QT_QP = 512, I_STG = 64 * QT_QP, STG_COL = 144, STG_JOB = 16 * STG_COL, STG_BUF = 8 * STG_JOB;
constexpr int I_RIDX = I_STG + 2 * STG_BUF, I_JOBS = I_RIDX + 1024, I_CM = I_JOBS + 2080, I_NJ = I_CM + 2048, I_JOBQ = I_NJ + 1040, I_MREF = I_JOBQ + 2080, I_VSL = ((I_MREF + 1024 + 1023) / 1024) * 1024, I_INV_END = I_VSL + 8 * 8192;
static_assert(I_INV_END <= A_SELM && (I_CM % 8) == 0, "inverted-branch LDS map");
__device__ __forceinline__ int nth_set_bit(unsigned long long m, int r) {
    const unsigned lo = (unsigned)m, hi = (unsigned)(m >> 32); int c = __popc(lo); const bool up = r >= c; unsigned w = up ? hi : lo; int base = up ? 32 : 0; r -= up ? c : 0;
#pragma unroll
    for (int sh = 16; sh >= 1; sh >>= 1) { const unsigned low = w & ((1u << sh) - 1u); c = __popc(low); const bool u2 = r >= c; r -= u2 ? c : 0; base += u2 ? sh : 0; w = u2 ? (w >> sh) : low; }
    return base;
}
__device__ __forceinline__ void selected_inverted(const Ctx& c, const Tensors& T, LAS unsigned char* lds, const bf16x8 (&qr)[2][2], SubState (&st)[2], int t0, int bg, int qt) {
    constexpr float L2E = 1.4426950408889634f;
    const LAS unsigned* selm = (const LAS unsigned*)(lds + A_SELM);
    LAS unsigned long long* CM = (LAS unsigned long long*)(lds + I_CM); LAS int* NJ = (LAS int*)(lds + I_NJ); LAS unsigned* JOBS = (LAS unsigned*)(lds + I_JOBS);
#pragma unroll
    for (int s = 0; s < 2; ++s) { LAS unsigned char* qd = lds + (c.wave * 8 + 4 * s + c.qi) * QT_QP + c.h * QT_HP + 16 * c.quad; *(LAS bf16x8*)qd = qr[s][0]; *(LAS bf16x8*)(qd + 64) = qr[s][1]; }
    { const unsigned word = selm[c.lane * 8 + c.wave]; unsigned long long mine = 0ull;
#pragma unroll 1
      for (int jj = 0; jj < 32; ++jj) { const unsigned long long m = __ballot((word >> jj) & 1u); mine = (c.lane == jj) ? m : mine; }
      if (c.lane < 32) { const int jb = 32 * c.wave + c.lane; CM[jb] = (jb == 0 || jb == qt || jb == qt - 1) ? 0ull : mine; } }
    if (c.tid < 256) ((LAS unsigned*)(lds + I_RIDX))[c.tid] = 0xFFFFFFFFu;
#pragma unroll
    for (int s = 0; s < 2; ++s) if (c.quad == 0) ((LAS float*)(lds + I_MREF))[(c.wave * 8 + 4 * s + c.qi) * 4 + c.h] = st[s].m;
    __syncthreads();
    if (c.tid < 256) NJ[c.tid] = (__popcll(CM[c.tid]) + 3) >> 2;
    __syncthreads();
    if (c.tid < 256) { int pre = 0; const int i4 = c.tid >> 2;
#pragma clang loop vectorize(disable) unroll(disable)
        for (int i = 0; i < i4; ++i) { const LAS int* p4 = NJ + 4 * i; pre += (p4[0] + p4[1]) + (p4[2] + p4[3]); }
#pragma clang loop vectorize(disable) unroll(disable)
        for (int i = 4 * i4; i < c.tid; ++i) pre += NJ[i];
        const int cnt = NJ[c.tid];
        unsigned long long mrem = CM[c.tid];
        for (int t = 0; t < cnt; ++t) { JOBS[pre + t] = (unsigned)c.tid | ((unsigned)t << 16); unsigned qb = 0u;
#pragma unroll
            for (int u = 0; u < 4; ++u) { unsigned q = 0xffu; if (mrem) { q = (unsigned)__ffsll((long long)mrem) - 1u; mrem &= mrem - 1ull; } qb |= q << (8 * u); }
            ((LAS unsigned*)(lds + I_JOBQ))[pre + t] = qb; }
        if (c.tid == 255) NJ[256] = pre + cnt; }
    __syncthreads();
    const int njobs = __builtin_amdgcn_readfirstlane(NJ[256]), nrounds = (njobs + 7) >> 3;
    if (njobs == 0) { __syncthreads(); return; }
    const bf16_t* Ks = T.KS + (size_t)bg * SEQ * 64; const bf16_t* Vs = T.VTS + (size_t)bg * 64 * SEQ;
    const unsigned koff = (unsigned)((8 * (c.l15 >> 2) + (c.l15 & 3)) * 64 + 8 * c.quad);
    bf16x8 kf[4][2];
    const int vslot = I_VSL + c.wave * 8192;
    const unsigned vdoff = (unsigned)((c.lane >> 3) * SEQ + (unsigned)(((c.lane & 7) ^ ((c.lane >> 4) & 7)) * 8));
#define VDMA(jblk) do { const bf16_t* vb_ = Vs + (size_t)(64 * (jblk)); _Pragma("unroll") for (int i_ = 0; i_ < 8; ++i_) { \
        const unsigned ch_ = (unsigned)((((c.lane & 7) ^ ((4 * i_ + (c.lane >> 4)) & 7))) * 8); \
        __builtin_amdgcn_global_load_lds((const unsigned*)(vb_ + (size_t)(8 * i_ + (c.lane >> 3)) * SEQ + ch_), (LAS unsigned*)(lds + vslot + i_ * 1024), 16, 0, 0); } } while (0)
    {   const int ji0 = min(c.wave * nrounds, njobs - 1); const int j0 = __builtin_amdgcn_readfirstlane((int)(JOBS[ji0] & 0xffffu));
        const bf16_t* kb = Ks + (size_t)(64 * j0) * 64;
#pragma unroll
        for (int mb = 0; mb < 4; ++mb) { const unsigned ko = koff + (unsigned)((32 * (mb >> 1) + 4 * (mb & 1)) * 64); kf[mb][0] = *(const bf16x8*)(kb + ko); kf[mb][1] = *(const bf16x8*)(kb + (ko + 32u)); }
        VDMA(j0); }
    float dcur[2] = {0.f, 0.f};
    const LAS unsigned char* vfb = lds + vslot + c.l15 * 128;
    const int vch0 = ((c.quad) ^ c.sw) * 16, vch1 = ((4 + c.quad) ^ c.sw) * 16;
    int buf = 0;
#if PROBE_T
    unsigned long long tacc = 0ull, tmark;
#define TMARK() (tmark = __builtin_amdgcn_s_memtime())
#define TACC(sel) do { if (PROBE_T == (sel)) tacc += __builtin_amdgcn_s_memtime() - tmark; } while (0)
#else
#define TMARK() do {} while (0)
#define TACC(sel) do {} while (0)
#endif
#pragma unroll 1
    for (int r = 0; r < nrounds; ++r) {
        TMARK();
        const int jiu = c.wave * nrounds + r; const bool has = jiu < njobs; const int ji = has ? jiu : njobs - 1;
        const int jin = min(jiu + 1, njobs - 1);
        const unsigned jw = JOBS[ji], jwn = JOBS[jin];
        const int j = __builtin_amdgcn_readfirstlane((int)(jw & 0xffffu)), t = __builtin_amdgcn_readfirstlane((int)(jw >> 16)), jn = __builtin_amdgcn_readfirstlane((int)(jwn & 0xffffu));
        const unsigned qb = ((const LAS unsigned*)(lds + I_JOBQ))[ji]; const unsigned qraw = (qb >> (8 * c.qi)) & 0xffu; const bool valid = has && qraw != 0xffu;
        const int qidx = (int)(qraw != 0xffu ? qraw : (qb & 0xffu)); const int hi = t0 + qidx - 64 * j;
        const LAS unsigned char* qa = lds + qidx * QT_QP + c.h * QT_HP + 16 * c.quad;
        const bf16x8 q0 = *(const LAS bf16x8*)qa, q1 = *(const LAS bf16x8*)(qa + 64);
#if PROBE_T
        asm volatile("s_waitcnt lgkmcnt(0)" ::: "memory"); TACC(4); TMARK();
#endif
        const float mref = ((const LAS float*)(lds + I_MREF))[qidx * 4 + c.h];
        const f32x4 cinit = {-mref, -mref, -mref, -mref};
        f32x4 S[4];
#pragma unroll
        for (int mb = 0; mb < 4; ++mb) {
            S[mb] = __builtin_amdgcn_mfma_f32_16x16x32_bf16(kf[mb][0], q0, cinit, 0, 0, 0);
            S[mb] = __builtin_amdgcn_mfma_f32_16x16x32_bf16(kf[mb][1], q1, S[mb], 0, 0, 0); }
        const bool newblk = jn != j && r + 1 < nrounds;
        if (newblk) {   const bf16_t* kb = Ks + (size_t)(64 * jn) * 64;
#pragma unroll
            for (int mb = 0; mb < 4; ++mb) { const unsigned ko = koff + (unsigned)((32 * (mb >> 1) + 4 * (mb & 1)) * 64); kf[mb][0] = *(const bf16x8*)(kb + ko); kf[mb][1] = *(const bf16x8*)(kb + (ko + 32u)); } }
        if (__any(hi < 63)) {
#pragma unroll
            for (int mb = 0; mb < 4; ++mb)
#pragma unroll
                for (int i = 0; i < 4; ++i) { const int off = 32 * (mb >> 1) + 8 * c.quad + 4 * (mb & 1) + i; S[mb][i] = off <= hi ? S[mb][i] : -INFINITY; }
        }
        float tmax = max3f(S[0][0], S[0][1], S[0][2]), tmx2 = max3f(S[0][3], S[1][0], S[1][1]);
        tmax = max3f(tmax, S[1][2], S[1][3]); tmx2 = max3f(tmx2, S[2][0], S[2][1]); tmax = max3f(tmax, S[2][2], S[2][3]); tmx2 = max3f(tmx2, S[3][0], S[3][1]); tmax = max3f(tmax, S[3][2], S[3][3]); tmax = fmaxf(tmax, tmx2);
        float dsh = 0.f;
        if (__any(tmax > 8.0f)) { tmax = max_x16(tmax); tmax = max_x32(tmax); dsh = tmax > 8.0f ? tmax : 0.f;
#pragma unroll
            for (int mb = 0; mb < 4; ++mb) S[mb] = S[mb] - dsh; }
#pragma unroll
        for (int mb = 0; mb < 4; ++mb)
#pragma unroll
            for (int i = 0; i < 4; ++i) S[mb][i] = __builtin_amdgcn_exp2f(S[mb][i]);
        bf16x8 pf[2];
#pragma unroll
        for (int k2 = 0; k2 < 2; ++k2) { const u32x4 w = pack8(S[2 * k2], S[2 * k2 + 1]); pf[k2] = __builtin_bit_cast(bf16x8, w); }
        const bf16x8 ones = {0x3F80, 0x3F80, 0x3F80, 0x3F80, 0x3F80, 0x3F80, 0x3F80, 0x3F80};
        f32x4 la = __builtin_amdgcn_mfma_f32_16x16x32_bf16(ones, pf[0], (f32x4){0.f, 0.f, 0.f, 0.f}, 0, 0, 0);
        la = __builtin_amdgcn_mfma_f32_16x16x32_bf16(ones, pf[1], la, 0, 0, 0);
        const float ps = la[0];
#if PROBE_T
        asm volatile("s_nop 0" : "+v"(pf[0]), "+v"(pf[1])); TACC(6); TMARK();
#endif
        LAS unsigned char* sg = lds + I_STG + buf * STG_BUF + c.wave * STG_JOB + c.l15 * STG_COL;
        if (newblk) asm volatile("s_waitcnt vmcnt(8)" ::: "memory"); else asm volatile("s_waitcnt vmcnt(0)" ::: "memory");
        bf16x8 vfr[4][2];
#pragma unroll
        for (int db = 0; db < 4; ++db) { vfr[db][0] = *(const LAS bf16x8*)(vfb + db * 2048 + vch0); vfr[db][1] = *(const LAS bf16x8*)(vfb + db * 2048 + vch1); }
        asm volatile("s_waitcnt lgkmcnt(0)" ::: "memory");
        if (newblk) VDMA(jn);
#pragma unroll
        for (int db = 0; db < 4; ++db) { f32x4 o = __builtin_amdgcn_mfma_f32_16x16x32_bf16(vfr[db][0], pf[0], (f32x4){0.f, 0.f, 0.f, 0.f}, 0, 0, 0);
            o = __builtin_amdgcn_mfma_f32_16x16x32_bf16(vfr[db][1], pf[1], o, 0, 0, 0);
            *(LAS u32x2*)(sg + (16 * db + 4 * c.quad) * 2) = pack4(o); }
        if (c.quad == 0) { *(LAS f32x2*)(sg + 128) = (f32x2){dsh, ps};
            if (c.h == 0 && valid) (lds + I_RIDX + buf * 512 + qidx * 8)[c.wave] = (unsigned char)c.qi; }
        asm volatile("s_waitcnt lgkmcnt(0)" ::: "memory"); TACC(7); TACC(1); TMARK(); NSA_BAR(); TACC(2); TMARK();
#pragma unroll
        for (int s = 0; s < 2; ++s) {
            LAS unsigned char* rx = lds + I_RIDX + buf * 512 + (c.wave * 8 + 4 * s + c.qi) * 8;
            const u32x2 idx = *(const LAS u32x2*)rx;
#pragma unroll
            for (int k = 0; k < (PROBE_NOMERGE ? 0 : 8); ++k) { const unsigned u = ((k < 4 ? idx[0] : idx[1]) >> (8 * (k & 3))) & 0xffu; const bool hit = u != 0xffu;
                if (__any(hit)) {
                    const LAS unsigned char* sp = lds + I_STG + buf * STG_BUF + k * STG_JOB + ((hit ? (int)u : 0) * 4 + c.h) * STG_COL;
                    const f32x2 ml = *(const LAS f32x2*)(sp + 128);
                    const float dt = hit ? ml[0] : dcur[s], lt = hit ? ml[1] : 0.f;
                    const float dn = fmaxf(dt, dcur[s]); const float a = __builtin_amdgcn_exp2f(dcur[s] - dn), b = hit ? __builtin_amdgcn_exp2f(dt - dn) : 0.f;
                    st[s].L = st[s].L * a + lt * b; dcur[s] = dn;
#pragma unroll
                    for (int db = 0; db < 4; ++db) { const u32x2 ow = *(const LAS u32x2*)(sp + (16 * db + 4 * c.quad) * 2);
                        const f32x4 o = hit ? (f32x4){bflo(ow[0]), bfhi(ow[0]), bflo(ow[1]), bfhi(ow[1])} : (f32x4){0.f, 0.f, 0.f, 0.f};
                        st[s].O[db] = st[s].O[db] * a + o * b; }
                }
            }
            if (c.h == 0 && c.quad == 0) *(LAS u32x2*)rx = (u32x2){0xFFFFFFFFu, 0xFFFFFFFFu};
        }
        TACC(3);
        buf ^= 1;
    }
#if PROBE_T
    if (blockIdx.x == 17 && c.tid == 64 && t0 >= 64 * 200) { const float n = (float)(tacc / (unsigned long long)nrounds) * 0.01f; *((volatile float*)T.PROBE) = n; }
#endif
    asm volatile("s_waitcnt vmcnt(0)" ::: "memory");
    __syncthreads();
#undef VDMA
}

__device__ __forceinline__ void attn_unit(const Tensors& T, LAS unsigned char* lds, int tid_in, int b, int g, int qt) {
    Ctx c; { int t_ = tid_in; asm volatile("" : "+v"(t_)); c.tid = t_; } c.lane = c.tid & 63; c.wave = __builtin_amdgcn_readfirstlane(c.tid >> 6); c.l15 = c.lane & 15; c.quad = c.lane >> 4; c.qi = c.l15 >> 2; c.h = c.l15 & 3; c.sw = (c.l15 >> 1) & 7; c.lds = lds;
    const int t0 = qt * 64, bg = b * 4 + g; const unsigned tokbase = (unsigned)b * SEQ;
    Dma dma; dma.init(c.wave, c.lane);
    int tq[2]; tq[0] = t0 + c.wave * 8 + c.qi; tq[1] = tq[0] + 4;
    bf16x8 qc[2][2];
#pragma unroll
    for (int s = 0; s < 2; ++s) {
        const bf16_t* qp = T.Q + (tokbase + tq[s]) * D + (g * 4 + c.h) * 64 + 8 * c.quad;
        qc[s][0] = *(const bf16x8*)qp; qc[s][1] = *(const bf16x8*)(qp + 32);
    }
#define NSA_GATE(s, br) (T.gates[(tokbase + tq[s]) * 48 + (g * 4 + c.h) * 3 + (br)])
    float* scr0 = T.SCR + (c.wave * 8 + c.qi) * 256 + c.h * 64 + 4 * c.quad;
    for (int i = c.tid; i < 64 * IMP_LD; i += NTHREADS) ((LAS float*)(lds + A_IMP))[i] = 0.f;

    SubState st[2]; int lo[2], hi[2]; bool act[2], rowsel[2] = {true, true}; float invl[2] = {0.f, 0.f};
#define RESET_ST() do { _Pragma("unroll") for (int s = 0; s < 2; ++s) { st[s].m = -INFINITY; st[s].l = 0.f; st[s].L = 0.f; _Pragma("unroll") for (int db = 0; db < 4; ++db) st[s].O[db] = (f32x4){0.f, 0.f, 0.f, 0.f}; } } while (0)
    const int ncmp = min(NCMP, t0 / 16 + 3), ntc = (ncmp + 63) >> 6;
    const bf16_t* Kc = T.KCMP + (size_t)bg * 1024 * 64; const bf16_t* Vc = T.VCMPT + (size_t)bg * 64 * 1024;
    int lim[2];
#pragma unroll
    for (int s = 0; s < 2; ++s) lim[s] = tq[s] >= 31 ? ((tq[s] - 31) >> 4) : -1;
    RESET_ST();
#define KPTR Kc
#define VPTR Vc
#define VPITCH 1024
#define TILE_C(i) (64 * (i))
#define BODY_C0(i, so) do { _Pragma("unroll") for (int s = 0; s < 2; ++s) { lo[s] = 0; hi[s] = lim[s] - 64 * (i); act[s] = true; } tile_compute<0>(c, so, qc, st, lo, hi, rowsel, act, 64 * (i), invl); } while (0)
#define BODY_C1(i, so) do { _Pragma("unroll") for (int s = 0; s < 2; ++s) { lo[s] = 0; hi[s] = lim[s] - 64 * (i); act[s] = true; } tile_compute<1>(c, so, qc, st, lo, hi, rowsel, act, 64 * (i), invl); } while (0)
    if (!(ATT_SKIP & 1)) NSA_RING(NS_CMP, false, ntc, TILE_C, BODY_C0);
#pragma unroll
    for (int s = 0; s < 2; ++s) { float l = st[s].l; l = sum_x16(l); l = sum_x32(l); invl[s] = l > 0.f ? 1.0f / l : 0.f; }
    if (!(ATT_SKIP & 1)) NSA_RING(NS_CMP, true, ntc, TILE_C, BODY_C1);
#undef KPTR
#undef VPTR
#undef VPITCH
#pragma unroll
    for (int s = 0; s < 2; ++s)
#pragma unroll
        for (int db = 0; db < 4; ++db) *(f32x4*)(scr0 + s * 4 * 256 + 16 * db) = st[s].O[db] * NSA_GATE(s, 0);
#if NSA_CHECK
    if (NSA_CHECK_BR == 0) {
#pragma unroll
        for (int s = 0; s < 2; ++s) { bf16_t* op = T.DBG + (tokbase + tq[s]) * D + (g * 4 + c.h) * 64 + 4 * c.quad;
#pragma unroll
            for (int db = 0; db < 4; ++db) *(u32x2*)(op + 16 * db) = pack4(st[s].O[db]); } }
#endif
    {
        LAS float* impw = (LAS float*)(lds + A_IMP) + (c.wave * 8) * IMP_LD;
        unsigned uw = 0u;
        const unsigned long long lt_mask = (1ull << c.lane) - 1ull;
#pragma unroll 1
        for (int qq = (ATT_SKIP & 2) ? 8 : 0; qq < 8; ++qq) {
            const int tqq = t0 + c.wave * 8 + qq, cur = tqq >> 6;
            const int K = 16 - (cur >= 2 ? 3 : cur + 1);
            unsigned key[4]; unsigned long long forced[4];
#pragma unroll
            for (int e = 0; e < 4; ++e) { const int j = c.lane + 64 * e; const bool valid = j <= cur; const bool fo = (j == 0) || (j == cur) || (j == cur - 1);
                key[e] = (valid && !fo) ? (__float_as_uint(impw[qq * IMP_LD + j]) + 1u) : 0u; forced[e] = __ballot(valid && fo); }
            unsigned T = 0u; bool exact = false;
#pragma unroll 1
            for (int bit = 30; bit >= 0; --bit) { const unsigned cand = T | (1u << bit);
                const int cnt = __popcll(__ballot(key[0] >= cand)) + __popcll(__ballot(key[1] >= cand)) + __popcll(__ballot(key[2] >= cand)) + __popcll(__ballot(key[3] >= cand));
                T = (cnt >= K) ? cand : T;
                if (cnt == K) { exact = true; break; } }
            const unsigned Tg = exact ? T - 1u : T;
            unsigned long long sel[4]; int ngt = 0;
#pragma unroll
            for (int e = 0; e < 4; ++e) { sel[e] = __ballot(key[e] > Tg); ngt += __popcll(sel[e]); }
            int r = (T != 0u && !exact) ? (K - ngt) : 0;
#pragma unroll
            for (int e = 0; e < 4; ++e) { const unsigned long long eq = (T != 0u && !exact) ? __ballot(key[e] == T) : 0ull;
                const bool take = ((eq >> c.lane) & 1ull) && (__popcll(eq & lt_mask) < r);
                sel[e] |= __ballot(take) | forced[e]; r -= min(r, (int)__popcll(eq)); }
            unsigned myword = 0u;
#pragma unroll
            for (int e = 0; e < 4; ++e) { myword = (c.lane == 2 * e) ? (unsigned)sel[e] : myword; myword = (c.lane == 2 * e + 1) ? (unsigned)(sel[e] >> 32) : myword; }
            if (c.lane < 8) ((LAS unsigned*)(lds + A_SELM))[(c.wave * 8 + qq) * 8 + c.lane] = myword;
            uw |= myword;
        }
        if (c.lane < 8) ((LAS unsigned*)(lds + A_UW))[c.wave * 8 + c.lane] = uw;
        __syncthreads();
        if (c.tid < 8) { unsigned u = 0u;
#pragma unroll
            for (int w = 0; w < 8; ++w) u |= ((LAS unsigned*)(lds + A_UW))[w * 8 + c.tid];
            ((LAS unsigned*)(lds + A_UB))[c.tid] = u; }
        __syncthreads();
        if (c.tid < 256) { const LAS unsigned* ub = (const LAS unsigned*)(lds + A_UB); const int wj = c.tid >> 5, bj = c.tid & 31; int pos = 0;
#pragma unroll
            for (int w = 0; w < 8; ++w) { const unsigned x = ub[w]; pos += (w < wj) ? __popc(x) : 0; }
            const unsigned xw = ub[wj]; pos += __popc(xw & ((1u << bj) - 1u));
            if ((xw >> bj) & 1u) ((LAS int*)(lds + A_TL))[pos] = c.tid; }
        __syncthreads();
    }
    bf16x8 qr[2][2];
#pragma unroll
    for (int s = 0; s < 2; ++s) {
        const bf16_t* qp = T.Q + (tokbase + tq[s]) * D + (g * 4 + c.h) * 64 + 8 * c.quad;
        const bf16x8 q0 = *(const bf16x8*)qp, q1 = *(const bf16x8*)(qp + 32);
        const f32x4* rp = (const f32x4*)(T.rope + (tokbase + tq[s]) * 32 + 8 * c.quad);
        u32x4 w0, w1;
#pragma unroll
        for (int p = 0; p < 4; ++p) { const f32x4 cs = rp[p];
            const float a0 = bf2f((unsigned short)q0[2 * p]), a1 = bf2f((unsigned short)q0[2 * p + 1]), b0 = bf2f((unsigned short)q1[2 * p]), b1 = bf2f((unsigned short)q1[2 * p + 1]);
            w0[p] = pk2(a0 * cs[0] - b0 * cs[1], a1 * cs[2] - b1 * cs[3]); w1[p] = pk2(b0 * cs[0] + a0 * cs[1], b1 * cs[2] + a1 * cs[3]); }
        qr[s][0] = __builtin_bit_cast(bf16x8, w0); qr[s][1] = __builtin_bit_cast(bf16x8, w1);
    }
    {
        const LAS unsigned* ub = (const LAS unsigned*)(lds + A_UB); int nsel = 0;
#pragma unroll
        for (int w = 0; w < 8; ++w) nsel += __popc(ub[w]);
        nsel = __builtin_amdgcn_readfirstlane(nsel);
        const LAS int* TL = (const LAS int*)(lds + A_TL); const LAS unsigned* selm = (const LAS unsigned*)(lds + A_SELM);
        const bf16_t* Ks = T.KS + (size_t)bg * SEQ * 64; const bf16_t* Vs = T.VTS + (size_t)bg * 64 * SEQ;
        RESET_ST();
#define KPTR Ks
#define VPTR Vs
#define VPITCH SEQ
#define TILE_S(i) (64 * __builtin_amdgcn_readfirstlane(TL[(i)]))
#define BODY_S(i, so) do { const int j = __builtin_amdgcn_readfirstlane(TL[(i)]); \
        _Pragma("unroll") for (int s = 0; s < 2; ++s) { const unsigned w = selm[(c.wave * 8 + 4 * s + c.qi) * 8 + (j >> 5)]; const bool sel = (w >> (j & 31)) & 1u; \
            lo[s] = 0; hi[s] = tq[s] - 64 * j; rowsel[s] = sel; act[s] = __any(sel ? 1 : 0) != 0; } \
        tile_compute<2>(c, so, qr, st, lo, hi, rowsel, act, 64 * j, invl); } while (0)
#if SEL_INVERTED
        if (!(ATT_SKIP & 4)) {
            const int nforced = qt >= 2 ? 3 : qt + 1;
#define TILE_F(i) (64 * ((i) == 0 ? 0 : ((i) == nforced - 1 ? qt : qt - 1)))
#define BODY_F(i, so) do { const int j = ((i) == 0 ? 0 : ((i) == nforced - 1 ? qt : qt - 1)); \
        _Pragma("unroll") for (int s = 0; s < 2; ++s) { lo[s] = 0; hi[s] = tq[s] - 64 * j; rowsel[s] = true; act[s] = true; } \
        tile_compute<2>(c, so, qr, st, lo, hi, rowsel, act, 64 * j, invl); } while (0)
            NSA_RING_B4(nforced, TILE_F, BODY_F);
            selected_inverted(c, T, lds, qr, st, t0, bg, qt);
        }
#else
        if (!(ATT_SKIP & 4)) NSA_RING_B4(nsel, TILE_S, BODY_S);
#endif
#undef KPTR
#undef VPTR
#pragma unroll
        for (int s = 0; s < 2; ++s) { const float l = st[s].L; const float fn = (l > 0.f ? 1.0f / l : 0.f), f = fn * NSA_GATE(s, 1);
#if NSA_CHECK
            if (NSA_CHECK_BR == 1) { bf16_t* op = T.DBG + (tokbase + tq[s]) * D + (g * 4 + c.h) * 64 + 4 * c.quad;
#pragma unroll
                for (int db = 0; db < 4; ++db) *(u32x2*)(op + 16 * db) = pack4(st[s].O[db] * fn); }
#endif
#pragma unroll
            for (int db = 0; db < 4; ++db) { f32x4* p = (f32x4*)(scr0 + s * 4 * 256 + 16 * db); *p = *p + st[s].O[db] * f; } }
    }
    {
        const bf16_t* Kw = T.KW + (size_t)bg * SEQ * 64; const bf16_t* Vw = T.VTW + (size_t)bg * 64 * SEQ;
        const int kt1 = qt, kt0 = max(0, qt - 8), nw = kt1 - kt0 + 1;
        RESET_ST();
#define KPTR Kw
#define VPTR Vw
#define TILE_W(i) (64 * (kt0 + (i)))
#define BODY_W(i, so) do { const int k0 = 64 * (kt0 + (i)); \
        _Pragma("unroll") for (int s = 0; s < 2; ++s) { hi[s] = tq[s] - k0; lo[s] = tq[s] - 511 - k0; act[s] = true; } \
        tile_compute<3>(c, so, qr, st, lo, hi, rowsel, act, k0, invl); } while (0)
        if (!(ATT_SKIP & 8)) NSA_RING_B4(nw, TILE_W, BODY_W);
#undef KPTR
#undef VPTR
#undef VPITCH
#pragma unroll
        for (int s = 0; s < 2; ++s) { const float l = st[s].L; const float fn = (l > 0.f ? 1.0f / l : 0.f), f = fn * NSA_GATE(s, 2);
#if NSA_CHECK
            if (NSA_CHECK_BR == 2) { bf16_t* op = T.DBG + (tokbase + tq[s]) * D + (g * 4 + c.h) * 64 + 4 * c.quad;
#pragma unroll
                for (int db = 0; db < 4; ++db) *(u32x2*)(op + 16 * db) = pack4(st[s].O[db] * fn); }
#endif
            bf16_t* op = T.O + (tokbase + tq[s]) * D + (g * 4 + c.h) * 64 + 4 * c.quad;
#pragma unroll
            for (int db = 0; db < 4; ++db) { const f32x4 v = *(const f32x4*)(scr0 + s * 4 * 256 + 16 * db) + st[s].O[db] * f; *(u32x2*)(op + 16 * db) = pack4(v); } }
    }
#undef RESET_ST
#undef NSA_GATE
}
}


#if NSA_CHECK
namespace chk {
__constant__ int tlist[24] = {0, 1, 30, 31, 32, 47, 63, 64, 65, 79, 127, 128, 510, 511, 512, 513, 1023, 1024, 1025, 1087, 4095, 4096, 8191, 16383};
__device__ __forceinline__ float blk_max(float v, LAS float* red, int tid) {
#pragma unroll
    for (int o = 1; o < 64; o <<= 1) v = fmaxf(v, __shfl_xor(v, o));
    __syncthreads(); if ((tid & 63) == 0) red[tid >> 6] = v; __syncthreads();
    float r = red[0]; for (int w = 1; w < 8; ++w) r = fmaxf(r, red[w]); __syncthreads(); return r; }
__device__ __forceinline__ float blk_sum(float v, LAS float* red, int tid) {
#pragma unroll
    for (int o = 1; o < 64; o <<= 1) v += __shfl_xor(v, o);
    __syncthreads(); if ((tid & 63) == 0) red[tid >> 6] = v; __syncthreads();
    float r = 0.f; for (int w = 0; w < 8; ++w) r += red[w]; __syncthreads(); return r; }

__device__ __forceinline__ void check_sample(const nsa::Tensors& T, LAS unsigned char* lds, int tid, int b, int g, int t, unsigned* flag) {
    LAS float* sc = (LAS float*)lds;
    LAS float* qf = sc + 4096;
    LAS float* oacc = qf + 512;
    LAS float* score = oacc + 768;
    LAS int* sel = (LAS int*)(score + 256);
    LAS float* red = (LAS float*)(sel + 16);
    const int bg = b * 4 + g; const size_t tok = (size_t)b * SEQ + t;
    if (tid < 256) { const int h = tid >> 6, d = tid & 63;
        const float q = bf2f(T.Q[tok * D + (g * 4 + h) * 64 + d]);
        const int dd = d & 31; const f32x2 cs = T.rope[tok * 32 + dd]; const float qo = bf2f(T.Q[tok * D + (g * 4 + h) * 64 + (d < 32 ? d + 32 : d - 32)]);
        const float r = d < 32 ? q * cs[0] - qo * cs[1] : q * cs[0] + qo * cs[1];
        qf[h * 64 + d] = q; qf[256 + h * 64 + d] = bf2f((unsigned short)f2bf(r)); }
    __syncthreads();
    const bf16_t* Kc = T.KCMP + (size_t)bg * 1024 * 64; const bf16_t* Vc = T.VCMPT + (size_t)bg * 64 * 1024;
    for (int i = tid; i < 4096; i += 512) { const int h = i >> 10, c = i & 1023; float s = -INFINITY;
        if (c < 1023 && 16 * c + 31 <= t) { s = 0.f; for (int d = 0; d < 64; ++d) s += qf[h * 64 + d] * bf2f(Kc[(size_t)c * 64 + d]); }
        sc[i] = s; }
    __syncthreads();
    for (int h = 0; h < 4; ++h) {
        float m = -INFINITY; for (int c = tid; c < 1024; c += 512) m = fmaxf(m, sc[h * 1024 + c]);
        m = blk_max(m, red, tid); if (m == -INFINITY) m = 0.f;
        float l = 0.f; for (int c = tid; c < 1024; c += 512) l += exp2f(sc[h * 1024 + c] - m);
        l = blk_sum(l, red, tid); l = fmaxf(l, 1e-30f);
        for (int c = tid; c < 1024; c += 512) sc[h * 1024 + c] = exp2f(sc[h * 1024 + c] - m) / l;
        __syncthreads();
    }
    if (tid < 256) { const int h = tid >> 6, d = tid & 63; float o = 0.f;
        for (int c = 0; c < 1023; ++c) o += bf2f((unsigned short)f2bf(sc[h * 1024 + c])) * bf2f(Vc[(size_t)d * 1024 + c]);
        oacc[h * 64 + d] = o; }
    if (tid < 256) { const int j = tid; float im = 0.f;
        for (int h = 0; h < 4; ++h) for (int c = 4 * j - 1; c <= 4 * j + 3; ++c) if (c >= 0 && c < 1023) {
            const int c0 = 16 * c, j0 = 64 * j; int ov = min(c0 + 32, j0 + 64) - max(c0, j0); if (ov < 0) ov = 0;
            im += sc[h * 1024 + c] * ((float)ov / 32.0f); }
        const int cur = t >> 6; const bool valid = 64 * j <= t, forced = (j == 0) || (j == cur) || (j == cur - 1);
        score[j] = valid ? im + (forced ? 1000.0f : 0.0f) : -1.0f; }
    __syncthreads();
    if (tid == 0) { for (int n = 0; n < 16; ++n) { int bi = 0; float bv = -INFINITY; for (int j = 0; j < 256; ++j) if (score[j] > bv) { bv = score[j]; bi = j; } sel[n] = bi; score[bi] = -INFINITY; } }
    __syncthreads();
    const bf16_t* Ks = T.KS + (size_t)bg * SEQ * 64; const bf16_t* Vs = T.VTS + (size_t)bg * 64 * SEQ;
    for (int i = tid; i < 4096; i += 512) { const int h = i >> 10, n = (i >> 6) & 15, k = i & 63; const int kpos = sel[n] * 64 + k; float s = -INFINITY;
        if (kpos <= t) { s = 0.f; for (int d = 0; d < 64; ++d) s += qf[256 + h * 64 + d] * bf2f(Ks[(size_t)kpos * 64 + d]); }
        sc[i] = s; }
    __syncthreads();
    for (int h = 0; h < 4; ++h) {
        float m = -INFINITY; for (int c = tid; c < 1024; c += 512) m = fmaxf(m, sc[h * 1024 + c]);
        m = blk_max(m, red, tid); if (m == -INFINITY) m = 0.f;
        float l = 0.f; for (int c = tid; c < 1024; c += 512) l += exp2f(sc[h * 1024 + c] - m);
        l = blk_sum(l, red, tid); l = fmaxf(l, 1e-30f);
        for (int c = tid; c < 1024; c += 512) sc[h * 1024 + c] = exp2f(sc[h * 1024 + c] - m) / l;
        __syncthreads();
    }
    if (tid < 256) { const int h = tid >> 6, d = tid & 63; float o = 0.f;
        for (int i = 0; i < 1024; ++i) { const float p = sc[h * 1024 + i]; if (p != 0.f) { const int kpos = sel[i >> 6] * 64 + (i & 63); o += bf2f((unsigned short)f2bf(p)) * bf2f(Vs[(size_t)d * SEQ + kpos]); } }
        oacc[256 + h * 64 + d] = o; }
    __syncthreads();
    const bf16_t* Kw = T.KW + (size_t)bg * SEQ * 64; const bf16_t* Vw = T.VTW + (size_t)bg * 64 * SEQ;
    for (int i = tid; i < 4096; i += 512) { const int h = i >> 10, k = i & 1023; const int kpos = t - 511 + k; float s = -INFINITY;
        if (k < 512 && kpos >= 0) { s = 0.f; for (int d = 0; d < 64; ++d) s += qf[256 + h * 64 + d] * bf2f(Kw[(size_t)kpos * 64 + d]); }
        sc[i] = s; }
    __syncthreads();
    for (int h = 0; h < 4; ++h) {
        float m = -INFINITY; for (int c = tid; c < 1024; c += 512) m = fmaxf(m, sc[h * 1024 + c]);
        m = blk_max(m, red, tid); if (m == -INFINITY) m = 0.f;
        float l = 0.f; for (int c = tid; c < 1024; c += 512) l += exp2f(sc[h * 1024 + c] - m);
        l = blk_sum(l, red, tid); l = fmaxf(l, 1e-30f);
        for (int c = tid; c < 1024; c += 512) sc[h * 1024 + c] = exp2f(sc[h * 1024 + c] - m) / l;
        __syncthreads();
    }
    if (tid < 256) { const int h = tid >> 6, d = tid & 63; float o = 0.f;
        for (int k = 0; k < 512; ++k) { const float p = sc[h * 1024 + k]; if (p != 0.f) o += bf2f((unsigned short)f2bf(p)) * bf2f(Vw[(size_t)d * SEQ + (t - 511 + k)]); }
        oacc[512 + h * 64 + d] = o; }
    __syncthreads();
    if (tid == 0) red[0] = 0.f;
    __syncthreads();
    if (tid < 256) { const int h = tid >> 6, d = tid & 63; const float* gt = T.gates + tok * 48 + (g * 4 + h) * 3;
        float ref = gt[0] * oacc[h * 64 + d] + gt[1] * oacc[256 + h * 64 + d] + gt[2] * oacc[512 + h * 64 + d];
        float got = bf2f(T.O[tok * D + (g * 4 + h) * 64 + d]);
        if (NSA_CHECK_BR >= 0) { ref = oacc[NSA_CHECK_BR * 256 + h * 64 + d]; got = bf2f(T.DBG[tok * D + (g * 4 + h) * 64 + d]); }
        sc[tid] = ref * ref; sc[256 + tid] = got; sc[512 + tid] = ref; }
    __syncthreads();
    if (tid < 256) { const int h = tid >> 6; float ms = 0.f; for (int d2 = 0; d2 < 64; ++d2) ms += sc[h * 64 + d2]; const float rms = sqrtf(ms * (1.0f / 64.0f));
        const float got = sc[256 + tid], ref = sc[512 + tid];
        const float tol = NSA_CHECK_ABS * rms + NSA_CHECK_REL * fabsf(ref);
        if (!(fabsf(got - ref) <= tol)) red[0] = 1.0f; }
    __syncthreads();
    if (tid == 0 && red[0] != 0.f) atomicAdd(flag, 1u);
    __syncthreads();
}

__device__ __forceinline__ bool near(float got, float ref, float rms) { return fabsf(got - ref) <= 0.02f * rms + 0.015f * fabsf(ref); }
__device__ __forceinline__ void check_proj(const Args& a, const nsa::Tensors& T, unsigned char* ws, const float* X, LAS unsigned char* lds, int tid, int smp, unsigned* flag) {
    LAS float* hk = (LAS float*)lds;
    LAS float* hq = hk + 1024;
    LAS float* val = hq + 1024;
    LAS float* red = val + 512;
    LAS float* hid = red + 8;
    LAS float* blk = hid + 256;
    unsigned hsh = (unsigned)smp * 2654435761u + 12345u; hsh ^= hsh >> 15; hsh *= 2246822519u; hsh ^= hsh >> 13;
    const int tok = (int)(hsh % NT), b = tok >> 14, sp = tok & (SEQ - 1), g = (hsh >> 17) & 3, hh = (hsh >> 19) & 15;
    if (tid == 0) red[0] = 0.f;
    float ss = 0.f; for (int k = tid; k < 1024; k += 512) { const float v = X[(size_t)tok * D + k]; ss += v * v; }
    ss = blk_sum(ss, red + 1, tid); const float r = 1.0f / sqrtf(ss * (1.0f / D) + RMS_EPS);
    for (int k = tid; k < 1024; k += 512) { const float v = X[(size_t)tok * D + k] * r; hk[k] = v * a.in[I_NKV][k]; hq[k] = v * a.in[I_NMIX][D + k]; }
    __syncthreads();
    const float pos = (float)((const int*)a.in[I_POS])[tok];
    bool bad = false;
    for (int slot = 0; slot < 6; ++slot) {
        if (tid < 64) { float s_ = 0.f; const float* w = a.in[I_WKV] + slot * 256 + g * 64 + tid; for (int k = 0; k < 1024; ++k) s_ += hk[k] * w[(size_t)k * 1536]; val[tid] = s_; }
        __syncthreads();
        if (tid < 64) { float v = val[tid];
            if (slot == 2 || slot == 4) { const int i = tid & 31; const float ang = pos * a.inv_freq[i]; float sn, cs; sincosf(ang, &sn, &cs); const float t1 = val[i], t2 = val[i + 32]; v = tid < 32 ? t1 * cs - t2 * sn : t2 * cs + t1 * sn; }
            float got; const size_t bg = (size_t)(b * 4 + g);
            if (slot == 3 || slot == 5) got = bf2f(((const bf16_t*)(ws + WS_RD + (size_t)slot * KVSTRIDE))[(bg * 64 + tid) * SEQ + sp]);
            else got = bf2f(((const bf16_t*)(ws + WS_RD + (size_t)slot * KVSTRIDE))[(bg * SEQ + sp) * 64 + tid]);
            if (!near(got, v, 1.0f)) bad = true; }
        __syncthreads();
    }
    if (tid < 112) { const int col = tid < 64 ? hh * 64 + tid : 1024 + (tid - 64); float s_ = 0.f; const float* w = a.in[I_AWIN] + col; for (int k = 0; k < 1024; ++k) s_ += hq[k] * w[(size_t)k * 1072];
        if (tid < 64) { if (!near(bf2f(T.Q[(size_t)tok * D + hh * 64 + tid]), s_ * (0.125f * 1.4426950408889634f), 0.18f)) bad = true; }
        else { const float gt = 1.0f / (1.0f + expf(-s_)); if (!near(T.gates[(size_t)tok * 48 + (tid - 64)], gt, 0.25f)) bad = true; } }
    const int c = (int)((hsh >> 8) % 1023);
    for (int kv = 0; kv < 2; ++kv) {
        const bf16_t* src = (const bf16_t*)(ws + WS_RD + (kv ? RD_VC : RD_KC)) + ((size_t)(b * 4 + g) * SEQ + 16 * c) * 64; const float* pe = a.in[kv ? I_CPV : I_CPK];
        for (int i = tid; i < 2048; i += 512) blk[i] = bf2f(src[i]) + pe[i];
        __syncthreads();
        if (tid < 256) { float s_ = 0.f; const float* w1 = a.in[kv ? I_CW1V : I_CW1K] + tid; for (int i = 0; i < 2048; ++i) s_ += blk[i] * w1[(size_t)i * 256];
            const float y = 0.7978845608028654f * (s_ + 0.044715f * s_ * s_ * s_); hid[tid] = 0.5f * s_ * (1.0f + tanhf(y)); }
        __syncthreads();
        if (tid < 64) { float s_ = 0.f; const float* w2 = a.in[kv ? I_CW2V : I_CW2K] + tid; for (int n = 0; n < 256; ++n) s_ += hid[n] * w2[n * 64];
            const float got = kv ? bf2f(T.VCMPT[((size_t)(b * 4 + g) * 64 + tid) * 1024 + c]) : bf2f(T.KCMP[((size_t)(b * 4 + g) * 1024 + c) * 64 + tid]);
            if (!near(got, s_, 0.5f)) bad = true; }
        __syncthreads();
    }
    if (bad) red[0] = 1.0f;
    __syncthreads();
    if (tid == 0 && red[0] != 0.f) atomicAdd(flag, 1u);
    __syncthreads();
}
}
#endif

#define XB_TMO      128
#define XB_XCNT(j)  (256  + 64 * (j))
#define XB_XSUB(j)  (1280 + 64 * (j))
#define XB_XGEN(j)  (2304 + 64 * (j))
#define XB_TOP      3328
#define XB_TOPGEN   3392
#define XCD_BAR_WORDS 3456
#define XB_SPIN_CAP (1u << 22)
__device__ __forceinline__ unsigned xb_ld(unsigned* p)              { return __hip_atomic_load(p, __ATOMIC_RELAXED, __HIP_MEMORY_SCOPE_AGENT); }
__device__ __forceinline__ unsigned xb_add(unsigned* p, unsigned v) { return __hip_atomic_fetch_add(p, v, __ATOMIC_RELAXED, __HIP_MEMORY_SCOPE_AGENT); }
__device__ __forceinline__ unsigned xb_xcc_id() { return (unsigned)__builtin_amdgcn_s_getreg((3 << 11) | 20) & 0xFu; }
#define XB_SPIN(cond, bar) do { unsigned _sp = 0; while (cond) { __builtin_amdgcn_s_sleep(1); \
    if ((++_sp & 255u) == 0u) { if (xb_ld(&(bar)[XB_TMO])) break; if (_sp > XB_SPIN_CAP) { atomicAdd(&(bar)[XB_TMO], 1u); break; } } } } while (0)
struct XcdBarrier { unsigned* bar; unsigned x; volatile LAS unsigned* st; };
__device__ __forceinline__ XcdBarrier xcd_barrier_post(unsigned* bar, volatile LAS unsigned* st, bool t0) {
    XcdBarrier b; b.bar = bar; b.x = xb_xcc_id(); b.st = st;
    if (t0) (void)xb_add(&bar[XB_XCNT(b.x)], 1u);
    return b;
}
__device__ __forceinline__ void xcd_barrier_complete(unsigned* bar, unsigned x, unsigned& nloc, unsigned& nx) {
    const unsigned G = gridDim.x;
    unsigned sum, cnt, mine, sp = 0u;
    for (;;) {
        sum = 0u; cnt = 0u; mine = 0u;
#pragma unroll
        for (unsigned j = 0; j < 16; ++j) { const unsigned c = xb_ld(&bar[XB_XCNT(j)]); sum += c; cnt += (c > 0u) ? 1u : 0u; mine = (j == x) ? c : mine; }
        if (sum == G) break;
        __builtin_amdgcn_s_sleep(1);
        if ((++sp & 255u) == 0u) { if (xb_ld(&bar[XB_TMO])) break; if (sp > XB_SPIN_CAP) { atomicAdd(&bar[XB_TMO], 1u); break; } }
    }
    nloc = mine > 0u ? mine : 1u; nx = cnt > 0u ? cnt : 1u;
}
__device__ __forceinline__ void xcd_barrier(const XcdBarrier& b, bool t0) {
    asm volatile("s_waitcnt vmcnt(0)" ::: "memory");
    __syncthreads();
    if (t0) {
        unsigned* bar = b.bar;
        __builtin_amdgcn_s_waitcnt(0);
        unsigned nloc = b.st[0], nx = b.st[1];
        if (nloc == 0u) { xcd_barrier_complete(bar, b.x, nloc, nx); b.st[0] = nloc; b.st[1] = nx; }
        const unsigned old = xb_add(&bar[XB_XSUB(b.x)], 1u);
        const unsigned gen = old / nloc;
        if (old + 1u == (gen + 1u) * nloc) {
            __builtin_amdgcn_fence(__ATOMIC_RELEASE, "agent");
            asm volatile("s_waitcnt vmcnt(0)" ::: "memory");
            const unsigned og = xb_add(&bar[XB_TOP], 1u);
            const unsigned tg = og / nx;
            if (og + 1u == (tg + 1u) * nx) xb_add(&bar[XB_TOPGEN], 1u);
            else XB_SPIN(xb_ld(&bar[XB_TOPGEN]) == tg, bar);
            __builtin_amdgcn_fence(__ATOMIC_ACQUIRE, "agent");
            xb_add(&bar[XB_XGEN(b.x)], 1u);
            asm volatile("s_waitcnt vmcnt(0)" ::: "memory");
        } else {
            XB_SPIN(xb_ld(&bar[XB_XGEN(b.x)]) == gen, bar);
            __builtin_amdgcn_fence(__ATOMIC_ACQUIRE, "agent");
            asm volatile("s_waitcnt vmcnt(0)" ::: "memory");
        }
    }
    __syncthreads();
}

__device__ __forceinline__ MoeTab moe_tables(const Frame& F0, int layer) {
    const Frame F = refresh(F0);
    MoeTab T; T.tstart = (volatile LAS int*)(F.lds + MISC_OFF); T.cnt = T.tstart + 64;
    const unsigned* gcnt = (const unsigned*)(F.ws + WS_CTL) + CW_CNT + layer * 32;
    __syncthreads();
    if (F.tid < 32) T.cnt[F.tid] = (int)__hip_atomic_load(gcnt + F.tid, __ATOMIC_RELAXED, __HIP_MEMORY_SCOPE_AGENT);
    __syncthreads();
    if (F.tid == 0) { int acc = 0; for (int e = 0; e < 32; ++e) { T.tstart[e] = acc; acc += (T.cnt[e] + 255) >> 8; } T.tstart[32] = acc; }
    __syncthreads();
    return T;
}

constexpr int N_PHASES = 17;
__global__ void __launch_bounds__(NTHREADS, 2) nsa_fwd(Args args) {
    extern __shared__ __attribute__((aligned(16))) unsigned char lds_raw[];
    cg::grid_group grid = cg::this_grid();
    Frame F; F.lds = (LAS unsigned char*)lds_raw; F.ws = args.ws;
    { const int t = threadIdx.x; F.wave = __builtin_amdgcn_readfirstlane(t >> 6); F.tid = t; F.lane = t & 63; }
    F.G = gridDim.x; { const int bx = blockIdx.x; F.vcu = (F.G % 8 == 0) ? (bx % 8) * (F.G / 8) + bx / 8 : bx; }
    unsigned char* ws = args.ws;
    float* X = args.out;
    const int lo = args.ph_lo, hi = args.ph_hi;
    volatile LAS unsigned* bst = (volatile LAS unsigned*)(F.lds + MISC_OFF + 1024);
    if (F.tid < 2) bst[F.tid] = 0u;
    __syncthreads();
    XcdBarrier xb; xb.bar = (unsigned*)(ws + WS_CTL) + CW_BAR; xb.x = 0; xb.st = bst;
    if (hi - lo > 1) xb = xcd_barrier_post((unsigned*)(ws + WS_CTL) + CW_BAR, bst, F.tid == 0);
#ifndef PH_MASK
#define PH_MASK 0x1ffff
#endif
#ifndef REPEAT_MASK
#define REPEAT_MASK 0
#endif
#define REPS(k) (1 + ((REPEAT_MASK >> (k)) & 1))
#define IN(k) (((PH_MASK >> (k)) & 1) && lo <= (k) && (k) < hi)
#if PROBE_PHASE >= 0
    unsigned long long ph_t0 = __builtin_amdgcn_s_memrealtime(), ph_dur = 0ull;
#define PH_STAMP(k) do { const unsigned long long now_ = __builtin_amdgcn_s_memrealtime(); if ((k) == PROBE_PHASE) ph_dur = now_ - ph_t0; ph_t0 = now_; } while (0)
#else
#define PH_STAMP(k) do {} while (0)
#endif
#define SEAM(k) do { if (IN(k) && IN((k) + 1)) { if ((k) == 0) grid.sync(); else xcd_barrier(xb, mytid(F) == 0); } PH_STAMP(k); } while (0)
    LAS unsigned char* ring = F.lds;

    if (IN(0)) for (int rep_ = 0; rep_ < REPS(0); ++rep_) { phase_prep(args, F); } SEAM(0);
    if (IN(1)) for (int rep_ = 0; rep_ < REPS(1); ++rep_) {
        DenseOrder S; S.init(ws + WS_RA, ws + WS_WIN, NT, 3 * D, D, D, F.G, (int)blockIdx.x);
        EpiInProj E{(const float*)(ws + WS_R0), (bf16_t*)(ws + WS_RB), (bf16_t*)(ws + WS_RC)};
        pg8::gemm_phase<EpiInProj, DenseOrder, false>(ring, mytid(F), pg8::Gemm{D, D}, S, E);
    } SEAM(1);
#ifdef EXTRA_BARS
    for (int eb_ = 0; eb_ < EXTRA_BARS; ++eb_) xcd_barrier(xb, mytid(F) == 0);
#endif
    if (IN(2)) for (int rep_ = 0; rep_ < REPS(2); ++rep_) { phase_conv(args, F); } SEAM(2);
    if (IN(3)) for (int rep_ = 0; rep_ < REPS(3); ++rep_) {
        DenseOrder S; S.init(ws + WS_RA, ws + WS_WOUT, NT, D, D, D, F.G, (int)blockIdx.x);
        EpiResid E{args.in[I_X], X};
        pg8::gemm_phase<EpiResid, DenseOrder, false>(ring, mytid(F), pg8::Gemm{D, D}, S, E);
    } SEAM(3);
    {
        if (IN(4)) for (int rep_ = 0; rep_ < REPS(4); ++rep_) { phase_router(args, F, 0, X, (bf16_t*)(ws + WS_RA), (float*)(ws + WS_R1)); } SEAM(4);
        if (IN(5)) for (int rep_ = 0; rep_ < REPS(5); ++rep_) {
            MoeTab T = moe_tables(F, 0);
            MoeGuOrder S{T, (const char*)(ws + WS_RA), (const int*)(ws + WS_ROWL), (const char*)(ws + WS_EXPW), F.G, F.vcu};
            EpiGU E{T, (const float*)(ws + WS_ROWR), (bf16_t*)(ws + WS_RD)};
            pg8::gemm_phase<EpiGU, MoeGuOrder, true>(ring, mytid(F), pg8::Gemm{D, D}, S, E);
        } SEAM(5);
        if (IN(6)) for (int rep_ = 0; rep_ < REPS(6); ++rep_) {
            MoeTab T = moe_tables(F, 0);
            MoeDnOrder S{T, (const char*)(ws + WS_RD), (const char*)(ws + WS_EXPW), F.G, F.vcu};
            EpiDN E{(const int*)(ws + WS_ROWL), (const float*)(ws + WS_WGT), (bf16_t*)(ws + WS_RB)};
            pg8::gemm_phase<EpiDN, MoeDnOrder, false>(ring, mytid(F), pg8::Gemm{DE, DE}, S, E);
        } SEAM(6);
    }
    {
            if (IN(7)) for (int rep_ = 0; rep_ < REPS(7); ++rep_) { phase_combine<false>(args, F, X, (bf16_t*)(ws + WS_RA), (float*)(ws + WS_R2)); } SEAM(7);
            if (IN(8)) for (int rep_ = 0; rep_ < REPS(8); ++rep_) {
                DenseOrder S; S.init(ws + WS_RA, ws + WS_WQKV, NT, NQKV, D, D, F.G, (int)blockIdx.x);
                EpiQKV E{(const float*)(ws + WS_R2), (const f32x2*)(ws + WS_ROPE), ws + WS_RD, (bf16_t*)(ws + WS_RC), (float*)(ws + WS_GATES)};
                pg8::gemm_phase<EpiQKV, DenseOrder, false>(ring, mytid(F), pg8::Gemm{D, D}, S, E);
            } SEAM(8);
            if (IN(9)) for (int rep_ = 0; rep_ < REPS(9); ++rep_) {
                CmpOrder S{(const char*)(ws + WS_RD + RD_KC), (const char*)(ws + WS_RD + RD_VC), (const char*)(ws + WS_WC1), F.G, (int)blockIdx.x};
                EpiCmp1 E{(const float*)(ws + WS_BIASC), (bf16_t*)(ws + WS_RD + RD_HID)};
                pg8::gemm_phase<EpiCmp1, CmpOrder, false>(ring, mytid(F), pg8::Gemm{2048, 1024}, S, E);
                const Frame F9 = refresh(F); LAS float* scr = (LAS float*)(F.lds + F.wave * 16384);
                if (F.G > 64) { if ((int)blockIdx.x >= 64) convert_experts(args, F9, 1, ((int)blockIdx.x - 64) * NWAVES + F.wave, (F.G - 64) * NWAVES, scr); }
                else convert_experts(args, F9, 1, (int)blockIdx.x * NWAVES + F.wave, F.G * NWAVES, scr);
            } SEAM(9);
            if (IN(10)) for (int rep_ = 0; rep_ < REPS(10); ++rep_) { phase_cmp2(F); } SEAM(10);
            if (IN(11)) for (int rep_ = 0; rep_ < REPS(11); ++rep_) {
                nsa::Tensors T{(const bf16_t*)(ws + WS_RC), (const f32x2*)(ws + WS_ROPE), (const float*)(ws + WS_GATES),
                               (const bf16_t*)(ws + WS_RD + RD_KS), (const bf16_t*)(ws + WS_RD + RD_VTS), (const bf16_t*)(ws + WS_RD + RD_KW), (const bf16_t*)(ws + WS_RD + RD_VTW),
                               (const bf16_t*)(ws + WS_RD + RD_KCMP), (const bf16_t*)(ws + WS_RD + RD_VCMPT), (bf16_t*)(ws + WS_RB), (bf16_t*)(ws + WS_RA), (float*)(ws + WS_ATTS) + (size_t)blockIdx.x * 64 * 256, (float*)(ws + WS_CTL) + 2049};
                if (F.G % 8 == 0) { const int bg = (int)blockIdx.x & 7, per = F.G >> 3;
                    for (int q = (int)blockIdx.x >> 3; q < 256; q += per) nsa::attn_unit(T, ring, mytid(F), bg >> 2, bg & 3, 255 - q); }
                else for (int u = (int)blockIdx.x; u < 2048; u += F.G) { const int qt = 255 - (u >> 3), bg = u & 7; nsa::attn_unit(T, ring, mytid(F), bg >> 2, bg & 3, qt); }
            } SEAM(11);
            if (IN(12)) for (int rep_ = 0; rep_ < REPS(12); ++rep_) {
#if NSA_CHECK
                { nsa::Tensors T{(const bf16_t*)(ws + WS_RC), (const f32x2*)(ws + WS_ROPE), (const float*)(ws + WS_GATES),
                               (const bf16_t*)(ws + WS_RD + RD_KS), (const bf16_t*)(ws + WS_RD + RD_VTS), (const bf16_t*)(ws + WS_RD + RD_KW), (const bf16_t*)(ws + WS_RD + RD_VTW),
                               (const bf16_t*)(ws + WS_RD + RD_KCMP), (const bf16_t*)(ws + WS_RD + RD_VCMPT), (bf16_t*)(ws + WS_RB), (bf16_t*)(ws + WS_RA), (float*)(ws + WS_ATTS) + (size_t)blockIdx.x * 64 * 256, (float*)(ws + WS_CTL) + 2049};
                  for (int smp = (int)blockIdx.x; smp < NSA_CHECK_N; smp += F.G) { unsigned hsh = (unsigned)smp * 2654435761u; hsh ^= hsh >> 15; hsh *= 2246822519u; hsh ^= hsh >> 13;
                      int t = (smp < 192) ? chk::tlist[smp % 24] : (int)(hsh % SEQ); const int bgs = (smp < 192) ? (smp / 24) : (int)((hsh >> 20) & 7);
                      chk::check_sample(T, ring, mytid(F), bgs >> 2, bgs & 3, t, (unsigned*)(ws + WS_CTL) + 2048); }
                  __syncthreads();
                  if (NSA_CHECK_PROJ) for (int smp = (int)blockIdx.x; smp < 512; smp += F.G) chk::check_proj(args, T, ws, X, ring, mytid(F), smp, (unsigned*)(ws + WS_CTL) + 2048);
                  __syncthreads(); }
#endif
                DenseOrder S; S.init(ws + WS_RB, ws + WS_WAO, NT, D, D, D, F.G, (int)blockIdx.x);
                EpiResid E{X, X};
                pg8::gemm_phase<EpiResid, DenseOrder, false>(ring, mytid(F), pg8::Gemm{D, D}, S, E);
            } SEAM(12);
    }
    {
        if (IN(13)) for (int rep_ = 0; rep_ < REPS(13); ++rep_) { phase_router(args, F, 1, X, (bf16_t*)(ws + WS_RA), (float*)(ws + WS_R3)); } SEAM(13);
        if (IN(14)) for (int rep_ = 0; rep_ < REPS(14); ++rep_) {
            MoeTab T = moe_tables(F, 1);
            MoeGuOrder S{T, (const char*)(ws + WS_RA), (const int*)(ws + WS_ROWL), (const char*)(ws + WS_EXPW), F.G, F.vcu};
            EpiGU E{T, (const float*)(ws + WS_ROWR), (bf16_t*)(ws + WS_RD)};
            pg8::gemm_phase<EpiGU, MoeGuOrder, true>(ring, mytid(F), pg8::Gemm{D, D}, S, E);
        } SEAM(14);
        if (IN(15)) for (int rep_ = 0; rep_ < REPS(15); ++rep_) {
            MoeTab T = moe_tables(F, 1);
            MoeDnOrder S{T, (const char*)(ws + WS_RD), (const char*)(ws + WS_EXPW), F.G, F.vcu};
            EpiDN E{(const int*)(ws + WS_ROWL), (const float*)(ws + WS_WGT), (bf16_t*)(ws + WS_RB)};
            pg8::gemm_phase<EpiDN, MoeDnOrder, false>(ring, mytid(F), pg8::Gemm{DE, DE}, S, E);
        } SEAM(15);
    }
    if (IN(16)) for (int rep_ = 0; rep_ < REPS(16); ++rep_) { phase_combine<true>(args, F, X, nullptr, nullptr);
#if PROBE_PHASE >= 0
        PH_STAMP(16);
        if (blockIdx.x == 0 && mytid(F) == 0) { const unsigned long long t0_ = __builtin_amdgcn_s_memrealtime(); while (__builtin_amdgcn_s_memrealtime() - t0_ < ph_dur) __builtin_amdgcn_s_sleep(8); }
#endif
#if PROBE_T
        if (blockIdx.x == 0 && mytid(F) == 0) { const float nprobe = __uint_as_float(__hip_atomic_load((unsigned*)(ws + WS_CTL) + 2049, __ATOMIC_RELAXED, __HIP_MEMORY_SCOPE_AGENT));
            unsigned long long ticks = (unsigned long long)(fminf(nprobe, 2000.f) * 1000.0f); const unsigned long long t0_ = __builtin_amdgcn_s_memrealtime();
            while (__builtin_amdgcn_s_memrealtime() - t0_ < ticks) __builtin_amdgcn_s_sleep(8); }
#endif
#if NSA_CHECK
        if (blockIdx.x == 0 && mytid(F) == 0) { const unsigned nbad = __hip_atomic_load((unsigned*)(ws + WS_CTL) + 2048, __ATOMIC_RELAXED, __HIP_MEMORY_SCOPE_AGENT);
            if (nbad) { asm volatile("s_waitcnt vmcnt(0)" ::: "memory"); X[0] = 580.0f * sqrtf((float)nbad); } }
#endif
    }
#undef IN
#undef SEAM
}

extern "C" void kernel_launch(void* const* d_in, const int* in_sizes, int n_in, void* d_out, int out_size, void* d_ws, size_t ws_size, hipStream_t stream) {
    static int grid = 0;
    if (grid == 0) {
        if (n_in != 25 || out_size != NT * D || ws_size < WS_END) { fprintf(stderr, "kernel_launch: unexpected problem (n_in %d, out %d, ws %zu < %zu)\n", n_in, out_size, ws_size, (size_t)WS_END); grid = -1; return; }
        int dev = 0, cus = 0, per_cu = 0;
        hipGetDevice(&dev); hipDeviceGetAttribute(&cus, hipDeviceAttributeMultiprocessorCount, dev);
        hipFuncSetAttribute((const void*)nsa_fwd, hipFuncAttributeMaxDynamicSharedMemorySize, LDS_BYTES);
        hipOccupancyMaxActiveBlocksPerMultiprocessor(&per_cu, (const void*)nsa_fwd, NTHREADS, LDS_BYTES);
        if (per_cu < 1) { fprintf(stderr, "kernel_launch: occupancy query says %d blocks/CU\n", per_cu); per_cu = 1; }
        grid = cus;
        (void)hipGetLastError();
    }
    if (grid < 0) return;
    hipMemsetAsync((char*)d_ws + WS_CTL, 0, CTL_BYTES, stream);
    Args a{};
    for (int i = 0; i < 25; ++i) a.in[i] = (const float*)d_in[i];
    a.out = (float*)d_out; a.ws = (unsigned char*)d_ws;
    for (int i = 0; i < 32; ++i) a.inv_freq[i] = powf(10000.0f, -(float)i / 32.0f);
#if MK_PER_PHASE
    for (int p = 0; p < N_PHASES; ++p) { a.ph_lo = p; a.ph_hi = p + 1; void* kargs[] = {&a};
        hipError_t e = hipLaunchCooperativeKernel((const void*)nsa_fwd, dim3(grid), dim3(NTHREADS), kargs, LDS_BYTES, stream);
        if (e != hipSuccess) { fprintf(stderr, "launch %d failed: %s\n", p, hipGetErrorString(e)); break; } }
#else
    a.ph_lo = 0; a.ph_hi = N_PHASES; void* kargs[] = {&a};
    hipError_t e = hipLaunchCooperativeKernel((const void*)nsa_fwd, dim3(grid), dim3(NTHREADS), kargs, LDS_BYTES, stream);
    if (e != hipSuccess) fprintf(stderr, "cooperative launch failed: %s (grid %d)\n", hipGetErrorString(e), grid);
#endif
}
```

```cpp
#include <hip/hip_runtime.h>
#include <hip/hip_cooperative_groups.h>
#include <cstdio>
#include <cstdint>
#include <cmath>
namespace cg = cooperative_groups;

#define LAS __attribute__((address_space(3)))
typedef unsigned short bf16_t;
typedef short bf16x8 __attribute__((ext_vector_type(8)));
typedef short s16x4 __attribute__((ext_vector_type(4)));
typedef float f32x4 __attribute__((ext_vector_type(4)));
typedef float f32x2 __attribute__((ext_vector_type(2)));
typedef unsigned u32x4 __attribute__((ext_vector_type(4)));
typedef unsigned u32x2 __attribute__((ext_vector_type(2)));

constexpr int NB = 2, SEQ = 16384, NT = NB * SEQ, D = 1024, NG = 4, HD = 64, NH = 16;
constexpr int NE = 32, EPG = 8, DE = 512, ECAP = 65536;
constexpr int NQKV = 2816;
constexpr int NCMP = 1023, CMPH = 256;
constexpr float RMS_EPS = 1e-6f;
constexpr int NWAVES = 8, NTHREADS = 512;
#ifndef MK_PER_PHASE
#define MK_PER_PHASE 0
#endif

#ifndef PROBE_PHASE
#define PROBE_PHASE (-1)
#endif
#ifndef TOPK_ROWPAR
#define TOPK_ROWPAR 1
#endif
#ifndef PROBE_SKIP
#define PROBE_SKIP 0
#endif
#ifndef PROBE_T
#define PROBE_T 0
#endif
#ifndef PROBE_NOMERGE
#define PROBE_NOMERGE 0
#endif
#ifndef SEL_INVERTED
#define SEL_INVERTED 1
#endif
#ifndef ATT_SKIP
#define ATT_SKIP 0
#endif
#ifndef NSA_CHECK
#define NSA_CHECK 0
#endif
#ifndef NSA_CHECK_PROJ
#define NSA_CHECK_PROJ 1
#endif
#ifndef NSA_CHECK_BR
#define NSA_CHECK_BR (-1)
#endif
#ifndef NSA_CHECK_N
#define NSA_CHECK_N 1024
#endif
#ifndef NSA_CHECK_ABS
#define NSA_CHECK_ABS 0.012f
#endif
#ifndef NSA_CHECK_REL
#define NSA_CHECK_REL 0.01f
#endif

constexpr size_t MiB = 1u << 20, KiB = 1u << 10;
constexpr size_t WS_CTL = 0, CTL_BYTES = 64 * KiB;
constexpr size_t WS_R0 = 1 * MiB, WS_R1 = WS_R0 + 128 * KiB, WS_R2 = WS_R1 + 128 * KiB, WS_R3 = WS_R2 + 128 * KiB;
constexpr size_t WS_WGT = 2 * MiB;
constexpr size_t WS_RW = 2 * MiB + 512 * KiB;
constexpr size_t WS_BIASC = 3 * MiB;
constexpr size_t WS_W2T = 3 * MiB + 64 * KiB;
constexpr size_t WS_ROWL = 4 * MiB;
constexpr size_t WS_ROWR = 12 * MiB;
constexpr size_t WS_WIN = 20 * MiB, WS_WOUT = 26 * MiB, WS_WQKV = 28 * MiB, WS_WC1 = 34 * MiB, WS_WAO = 36 * MiB;
constexpr size_t WS_ROPE = 38 * MiB;
constexpr size_t WS_GATES = 46 * MiB;
constexpr size_t WS_EXPW = 52 * MiB;
constexpr size_t WS_RA = 148 * MiB;
constexpr size_t WS_RB = 212 * MiB;
constexpr size_t WS_RC = 276 * MiB;
constexpr size_t WS_RD = 340 * MiB;
constexpr size_t WS_ATTS = 452 * MiB;
constexpr size_t WS_STG2 = 468 * MiB;
constexpr size_t STG_WG = (64 * 13 + 1) * 4 * 144;
constexpr size_t WS_END = 528 * MiB;
constexpr size_t KVSTRIDE = 17 * MiB;
constexpr size_t RD_KC = 0, RD_VC = 1 * KVSTRIDE, RD_KS = 2 * KVSTRIDE, RD_VTS = 3 * KVSTRIDE, RD_KW = 4 * KVSTRIDE, RD_VTW = 5 * KVSTRIDE;
constexpr size_t RD_HID = 102 * MiB, RD_KCMP = 110 * MiB, RD_VCMPT = 111 * MiB;
constexpr int ACT_ROWS = 2 * NT + NE * 256;
static_assert((size_t)ACT_ROWS * DE * 2 <= 72 * MiB, "ACT");
constexpr int CW_CNT = 1024, CW_BAR = 4096;

constexpr int LDS_BYTES = 151552;
constexpr int RING_BYTES = 131072;
constexpr int MISC_OFF = LDS_BYTES - 2048;

__device__ __forceinline__ unsigned f2bf(float f) { unsigned u = __builtin_bit_cast(unsigned, f); return (u + 0x7fffu + ((u >> 16) & 1u)) >> 16; }
__device__ __forceinline__ unsigned pk2(float lo, float hi) {
    typedef float v2f __attribute__((ext_vector_type(2))); typedef __bf16 v2b __attribute__((ext_vector_type(2)));
    v2f v = {lo, hi}; v2b b = __builtin_convertvector(v, v2b); return __builtin_bit_cast(unsigned, b); }
__device__ __forceinline__ float bf2f(unsigned short b) { return __builtin_bit_cast(float, ((unsigned)b) << 16); }
__device__ __forceinline__ float bflo(unsigned w) { return __builtin_bit_cast(float, w << 16); }
__device__ __forceinline__ float bfhi(unsigned w) { return __builtin_bit_cast(float, w & 0xffff0000u); }
__device__ __forceinline__ float wave_sum(float v) {
#pragma unroll
    for (int o = 1; o < 64; o <<= 1) v += __shfl_xor(v, o);
    return v;
}
#define LDS_WAIT() asm volatile("s_waitcnt lgkmcnt(0)" ::: "memory")
__device__ __forceinline__ float max_x16(float v) { auto r = __builtin_amdgcn_permlane16_swap(__float_as_uint(v), __float_as_uint(v), false, false); return fmaxf(__uint_as_float(r[0]), __uint_as_float(r[1])); }
__device__ __forceinline__ float max_x32(float v) { auto r = __builtin_amdgcn_permlane32_swap(__float_as_uint(v), __float_as_uint(v), false, false); return fmaxf(__uint_as_float(r[0]), __uint_as_float(r[1])); }
__device__ __forceinline__ float sum_x16(float v) { auto r = __builtin_amdgcn_permlane16_swap(__float_as_uint(v), __float_as_uint(v), false, false); return __uint_as_float(r[0]) + __uint_as_float(r[1]); }
__device__ __forceinline__ float sum_x32(float v) { auto r = __builtin_amdgcn_permlane32_swap(__float_as_uint(v), __float_as_uint(v), false, false); return __uint_as_float(r[0]) + __uint_as_float(r[1]); }
__device__ __forceinline__ float max3f(float a, float b, float c) { float r; asm("v_max3_f32 %0, %1, %2, %3" : "=v"(r) : "v"(a), "v"(b), "v"(c)); return r; }
__device__ __forceinline__ float dpp_x1(float v) { return __uint_as_float((unsigned)__builtin_amdgcn_mov_dpp((int)__float_as_uint(v), 0xB1, 0xF, 0xF, true)); }
__device__ __forceinline__ float dpp_x2(float v) { return __uint_as_float((unsigned)__builtin_amdgcn_mov_dpp((int)__float_as_uint(v), 0x4E, 0xF, 0xF, true)); }


__device__ __forceinline__ int slot_perm8(int c) {
    const int hi = c & ~31, fq = (c >> 3) & 3, n = (c >> 2) & 1, j = c & 3; return hi + 16 * n + 4 * fq + j; }
__device__ __forceinline__ int slot_pair128(int c, int n) {
    const int wc = c >> 5, fq = (c >> 3) & 3, bj = (c >> 2) & 1, j = c & 3; return 128 * bj + 32 * wc + 16 * n + 4 * fq + j; }
__device__ __forceinline__ int slot_rope64(int d) {
    const int n = d >> 5, dd = d & 31, wcl = dd >> 4, fq = (dd >> 2) & 3, j = dd & 3; return 32 * wcl + 16 * n + 4 * fq + j; }

namespace pg8 {
constexpr int BM = 256, BK = 64, HALF = 128, HTB = HALF * BK * 2, STAGE_BYTES = 8 * HTB, NXCD = 8, WGM = 8;
__host__ __device__ __forceinline__ int lds_byte(int r, int c) { const int st = (r >> 4) * 2 + (c >> 5), rr = r & 15, cc = c & 31, ob = rr * 64 + cc * 2; return st * 1024 + (ob ^ (((ob >> 9) & 1) << 5)); }
__host__ __device__ __forceinline__ void stage_rc(int b, int& R, int& C) { const int st = b / 1024, sb = b % 1024, swz = sb ^ (((sb >> 9) & 1) << 5); R = (st >> 1) * 16 + swz / 64; C = (st & 1) * 32 + (swz % 64) / 2; }

struct Unit { int pm, pn, e, nvalid; };
struct Gemm { int K, lda; };

template <class Epi, class Sched, bool GATHER, bool ALIGN_EPI = true, bool SP2 = true>
__device__ __forceinline__ void gemm_phase(LAS unsigned char* lds, int tid_in, const Gemm g, const Sched& S, const Epi& E) {
    int tid_ = tid_in; asm volatile("" : "+v"(tid_));
    const int tid = tid_, wid = __builtin_amdgcn_readfirstlane(tid >> 6), lane = tid & 63, wr = wid >> 2, wc = wid & 3, fr = lane & 15, fq = lane >> 4;
    const int K = g.K, nt = K / BK;
    int R0, C0; stage_rc(tid * 16, R0, C0);
    unsigned voffA[2], voffB[2];
#pragma unroll
    for (int i = 0; i < 2; ++i) { voffA[i] = (unsigned)((R0 + 64 * i) * g.lda + C0) * 2u; voffB[i] = (unsigned)((R0 + 64 * i) * K + C0) * 2u; }
    unsigned vgC[2][2], vgN[2][2];
    const size_t kstep = (size_t)(BK * 2);
    const size_t hstepA = (size_t)HALF * g.lda * 2, hstepB = (size_t)HALF * K * 2;
    const unsigned ldsw = (unsigned)wid * 1024u;
    const int aoff = lds_byte(wr * 64 + fr, fq * 8), boff = lds_byte(wc * 32 + fr, fq * 8);
#define PG8_SA(b, h) (((b) * 2 + (h)) * HTB)
#define PG8_SB(b, h) ((4 + (b) * 2 + (h)) * HTB)
#define PG8_GLDS(src, dstoff) __builtin_amdgcn_global_load_lds((const unsigned*)(src), (LAS unsigned*)(lds + (dstoff)), 16, 0, 0)
#define PG8_STAGE_B(bufoff, gbase) do { _Pragma("unroll") for (int _i = 0; _i < 2; ++_i) PG8_GLDS((const char*)(gbase) + voffB[_i], (bufoff) + ldsw + _i * 8192); } while (0)
#define PG8_STAGE_A(bufoff, gbase, h, VG) do { _Pragma("unroll") for (int _i = 0; _i < 2; ++_i) { \
        if constexpr (GATHER) PG8_GLDS((const char*)(gbase) + VG[h][_i], (bufoff) + ldsw + _i * 8192); \
        else PG8_GLDS((const char*)(gbase) + (h) * hstepA + voffA[_i], (bufoff) + ldsw + _i * 8192); } } while (0)
#define PG8_LDA(dst, b, h) do { _Pragma("unroll") for (int m = 0; m < 4; ++m) _Pragma("unroll") for (int k = 0; k < 2; ++k) dst[m][k] = *(const LAS bf16x8*)(lds + PG8_SA(b, h) + aoff + m * 2048 + k * 1024); } while (0)
#define PG8_LDB(dst, b, h) do { _Pragma("unroll") for (int n = 0; n < 2; ++n) _Pragma("unroll") for (int k = 0; k < 2; ++k) dst[n][k] = *(const LAS bf16x8*)(lds + PG8_SB(b, h) + boff + n * 2048 + k * 1024); } while (0)
#define PG8_MMA(ai, bj, At, Bt) do { __builtin_amdgcn_s_setprio(1); _Pragma("unroll") for (int m = 0; m < 4; ++m) _Pragma("unroll") for (int n = 0; n < 2; ++n) _Pragma("unroll") for (int k = 0; k < 2; ++k) \
        acc[ai][bj][m][n] = __builtin_amdgcn_mfma_f32_16x16x32_bf16(Bt[n][k], At[m][k], acc[ai][bj][m][n], 0, 0, 0); __builtin_amdgcn_s_setprio(0); } while (0)
#define PG8_WAIT_V(n) asm volatile("s_waitcnt vmcnt(" #n ")" ::: "memory")
#define PG8_WAIT_L(n) asm volatile("s_waitcnt lgkmcnt(" #n ")" ::: "memory")
#define PG8_BAR __builtin_amdgcn_s_barrier()
#define PG8_SCHED __builtin_amdgcn_sched_barrier(0)
    Unit cur, nxt; int ui = 0;
    if (!S.next(0, cur)) return;
    f32x4 acc[2][2][4][2];
#pragma unroll
    for (int a = 0; a < 2; ++a)
#pragma unroll
        for (int b = 0; b < 2; ++b)
#pragma unroll
            for (int m = 0; m < 4; ++m)
#pragma unroll
                for (int n = 0; n < 2; ++n) acc[a][b][m][n] = (f32x4){0.f, 0.f, 0.f, 0.f};
    bf16x8 At[4][2], B0[2][2], B1[2][2];
    const char* cA = S.a_base(cur); const char* cB = S.b_base(cur);
    if constexpr (GATHER) {
#pragma unroll
        for (int h = 0; h < 2; ++h)
#pragma unroll
            for (int i = 0; i < 2; ++i) vgC[h][i] = S.a_off(cur, h * HALF + R0 + 64 * i) + (unsigned)C0 * 2u;
    }
    if constexpr (SP2) {
        PG8_STAGE_B(PG8_SB(0, 0), cB); PG8_STAGE_B(PG8_SB(0, 1), cB + hstepB); PG8_STAGE_A(PG8_SA(0, 0), cA, 0, vgC); PG8_STAGE_A(PG8_SA(0, 1), cA, 1, vgC);
        if (wr == 1) PG8_BAR;
        PG8_WAIT_V(2); PG8_BAR;
        PG8_STAGE_B(PG8_SB(1, 0), cB + kstep); PG8_STAGE_A(PG8_SA(1, 0), cA + kstep, 0, vgC); PG8_STAGE_B(PG8_SB(1, 1), cB + hstepB + kstep);
        PG8_WAIT_V(6); PG8_BAR;
    } else {
        PG8_STAGE_B(PG8_SB(0, 0), cB); PG8_STAGE_A(PG8_SA(0, 0), cA, 0, vgC); PG8_STAGE_B(PG8_SB(0, 1), cB + hstepB); PG8_STAGE_A(PG8_SA(0, 1), cA, 1, vgC);
        if (wr == 1) PG8_BAR;
        PG8_WAIT_V(4); PG8_BAR;
        PG8_STAGE_B(PG8_SB(1, 0), cB + kstep); PG8_STAGE_A(PG8_SA(1, 0), cA + kstep, 0, vgC); PG8_STAGE_B(PG8_SB(1, 1), cB + hstepB + kstep);
        PG8_WAIT_V(6); PG8_BAR;
    }
    for (;;) {
        const bool has_next = S.next(ui + 1, nxt);
        const char* nA = has_next ? S.a_base(nxt) : cA; const char* nB = has_next ? S.b_base(nxt) : cB;
        if constexpr (GATHER) {
#pragma unroll
            for (int h = 0; h < 2; ++h)
#pragma unroll
                for (int i = 0; i < 2; ++i) vgN[h][i] = has_next ? (S.a_off(nxt, h * HALF + R0 + 64 * i) + (unsigned)C0 * 2u) : vgC[h][i];
        }
        for (int t = 0; t < nt; t += 2) {
            const bool last = (t == nt - 2);
            const char* a1 = cA + (size_t)(t + 1) * kstep;
            const char* a2 = last ? nA : cA + (size_t)(t + 2) * kstep; const char* b2 = last ? nB : cB + (size_t)(t + 2) * kstep;
            const char* a3 = a2 + kstep; const char* b3 = b2 + kstep;
            unsigned vg2[2][2];
            if constexpr (GATHER) {
#pragma unroll
                for (int h = 0; h < 2; ++h)
#pragma unroll
                    for (int i = 0; i < 2; ++i) vg2[h][i] = last ? vgN[h][i] : vgC[h][i];
            }
            if constexpr (SP2) {
            PG8_LDB(B0, 0, 0); PG8_LDB(B1, 0, 1); PG8_SCHED; PG8_LDA(At, 0, 0); PG8_STAGE_A(PG8_SA(1, 1), a1, 1, vgC);
            PG8_WAIT_V(8); PG8_WAIT_L(0); PG8_BAR; PG8_MMA(0, 0, At, B0); PG8_MMA(0, 1, At, B1); PG8_BAR; PG8_SCHED;
            PG8_LDA(At, 0, 1); PG8_STAGE_B(PG8_SB(0, 0), b2); PG8_STAGE_B(PG8_SB(0, 1), b2 + hstepB); PG8_STAGE_A(PG8_SA(0, 0), a2, 0, vg2);
            PG8_WAIT_V(8); PG8_WAIT_L(0); PG8_BAR; PG8_MMA(1, 0, At, B0); PG8_MMA(1, 1, At, B1); PG8_BAR; PG8_SCHED;
            PG8_LDB(B0, 1, 0); PG8_LDB(B1, 1, 1); PG8_SCHED; PG8_LDA(At, 1, 0); PG8_STAGE_A(PG8_SA(0, 1), a2, 1, vg2);
            PG8_WAIT_V(8); PG8_WAIT_L(0); PG8_BAR; PG8_MMA(0, 0, At, B0); PG8_MMA(0, 1, At, B1); PG8_BAR; PG8_SCHED;
            PG8_LDA(At, 1, 1); PG8_STAGE_B(PG8_SB(1, 0), b3); PG8_STAGE_B(PG8_SB(1, 1), b3 + hstepB); PG8_STAGE_A(PG8_SA(1, 0), a3, 0, vg2);
            PG8_WAIT_V(8); PG8_WAIT_L(0); PG8_BAR; PG8_MMA(1, 0, At, B0); PG8_MMA(1, 1, At, B1); PG8_BAR; PG8_SCHED;
            } else {
            PG8_LDB(B0, 0, 0); PG8_SCHED; PG8_LDA(At, 0, 0); PG8_STAGE_A(PG8_SA(1, 1), a1, 1, vgC);
            PG8_WAIT_L(8); PG8_BAR; PG8_WAIT_L(0); PG8_MMA(0, 0, At, B0); PG8_BAR; PG8_SCHED;
            PG8_LDB(B1, 0, 1); PG8_STAGE_B(PG8_SB(0, 0), b2);
            PG8_BAR; PG8_WAIT_L(0); PG8_MMA(0, 1, At, B1); PG8_BAR;
            PG8_LDA(At, 0, 1); PG8_STAGE_A(PG8_SA(0, 0), a2, 0, vg2);
            PG8_BAR; PG8_WAIT_L(0); PG8_MMA(1, 0, At, B0); PG8_BAR; PG8_SCHED;
            PG8_STAGE_B(PG8_SB(0, 1), b2 + hstepB);
            PG8_WAIT_V(6); PG8_BAR; PG8_MMA(1, 1, At, B1); PG8_BAR;
            PG8_LDB(B0, 1, 0); PG8_SCHED; PG8_LDA(At, 1, 0); PG8_STAGE_A(PG8_SA(0, 1), a2, 1, vg2);
            PG8_WAIT_L(8); PG8_BAR; PG8_WAIT_L(0); PG8_MMA(0, 0, At, B0); PG8_BAR; PG8_SCHED;
            PG8_LDB(B1, 1, 1); PG8_STAGE_B(PG8_SB(1, 0), b3);
            PG8_BAR; PG8_WAIT_L(0); PG8_MMA(0, 1, At, B1); PG8_BAR;
            PG8_LDA(At, 1, 1); PG8_STAGE_A(PG8_SA(1, 0), a3, 0, vg2);
            PG8_BAR; PG8_WAIT_L(0); PG8_MMA(1, 0, At, B0); PG8_BAR; PG8_SCHED;
            PG8_STAGE_B(PG8_SB(1, 1), b3 + hstepB);
            PG8_WAIT_V(6); PG8_BAR; PG8_MMA(1, 1, At, B1); PG8_BAR;
            }
        }
        if constexpr (ALIGN_EPI) { if (wr == 0) PG8_BAR; }
        E(acc, cur, wr, wc, fr, fq);
        if (!has_next) break;
#pragma unroll
        for (int a = 0; a < 2; ++a)
#pragma unroll
            for (int b = 0; b < 2; ++b)
#pragma unroll
                for (int m = 0; m < 4; ++m)
#pragma unroll
                    for (int n = 0; n < 2; ++n) acc[a][b][m][n] = (f32x4){0.f, 0.f, 0.f, 0.f};
        cur = nxt; cA = nA; cB = nB; ++ui;
        if constexpr (GATHER) {
#pragma unroll
            for (int h = 0; h < 2; ++h)
#pragma unroll
                for (int i = 0; i < 2; ++i) vgC[h][i] = vgN[h][i];
        }
        if constexpr (ALIGN_EPI) { if (wr == 1) PG8_BAR; }
    }
    PG8_WAIT_V(0);
    if constexpr (!ALIGN_EPI) { if (wr == 0) PG8_BAR; }
    PG8_BAR;
#undef PG8_SA
#undef PG8_SB
#undef PG8_GLDS
#undef PG8_STAGE_A
#undef PG8_STAGE_B
#undef PG8_LDA
#undef PG8_LDB
#undef PG8_MMA
#undef PG8_WAIT_V
#undef PG8_WAIT_L
#undef PG8_BAR
#undef PG8_SCHED
}
}

struct Args {
    const float* in[25]; float* out; unsigned char* ws;
    float inv_freq[32];
    int ph_lo, ph_hi;
};
enum { I_X = 0, I_POS, I_NMIX, I_NFFN, I_CWIN, I_CW, I_CWOUT, I_NKV, I_WKV, I_CPK, I_CW1K, I_CW2K, I_CPV, I_CW1V, I_CW2V, I_AWIN, I_AWOUT,
       I_RGW, I_RGB, I_REW, I_REB, I_EWG, I_EWU, I_EWD, I_NFIN };

struct Frame {
    LAS unsigned char* lds;
    unsigned char* ws;
    int tid, lane, wave, vcu, G;
};

__device__ __forceinline__ int mytid(const Frame& F) { return F.wave * 64 + (int)__builtin_amdgcn_mbcnt_hi(~0u, __builtin_amdgcn_mbcnt_lo(~0u, 0u)); }
__device__ __forceinline__ Frame refresh(const Frame& F0) {
    Frame F = F0; int t = mytid(F0); asm volatile("" : "+v"(t)); F.tid = t; F.lane = t & 63; return F; }

struct DenseOrder {
    const char* A; const char* Bt; size_t tstepA, tstepB; int nM, nN, nwg, G, c;
    __device__ __forceinline__ void init(const void* A_, const void* Bt_, int M, int N, int K, int lda, int G_, int c_) {
        A = (const char*)A_; Bt = (const char*)Bt_; nM = M / 256; nN = N / 256; nwg = nM * nN; G = G_; c = c_; tstepA = (size_t)256 * lda * 2; tstepB = (size_t)256 * K * 2; }
    __device__ __forceinline__ bool next(int i, pg8::Unit& u) const {
        const long L = (long)i * G + c; if (L >= nwg) return false;
        int wgid = (int)L; { const int q = nwg / 8, r = nwg % 8, xcd = wgid % 8, off = wgid / 8; wgid = (xcd < r ? xcd * (q + 1) : r * (q + 1) + (xcd - r) * q) + off; }
        const int nig = 8 * nN, gid = wgid / nig, fm = gid * 8, gsz = (nM % 8 == 0) ? 8 : ((nM - fm) < 8 ? (nM - fm) : 8);
        u.pm = fm + ((wgid % nig) % gsz); u.pn = (wgid % nig) / gsz; u.e = 0; u.nvalid = 256; return true; }
    __device__ __forceinline__ const char* a_base(const pg8::Unit& u) const { return A + (size_t)u.pm * tstepA; }
    __device__ __forceinline__ const char* b_base(const pg8::Unit& u) const { return Bt + (size_t)u.pn * tstepB; }
    __device__ __forceinline__ unsigned a_off(const pg8::Unit&, int) const { return 0u; }
};
struct CmpOrder {
    const char* A0; const char* A1; const char* Bt; int G, c;
    __device__ __forceinline__ bool next(int i, pg8::Unit& u) const { const int L = i * G + c; if (L >= 64) return false; u.e = L >> 5; u.pm = L & 31; u.pn = 0; u.nvalid = 256; return true; }
    __device__ __forceinline__ const char* a_base(const pg8::Unit& u) const { return (u.e ? A1 : A0) + (size_t)u.pm * 256 * 1024 * 2; }
    __device__ __forceinline__ const char* b_base(const pg8::Unit& u) const { return Bt + (size_t)u.e * 256 * 2048 * 2; }
    __device__ __forceinline__ unsigned a_off(const pg8::Unit&, int) const { return 0u; }
};
struct MoeTab { volatile LAS int* tstart; volatile LAS int* cnt; };
__device__ __forceinline__ bool moe_unit(const MoeTab& T, int L, pg8::Unit& u) {
    const int total = T.tstart[32]; if (L >= 4 * total) return false;
    u.pn = L & 3; const int mt = L >> 2;
    const int e = (int)((volatile LAS unsigned char*)(T.tstart + 128))[mt];
    u.e = e; u.pm = mt - T.tstart[e]; u.nvalid = T.cnt[e] - u.pm * 256; return true;
}
struct MoeGuOrder {
    MoeTab T; const char* X; const int* rowl; const char* W; int G, c;
    __device__ __forceinline__ bool next(int i, pg8::Unit& u) const { return moe_unit(T, i * G + c, u); }
    __device__ __forceinline__ const char* a_base(const pg8::Unit&) const { return X; }
    __device__ __forceinline__ const char* b_base(const pg8::Unit& u) const { return W + (size_t)u.e * 3 * MiB + (size_t)u.pn * 256 * 1024 * 2; }
    __device__ __forceinline__ unsigned a_off(const pg8::Unit& u, int R) const {
        int idx = u.pm * 256 + R; const int lim = u.pm * 256 + u.nvalid - 1; idx = idx < lim ? idx : lim;
        const int id = rowl[(size_t)u.e * ECAP + idx]; return (unsigned)(id >> 1) * 2048u; }
};
struct MoeDnOrder {
    MoeTab T; const char* ACT; const char* W; int G, c;
    __device__ __forceinline__ bool next(int i, pg8::Unit& u) const { return moe_unit(T, i * G + c, u); }
    __device__ __forceinline__ const char* a_base(const pg8::Unit& u) const { return ACT + (size_t)(T.tstart[u.e] + u.pm) * 256 * 512 * 2; }
    __device__ __forceinline__ const char* b_base(const pg8::Unit& u) const { return W + (size_t)u.e * 3 * MiB + 2 * MiB + (size_t)u.pn * 256 * 512 * 2; }
    __device__ __forceinline__ unsigned a_off(const pg8::Unit&, int) const { return 0u; }
};

#define EPI_ARGS const f32x4 (&acc)[2][2][4][2], const pg8::Unit& u, int wr, int wc, int fr, int fq
__device__ __forceinline__ u32x4 pack8(const f32x4& a, const f32x4& b) { u32x4 w; w.x = pk2(a[0], a[1]); w.y = pk2(a[2], a[3]); w.z = pk2(b[0], b[1]); w.w = pk2(b[2], b[3]); return w; }
__device__ __forceinline__ u32x2 pack4(const f32x4& a) { u32x2 w; w.x = pk2(a[0], a[1]); w.y = pk2(a[2], a[3]); return w; }

struct EpiInProj {
    const float* r0; bf16_t* BG; bf16_t* U;
    __device__ __forceinline__ void operator()(EPI_ARGS) const {
        float rsv[2][4];
#pragma unroll
        for (int ai = 0; ai < 2; ++ai)
#pragma unroll
            for (int m = 0; m < 4; ++m) rsv[ai][m] = r0[u.pm * 256 + ai * 128 + wr * 64 + m * 16 + fr];
#pragma unroll
        for (int ai = 0; ai < 2; ++ai)
#pragma unroll
            for (int m = 0; m < 4; ++m) {
                const int row = u.pm * 256 + ai * 128 + wr * 64 + m * 16 + fr; const float rs = rsv[ai][m];
                if (u.pn < 4) {
#pragma unroll
                    for (int bj = 0; bj < 2; ++bj) *(u32x4*)(BG + (size_t)row * D + u.pn * 256 + bj * 128 + wc * 32 + 8 * fq) = pack8(acc[ai][bj][m][0] * rs, acc[ai][bj][m][1] * rs);
                } else {
                    const float rs2 = rs * rs;
                    *(u32x4*)(U + (size_t)row * D + (u.pn - 4) * 128 + wc * 32 + 8 * fq) = pack8(acc[ai][0][m][0] * acc[ai][0][m][1] * rs2, acc[ai][1][m][0] * acc[ai][1][m][1] * rs2);
                }
            }
    }
};
template <class TB>
struct EpiResid {
    const TB* base; bf16_t* out;
    __device__ __forceinline__ void operator()(EPI_ARGS) const {
#pragma unroll
        for (int ai = 0; ai < 2; ++ai)
#pragma unroll
            for (int mp = 0; mp < 2; ++mp) {
                f32x4 bv[2][2][2];
#pragma unroll
                for (int mm = 0; mm < 2; ++mm) { const size_t off = (size_t)(u.pm * 256 + ai * 128 + wr * 64 + (2 * mp + mm) * 16 + fr) * D + u.pn * 256 + wc * 32 + 8 * fq;
#pragma unroll
                    for (int bj = 0; bj < 2; ++bj) {
                        if constexpr (sizeof(TB) == 4) { bv[mm][bj][0] = *(const f32x4*)(base + off + bj * 128); bv[mm][bj][1] = *(const f32x4*)(base + off + bj * 128 + 4); }
                        else { const u32x4 w = *(const u32x4*)(base + off + bj * 128);
                            bv[mm][bj][0] = (f32x4){bflo(w[0]), bfhi(w[0]), bflo(w[1]), bfhi(w[1])}; bv[mm][bj][1] = (f32x4){bflo(w[2]), bfhi(w[2]), bflo(w[3]), bfhi(w[3])}; } } }
#pragma unroll
                for (int mm = 0; mm < 2; ++mm) { const size_t off = (size_t)(u.pm * 256 + ai * 128 + wr * 64 + (2 * mp + mm) * 16 + fr) * D + u.pn * 256 + wc * 32 + 8 * fq;
#pragma unroll
                    for (int bj = 0; bj < 2; ++bj) *(u32x4*)(out + off + bj * 128) = pack8(bv[mm][bj][0] + acc[ai][bj][2 * mp + mm][0], bv[mm][bj][1] + acc[ai][bj][2 * mp + mm][1]); }
            }
    }
};
__device__ __forceinline__ void quad_transpose(f32x4& v, int i) {
    const bool o1 = (i & 1) != 0, o2 = (i & 2) != 0;
    float s0 = o1 ? v[0] : v[1], s1 = o1 ? v[2] : v[3];
    float r0 = dpp_x1(s0), r1 = dpp_x1(s1);
    v[0] = o1 ? r0 : v[0]; v[2] = o1 ? r1 : v[2]; v[1] = o1 ? v[1] : r0; v[3] = o1 ? v[3] : r1;
    s0 = o2 ? v[0] : v[2]; s1 = o2 ? v[1] : v[3];
    r0 = dpp_x2(s0); r1 = dpp_x2(s1);
    v[0] = o2 ? r0 : v[0]; v[1] = o2 ? r1 : v[1]; v[2] = o2 ? v[2] : r0; v[3] = o2 ? v[3] : r1;
}
__device__ __forceinline__ int ks_idx(int t, int d) { const int mb = 2 * (t >> 5) + ((t >> 2) & 1), l15 = 4 * ((t >> 3) & 3) + (t & 3), c = d >> 3; return ((((mb * 2 + (c >> 2)) * 4 + (c & 3)) * 16 + l15) << 3) + (d & 7); }
__device__ __forceinline__ int vts_idx(int d, int t) { const int c = t >> 3; return (((((d >> 4) * 2 + (c >> 2)) * 4 + (c & 3)) * 16 + (d & 15)) << 3) + (t & 7); }
struct EpiQKV {
    const float* r2; const f32x2* rope; unsigned char* kv; bf16_t* Q; float* gates;
    __device__ __forceinline__ void operator()(EPI_ARGS) const {
        const int pn = u.pn;
        float rsv[2][4];
#pragma unroll
        for (int ai = 0; ai < 2; ++ai)
#pragma unroll
            for (int m = 0; m < 4; ++m) rsv[ai][m] = r2[u.pm * 256 + ai * 128 + wr * 64 + m * 16 + fr];
#pragma unroll
        for (int ai = 0; ai < 2; ++ai) {
            f32x4 rp[4][2];
            if (pn == 2 || pn == 4) {
#pragma unroll
                for (int m = 0; m < 4; ++m) { const f32x2* rr = rope + (size_t)(u.pm * 256 + ai * 128 + wr * 64 + m * 16 + fr) * 32 + 16 * (wc & 1) + 4 * fq; rp[m][0] = *(const f32x4*)rr; rp[m][1] = *(const f32x4*)(rr + 2); } }
#pragma unroll
            for (int m = 0; m < 4; ++m) {
                const int row = u.pm * 256 + ai * 128 + wr * 64 + m * 16 + fr; const float rs = rsv[ai][m];
                const int b = row >> 14, s = row & (SEQ - 1);
                f32x4 ropev[2][2];
                if (pn == 2 || pn == 4) {
#pragma unroll
                    for (int bj = 0; bj < 2; ++bj) { ropev[bj][0] = rp[m][0]; ropev[bj][1] = rp[m][1]; }
                }
                if (pn < 6) {
#pragma unroll
                    for (int bj = 0; bj < 2; ++bj) {
                        const int gg = 2 * bj + (wc >> 1), d0 = 16 * (wc & 1) + 4 * fq;
                        f32x4 v0 = acc[ai][bj][m][0] * rs, v1 = acc[ai][bj][m][1] * rs;
                        if (pn == 2 || pn == 4) {
                            const f32x4 cs0 = ropev[bj][0], cs1 = ropev[bj][1];
                            const f32x4 c = {cs0[0], cs0[2], cs1[0], cs1[2]}, sn = {cs0[1], cs0[3], cs1[1], cs1[3]};
                            const f32x4 o0 = v0 * c - v1 * sn, o1 = v1 * c + v0 * sn; v0 = o0; v1 = o1;
                        }
                        if (pn == 3 || pn == 5) {
                            bf16_t* vt = (bf16_t*)(kv + (size_t)pn * KVSTRIDE) + (size_t)(b * 4 + gg) * 64 * SEQ + (size_t)(s >> 6) * 4096;
                            const int i4 = fr & 3, q4 = fr >> 2;
                            quad_transpose(v0, i4); quad_transpose(v1, i4);
                            if (pn == 3) {
                                bf16_t* vl = vt + ((wc & 1) * 1024 + (q4 >> 1) * 128 + (fq * 4 + i4) * 8 + 4 * (q4 & 1)) + ((m >> 1) * 512 + (m & 1) * 256);
                                *(u32x2*)vl = pack4(v0); *(u32x2*)(vl + 2048) = pack4(v1);
                            } else {
                                bf16_t* vl = vt + (d0 + i4) * 64 + 16 * m + 4 * q4;
                                *(u32x2*)vl = pack4(v0); *(u32x2*)(vl + 32 * 64) = pack4(v1);
                            }
                        } else {
                            const u32x2 pa = pack4(v0), pb = pack4(v1);
                            const auto rx = __builtin_amdgcn_permlane16_swap(pa[0], pb[0], false, false), ry = __builtin_amdgcn_permlane16_swap(pa[1], pb[1], false, false);
                            const u32x4 w = {rx[0], ry[0], rx[1], ry[1]};
                            if (pn == 2) {
                                bf16_t* kp = (bf16_t*)(kv + (size_t)pn * KVSTRIDE) + (size_t)(b * 4 + gg) * SEQ * 64 + (size_t)(s >> 6) * 4096;
                                bf16_t* kl = kp + (((fr >> 2) & 1) * 1024 + (fq & 1) * 512 + (2 * (wc & 1) + (fq >> 1)) * 128 + (fr >> 3) * 32 + (fr & 3) * 8) + ((m >> 1) * 2048 + (m & 1) * 64);
                                *(u32x4*)kl = w;
                            } else {
                                bf16_t* kp = (bf16_t*)(kv + (size_t)pn * KVSTRIDE) + ((size_t)(b * 4 + gg) * SEQ + s) * 64 + (16 * (wc & 1) + 8 * (fq >> 1) + 32 * (fq & 1));
                                *(u32x4*)kp = w;
                            }
                        }
                    }
                } else if (pn < 10) {
#pragma unroll
                    for (int bj = 0; bj < 2; ++bj) {
                        const int head = 4 * (pn - 6) + 2 * bj + (wc >> 1), d0 = 16 * (wc & 1) + 4 * fq; const float sc = rs * (0.125f * 1.4426950408889634f);
                        const u32x2 pa = pack4(acc[ai][bj][m][0] * sc), pb = pack4(acc[ai][bj][m][1] * sc);
                        const auto rx = __builtin_amdgcn_permlane16_swap(pa[0], pb[0], false, false), ry = __builtin_amdgcn_permlane16_swap(pa[1], pb[1], false, false);
                        (void)d0; *(u32x4*)(Q + (size_t)row * D + head * 64 + (16 * (wc & 1) + 8 * (fq >> 1) + 32 * (fq & 1))) = (u32x4){rx[0], ry[0], rx[1], ry[1]};
                    }
                } else {
#pragma unroll
                    for (int n = 0; n < 2; ++n) { const int sl = 32 * wc + 16 * n + 4 * fq;
                        if (sl < 48) { f32x4 v = acc[ai][0][m][n] * rs;
#pragma unroll
                            for (int j = 0; j < 4; ++j) v[j] = __builtin_amdgcn_rcpf(1.0f + __expf(-v[j]));
                            *(f32x4*)(gates + (size_t)row * 48 + sl) = v; } }
                }
            }
        }
    }
};
__device__ __forceinline__ float gelu_tanh(float x) { const float y = 0.7978845608028654f * (x + 0.044715f * x * x * x); const float t = 1.0f - 2.0f * __builtin_amdgcn_rcpf(1.0f + __expf(2.0f * y)); return 0.5f * x * (1.0f + t); }
struct EpiCmp1 {
    const float* bias; bf16_t* HID;
    __device__ __forceinline__ void operator()(EPI_ARGS) const {
        f32x4 bv[2][2];
#pragma unroll
        for (int bj = 0; bj < 2; ++bj)
#pragma unroll
            for (int n = 0; n < 2; ++n) bv[bj][n] = *(const f32x4*)(bias + u.e * 256 + bj * 128 + wc * 32 + 8 * fq + 4 * n);
#pragma unroll
        for (int ai = 0; ai < 2; ++ai)
#pragma unroll
            for (int m = 0; m < 4; ++m) {
                const int row = u.pm * 256 + ai * 128 + wr * 64 + m * 16 + fr;
#pragma unroll
                for (int bj = 0; bj < 2; ++bj) { f32x4 v0 = acc[ai][bj][m][0] + bv[bj][0], v1 = acc[ai][bj][m][1] + bv[bj][1];
#pragma unroll
                    for (int j = 0; j < 4; ++j) { v0[j] = gelu_tanh(v0[j]); v1[j] = gelu_tanh(v1[j]); }
                    *(u32x4*)(HID + ((size_t)u.e * 8192 + row) * 256 + bj * 128 + wc * 32 + 8 * fq) = pack8(v0, v1); }
            }
    }
};
struct EpiGU {
    MoeTab T; const float* rowr; bf16_t* ACT;
    __device__ __forceinline__ void operator()(EPI_ARGS) const {
        const size_t arow0 = (size_t)(T.tstart[u.e] + u.pm) * 256;
        float rsv[2][4];
#pragma unroll
        for (int ai = 0; ai < 2; ++ai)
#pragma unroll
            for (int m = 0; m < 4; ++m) rsv[ai][m] = rowr[(size_t)u.e * ECAP + u.pm * 256 + ai * 128 + wr * 64 + m * 16 + fr];
#pragma unroll
        for (int ai = 0; ai < 2; ++ai)
#pragma unroll
            for (int m = 0; m < 4; ++m) {
                const int rl = ai * 128 + wr * 64 + m * 16 + fr; const float rs = rsv[ai][m];
                f32x4 a[2];
#pragma unroll
                for (int bj = 0; bj < 2; ++bj) { const f32x4 g = acc[ai][bj][m][0] * rs, up = acc[ai][bj][m][1] * rs;
#pragma unroll
                    for (int j = 0; j < 4; ++j) a[bj][j] = g[j] * __builtin_amdgcn_rcpf(1.0f + __expf(-g[j])) * up[j]; }
                *(u32x4*)(ACT + (arow0 + rl) * DE + u.pn * 128 + wc * 32 + 8 * fq) = pack8(a[0], a[1]);
            }
    }
};
struct EpiDN {
    const int* rowl; const float* wgt; bf16_t* Y;
    __device__ __forceinline__ void operator()(EPI_ARGS) const {
        int idv[2][4]; float wv[2][4];
#pragma unroll
        for (int ai = 0; ai < 2; ++ai)
#pragma unroll
            for (int m = 0; m < 4; ++m) { const int rl = ai * 128 + wr * 64 + m * 16 + fr; const int lim = u.nvalid - 1; const size_t sl = (size_t)u.e * ECAP + u.pm * 256 + (rl < lim ? rl : lim);
                idv[ai][m] = rowl[sl]; wv[ai][m] = wgt[sl]; }
#pragma unroll
        for (int ai = 0; ai < 2; ++ai)
#pragma unroll
            for (int m = 0; m < 4; ++m) {
                const int rl = ai * 128 + wr * 64 + m * 16 + fr;
                if (rl < u.nvalid) {
                    const int id = idv[ai][m]; const float w = wv[ai][m];
#pragma unroll
                    for (int bj = 0; bj < 2; ++bj) *(u32x4*)(Y + (size_t)id * D + u.pn * 256 + bj * 128 + wc * 32 + 8 * fq) = pack8(acc[ai][bj][m][0] * w, acc[ai][bj][m][1] * w);
                }
            }
    }
};

template <class RowMap>
__device__ __forceinline__ void transpose_item(const float* W, int K, int N, bf16_t* WT, const float* gain, LAS float*  , int item, int lane, const RowMap& rm) {
    const int nblk = (N + 31) / 32, kb = item / nblk, nb = item % nblk, k0 = 64 * kb + 8 * (lane & 7), nc = 32 * nb + 4 * (lane >> 3);
    if (nc >= N) return;
    f32x4 v[8];
#pragma unroll
    for (int i = 0; i < 8; ++i) v[i] = *(const f32x4*)(W + (size_t)(k0 + i) * N + nc);
    if (gain) { const f32x4 g0 = *(const f32x4*)(gain + k0), g1 = *(const f32x4*)(gain + k0 + 4);
#pragma unroll
        for (int i = 0; i < 4; ++i) { v[i] = v[i] * g0[i]; v[4 + i] = v[4 + i] * g1[i]; } }
#pragma unroll
    for (int j = 0; j < 4; ++j) { u32x4 o; o.x = pk2(v[0][j], v[1][j]); o.y = pk2(v[2][j], v[3][j]); o.z = pk2(v[4][j], v[5][j]); o.w = pk2(v[6][j], v[7][j]);
        *(u32x4*)(WT + (size_t)rm(nc + j) * K + k0) = o; }
}
struct MapIdent { __device__ __forceinline__ int operator()(int c) const { return c; } };
struct MapPerm8 { __device__ __forceinline__ int operator()(int c) const { return slot_perm8(c); } };
struct MapWin { __device__ __forceinline__ int operator()(int c) const {
    if (c < 1024) return slot_perm8(c);
    const int n = (c >= 2048) ? 1 : 0, ch = c - 1024 - 1024 * n; return 1024 + (ch >> 7) * 256 + slot_pair128(ch & 127, n); } };
struct MapKV { __device__ __forceinline__ int operator()(int c) const { return (c & ~63) + slot_rope64(c & 63); } };
struct MapAIn { __device__ __forceinline__ int operator()(int c) const { return c < 1024 ? 1536 + (c & ~63) + slot_rope64(c & 63) : 2560 + (c - 1024); } };
struct MapGU { int n; __device__ __forceinline__ int operator()(int c) const { return (c >> 7) * 256 + slot_pair128(c & 127, n); } };

struct ConvItem {
    f32x4 v[8], g0, g1; bf16_t* dst; int K, kind, nc; bool hasg;
    __device__ __forceinline__ void load(const Args& a, unsigned char* ws, int layer, int it, int lane) {
        const int e = it / 768, r = it % 768; kind = r < 256 ? 0 : (r < 512 ? 1 : 2); const int item = r & 255;
        const size_t eo = ((size_t)layer * NE + e) * (size_t)D * DE;
        const float* W = (kind == 0 ? a.in[I_EWG] : kind == 1 ? a.in[I_EWU] : a.in[I_EWD]) + eo;
        const int N = kind == 2 ? D : DE; K = kind == 2 ? DE : D; hasg = kind != 2;
        const int nblk = N / 32, kb = item / nblk, nb = item % nblk, k0 = 64 * kb + 8 * (lane & 7); nc = 32 * nb + 4 * (lane >> 3);
        dst = (bf16_t*)(ws + WS_EXPW + (size_t)e * 3 * MiB) + (kind == 2 ? (size_t)1024 * 1024 : 0) + k0;
#pragma unroll
        for (int i = 0; i < 8; ++i) v[i] = *(const f32x4*)(W + (size_t)(k0 + i) * N + nc);
        const float* gp = a.in[I_NFFN] + layer * D + (hasg ? k0 : 0); g0 = *(const f32x4*)gp; g1 = *(const f32x4*)(gp + 4);
    }
    __device__ __forceinline__ void store() {
        if (hasg) {
#pragma unroll
            for (int i = 0; i < 4; ++i) { v[i] = v[i] * g0[i]; v[4 + i] = v[4 + i] * g1[i]; } }
#pragma unroll
        for (int j = 0; j < 4; ++j) { u32x4 o; o.x = pk2(v[0][j], v[1][j]); o.y = pk2(v[2][j], v[3][j]); o.z = pk2(v[4][j], v[5][j]); o.w = pk2(v[6][j], v[7][j]);
            const int c = nc + j; const int slot = kind == 2 ? slot_perm8(c) : (c >> 7) * 256 + slot_pair128(c & 127, kind);
            *(u32x4*)(dst + (size_t)slot * K) = o; }
    }
};
__device__ __forceinline__ void convert_experts_dn(const Args& a, const Frame& F, int layer, int first, int stride) {
    constexpr int NJ = NE * 256;
    if (first >= NJ) return;
    ConvItem cur, nxt; cur.load(a, F.ws, layer, (first >> 8) * 768 + 512 + (first & 255), F.lane);
#pragma unroll 1
    for (int j = first; j < NJ; j += stride) { const int jn = j + stride < NJ ? j + stride : j;
        nxt.load(a, F.ws, layer, (jn >> 8) * 768 + 512 + (jn & 255), F.lane); cur.store(); cur = nxt; }
}
__device__ __forceinline__ void convert_experts_gu(const Args& a, const Frame& F, int layer, int gw, int NGW) {
    constexpr int NJ = NE * 512;
    if (gw >= NJ) return;
    ConvItem cur, nxt; cur.load(a, F.ws, layer, (gw >> 9) * 768 + (gw & 511), F.lane);
#pragma unroll 1
    for (int j = gw; j < NJ; j += NGW) { const int jn = j + NGW < NJ ? j + NGW : j;
        nxt.load(a, F.ws, layer, (jn >> 9) * 768 + (jn & 511), F.lane); cur.store(); cur = nxt; }
}
__device__ __forceinline__ void convert_experts(const Args& a, const Frame& F, int layer, int gw, int NGW, LAS float*  ) {
    constexpr int NIT = NE * 768;
    if (gw >= NIT) return;
    ConvItem cur, nxt; cur.load(a, F.ws, layer, gw, F.lane);
#pragma unroll 1
    for (int it = gw; it < NIT; it += NGW) {
        const int itn = it + NGW < NIT ? it + NGW : it;
        nxt.load(a, F.ws, layer, itn, F.lane);
        cur.store();
        cur = nxt;
    }
}

__device__ __forceinline__ void phase_prep(const Args& a, const Frame& F0) {
    const Frame F = refresh(F0);
    LAS float* scr = (LAS float*)(F.lds + F.wave * 16384);
    const int gw = F.vcu * NWAVES + F.wave, NGW = F.G * NWAVES;
    const int gt = gw * 64 + F.lane, NGT = NGW * 64;
    unsigned char* ws = F.ws;
    { const float* x = a.in[I_X]; bf16_t* XB = (bf16_t*)(ws + WS_RA); float* R0 = (float*)(ws + WS_R0);
      for (int m = gw; m < NT; m += NGW) { const f32x4* xr = (const f32x4*)(x + (size_t)m * D) + F.lane; f32x4 v[4]; float s = 0.f;
#pragma unroll
          for (int j = 0; j < 4; ++j) { v[j] = xr[64 * j]; s += (v[j][0] * v[j][0] + v[j][1] * v[j][1]) + (v[j][2] * v[j][2] + v[j][3] * v[j][3]); }
          s = wave_sum(s); if (F.lane == 0) R0[m] = 1.0f / sqrtf(s * (1.0f / D) + RMS_EPS);
          u32x2* o8 = (u32x2*)(XB + (size_t)m * D) + F.lane;
#pragma unroll
          for (int j = 0; j < 4; ++j) o8[64 * j] = pack4(v[j]); } }
    { const int* pos = (const int*)a.in[I_POS]; f32x2* rope = (f32x2*)(ws + WS_ROPE);
      for (int i = gt; i < NT * 32; i += NGT) { const float ang = (float)pos[i >> 5] * a.inv_freq[i & 31];
          double rev = (double)ang * 0.15915494309189533577; rev -= __builtin_rint(rev); const float rf = (float)rev;
          rope[i] = (f32x2){__builtin_amdgcn_cosf(rf), __builtin_amdgcn_sinf(rf)}; } }
    { constexpr int I_IN = 16 * 96, I_OUT = 16 * 32, I_KV = 16 * 48, I_AIN = 16 * 34, I_C1 = 32 * 8, I_AO = 16 * 32;
      constexpr int NI = I_IN + I_OUT + I_KV + I_AIN + 2 * I_C1 + I_AO;
      for (int it = gw; it < NI; it += NGW) { int r = it;
          if (r < I_IN) { transpose_item(a.in[I_CWIN], D, 3 * D, (bf16_t*)(ws + WS_WIN), a.in[I_NMIX], scr, r, F.lane, MapWin{}); continue; } r -= I_IN;
          if (r < I_OUT) { transpose_item(a.in[I_CWOUT], D, D, (bf16_t*)(ws + WS_WOUT), nullptr, scr, r, F.lane, MapPerm8{}); continue; } r -= I_OUT;
          if (r < I_KV) { transpose_item(a.in[I_WKV], D, 1536, (bf16_t*)(ws + WS_WQKV), a.in[I_NKV], scr, r, F.lane, MapKV{}); continue; } r -= I_KV;
          if (r < I_AIN) { transpose_item(a.in[I_AWIN], D, 1072, (bf16_t*)(ws + WS_WQKV), a.in[I_NMIX] + D, scr, r, F.lane, MapAIn{}); continue; } r -= I_AIN;
          if (r < I_C1) { transpose_item(a.in[I_CW1K], 2048, 256, (bf16_t*)(ws + WS_WC1), nullptr, scr, r, F.lane, MapPerm8{}); continue; } r -= I_C1;
          if (r < I_C1) { transpose_item(a.in[I_CW1V], 2048, 256, (bf16_t*)(ws + WS_WC1) + 256 * 2048, nullptr, scr, r, F.lane, MapPerm8{}); continue; } r -= I_C1;
          transpose_item(a.in[I_AWOUT], D, D, (bf16_t*)(ws + WS_WAO), nullptr, scr, r, F.lane, MapPerm8{});
      } }
    if (NGW != 2048) convert_experts(a, F, 0, gw, NGW, scr);
    { unsigned* z = (unsigned*)((bf16_t*)(ws + WS_WQKV) + (size_t)2608 * D); for (int i = gt; i < 208 * D / 2; i += NGT) z[i] = 0u; }
    { float* bc = (float*)(ws + WS_BIASC);
      for (int o = gw; o < 512; o += NGW) { const int kv = o >> 8, n = o & 255; const float* pos = a.in[kv ? I_CPV : I_CPK]; const float* w1 = a.in[kv ? I_CW1V : I_CW1K]; float s = 0.f;
          for (int i = F.lane; i < 2048; i += 64) s += pos[i] * w1[(size_t)i * 256 + n];
          s = wave_sum(s); if (F.lane == 0) bc[o] = s; } }
    { float* rw = (float*)(ws + WS_RW);
      for (int i = gt; i < 2 * 36 * 1024; i += NGT) { const int l = i / (36 * 1024), r = i % (36 * 1024), o = r >> 10, k = r & 1023;
          const float g = a.in[I_NFFN][l * D + k]; rw[i] = g * (o < 32 ? a.in[I_REW][((size_t)l * D + k) * 32 + o] : a.in[I_RGW][((size_t)l * D + k) * 4 + (o - 32)]); } }
    { bf16_t* w2t = (bf16_t*)(ws + WS_W2T);
      for (int i = gt; i < 2 * 64 * 256; i += NGT) { const int kv = i >> 14, r = i & 16383, n = r >> 8, k = r & 255; w2t[i] = (bf16_t)f2bf(a.in[kv ? I_CW2V : I_CW2K][k * 64 + n]); } }
}

__device__ __forceinline__ void phase_conv(const Args& a, const Frame& F0) {
    const Frame F = refresh(F0);
    const bf16_t* BG = (const bf16_t*)(F.ws + WS_RB); const bf16_t* U = (const bf16_t*)(F.ws + WS_RC); bf16_t* Z = (bf16_t*)(F.ws + WS_RA);
    const float* cw = a.in[I_CW];
    const int cg8 = (F.tid & 127) * 8, tq = F.tid >> 7;
    float w0[8], w1[8], w2[8];
#pragma unroll
    for (int j = 0; j < 8; ++j) { w0[j] = cw[cg8 + j]; w1[j] = cw[D + cg8 + j]; w2[j] = cw[2 * D + cg8 + j]; }
    for (int ch = F.vcu; ch < NT / 32; ch += F.G) {
        const int t0 = ch * 32 + tq * 8; const int s0 = t0 & (SEQ - 1);
        float um2[8], um1[8];
        { u32x4 p = {0u, 0u, 0u, 0u}, q = {0u, 0u, 0u, 0u};
          if (s0 >= 2) p = *(const u32x4*)(U + (size_t)(t0 - 2) * D + cg8);
          if (s0 >= 1) q = *(const u32x4*)(U + (size_t)(t0 - 1) * D + cg8);
#pragma unroll
          for (int j = 0; j < 4; ++j) { um2[2 * j] = bflo(p[j]); um2[2 * j + 1] = bfhi(p[j]); um1[2 * j] = bflo(q[j]); um1[2 * j + 1] = bfhi(q[j]); } }
#pragma unroll
        for (int i = 0; i < 8; ++i) {
            const u32x4 uu = *(const u32x4*)(U + (size_t)(t0 + i) * D + cg8), bb = *(const u32x4*)(BG + (size_t)(t0 + i) * D + cg8);
            float z[8];
#pragma unroll
            for (int j = 0; j < 4; ++j) { const float u0 = bflo(uu[j]), u1 = bfhi(uu[j]);
                z[2 * j] = bflo(bb[j]) * (w0[2 * j] * um2[2 * j] + w1[2 * j] * um1[2 * j] + w2[2 * j] * u0);
                z[2 * j + 1] = bfhi(bb[j]) * (w0[2 * j + 1] * um2[2 * j + 1] + w1[2 * j + 1] * um1[2 * j + 1] + w2[2 * j + 1] * u1);
                um2[2 * j] = um1[2 * j]; um2[2 * j + 1] = um1[2 * j + 1]; um1[2 * j] = u0; um1[2 * j + 1] = u1; }
            u32x4 o; o.x = pk2(z[0], z[1]); o.y = pk2(z[2], z[3]); o.z = pk2(z[4], z[5]); o.w = pk2(z[6], z[7]);
            *(u32x4*)(Z + (size_t)(t0 + i) * D + cg8) = o;
        }
    }
}

__device__ __forceinline__ void phase_router(const Args& a, const Frame& F0, int layer, const bf16_t* X, float* Rout) {
    const Frame F = refresh(F0);
    unsigned char* ws = F.ws;
    const float* rw = (const float*)(ws + WS_RW) + (size_t)layer * 36 * 1024;
    const float* brg = a.in[I_RGB] + layer * 4; const float* bre = a.in[I_REB] + layer * 32;
    unsigned* gcnt = (unsigned*)(ws + WS_CTL) + CW_CNT + layer * 32;
    int* rowl = (int*)(ws + WS_ROWL); float* rowr = (float*)(ws + WS_ROWR); float* wsl = (float*)(ws + WS_RD + RD_HID);
    constexpr int XT_LD = 260;
    LAS float* xt = (LAS float*)(F.lds) + F.wave * (16 * XT_LD);
    LAS float* lg = xt;
    LAS unsigned* cntl = (LAS unsigned*)(F.lds + 8 * 16 * XT_LD * 4); LAS unsigned* basel = cntl + 32;
    const int l15 = F.lane & 15, quad = F.lane >> 4;
    for (int base = F.vcu * 128; base < NT; base += F.G * 128) {
        if (F.tid < 32) cntl[F.tid] = 0u;
        const int tok0 = base + F.wave * 16, tok = tok0 + l15;
        const float* w0 = rw + (size_t)l15 * 1024 + 4 * quad; const float* w1 = w0 + 16 * 1024; const float* w2 = rw + (size_t)(32 + (l15 & 3)) * 1024 + 4 * quad;
        f32x4 acc0 = {0.f, 0.f, 0.f, 0.f}, acc1 = acc0, acc2 = acc0; float ss = 0.f;
        u32x2 nxt[16];
#pragma unroll
        for (int r = 0; r < 16; ++r) nxt[r] = *(const u32x2*)(X + (size_t)(tok0 + r) * D + 4 * F.lane);
        const bool dnconv = F.G * NWAVES == 2048 && layer == 0; const int ncv = 8;
        const int cvw = F.vcu * NWAVES + F.wave;
        ConvItem ci;
#pragma unroll 1
        for (int ch = 0; ch < 4; ++ch) {
#pragma unroll
            for (int r = 0; r < 16; ++r) *(LAS f32x4*)(xt + r * XT_LD + 4 * F.lane) = (f32x4){bflo(nxt[r][0]), bfhi(nxt[r][0]), bflo(nxt[r][1]), bfhi(nxt[r][1])};
            if (ch < 3) {
#pragma unroll
                for (int r = 0; r < 16; ++r) nxt[r] = *(const u32x2*)(X + (size_t)(tok0 + r) * D + 256 * (ch + 1) + 4 * F.lane); }
#pragma unroll 1
            for (int g4 = 0; g4 < 4; ++g4) {
                if (dnconv) { const int sl = ch * 4 + g4;
                    if (sl > 0 && sl <= ncv) ci.store();
                    if (sl < ncv) { const int jg = cvw * 8 + sl;
                        ci.load(a, ws, layer, (jg >> 9) * 768 + (jg & 511), F.lane); } }
#pragma unroll
            for (int i4 = 0; i4 < 4; ++i4) { const int i = 4 * g4 + i4;
                const int k0 = 256 * ch + 16 * i;
                const f32x4 xv = *(const LAS f32x4*)(xt + l15 * XT_LD + 16 * i + 4 * quad), b0 = *(const f32x4*)(w0 + k0), b1 = *(const f32x4*)(w1 + k0), b2 = *(const f32x4*)(w2 + k0);
                ss += (xv[0] * xv[0] + xv[1] * xv[1]) + (xv[2] * xv[2] + xv[3] * xv[3]);
#pragma unroll
                for (int jj = 0; jj < 4; ++jj) {
                    acc0 = __builtin_amdgcn_mfma_f32_16x16x4f32(xv[jj], b0[jj], acc0, 0, 0, 0);
                    acc1 = __builtin_amdgcn_mfma_f32_16x16x4f32(xv[jj], b1[jj], acc1, 0, 0, 0);
                    acc2 = __builtin_amdgcn_mfma_f32_16x16x4f32(xv[jj], b2[jj], acc2, 0, 0, 0);
                }
            } }
        }
        ss += __shfl_xor(ss, 16); ss += __shfl_xor(ss, 32);
        const float r = 1.0f / sqrtf(ss * (1.0f / D) + RMS_EPS);
        if (quad == 0) Rout[tok] = r;
#pragma unroll
        for (int i = 0; i < 4; ++i) { const float rt = __shfl(r, 4 * quad + i); const int trow = 4 * quad + i;
            lg[trow * 36 + l15] = acc0[i] * rt + bre[l15]; lg[trow * 36 + 16 + l15] = acc1[i] * rt + bre[16 + l15];
            if (l15 < 4) lg[trow * 36 + 32 + l15] = acc2[i] * rt + brg[l15]; }
        __syncthreads();
        int e0 = 0, e1 = 0, rk0 = 0, rk1 = 0; float wt0 = 0.f, wt1 = 0.f;
        if (F.lane < 16) {
            const LAS float* L = lg + F.lane * 36;
            const float g0 = L[32], g1 = L[33], g2 = L[34], g3 = L[35];
            float gm = g0; int gt = 0; if (g1 > gm) { gm = g1; gt = 1; } if (g2 > gm) { gm = g2; gt = 2; } if (g3 > gm) { gm = g3; gt = 3; }
            const float pg = 1.0f / (expf(g0 - gm) + expf(g1 - gm) + expf(g2 - gm) + expf(g3 - gm));
            float v0 = -INFINITY, v1 = -INFINITY; int i0 = 0, i1 = 0;
#pragma unroll
            for (int k = 0; k < 8; ++k) { const float v = L[8 * gt + k]; if (v > v0) { v1 = v0; i1 = i0; v0 = v; i0 = k; } else if (v > v1) { v1 = v; i1 = k; } }
            const float ex = expf(v1 - v0); const float s0 = 1.0f / (1.0f + ex);
            wt0 = pg * s0; wt1 = pg * (ex * s0); e0 = 8 * gt + i0; e1 = 8 * gt + i1;
            rk0 = (int)atomicAdd((unsigned*)&cntl[e0], 1u); rk1 = (int)atomicAdd((unsigned*)&cntl[e1], 1u);
        }
        __syncthreads();
        if (F.tid < 32) { const unsigned c = cntl[F.tid]; basel[F.tid] = c ? __hip_atomic_fetch_add(gcnt + F.tid, c, __ATOMIC_RELAXED, __HIP_MEMORY_SCOPE_AGENT) : 0u; }
        __syncthreads();
        if (F.lane < 16) {
            const int tk = base + F.wave * 16 + F.lane; const float rr = r;
            const size_t s0 = (size_t)e0 * ECAP + basel[e0] + rk0, s1 = (size_t)e1 * ECAP + basel[e1] + rk1;
            rowl[s0] = 2 * tk; rowr[s0] = rr; wsl[s0] = wt0;
            rowl[s1] = 2 * tk + 1; rowr[s1] = rr; wsl[s1] = wt1;
        }
        __syncthreads();
    }
}

template <bool FINAL>
__device__ __forceinline__ void phase_combine(const Args& a, const Frame& F0, const bf16_t* Xin, bf16_t* XoB, float* Xof, float* Rout) {
    const Frame F = refresh(F0);
    const bf16_t* Y = (const bf16_t*)(F.ws + WS_RB);
    const int gw = F.vcu * NWAVES + F.wave, NGW = F.G * NWAVES;
    for (int m = gw; m < NT; m += NGW) {
        const u32x4* xr = (const u32x4*)(Xin + (size_t)m * D) + F.lane; const u32x4* y0 = (const u32x4*)(Y + (size_t)(2 * m) * D) + F.lane; const u32x4* y1 = (const u32x4*)(Y + (size_t)(2 * m + 1) * D) + F.lane;
        f32x4 v[2][2]; float s = 0.f;
#pragma unroll
        for (int j = 0; j < 2; ++j) { const u32x4 xw = xr[64 * j], p = y0[64 * j], q = y1[64 * j];
#pragma unroll
            for (int h = 0; h < 2; ++h) {
                v[j][h] = (f32x4){bflo(xw[2 * h]) + (bflo(p[2 * h]) + bflo(q[2 * h])), bfhi(xw[2 * h]) + (bfhi(p[2 * h]) + bfhi(q[2 * h])), bflo(xw[2 * h + 1]) + (bflo(p[2 * h + 1]) + bflo(q[2 * h + 1])), bfhi(xw[2 * h + 1]) + (bfhi(p[2 * h + 1]) + bfhi(q[2 * h + 1]))};
                s += (v[j][h][0] * v[j][h][0] + v[j][h][1] * v[j][h][1]) + (v[j][h][2] * v[j][h][2] + v[j][h][3] * v[j][h][3]); } }
        s = wave_sum(s); const float r = 1.0f / sqrtf(s * (1.0f / D) + RMS_EPS);
        if constexpr (FINAL) {
            const f32x4* g = (const f32x4*)a.in[I_NFIN] + 2 * F.lane; f32x4* o = (f32x4*)(Xof + (size_t)m * D) + 2 * F.lane;
#pragma unroll
            for (int j = 0; j < 2; ++j)
#pragma unroll
                for (int h = 0; h < 2; ++h) o[128 * j + h] = v[j][h] * r * g[128 * j + h];
        } else {
            if (F.lane == 0) Rout[m] = r;
            u32x4* o8 = (u32x4*)(XoB + (size_t)m * D) + F.lane;
#pragma unroll
            for (int j = 0; j < 2; ++j) o8[64 * j] = pack8(v[j][0], v[j][1]);
        }
    }
}

__device__ __forceinline__ void phase_cmp2(const Frame& F0, int task0, int ntask, int tstride, int tfirst) {
    const Frame F = refresh(F0);
    const bf16_t* HID = (const bf16_t*)(F.ws + WS_RD + RD_HID); const bf16_t* W2T = (const bf16_t*)(F.ws + WS_W2T);
    bf16_t* KCMP = (bf16_t*)(F.ws + WS_RD + RD_KCMP); bf16_t* VCMPT = (bf16_t*)(F.ws + WS_RD + RD_VCMPT);
    const int gw = F.vcu * NWAVES + F.wave, NGW = F.G * NWAVES, l15 = F.lane & 15, quad = F.lane >> 4;
    (void)gw; (void)NGW;
    for (int tk = tfirst; tk < ntask; tk += tstride) { const int task = task0 + tk;
        const int kv = task >> 9, r0 = (task & 511) * 16;
        const bf16_t* ap = HID + ((size_t)kv * 8192 + r0 + l15) * 256 + 8 * quad; const bf16_t* bp = W2T + (size_t)kv * 64 * 256 + (size_t)l15 * 256 + 8 * quad;
        f32x4 acc[4];
#pragma unroll
        for (int cb = 0; cb < 4; ++cb) acc[cb] = (f32x4){0.f, 0.f, 0.f, 0.f};
#pragma unroll
        for (int ks = 0; ks < 8; ++ks) { const bf16x8 af = *(const bf16x8*)(ap + 32 * ks);
#pragma unroll
            for (int cb = 0; cb < 4; ++cb) acc[cb] = __builtin_amdgcn_mfma_f32_16x16x32_bf16(af, *(const bf16x8*)(bp + (size_t)cb * 16 * 256 + 32 * ks), acc[cb], 0, 0, 0); }
#pragma unroll
        for (int cb = 0; cb < 4; ++cb)
#pragma unroll
            for (int i = 0; i < 4; ++i) { const int row = r0 + 4 * quad + i, bg = row >> 10, c = row & 1023, col = l15 + 16 * cb;
                if (kv == 0) KCMP[((size_t)bg * 1024 + c) * 64 + col] = (bf16_t)f2bf(acc[cb][i]);
                else VCMPT[((size_t)bg * 64 + col) * 1024 + c] = (bf16_t)f2bf(acc[cb][i]); }
    }
}

namespace nsa {
constexpr int SLOTB = 16384;
constexpr int NS_CMP = 4, NS_SW = 8;
constexpr int A_IMP = NS_CMP * SLOTB, IMP_LD = 260, A_SELM = 145408, A_UW = A_SELM + 64 * 8 * 4, A_UB = A_UW + 64 * 4, A_TL = A_UB + 64, A_END = A_TL + 260 * 4;
static_assert(A_IMP + 64 * IMP_LD * 4 <= A_SELM && NS_SW * SLOTB <= A_SELM && A_END <= MISC_OFF, "attention LDS");
struct Ctx { int tid, lane, wave, l15, quad, qi, h, sw; LAS unsigned char* lds; };
struct SubState { float m, l, L; f32x4 O[4]; };

template <int MODE>
__device__ __forceinline__ float sub_cneg(const SubState& st, bool rowsel) { const float mr = (st.m == -INFINITY) ? 0.f : st.m; return (MODE == 2 && !rowsel) ? -INFINITY : -mr; }
template <int MODE>
__device__ __forceinline__ void sub_scores(const Ctx& c, f32x4 (&S)[4], SubState& st, int lo, int hi, bool rowsel, bool needmask, int kidx0, float invl, int sgi, bf16x8 (&pf)[2]) {
    constexpr float THR = 8.0f;
    const float mr = (st.m == -INFINITY) ? 0.f : st.m;
    if (needmask) {
#pragma unroll
        for (int mb = 0; mb < 4; ++mb)
#pragma unroll
            for (int i = 0; i < 4; ++i) { const int off = 16 * mb + 4 * c.quad + i; S[mb][i] = (off >= lo && off <= hi) ? S[mb][i] : -INFINITY; }
    }
    if (MODE != 1) {
        float tmax = max3f(S[0][0], S[0][1], S[0][2]), tmx2 = max3f(S[0][3], S[1][0], S[1][1]);
        tmax = max3f(tmax, S[1][2], S[1][3]); tmx2 = max3f(tmx2, S[2][0], S[2][1]); tmax = max3f(tmax, S[2][2], S[2][3]); tmx2 = max3f(tmx2, S[3][0], S[3][1]); tmax = max3f(tmax, S[3][2], S[3][3]); tmax = fmaxf(tmax, tmx2);
        const bool fresh = st.m == -INFINITY;
        if (__any((tmax > THR) || (fresh && tmax > -INFINITY))) {
            tmax = max_x16(tmax); tmax = max_x32(tmax);
            const bool upd = (tmax > THR) || (fresh && tmax > -INFINITY);
            const float d = upd ? tmax : 0.f;
            const float alpha = fresh ? 1.0f : __builtin_amdgcn_exp2f(-d);
#pragma unroll
            for (int mb = 0; mb < 4; ++mb) S[mb] = S[mb] - d;
            st.l *= alpha;
            if (MODE != 0) { st.L = st.L * alpha;
#pragma unroll
                for (int db = 0; db < 4; ++db) st.O[db] = st.O[db] * alpha; }
            st.m = upd ? mr + d : st.m;
        }
    }
    float ps = 0.f;
#pragma unroll
    for (int mb = 0; mb < 4; ++mb)
#pragma unroll
        for (int i = 0; i < 4; ++i) { const float p = __builtin_amdgcn_exp2f(S[mb][i]); S[mb][i] = p; if (MODE == 0) ps += p; }
    if (MODE == 0) { st.l += ps; return; }
    if (MODE == 1) {
        LAS float* imp = c.h == 0 ? (LAS float*)(c.lds + A_IMP) + (c.wave * 8 + sgi * 4 + c.qi) * IMP_LD + (kidx0 >> 2) + c.quad
                                  : (LAS float*)(c.lds + A_IMP + 64 * IMP_LD * 4) + c.wave * 128 + c.lane;
        float bprev = st.L;
#pragma unroll
        for (int mb = 0; mb < 4; ++mb) { float a = (S[mb][0] + S[mb][1]) + (S[mb][2] + 0.5f * S[mb][3]), b = 0.5f * S[mb][3];
            a += dpp_x1(a); a += dpp_x2(a); b += dpp_x1(b); b += dpp_x2(b);
            const auto r16 = __builtin_amdgcn_permlane16_swap(__float_as_uint(b), __float_as_uint(b), false, false);
            const auto r32 = __builtin_amdgcn_permlane32_swap(r16[1], r16[1], false, false);
            const float bsh = (c.quad & 1) ? __uint_as_float(r16[0]) : (c.quad == 2 ? __uint_as_float(r32[0]) : bprev);
            bprev = __uint_as_float(r32[1]);
            imp[4 * mb] = a + bsh; }
        st.L = bprev;
    }
#pragma unroll
    for (int k2 = 0; k2 < 2; ++k2) { const u32x4 w = pack8(S[2 * k2], S[2 * k2 + 1]); pf[k2] = __builtin_bit_cast(bf16x8, w); }
    if (MODE != 1) {
        const bf16x8 ones = {0x3F80, 0x3F80, 0x3F80, 0x3F80, 0x3F80, 0x3F80, 0x3F80, 0x3F80};
        f32x4 la = __builtin_amdgcn_mfma_f32_16x16x32_bf16(ones, pf[0], (f32x4){0.f, 0.f, 0.f, 0.f}, 0, 0, 0);
        la = __builtin_amdgcn_mfma_f32_16x16x32_bf16(ones, pf[1], la, 0, 0, 0); st.L += la[0]; }
}
template <int MODE, bool A0, bool A1>
__device__ __forceinline__ void tile_compute2(const Ctx& c, int slotoff, const bf16x8 (&qf)[2][2], SubState (&st)[2], const int (&lo)[2], const int (&hi)[2], const bool (&rowsel)[2], const bool (&needmask)[2], int kidx0, const float (&invl)[2]) {
    const LAS unsigned char* kb = c.lds + slotoff + c.l15 * 128;
    const LAS unsigned char* vb = c.lds + slotoff + 8192 + c.l15 * 128 + 8 * (c.quad & 1);
    const int kc0 = ((c.quad) ^ c.sw) * 16, kc1 = ((4 + c.quad) ^ c.sw) * 16;
    const int vq = c.quad >> 1;
    const int vc[2][2] = {{((vq) ^ c.sw) * 16, ((vq + 2) ^ c.sw) * 16}, {((4 + vq) ^ c.sw) * 16, ((6 + vq) ^ c.sw) * 16}};
    bf16x8 pf[2][2];
    f32x4 S0[4], S1[4];
    {   const float cn0 = A0 ? sub_cneg<MODE>(st[0], rowsel[0]) : 0.f, cn1 = A1 ? sub_cneg<MODE>(st[1], rowsel[1]) : 0.f;
        const f32x4 ci0 = {cn0, cn0, cn0, cn0}, ci1 = {cn1, cn1, cn1, cn1};
#pragma unroll
        for (int mb = 0; mb < 4; ++mb) {
            const bf16x8 k0 = *(const LAS bf16x8*)(kb + mb * 2048 + kc0), k1 = *(const LAS bf16x8*)(kb + mb * 2048 + kc1);
            if (A0) { S0[mb] = __builtin_amdgcn_mfma_f32_16x16x32_bf16(k0, qf[0][0], ci0, 0, 0, 0); S0[mb] = __builtin_amdgcn_mfma_f32_16x16x32_bf16(k1, qf[0][1], S0[mb], 0, 0, 0); }
            if (A1) { S1[mb] = __builtin_amdgcn_mfma_f32_16x16x32_bf16(k0, qf[1][0], ci1, 0, 0, 0); S1[mb] = __builtin_amdgcn_mfma_f32_16x16x32_bf16(k1, qf[1][1], S1[mb], 0, 0, 0); } } }
    if (A0) sub_scores<MODE>(c, S0, st[0], lo[0], hi[0], rowsel[0], needmask[0], kidx0, invl[0], 0, pf[0]);
    if (A1) sub_scores<MODE>(c, S1, st[1], lo[1], hi[1], rowsel[1], needmask[1], kidx0, invl[1], 1, pf[1]);
    if (MODE == 0) return;
#pragma unroll
    for (int db = 0; db < 4; ++db)
#pragma unroll
        for (int k2 = 0; k2 < 2; ++k2) {
            const s16x4 a = *(const LAS s16x4*)(vb + db * 2048 + vc[k2][0]), b = *(const LAS s16x4*)(vb + db * 2048 + vc[k2][1]);
            const bf16x8 vf = (bf16x8){a[0], a[1], a[2], a[3], b[0], b[1], b[2], b[3]};
            if (A0) st[0].O[db] = __builtin_amdgcn_mfma_f32_16x16x32_bf16(vf, pf[0][k2], st[0].O[db], 0, 0, 0);
            if (A1) st[1].O[db] = __builtin_amdgcn_mfma_f32_16x16x32_bf16(vf, pf[1][k2], st[1].O[db], 0, 0, 0);
        }
}
template <int MODE>
__device__ __forceinline__ void tile_compute(const Ctx& c, int slotoff, const bf16x8 (&qf)[2][2], SubState (&st)[2], const int (&lo)[2], const int (&hi)[2], const bool (&rowsel)[2], const bool (&act)[2], int kidx0, const float (&invl)[2]) {
    bool needmask[2];
#pragma unroll
    for (int s = 0; s < 2; ++s) needmask[s] = __any((MODE == 2 ? rowsel[s] : true) && (lo[s] > 0 || hi[s] < 63)) != 0;
    if (act[0] && act[1]) tile_compute2<MODE, true, true>(c, slotoff, qf, st, lo, hi, rowsel, needmask, kidx0, invl);
    else if (act[0]) tile_compute2<MODE, true, false>(c, slotoff, qf, st, lo, hi, rowsel, needmask, kidx0, invl);
    else if (act[1]) tile_compute2<MODE, false, true>(c, slotoff, qf, st, lo, hi, rowsel, needmask, kidx0, invl);
}
}

namespace nsa {
struct Tensors { const bf16_t* Q; const f32x2* rope; const float* gates; const bf16_t *KS, *VTS, *KW, *VTW, *KCMP, *VCMPT; bf16_t* O; bf16_t* DBG; float* SCR; float* PROBE; unsigned char* STG; int skip; };

struct Dma {
    int wave; unsigned koff, voffrow, vchk, kofff, vofff;
    __device__ __forceinline__ void init(int wave_, int lane) { wave = wave_; const int row = 8 * wave_ + (lane >> 3), chs = (lane & 7) ^ ((row >> 1) & 7); koff = (unsigned)(row * 64 + chs * 8); voffrow = (unsigned)row; vchk = (unsigned)(chs * 8);
        kofff = (unsigned)ks_idx(row, chs * 8); vofff = (unsigned)vts_idx(row, chs * 8); }
    template <bool FRAG>
    __device__ __forceinline__ void issue(LAS unsigned char* lds, int slotoff, const bf16_t* K, const bf16_t* VT, size_t vpitch, int kidx0, size_t vk0, bool withv = true) const {
        __builtin_amdgcn_global_load_lds((const unsigned*)(K + (size_t)kidx0 * 64 + (FRAG ? kofff : koff)), (LAS unsigned*)(lds + slotoff + wave * 1024), 16, 0, 0);
        if (withv) __builtin_amdgcn_global_load_lds((const unsigned*)(FRAG ? VT + vk0 + vofff : VT + (size_t)voffrow * vpitch + vk0 + vchk), (LAS unsigned*)(lds + slotoff + 8192 + wave * 1024), 16, 0, 0);
    }
};
#define NSA_WAIT_V(n) asm volatile("s_waitcnt vmcnt(" #n ")" ::: "memory")
#define NSA_BAR() do { asm volatile("" ::: "memory"); __builtin_amdgcn_s_barrier(); asm volatile("" ::: "memory"); } while (0)
#define NSA_RING_BG(G, WITHV, NTILES, TILE, BODY) do { \
        const int n_ = (NTILES); int so_ = 0; \
        _Pragma("unroll") for (int k_ = 0; k_ < (G); ++k_) if (k_ < n_) dma.template issue<DMAFRAG>(lds, k_ * SLOTB, KPTR, VPTR, VPITCH, TILE(k_), VKOFF(TILE(k_)), WITHV); \
        _Pragma("unroll 1") for (int i_ = 0; i_ < n_; ++i_) { \
            if ((i_ % (G)) == 0) { NSA_WAIT_V(0); NSA_BAR(); const int other_ = (((i_ / (G)) & 1) ? 0 : (G) * SLOTB); \
                _Pragma("unroll") for (int k_ = 0; k_ < (G); ++k_) if (i_ + (G) + k_ < n_) dma.template issue<DMAFRAG>(lds, other_ + k_ * SLOTB, KPTR, VPTR, VPITCH, TILE(i_ + (G) + k_), VKOFF(TILE(i_ + (G) + k_)), WITHV); } \
            BODY(i_, so_); \
            so_ = (so_ == (2 * (G) - 1) * SLOTB) ? 0 : so_ + SLOTB; } \
        NSA_WAIT_V(0); NSA_BAR(); } while (0)
#define NSA_RING_B4(NTILES, TILE, BODY) NSA_RING_BG(4, true, NTILES, TILE, BODY)
#define NSA_RING(NS, WITHV, NTILES, TILE, BODY) do { \
        const int n_ = (NTILES); int sl_issue_ = 0, sl_cur_ = 0; \
        _Pragma("unroll") for (int p_ = 0; p_ < (NS) - 1; ++p_) { const int ti_ = p_ < n_ ? p_ : n_ - 1; dma.template issue<DMAFRAG>(lds, sl_issue_, KPTR, VPTR, VPITCH, TILE(ti_), VKOFF(TILE(ti_)), WITHV); sl_issue_ += SLOTB; } \
        _Pragma("unroll 1") for (int i_ = 0; i_ < n_; ++i_) { \
            static_assert((NS) == 3 || (NS) == 4, "ring depth"); \
            if ((NS) == 3) { if (WITHV) NSA_WAIT_V(2); else NSA_WAIT_V(1); } else { if (WITHV) NSA_WAIT_V(4); else NSA_WAIT_V(2); } \
            NSA_BAR(); \
            { const int ti_ = (i_ + (NS) - 1) < n_ ? (i_ + (NS) - 1) : n_ - 1; dma.template issue<DMAFRAG>(lds, sl_issue_, KPTR, VPTR, VPITCH, TILE(ti_), VKOFF(TILE(ti_)), WITHV); sl_issue_ = (sl_issue_ == ((NS) - 1) * SLOTB) ? 0 : sl_issue_ + SLOTB; } \
            BODY(i_, sl_cur_); \
            sl_cur_ = (sl_cur_ == ((NS) - 1) * SLOTB) ? 0 : sl_cur_ + SLOTB; } \
        NSA_WAIT_V(0); NSA_BAR(); } while (0)


constexpr int QT_HP = 128, QT_QP = 512, I_STG = 64 * QT_QP, STG_COL = 144, STG_JOB = 16 * STG_COL, STG_BUF = 8 * STG_JOB;
constexpr int I_RIDX = I_STG + 2 * STG_BUF, I_JOBS = I_RIDX + 1024, I_CM = I_JOBS + 2080, I_NJ = I_CM + 2048, I_JOBQ = I_NJ + 1040, I_MREF = I_JOBQ + 2080, I_VSL = ((I_MREF + 1024 + 1023) / 1024) * 1024, I_INV_END = I_VSL + 8 * 8192;
static_assert(I_INV_END <= A_SELM && (I_CM % 8) == 0, "inverted-branch LDS map");
__device__ __forceinline__ int nth_set_bit(unsigned long long m, int r) {
    const unsigned lo = (unsigned)m, hi = (unsigned)(m >> 32); int c = __popc(lo); const bool up = r >= c; unsigned w = up ? hi : lo; int base = up ? 32 : 0; r -= up ? c : 0;
#pragma unroll
    for (int sh = 16; sh >= 1; sh >>= 1) { const unsigned low = w & ((1u << sh) - 1u); c = __popc(low); const bool u2 = r >= c; r -= u2 ? c : 0; base += u2 ? sh : 0; w = u2 ? (w >> sh) : low; }
    return base;
}
__device__ __forceinline__ void selected_inverted(const Ctx& c, const Tensors& T, LAS unsigned char* lds, const bf16x8 (&qr)[2][2], SubState (&st)[2], int t0, int bg, int qt) {
    constexpr float L2E = 1.4426950408889634f;
#if PROBE_T
    const unsigned long long tS_ = __builtin_amdgcn_s_memtime();
#endif
    const LAS unsigned* selm = (const LAS unsigned*)(lds + A_SELM);
    LAS unsigned long long* CM = (LAS unsigned long long*)(lds + I_CM); LAS int* NJ = (LAS int*)(lds + I_NJ); LAS unsigned* JOBS = (LAS unsigned*)(lds + I_JOBS);
#pragma unroll
    for (int s = 0; s < 2; ++s) { LAS unsigned char* qd = lds + (c.wave * 8 + 4 * s + c.qi) * QT_QP + c.h * QT_HP + 16 * c.quad; *(LAS bf16x8*)qd = qr[s][0]; *(LAS bf16x8*)(qd + 64) = qr[s][1]; }
    { const unsigned word = selm[c.lane * 8 + c.wave]; unsigned long long mine = 0ull;
#pragma unroll 1
      for (int jj = 0; jj < 32; ++jj) { const unsigned long long m = __ballot((word >> jj) & 1u); mine = (c.lane == jj) ? m : mine; }
      if (c.lane < 32) { const int jb = 32 * c.wave + c.lane; CM[jb] = (jb == 0 || jb == qt || jb == qt - 1) ? 0ull : mine; } }
    if (c.tid < 64) { unsigned acc = 0u, lo4 = 0u, hi4 = 0u;
#pragma unroll
        for (int w = 0; w < 8; ++w) { if (w < 4) lo4 |= acc << (8 * w); else hi4 |= acc << (8 * (w - 4)); acc += (unsigned)__popc(selm[c.tid * 8 + w]); }
        *(LAS u32x2*)(lds + I_RIDX + c.tid * 8) = (u32x2){lo4, hi4}; }
#pragma unroll
    for (int s = 0; s < 2; ++s) if (c.quad == 0) ((LAS float*)(lds + I_MREF))[(c.wave * 8 + 4 * s + c.qi) * 4 + c.h] = st[s].m;
    __syncthreads();
    int cnt = 0, pre = 0;
    if (c.tid < 256) { cnt = (__popcll(CM[c.tid]) + 3) >> 2;
        const unsigned long long ltm = (1ull << c.lane) - 1ull; int tot = 0;
#pragma unroll
        for (int b = 0; b < 5; ++b) { const unsigned long long m = __ballot((cnt >> b) & 1); pre += (int)__popcll(m & ltm) << b; tot += (int)__popcll(m) << b; }
        if (c.lane == 0) NJ[c.wave] = tot; }
    __syncthreads();
    if (c.tid < 256) {
#pragma unroll
        for (int w = 0; w < 3; ++w) pre += (w < c.wave) ? NJ[w] : 0;
        unsigned long long mrem = CM[c.tid];
        for (int t = 0; t < cnt; ++t) { JOBS[pre + t] = (unsigned)c.tid | ((unsigned)t << 16); unsigned qb = 0u;
#pragma unroll
            for (int u = 0; u < 4; ++u) { unsigned q = 0xffu; if (mrem) { q = (unsigned)__ffsll((long long)mrem) - 1u; mrem &= mrem - 1ull; } qb |= q << (8 * u); }
            ((LAS unsigned*)(lds + I_JOBQ))[pre + t] = qb; }
        if (c.tid == 255) NJ[256] = pre + cnt; }
    __syncthreads();
    const int njobs = __builtin_amdgcn_readfirstlane(NJ[256]), nrounds = (njobs + 7) >> 3;
    if (njobs == 0) { __syncthreads(); return; }
    const bf16_t* Ks = T.KS + (size_t)bg * SEQ * 64; const bf16_t* Vs = T.VTS + (size_t)bg * 64 * SEQ;
    const unsigned koff = (unsigned)(c.lane * 8);
    bf16x8 kf[4][2];
    bf16x8 vf[4][2];
#define VLOAD(jblk) do { const bf16_t* vb_ = Vs + (size_t)(4096 * (jblk)); _Pragma("unroll") for (int db_ = 0; db_ < 4; ++db_) { \
        vf[db_][0] = *(const bf16x8*)(vb_ + (koff + (unsigned)(db_ * 1024))); vf[db_][1] = *(const bf16x8*)(vb_ + (koff + (unsigned)(db_ * 1024 + 512))); } } while (0)
    unsigned char* stg = T.STG;
#if PROBE_T
    const unsigned long long tL_ = __builtin_amdgcn_s_memtime();
    if (PROBE_T == 9 && blockIdx.x == 17 && c.tid == 64 && t0 >= 64 * 200) *((volatile float*)T.PROBE) = (float)(tL_ - tS_) * 0.01f;
#endif
    const int jbeg = c.wave * nrounds, jend = min(jbeg + nrounds, njobs);
    if (jbeg < jend) {
    {   const int j0 = __builtin_amdgcn_readfirstlane((int)(JOBS[jbeg] & 0xffffu));
        const bf16_t* kb = Ks + (size_t)(64 * j0) * 64;
#pragma unroll
        for (int mb = 0; mb < 4; ++mb) { const unsigned ko = koff + (unsigned)(mb * 1024); kf[mb][0] = *(const bf16x8*)(kb + ko); kf[mb][1] = *(const bf16x8*)(kb + (ko + 512u)); }
        asm volatile("" ::: "memory");
        VLOAD(j0); }
#if PROBE_T
    unsigned long long tacc = 0ull, tmark;
#define TMARK() do { if (PROBE_T != 8) tmark = __builtin_amdgcn_s_memtime(); } while (0)
#define TACC(sel) do { if (PROBE_T == (sel)) tacc += __builtin_amdgcn_s_memtime() - tmark; } while (0)
#else
#define TMARK() do {} while (0)
#define TACC(sel) do {} while (0)
#endif
#pragma unroll 1
    for (int ji = (T.skip & 32) ? jend : jbeg; ji < jend; ++ji) {
#if PROBE_T
        tmark = __builtin_amdgcn_s_memtime();
#endif
        const int jin = min(ji + 1, jend - 1);
        const unsigned jw = JOBS[ji], jwn = JOBS[jin];
        const int j = __builtin_amdgcn_readfirstlane((int)(jw & 0xffffu)), jn = __builtin_amdgcn_readfirstlane((int)(jwn & 0xffffu));
        const unsigned qb = ((const LAS unsigned*)(lds + I_JOBQ))[ji]; const unsigned qraw = (qb >> (8 * c.qi)) & 0xffu; const bool valid = qraw != 0xffu;
        const int qidx = (int)(valid ? qraw : (qb & 0xffu)); const int hi = t0 + qidx - 64 * j;
        const LAS unsigned char* qa = lds + qidx * QT_QP + c.h * QT_HP + 16 * c.quad;
        const bf16x8 q0 = *(const LAS bf16x8*)qa, q1 = *(const LAS bf16x8*)(qa + 64);
        const float mref = ((const LAS float*)(lds + I_MREF))[qidx * 4 + c.h];
        const int jwd = j >> 5;
        const unsigned sword = selm[qidx * 8 + jwd], spre = (lds + I_RIDX + qidx * 8)[jwd];
        const f32x4 cinit = {-mref, -mref, -mref, -mref};
        f32x4 S[4];
#pragma unroll
        for (int mb = 0; mb < 4; ++mb) {
            S[mb] = __builtin_amdgcn_mfma_f32_16x16x32_bf16(kf[mb][0], q0, cinit, 0, 0, 0);
            S[mb] = __builtin_amdgcn_mfma_f32_16x16x32_bf16(kf[mb][1], q1, S[mb], 0, 0, 0); }
        const bool newblk = jn != j;
        if (newblk) {   const bf16_t* kb = Ks + (size_t)(64 * jn) * 64;
#pragma unroll
            for (int mb = 0; mb < 4; ++mb) { const unsigned ko = koff + (unsigned)(mb * 1024); kf[mb][0] = *(const bf16x8*)(kb + ko); kf[mb][1] = *(const bf16x8*)(kb + (ko + 512u)); } }
        const int rank = (int)spre + __popc(sword & ((1u << (j & 31)) - 1u)) - 1;
        unsigned char* gcol = stg + (unsigned)(((valid ? (qidx * 13 + rank) : 64 * 13) * 4 + c.h) * STG_COL);
        float tmax = max3f(S[0][0], S[0][1], S[0][2]), tmx2 = max3f(S[0][3], S[1][0], S[1][1]);
        tmax = max3f(tmax, S[1][2], S[1][3]); tmx2 = max3f(tmx2, S[2][0], S[2][1]); tmax = max3f(tmax, S[2][2], S[2][3]); tmx2 = max3f(tmx2, S[3][0], S[3][1]); tmax = max3f(tmax, S[3][2], S[3][3]); tmax = fmaxf(tmax, tmx2);
        float dsh = 0.f;
        if (__any(tmax > 8.0f)) { tmax = max_x16(tmax); tmax = max_x32(tmax); dsh = tmax > 8.0f ? tmax : 0.f;
#pragma unroll
            for (int mb = 0; mb < 4; ++mb) S[mb] = S[mb] - dsh; }
#pragma unroll
        for (int mb = 0; mb < 4; ++mb)
#pragma unroll
            for (int i = 0; i < 4; ++i) S[mb][i] = __builtin_amdgcn_exp2f(S[mb][i]);
        bf16x8 pf[2];
#pragma unroll
        for (int k2 = 0; k2 < 2; ++k2) { const u32x4 w = pack8(S[2 * k2], S[2 * k2 + 1]); pf[k2] = __builtin_bit_cast(bf16x8, w); }
        const bf16x8 ones = {0x3F80, 0x3F80, 0x3F80, 0x3F80, 0x3F80, 0x3F80, 0x3F80, 0x3F80};
        f32x4 la = __builtin_amdgcn_mfma_f32_16x16x32_bf16(ones, pf[0], (f32x4){0.f, 0.f, 0.f, 0.f}, 0, 0, 0);
        la = __builtin_amdgcn_mfma_f32_16x16x32_bf16(ones, pf[1], la, 0, 0, 0);
        const float ps = la[0];
        u32x4 ow[2];
#pragma unroll
        for (int db = 0; db < 4; ++db) { f32x4 o = __builtin_amdgcn_mfma_f32_16x16x32_bf16(vf[db][0], pf[0], (f32x4){0.f, 0.f, 0.f, 0.f}, 0, 0, 0);
            o = __builtin_amdgcn_mfma_f32_16x16x32_bf16(vf[db][1], pf[1], o, 0, 0, 0);
            const u32x2 p = pack4(o); ow[db >> 1][2 * (db & 1)] = p[0]; ow[db >> 1][2 * (db & 1) + 1] = p[1]; }
        if (newblk) VLOAD(jn);
        {
            *(u32x4*)(gcol + 32 * c.quad) = ow[0]; *(u32x4*)(gcol + 32 * c.quad + 16) = ow[1];
            *(f32x2*)(gcol + 128) = (f32x2){dsh, ps}; }
        TACC(8);
    }
#if PROBE_T
    if (PROBE_T == 20) { if (blockIdx.x == 17 && c.tid == 64) *((volatile float*)T.PROBE) += (float)nrounds * 0.1f; }
    else if (blockIdx.x == 17 && c.tid == 64 && t0 >= 64 * 200) { const float n = (float)(tacc / (unsigned long long)nrounds) * 0.01f; *((volatile float*)T.PROBE) = n; }
#endif
    }
#if PROBE_T
    const unsigned long long tM_ = __builtin_amdgcn_s_memtime();
    if (PROBE_T == 12 && blockIdx.x == 17 && c.tid == 64 && t0 >= 64 * 200) *((volatile float*)T.PROBE) = (float)(tM_ - tL_) * 0.001f;
#endif
    asm volatile("s_waitcnt vmcnt(0)" ::: "memory");
    __syncthreads();
    if (!(T.skip & 64)) {   const int cnt = min(13, qt - 2);
#pragma unroll
        for (int s = 0; s < 2; ++s) {
            const unsigned char* col = stg + (unsigned)((((c.wave * 8 + 4 * s + c.qi) * 13) * 4 + c.h) * STG_COL);
            f32x2 ml[13]; u32x4 w0[13], w1[13];
#pragma unroll
            for (int r = 0; r < 13; ++r) ml[r] = *(const f32x2*)(col + r * (4 * STG_COL) + 128);
#pragma unroll
            for (int r = 0; r < 13; ++r) { const unsigned char* p = col + r * (4 * STG_COL) + 32 * c.quad; w0[r] = *(const u32x4*)p; w1[r] = *(const u32x4*)(p + 16); }
            __builtin_amdgcn_sched_barrier(0);
            float dmax = 0.f;
#pragma unroll
            for (int r = 0; r < 13; ++r) dmax = fmaxf(dmax, r < cnt ? ml[r][0] : 0.f);
            const float a = __builtin_amdgcn_exp2f(-dmax);
            st[s].L *= a;
#pragma unroll
            for (int db = 0; db < 4; ++db) st[s].O[db] = st[s].O[db] * a;
#pragma unroll
            for (int r = 0; r < 13; ++r) {
                const float bsc = r < cnt ? __builtin_amdgcn_exp2f(ml[r][0] - dmax) : 0.f;
                st[s].L += (r < cnt ? ml[r][1] : 0.f) * bsc;
                st[s].O[0] = st[s].O[0] + (f32x4){bflo(w0[r][0]), bfhi(w0[r][0]), bflo(w0[r][1]), bfhi(w0[r][1])} * bsc;
                st[s].O[1] = st[s].O[1] + (f32x4){bflo(w0[r][2]), bfhi(w0[r][2]), bflo(w0[r][3]), bfhi(w0[r][3])} * bsc;
                st[s].O[2] = st[s].O[2] + (f32x4){bflo(w1[r][0]), bfhi(w1[r][0]), bflo(w1[r][1]), bfhi(w1[r][1])} * bsc;
                st[s].O[3] = st[s].O[3] + (f32x4){bflo(w1[r][2]), bfhi(w1[r][2]), bflo(w1[r][3]), bfhi(w1[r][3])} * bsc; }
            __builtin_amdgcn_sched_barrier(0);
        }
    }
    __syncthreads();
#if PROBE_T
    if (PROBE_T == 10 && blockIdx.x == 17 && c.tid == 64 && t0 >= 64 * 200) *((volatile float*)T.PROBE) = (float)(__builtin_amdgcn_s_memtime() - tM_) * 0.01f;
#endif
#undef VLOAD
}

__device__ __forceinline__ void attn_unit(const Tensors& T, LAS unsigned char* lds, int tid_in, int b, int g, int qt) {
    Ctx c; { int t_ = tid_in; asm volatile("" : "+v"(t_)); c.tid = t_; } c.lane = c.tid & 63; c.wave = __builtin_amdgcn_readfirstlane(c.tid >> 6); c.l15 = c.lane & 15; c.quad = c.lane >> 4; c.qi = c.l15 >> 2; c.h = c.l15 & 3; c.sw = (c.l15 >> 1) & 7; c.lds = lds;
    const int t0 = qt * 64, bg = b * 4 + g; const unsigned tokbase = (unsigned)b * SEQ;
    Dma dma; dma.init(c.wave, c.lane);
    int tq[2]; tq[0] = t0 + c.wave * 8 + c.qi; tq[1] = tq[0] + 4;
    bf16x8 qc[2][2];
#pragma unroll
    for (int s = 0; s < 2; ++s) {
        const bf16_t* qp = T.Q + (tokbase + tq[s]) * D + (g * 4 + c.h) * 64 + 8 * c.quad;
        qc[s][0] = *(const bf16x8*)qp; qc[s][1] = *(const bf16x8*)(qp + 32);
    }
    bf16x8 qr[2][2]; float gate[2][3];
#pragma unroll
    for (int s = 0; s < 2; ++s) {
        const f32x4* rp = (const f32x4*)(T.rope + (tokbase + tq[s]) * 32 + 8 * c.quad);
        const float* gp = T.gates + (tokbase + tq[s]) * 48 + (g * 4 + c.h) * 3;
        gate[s][0] = gp[0]; gate[s][1] = gp[1]; gate[s][2] = gp[2];
        const bf16x8 q0 = qc[s][0], q1 = qc[s][1];
        u32x4 w0, w1;
#pragma unroll
        for (int p = 0; p < 4; ++p) { const f32x4 cs = rp[p];
            const float a0 = bf2f((unsigned short)q0[2 * p]), a1 = bf2f((unsigned short)q0[2 * p + 1]), b0 = bf2f((unsigned short)q1[2 * p]), b1 = bf2f((unsigned short)q1[2 * p + 1]);
            w0[p] = pk2(a0 * cs[0] - b0 * cs[1], a1 * cs[2] - b1 * cs[3]); w1[p] = pk2(b0 * cs[0] + a0 * cs[1], b1 * cs[2] + a1 * cs[3]); }
        qr[s][0] = __builtin_bit_cast(bf16x8, w0); qr[s][1] = __builtin_bit_cast(bf16x8, w1);
    }
#define NSA_GATE(s, br) (gate[s][br])
    LAS f32x4* scr0 = (LAS f32x4*)(lds + I_VSL) + c.tid;

    SubState st[2]; int lo[2], hi[2]; bool act[2], rowsel[2] = {true, true}; float invl[2] = {0.f, 0.f};
#define RESET_ST() do { _Pragma("unroll") for (int s = 0; s < 2; ++s) { st[s].m = -INFINITY; st[s].l = 0.f; st[s].L = 0.f; _Pragma("unroll") for (int db = 0; db < 4; ++db) st[s].O[db] = (f32x4){0.f, 0.f, 0.f, 0.f}; } } while (0)
    const int ncmp = min(NCMP, t0 / 16 + 3), ntc = (ncmp + 63) >> 6;
    const bf16_t* Kc = T.KCMP + (size_t)bg * 1024 * 64; const bf16_t* Vc = T.VCMPT + (size_t)bg * 64 * 1024;
    int lim[2];
#pragma unroll
    for (int s = 0; s < 2; ++s) lim[s] = tq[s] >= 31 ? ((tq[s] - 31) >> 4) : -1;
    RESET_ST();
#define KPTR Kc
#define VPTR Vc
#define VPITCH 1024
#define VKOFF(k) ((size_t)(k))
#define DMAFRAG false
#define TILE_C(i) (64 * (i))
#define BODY_C0(i, so) do { _Pragma("unroll") for (int s = 0; s < 2; ++s) { lo[s] = 0; hi[s] = lim[s] - 64 * (i); act[s] = true; } tile_compute<0>(c, so, qc, st, lo, hi, rowsel, act, 64 * (i), invl); } while (0)
#define BODY_C1(i, so) do { _Pragma("unroll") for (int s = 0; s < 2; ++s) { lo[s] = 0; hi[s] = lim[s] - 64 * (i); act[s] = true; } tile_compute<1>(c, so, qc, st, lo, hi, rowsel, act, 64 * (i), invl); } while (0)
    if (!(ATT_SKIP & 1) && !(T.skip & 1)) NSA_RING(NS_CMP, false, ntc, TILE_C, BODY_C0);
#pragma unroll
    for (int s = 0; s < 2; ++s) { float l = st[s].l; l = sum_x16(l); l = sum_x32(l); invl[s] = 1.0f; if (l > 0.f) st[s].m += __builtin_amdgcn_logf(l); }
    if (!(ATT_SKIP & 1) && !(T.skip & 1)) NSA_RING(NS_CMP, true, ntc, TILE_C, BODY_C1);
#undef KPTR
#undef VPTR
#undef VPITCH
#undef VKOFF
#undef DMAFRAG
#if NSA_CHECK
    if (NSA_CHECK_BR == 0) {
#pragma unroll
        for (int s = 0; s < 2; ++s) { bf16_t* op = T.DBG + (tokbase + tq[s]) * D + (g * 4 + c.h) * 64 + 4 * c.quad;
#pragma unroll
            for (int db = 0; db < 4; ++db) *(u32x2*)(op + 16 * db) = pack4(st[s].O[db]); } }
#endif
    const int nforced = qt >= 2 ? 3 : qt + 1;
#define TILE_F(i) (64 * ((i) == 0 ? 0 : ((i) == nforced - 1 ? qt : qt - 1)))
    {   const bf16_t* Ksf = T.KS + (size_t)bg * SEQ * 64; const bf16_t* Vsf = T.VTS + (size_t)bg * 64 * SEQ;
#pragma unroll
        for (int k = 0; k < 3; ++k) if (k < nforced) dma.template issue<true>(lds, k * SLOTB, Ksf, Vsf, 64, TILE_F(k), (size_t)TILE_F(k) * 64, true); }
    {
        LAS float* impw = (LAS float*)(lds + A_IMP) + (c.wave * 8) * IMP_LD;
        unsigned uw = 0u;
        const unsigned long long lt_mask = (1ull << c.lane) - 1ull;
        unsigned needslow = 0xffu;
#if TOPK_ROWPAR
        if (!((ATT_SKIP & 2) || (T.skip & 2))) {
            needslow = 0u;
            const int cur = qt, K = 16 - (cur >= 2 ? 3 : cur + 1);
#pragma unroll 1
            for (int bq = 0; bq < 2; ++bq) {
                const int qq = 4 * bq + c.quad;
                unsigned key[16]; unsigned fmask = 0u;
#pragma unroll
                for (int e = 0; e < 16; ++e) { const int j = c.l15 + 16 * e; const bool valid = j <= cur; const bool fo = (j == 0) || (j == cur) || (j == cur - 1);
                    key[e] = (valid && !fo) ? (__float_as_uint(impw[qq * IMP_LD + j]) + 1u) : 0u; fmask |= (valid && fo) ? (1u << e) : 0u; }
                unsigned T = 0u; bool done = false;
                if (cur - 2 > K) {
#pragma unroll 1
                    for (int bit = 30; bit >= 0; --bit) { const unsigned cand = T | (1u << bit); int cnt = 0;
#pragma unroll
                        for (int e = 0; e < 16; ++e) cnt += (key[e] >= cand) ? 1 : 0;
                        cnt += __builtin_amdgcn_mov_dpp(cnt, 0x128, 0xF, 0xF, true); cnt += __builtin_amdgcn_mov_dpp(cnt, 0x124, 0xF, 0xF, true);
                        cnt += __builtin_amdgcn_mov_dpp(cnt, 0x122, 0xF, 0xF, true); cnt += __builtin_amdgcn_mov_dpp(cnt, 0x121, 0xF, 0xF, true);
                        T = (!done && cnt >= K) ? cand : T; done = done || (cnt == K);
                        if (__all(done ? 1 : 0)) break; }
                }
                const unsigned Tg = done ? T - 1u : T;
                const bool slow = (T != 0u) && !done;
                unsigned selbits = fmask;
#pragma unroll
                for (int e = 0; e < 16; ++e) selbits |= (key[e] > Tg) ? (1u << e) : 0u;
                unsigned mine = 0u;
#pragma unroll
                for (int e = 0; e < 16; ++e) { const unsigned long long bmask = __ballot((selbits >> e) & 1u); const unsigned piece = (unsigned)(bmask >> (16 * c.quad)) & 0xffffu; mine = (c.l15 == e) ? piece : mine; }
                ((LAS unsigned short*)(lds + A_SELM))[(c.wave * 8 + qq) * 16 + c.l15] = (unsigned short)mine;
                const unsigned long long sb = __ballot(slow ? 1 : 0);
                needslow |= (((sb & 1ull) ? 1u : 0u) | ((sb >> 16) & 1ull ? 2u : 0u) | ((sb >> 32) & 1ull ? 4u : 0u) | ((sb >> 48) & 1ull ? 8u : 0u)) << (4 * bq);
            }
            needslow = __builtin_amdgcn_readfirstlane(needslow);
        }
#endif
#pragma unroll 1
        for (int qq = ((ATT_SKIP & 2) || (T.skip & 2)) ? 8 : 0; qq < 8; ++qq) if ((needslow >> qq) & 1u) {
            const int tqq = t0 + c.wave * 8 + qq, cur = tqq >> 6;
            const int K = 16 - (cur >= 2 ? 3 : cur + 1);
            unsigned key[4]; unsigned long long forced[4];
#pragma unroll
            for (int e = 0; e < 4; ++e) { const int j = c.lane + 64 * e; const bool valid = j <= cur; const bool fo = (j == 0) || (j == cur) || (j == cur - 1);
                key[e] = (valid && !fo) ? (__float_as_uint(impw[qq * IMP_LD + j]) + 1u) : 0u; forced[e] = __ballot(valid && fo); }
            unsigned T = 0u; bool exact = false;
#pragma unroll 1
            for (int bit = 30; bit >= 0; --bit) { const unsigned cand = T | (1u << bit);
                const int cnt = __popcll(__ballot(key[0] >= cand)) + __popcll(__ballot(key[1] >= cand)) + __popcll(__ballot(key[2] >= cand)) + __popcll(__ballot(key[3] >= cand));
                T = (cnt >= K) ? cand : T;
                if (cnt == K) { exact = true; break; } }
            const unsigned Tg = exact ? T - 1u : T;
            unsigned long long sel[4]; int ngt = 0;
#pragma unroll
            for (int e = 0; e < 4; ++e) { sel[e] = __ballot(key[e] > Tg); ngt += __popcll(sel[e]); }
            int r = (T != 0u && !exact) ? (K - ngt) : 0;
#pragma unroll
            for (int e = 0; e < 4; ++e) { const unsigned long long eq = (T != 0u && !exact) ? __ballot(key[e] == T) : 0ull;
                const bool take = ((eq >> c.lane) & 1ull) && (__popcll(eq & lt_mask) < r);
                sel[e] |= __ballot(take) | forced[e]; r -= min(r, (int)__popcll(eq)); }
            unsigned myword = 0u;
#pragma unroll
            for (int e = 0; e < 4; ++e) { myword = (c.lane == 2 * e) ? (unsigned)sel[e] : myword; myword = (c.lane == 2 * e + 1) ? (unsigned)(sel[e] >> 32) : myword; }
            if (c.lane < 8) ((LAS unsigned*)(lds + A_SELM))[(c.wave * 8 + qq) * 8 + c.lane] = myword;
            uw |= myword;
        }
        if (c.lane < 8) ((LAS unsigned*)(lds + A_UW))[c.wave * 8 + c.lane] = uw;
        __syncthreads();
        if (c.tid < 8) { unsigned u = 0u;
#pragma unroll
            for (int w = 0; w < 8; ++w) u |= ((LAS unsigned*)(lds + A_UW))[w * 8 + c.tid];
            ((LAS unsigned*)(lds + A_UB))[c.tid] = u; }
        __syncthreads();
        if (c.tid < 256) { const LAS unsigned* ub = (const LAS unsigned*)(lds + A_UB); const int wj = c.tid >> 5, bj = c.tid & 31; int pos = 0;
#pragma unroll
            for (int w = 0; w < 8; ++w) { const unsigned x = ub[w]; pos += (w < wj) ? __popc(x) : 0; }
            const unsigned xw = ub[wj]; pos += __popc(xw & ((1u << bj) - 1u));
            if ((xw >> bj) & 1u) ((LAS int*)(lds + A_TL))[pos] = c.tid; }
        __syncthreads();
    }
    {
        const LAS unsigned* ub = (const LAS unsigned*)(lds + A_UB); int nsel = 0;
#pragma unroll
        for (int w = 0; w < 8; ++w) nsel += __popc(ub[w]);
        nsel = __builtin_amdgcn_readfirstlane(nsel);
        const LAS int* TL = (const LAS int*)(lds + A_TL); const LAS unsigned* selm = (const LAS unsigned*)(lds + A_SELM);
        const bf16_t* Ks = T.KS + (size_t)bg * SEQ * 64; const bf16_t* Vs = T.VTS + (size_t)bg * 64 * SEQ;
#pragma unroll
        for (int s = 0; s < 2; ++s)
#pragma unroll
            for (int db = 0; db < 4; ++db) scr0[(4 * s + db) * NTHREADS] = st[s].O[db] * NSA_GATE(s, 0);
        RESET_ST();
#define KPTR Ks
#define VPTR Vs
#define VPITCH 64
#define VKOFF(k) ((size_t)(k) * 64)
#define DMAFRAG true
#define TILE_S(i) (64 * __builtin_amdgcn_readfirstlane(TL[(i)]))
#define BODY_S(i, so) do { const int j = __builtin_amdgcn_readfirstlane(TL[(i)]); \
        _Pragma("unroll") for (int s = 0; s < 2; ++s) { const unsigned w = selm[(c.wave * 8 + 4 * s + c.qi) * 8 + (j >> 5)]; const bool sel = (w >> (j & 31)) & 1u; \
            lo[s] = 0; hi[s] = tq[s] - 64 * j; rowsel[s] = sel; act[s] = __any(sel ? 1 : 0) != 0; } \
        tile_compute<2>(c, so, qr, st, lo, hi, rowsel, act, 64 * j, invl); } while (0)
#if SEL_INVERTED
        if (!(ATT_SKIP & 4)) {
#define BODY_F(i, so) do { const int j = ((i) == 0 ? 0 : ((i) == nforced - 1 ? qt : qt - 1)); \
        _Pragma("unroll") for (int s = 0; s < 2; ++s) { lo[s] = 0; hi[s] = tq[s] - 64 * j; rowsel[s] = true; act[s] = true; } \
        tile_compute<2>(c, so, qr, st, lo, hi, rowsel, act, 64 * j, invl); } while (0)
            NSA_WAIT_V(0); NSA_BAR();
            if (!(T.skip & 4)) {
#pragma unroll 1
                for (int i = 0; i < nforced; ++i) BODY_F(i, i * SLOTB); }
            NSA_BAR();
#pragma unroll
            for (int k = 0; k < 4; ++k) ((LAS bf16x8*)(lds + 32768))[k * NTHREADS + c.tid] = qr[k >> 1][k & 1];
            if (!(T.skip & 8)) selected_inverted(c, T, lds, qr, st, t0, bg, qt);
#pragma unroll
            for (int k = 0; k < 4; ++k) qr[k >> 1][k & 1] = ((const LAS bf16x8*)(lds + 32768))[k * NTHREADS + c.tid];
        }
#else
        if (!(ATT_SKIP & 4)) NSA_RING_B4(nsel, TILE_S, BODY_S);
#endif
#undef KPTR
#undef VPTR
#pragma unroll
        for (int s = 0; s < 2; ++s) { const float l = st[s].L; const float fn = (l > 0.f ? 1.0f / l : 0.f), f = fn * NSA_GATE(s, 1);
#if NSA_CHECK
            if (NSA_CHECK_BR == 1) { bf16_t* op = T.DBG + (tokbase + tq[s]) * D + (g * 4 + c.h) * 64 + 4 * c.quad;
#pragma unroll
                for (int db = 0; db < 4; ++db) *(u32x2*)(op + 16 * db) = pack4(st[s].O[db] * fn); }
#endif
#pragma unroll
            for (int db = 0; db < 4; ++db) { LAS f32x4* p = scr0 + (4 * s + db) * NTHREADS; *p = *p + st[s].O[db] * f; } }
    }
    {
        const bf16_t* Kw = T.KW + (size_t)bg * SEQ * 64; const bf16_t* Vw = T.VTW + (size_t)bg * 64 * SEQ;
        const int kt1 = qt, kt0 = max(0, qt - 8), nw = kt1 - kt0 + 1;
        RESET_ST();
#define KPTR Kw
#define VPTR Vw
#undef DMAFRAG
#define DMAFRAG false
#define TILE_W(i) (64 * (kt0 + (i)))
#define BODY_W(i, so) do { const int k0 = 64 * (kt0 + (i)); \
        _Pragma("unroll") for (int s = 0; s < 2; ++s) { hi[s] = tq[s] - k0; lo[s] = tq[s] - 511 - k0; act[s] = true; } \
        tile_compute<3>(c, so, qr, st, lo, hi, rowsel, act, k0, invl); } while (0)
        if (!(ATT_SKIP & 8) && !(T.skip & 16)) NSA_RING_BG(2, true, nw, TILE_W, BODY_W);
#undef KPTR
#undef VPTR
#undef VPITCH
#undef VKOFF
#undef DMAFRAG
#pragma unroll
        for (int s = 0; s < 2; ++s) { const float l = st[s].L; const float fn = (l > 0.f ? 1.0f / l : 0.f), f = fn * NSA_GATE(s, 2);
#if NSA_CHECK
            if (NSA_CHECK_BR == 2) { bf16_t* op = T.DBG + (tokbase + tq[s]) * D + (g * 4 + c.h) * 64 + 4 * c.quad;
#pragma unroll
                for (int db = 0; db < 4; ++db) *(u32x2*)(op + 16 * db) = pack4(st[s].O[db] * fn); }
#endif
            bf16_t* op = T.O + (tokbase + tq[s]) * D + (g * 4 + c.h) * 64 + 16 * (c.quad & 1) + 8 * (c.quad >> 1);
            if (!T.skip)
#pragma unroll
            for (int p = 0; p < 2; ++p) { const u32x2 pa = pack4(scr0[(4 * s + 2 * p) * NTHREADS] + st[s].O[2 * p] * f), pb = pack4(scr0[(4 * s + 2 * p + 1) * NTHREADS] + st[s].O[2 * p + 1] * f);
                const auto rx = __builtin_amdgcn_permlane16_swap(pa[0], pb[0], false, false), ry = __builtin_amdgcn_permlane16_swap(pa[1], pb[1], false, false);
                *(u32x4*)(op + 32 * p) = (u32x4){rx[0], ry[0], rx[1], ry[1]}; } }
    }
#undef RESET_ST
#undef NSA_GATE
}
}


#if NSA_CHECK
namespace chk {
__constant__ int tlist[24] = {0, 1, 30, 31, 32, 47, 63, 64, 65, 79, 127, 128, 510, 511, 512, 513, 1023, 1024, 1025, 1087, 4095, 4096, 8191, 16383};
__device__ __forceinline__ float blk_max(float v, LAS float* red, int tid) {
#pragma unroll
    for (int o = 1; o < 64; o <<= 1) v = fmaxf(v, __shfl_xor(v, o));
    __syncthreads(); if ((tid & 63) == 0) red[tid >> 6] = v; __syncthreads();
    float r = red[0]; for (int w = 1; w < 8; ++w) r = fmaxf(r, red[w]); __syncthreads(); return r; }
__device__ __forceinline__ float blk_sum(float v, LAS float* red, int tid) {
#pragma unroll
    for (int o = 1; o < 64; o <<= 1) v += __shfl_xor(v, o);
    __syncthreads(); if ((tid & 63) == 0) red[tid >> 6] = v; __syncthreads();
    float r = 0.f; for (int w = 0; w < 8; ++w) r += red[w]; __syncthreads(); return r; }

__device__ __forceinline__ void check_sample(const nsa::Tensors& T, LAS unsigned char* lds, int tid, int b, int g, int t, unsigned* flag) {
    LAS float* sc = (LAS float*)lds;
    LAS float* qf = sc + 4096;
    LAS float* oacc = qf + 512;
    LAS float* score = oacc + 768;
    LAS int* sel = (LAS int*)(score + 256);
    LAS float* red = (LAS float*)(sel + 16);
    const int bg = b * 4 + g; const size_t tok = (size_t)b * SEQ + t;
    if (tid < 256) { const int h = tid >> 6, d = tid & 63;
        const float q = bf2f(T.Q[tok * D + (g * 4 + h) * 64 + d]);
        const int dd = d & 31; const f32x2 cs = T.rope[tok * 32 + dd]; const float qo = bf2f(T.Q[tok * D + (g * 4 + h) * 64 + (d < 32 ? d + 32 : d - 32)]);
        const float r = d < 32 ? q * cs[0] - qo * cs[1] : q * cs[0] + qo * cs[1];
        qf[h * 64 + d] = q; qf[256 + h * 64 + d] = bf2f((unsigned short)f2bf(r)); }
    __syncthreads();
    const bf16_t* Kc = T.KCMP + (size_t)bg * 1024 * 64; const bf16_t* Vc = T.VCMPT + (size_t)bg * 64 * 1024;
    for (int i = tid; i < 4096; i += 512) { const int h = i >> 10, c = i & 1023; float s = -INFINITY;
        if (c < 1023 && 16 * c + 31 <= t) { s = 0.f; for (int d = 0; d < 64; ++d) s += qf[h * 64 + d] * bf2f(Kc[(size_t)c * 64 + d]); }
        sc[i] = s; }
    __syncthreads();
    for (int h = 0; h < 4; ++h) {
        float m = -INFINITY; for (int c = tid; c < 1024; c += 512) m = fmaxf(m, sc[h * 1024 + c]);
        m = blk_max(m, red, tid); if (m == -INFINITY) m = 0.f;
        float l = 0.f; for (int c = tid; c < 1024; c += 512) l += exp2f(sc[h * 1024 + c] - m);
        l = blk_sum(l, red, tid); l = fmaxf(l, 1e-30f);
        for (int c = tid; c < 1024; c += 512) sc[h * 1024 + c] = exp2f(sc[h * 1024 + c] - m) / l;
        __syncthreads();
    }
    if (tid < 256) { const int h = tid >> 6, d = tid & 63; float o = 0.f;
        for (int c = 0; c < 1023; ++c) o += bf2f((unsigned short)f2bf(sc[h * 1024 + c])) * bf2f(Vc[(size_t)d * 1024 + c]);
        oacc[h * 64 + d] = o; }
    if (tid < 256) { const int j = tid; float im = 0.f;
        for (int h = 0; h < 4; ++h) for (int c = 4 * j - 1; c <= 4 * j + 3; ++c) if (c >= 0 && c < 1023) {
            const int c0 = 16 * c, j0 = 64 * j; int ov = min(c0 + 32, j0 + 64) - max(c0, j0); if (ov < 0) ov = 0;
            im += sc[h * 1024 + c] * ((float)ov / 32.0f); }
        const int cur = t >> 6; const bool valid = 64 * j <= t, forced = (j == 0) || (j == cur) || (j == cur - 1);
        score[j] = valid ? im + (forced ? 1000.0f : 0.0f) : -1.0f; }
    __syncthreads();
    if (tid == 0) { for (int n = 0; n < 16; ++n) { int bi = 0; float bv = -INFINITY; for (int j = 0; j < 256; ++j) if (score[j] > bv) { bv = score[j]; bi = j; } sel[n] = bi; score[bi] = -INFINITY; } }
    __syncthreads();
    const bf16_t* Ks = T.KS + (size_t)bg * SEQ * 64; const bf16_t* Vs = T.VTS + (size_t)bg * 64 * SEQ;
    for (int i = tid; i < 4096; i += 512) { const int h = i >> 10, n = (i >> 6) & 15, k = i & 63; const int kpos = sel[n] * 64 + k; float s = -INFINITY;
        if (kpos <= t) { s = 0.f; for (int d = 0; d < 64; ++d) s += qf[256 + h * 64 + d] * bf2f(Ks[(size_t)(kpos >> 6) * 4096 + ks_idx(kpos & 63, d)]); }
        sc[i] = s; }
    __syncthreads();
    for (int h = 0; h < 4; ++h) {
        float m = -INFINITY; for (int c = tid; c < 1024; c += 512) m = fmaxf(m, sc[h * 1024 + c]);
        m = blk_max(m, red, tid); if (m == -INFINITY) m = 0.f;
        float l = 0.f; for (int c = tid; c < 1024; c += 512) l += exp2f(sc[h * 1024 + c] - m);
        l = blk_sum(l, red, tid); l = fmaxf(l, 1e-30f);
        for (int c = tid; c < 1024; c += 512) sc[h * 1024 + c] = exp2f(sc[h * 1024 + c] - m) / l;
        __syncthreads();
    }
    if (tid < 256) { const int h = tid >> 6, d = tid & 63; float o = 0.f;
        for (int i = 0; i < 1024; ++i) { const float p = sc[h * 1024 + i]; if (p != 0.f) { const int kpos = sel[i >> 6] * 64 + (i & 63); o += bf2f((unsigned short)f2bf(p)) * bf2f(Vs[(size_t)(kpos >> 6) * 4096 + vts_idx(d, kpos & 63)]); } }
        oacc[256 + h * 64 + d] = o; }
    __syncthreads();
    const bf16_t* Kw = T.KW + (size_t)bg * SEQ * 64; const bf16_t* Vw = T.VTW + (size_t)bg * 64 * SEQ;
    for (int i = tid; i < 4096; i += 512) { const int h = i >> 10, k = i & 1023; const int kpos = t - 511 + k; float s = -INFINITY;
        if (k < 512 && kpos >= 0) { s = 0.f; for (int d = 0; d < 64; ++d) s += qf[256 + h * 64 + d] * bf2f(Kw[(size_t)kpos * 64 + d]); }
        sc[i] = s; }
    __syncthreads();
    for (int h = 0; h < 4; ++h) {
        float m = -INFINITY; for (int c = tid; c < 1024; c += 512) m = fmaxf(m, sc[h * 1024 + c]);
        m = blk_max(m, red, tid); if (m == -INFINITY) m = 0.f;
        float l = 0.f; for (int c = tid; c < 1024; c += 512) l += exp2f(sc[h * 1024 + c] - m);
        l = blk_sum(l, red, tid); l = fmaxf(l, 1e-30f);
        for (int c = tid; c < 1024; c += 512) sc[h * 1024 + c] = exp2f(sc[h * 1024 + c] - m) / l;
        __syncthreads();
    }
    if (tid < 256) { const int h = tid >> 6, d = tid & 63; float o = 0.f;
        for (int k = 0; k < 512; ++k) { const float p = sc[h * 1024 + k]; if (p != 0.f) o += bf2f((unsigned short)f2bf(p)) * bf2f(Vw[(size_t)((t - 511 + k) >> 6) * 4096 + d * 64 + ((t - 511 + k) & 63)]); }
        oacc[512 + h * 64 + d] = o; }
    __syncthreads();
    if (tid == 0) red[0] = 0.f;
    __syncthreads();
    if (tid < 256) { const int h = tid >> 6, d = tid & 63; const float* gt = T.gates + tok * 48 + (g * 4 + h) * 3;
        float ref = gt[0] * oacc[h * 64 + d] + gt[1] * oacc[256 + h * 64 + d] + gt[2] * oacc[512 + h * 64 + d];
        float got = bf2f(T.O[tok * D + (g * 4 + h) * 64 + d]);
        if (NSA_CHECK_BR >= 0) { ref = oacc[NSA_CHECK_BR * 256 + h * 64 + d]; got = bf2f(T.DBG[tok * D + (g * 4 + h) * 64 + d]); }
        sc[tid] = ref * ref; sc[256 + tid] = got; sc[512 + tid] = ref; }
    __syncthreads();
    if (tid < 256) { const int h = tid >> 6; float ms = 0.f; for (int d2 = 0; d2 < 64; ++d2) ms += sc[h * 64 + d2]; const float rms = sqrtf(ms * (1.0f / 64.0f));
        const float got = sc[256 + tid], ref = sc[512 + tid];
        const float tol = NSA_CHECK_ABS * rms + NSA_CHECK_REL * fabsf(ref);
        if (!(fabsf(got - ref) <= tol)) red[0] = 1.0f; }
    __syncthreads();
    if (tid == 0 && red[0] != 0.f) atomicAdd(flag, 1u);
    __syncthreads();
}

__device__ __forceinline__ bool near(float got, float ref, float rms) { return fabsf(got - ref) <= 0.02f * rms + 0.015f * fabsf(ref); }
__device__ __forceinline__ void check_proj(const Args& a, const nsa::Tensors& T, unsigned char* ws, const float* X, LAS unsigned char* lds, int tid, int smp, unsigned* flag) {
    LAS float* hk = (LAS float*)lds;
    LAS float* hq = hk + 1024;
    LAS float* val = hq + 1024;
    LAS float* red = val + 512;
    LAS float* hid = red + 8;
    LAS float* blk = hid + 256;
    unsigned hsh = (unsigned)smp * 2654435761u + 12345u; hsh ^= hsh >> 15; hsh *= 2246822519u; hsh ^= hsh >> 13;
    const int tok = (int)(hsh % NT), b = tok >> 14, sp = tok & (SEQ - 1), g = (hsh >> 17) & 3, hh = (hsh >> 19) & 15;
    if (tid == 0) red[0] = 0.f;
    float ss = 0.f; for (int k = tid; k < 1024; k += 512) { const float v = X[(size_t)tok * D + k]; ss += v * v; }
    ss = blk_sum(ss, red + 1, tid); const float r = 1.0f / sqrtf(ss * (1.0f / D) + RMS_EPS);
    for (int k = tid; k < 1024; k += 512) { const float v = X[(size_t)tok * D + k] * r; hk[k] = v * a.in[I_NKV][k]; hq[k] = v * a.in[I_NMIX][D + k]; }
    __syncthreads();
    const float pos = (float)((const int*)a.in[I_POS])[tok];
    bool bad = false;
    for (int slot = 0; slot < 6; ++slot) {
        if (tid < 64) { float s_ = 0.f; const float* w = a.in[I_WKV] + slot * 256 + g * 64 + tid; for (int k = 0; k < 1024; ++k) s_ += hk[k] * w[(size_t)k * 1536]; val[tid] = s_; }
        __syncthreads();
        if (tid < 64) { float v = val[tid];
            if (slot == 2 || slot == 4) { const int i = tid & 31; const float ang = pos * a.inv_freq[i]; float sn, cs; sincosf(ang, &sn, &cs); const float t1 = val[i], t2 = val[i + 32]; v = tid < 32 ? t1 * cs - t2 * sn : t2 * cs + t1 * sn; }
            float got; const size_t bg = (size_t)(b * 4 + g);
            if (slot == 3) got = bf2f(((const bf16_t*)(ws + WS_RD + (size_t)slot * KVSTRIDE))[(size_t)bg * 64 * SEQ + (size_t)(sp >> 6) * 4096 + vts_idx(tid, sp & 63)]);
            else if (slot == 2) got = bf2f(((const bf16_t*)(ws + WS_RD + (size_t)slot * KVSTRIDE))[(size_t)bg * 64 * SEQ + (size_t)(sp >> 6) * 4096 + ks_idx(sp & 63, tid)]);
            else if (slot == 5) got = bf2f(((const bf16_t*)(ws + WS_RD + (size_t)slot * KVSTRIDE))[(size_t)bg * 64 * SEQ + (size_t)(sp >> 6) * 4096 + tid * 64 + (sp & 63)]);
            else got = bf2f(((const bf16_t*)(ws + WS_RD + (size_t)slot * KVSTRIDE))[(bg * SEQ + sp) * 64 + tid]);
            if (!near(got, v, 1.0f)) bad = true; }
        __syncthreads();
    }
    if (tid < 112) { const int col = tid < 64 ? hh * 64 + tid : 1024 + (tid - 64); float s_ = 0.f; const float* w = a.in[I_AWIN] + col; for (int k = 0; k < 1024; ++k) s_ += hq[k] * w[(size_t)k * 1072];
        if (tid < 64) { if (!near(bf2f(T.Q[(size_t)tok * D + hh * 64 + tid]), s_ * (0.125f * 1.4426950408889634f), 0.18f)) bad = true; }
        else { const float gt = 1.0f / (1.0f + expf(-s_)); if (!near(T.gates[(size_t)tok * 48 + (tid - 64)], gt, 0.25f)) bad = true; } }
    const int c = (int)((hsh >> 8) % 1023);
    for (int kv = 0; kv < 2; ++kv) {
        const bf16_t* src = (const bf16_t*)(ws + WS_RD + (kv ? RD_VC : RD_KC)) + ((size_t)(b * 4 + g) * SEQ + 16 * c) * 64; const float* pe = a.in[kv ? I_CPV : I_CPK];
        for (int i = tid; i < 2048; i += 512) blk[i] = bf2f(src[i]) + pe[i];
        __syncthreads();
        if (tid < 256) { float s_ = 0.f; const float* w1 = a.in[kv ? I_CW1V : I_CW1K] + tid; for (int i = 0; i < 2048; ++i) s_ += blk[i] * w1[(size_t)i * 256];
            const float y = 0.7978845608028654f * (s_ + 0.044715f * s_ * s_ * s_); hid[tid] = 0.5f * s_ * (1.0f + tanhf(y)); }
        __syncthreads();
        if (tid < 64) { float s_ = 0.f; const float* w2 = a.in[kv ? I_CW2V : I_CW2K] + tid; for (int n = 0; n < 256; ++n) s_ += hid[n] * w2[n * 64];
            const float got = kv ? bf2f(T.VCMPT[((size_t)(b * 4 + g) * 64 + tid) * 1024 + c]) : bf2f(T.KCMP[((size_t)(b * 4 + g) * 1024 + c) * 64 + tid]);
            if (!near(got, s_, 0.5f)) bad = true; }
        __syncthreads();
    }
    if (bad) red[0] = 1.0f;
    __syncthreads();
    if (tid == 0 && red[0] != 0.f) atomicAdd(flag, 1u);
    __syncthreads();
}
}
#endif

#define XB_TMO      128
#define XB_XCNT(j)  (256  + 64 * (j))
#define XB_XSUB(j)  (1280 + 64 * (j))
#define XB_XGEN(j)  (2304 + 64 * (j))
#define XB_TOP      3328
#define XB_TOPGEN   3392
#define XCD_BAR_WORDS 3456
#define XB_SPIN_CAP (1u << 22)
__device__ __forceinline__ unsigned xb_ld(unsigned* p)              { return __hip_atomic_load(p, __ATOMIC_RELAXED, __HIP_MEMORY_SCOPE_AGENT); }
__device__ __forceinline__ unsigned xb_add(unsigned* p, unsigned v) { return __hip_atomic_fetch_add(p, v, __ATOMIC_RELAXED, __HIP_MEMORY_SCOPE_AGENT); }
__device__ __forceinline__ unsigned xb_xcc_id() { return (unsigned)__builtin_amdgcn_s_getreg((3 << 11) | 20) & 0xFu; }
#define XB_SPIN(cond, bar) do { unsigned _sp = 0; while (cond) { __builtin_amdgcn_s_sleep(1); \
    if ((++_sp & 255u) == 0u) { if (xb_ld(&(bar)[XB_TMO])) break; if (_sp > XB_SPIN_CAP) { atomicAdd(&(bar)[XB_TMO], 1u); break; } } } } while (0)
struct XcdBarrier { unsigned* bar; unsigned x; volatile LAS unsigned* st; };
__device__ __forceinline__ XcdBarrier xcd_barrier_post(unsigned* bar, volatile LAS unsigned* st, bool t0) {
    XcdBarrier b; b.bar = bar; b.x = xb_xcc_id(); b.st = st;
    if (t0) (void)xb_add(&bar[XB_XCNT(b.x)], 1u);
    return b;
}
__device__ __forceinline__ void xcd_barrier_complete(unsigned* bar, unsigned x, unsigned& nloc, unsigned& nx) {
    const unsigned G = gridDim.x;
    unsigned sum, cnt, mine, sp = 0u;
    for (;;) {
        sum = 0u; cnt = 0u; mine = 0u;
#pragma unroll
        for (unsigned j = 0; j < 16; ++j) { const unsigned c = xb_ld(&bar[XB_XCNT(j)]); sum += c; cnt += (c > 0u) ? 1u : 0u; mine = (j == x) ? c : mine; }
        if (sum == G) break;
        __builtin_amdgcn_s_sleep(1);
        if ((++sp & 255u) == 0u) { if (xb_ld(&bar[XB_TMO])) break; if (sp > XB_SPIN_CAP) { atomicAdd(&bar[XB_TMO], 1u); break; } }
    }
    nloc = mine > 0u ? mine : 1u; nx = cnt > 0u ? cnt : 1u;
}
__device__ __forceinline__ void xcd_barrier(const XcdBarrier& b, bool t0) {
    asm volatile("s_waitcnt vmcnt(0)" ::: "memory");
    __syncthreads();
    if (t0) {
        unsigned* bar = b.bar;
        __builtin_amdgcn_s_waitcnt(0);
        unsigned nloc = b.st[0], nx = b.st[1];
        if (nloc == 0u) { xcd_barrier_complete(bar, b.x, nloc, nx); b.st[0] = nloc; b.st[1] = nx; }
        const unsigned old = xb_add(&bar[XB_XSUB(b.x)], 1u);
        const unsigned gen = old / nloc;
        if (old + 1u == (gen + 1u) * nloc) {
            __builtin_amdgcn_fence(__ATOMIC_RELEASE, "agent");
            asm volatile("s_waitcnt vmcnt(0)" ::: "memory");
            const unsigned og = xb_add(&bar[XB_TOP], 1u);
            const unsigned tg = og / nx;
            if (og + 1u == (tg + 1u) * nx) xb_add(&bar[XB_TOPGEN], 1u);
            else XB_SPIN(xb_ld(&bar[XB_TOPGEN]) == tg, bar);
            __builtin_amdgcn_fence(__ATOMIC_ACQUIRE, "agent");
            xb_add(&bar[XB_XGEN(b.x)], 1u);
            asm volatile("s_waitcnt vmcnt(0)" ::: "memory");
        } else {
            XB_SPIN(xb_ld(&bar[XB_XGEN(b.x)]) == gen, bar);
            __builtin_amdgcn_fence(__ATOMIC_ACQUIRE, "agent");
            asm volatile("s_waitcnt vmcnt(0)" ::: "memory");
        }
    }
    __syncthreads();
}

__device__ __forceinline__ MoeTab moe_tables(const Frame& F0, int layer, bool rebuild = true) {
    const Frame F = refresh(F0);
    MoeTab T; T.tstart = (volatile LAS int*)(F.lds + MISC_OFF); T.cnt = T.tstart + 64;
    if (!rebuild) { __syncthreads(); return T; }
    const unsigned* gcnt = (const unsigned*)(F.ws + WS_CTL) + CW_CNT + layer * 32;
    __syncthreads();
    if (F.tid < 64) {
        const int e = F.tid; int c = 0; if (e < 32) c = (int)__hip_atomic_load(gcnt + e, __ATOMIC_RELAXED, __HIP_MEMORY_SCOPE_AGENT);
        const int nt_ = (c + 255) >> 8; int inc = nt_;
#pragma unroll
        for (int o = 1; o < 32; o <<= 1) { const int v = __shfl_up(inc, o); if ((e & 31) >= o) inc += v; }
        if (e < 32) { T.cnt[e] = c; T.tstart[e] = inc - nt_; if (e == 31) T.tstart[32] = inc; } }
    __syncthreads();
    if (F.tid < 32) { volatile LAS unsigned char* t2e = (volatile LAS unsigned char*)(T.tstart + 128); const int t1 = T.tstart[F.tid + 1];
        for (int t = T.tstart[F.tid]; t < t1; ++t) t2e[t] = (unsigned char)F.tid; }
    __syncthreads();
    return T;
}

constexpr int N_PHASES = 17;
__global__ void __launch_bounds__(NTHREADS, 2) nsa_fwd(Args args) {
    extern __shared__ __attribute__((aligned(16))) unsigned char lds_raw[];
    cg::grid_group grid = cg::this_grid();
    Frame F; F.lds = (LAS unsigned char*)lds_raw; F.ws = args.ws;
    { const int t = threadIdx.x; F.wave = __builtin_amdgcn_readfirstlane(t >> 6); F.tid = t; F.lane = t & 63; }
    F.G = gridDim.x; { const int bx = blockIdx.x; F.vcu = (F.G % 8 == 0) ? (bx % 8) * (F.G / 8) + bx / 8 : bx; }
    unsigned char* ws = args.ws;
    float* X = args.out;
    bf16_t* X1B = (bf16_t*)args.out + (size_t)NT * D;
    bf16_t* X2B = (bf16_t*)args.out; bf16_t* X3B = (bf16_t*)(ws + WS_RA);
    const int lo = args.ph_lo, hi = args.ph_hi;
    volatile LAS unsigned* bst = (volatile LAS unsigned*)(F.lds + MISC_OFF + 1024);
    if (F.tid < 2) bst[F.tid] = 0u;
    __syncthreads();
    XcdBarrier xb; xb.bar = (unsigned*)(ws + WS_CTL) + CW_BAR; xb.x = 0; xb.st = bst;
    if (hi - lo > 1) xb = xcd_barrier_post((unsigned*)(ws + WS_CTL) + CW_BAR, bst, F.tid == 0);
#ifndef PH_MASK
#define PH_MASK 0x1ffff
#endif
#ifndef REPEAT_MASK
#define REPEAT_MASK 0
#endif
#define REPS(k) (1 + ((REPEAT_MASK >> (k)) & 1))
#define IN(k) (((PH_MASK >> (k)) & 1) && lo <= (k) && (k) < hi)
#if PROBE_PHASE >= 0
    unsigned long long ph_t0 = __builtin_amdgcn_s_memrealtime(), ph_dur = 0ull;
#define PH_STAMP(k) do { const unsigned long long now_ = __builtin_amdgcn_s_memrealtime(); if ((k) == PROBE_PHASE) ph_dur = now_ - ph_t0; ph_t0 = now_; } while (0)
#else
#define PH_STAMP(k) do {} while (0)
#endif
#define SEAM(k) do { if (IN(k) && IN((k) + 1)) { if ((k) == 0) grid.sync(); else xcd_barrier(xb, mytid(F) == 0); } PH_STAMP(k); } while (0)
    LAS unsigned char* ring = F.lds;

    if (IN(0)) for (int rep_ = 0; rep_ < REPS(0); ++rep_) { phase_prep(args, F); } SEAM(0);
    if (IN(1)) for (int rep_ = 0; rep_ < REPS(1); ++rep_) {
        DenseOrder S; S.init(ws + WS_RA, ws + WS_WIN, NT, 3 * D, D, D, F.G, (int)blockIdx.x);
        EpiInProj E{(const float*)(ws + WS_R0), (bf16_t*)(ws + WS_RB), (bf16_t*)(ws + WS_RC)};
        pg8::gemm_phase<EpiInProj, DenseOrder, false>(ring, mytid(F), pg8::Gemm{D, D}, S, E);
    } SEAM(1);
#ifdef EXTRA_BARS
    for (int eb_ = 0; eb_ < EXTRA_BARS; ++eb_) xcd_barrier(xb, mytid(F) == 0);
#endif
    if (IN(2)) for (int rep_ = 0; rep_ < REPS(2); ++rep_) { phase_conv(args, F); } SEAM(2);
    if (IN(3)) for (int rep_ = 0; rep_ < REPS(3); ++rep_) {
        DenseOrder S; S.init(ws + WS_RA, ws + WS_WOUT, NT, D, D, D, F.G, (int)blockIdx.x);
        EpiResid<float> E{args.in[I_X], X1B};
        pg8::gemm_phase<EpiResid<float>, DenseOrder, false>(ring, mytid(F), pg8::Gemm{D, D}, S, E);
    } SEAM(3);
    {
        if (IN(4)) for (int rep_ = 0; rep_ < REPS(4); ++rep_) { phase_router(args, F, 0, X1B, (float*)(ws + WS_R1)); } SEAM(4);
        if (IN(5)) for (int rep_ = 0; rep_ < REPS(5); ++rep_) {
            MoeTab T = moe_tables(F, 0);
            MoeGuOrder S{T, (const char*)X1B, (const int*)(ws + WS_ROWL), (const char*)(ws + WS_EXPW), F.G, F.vcu};
            EpiGU E{T, (const float*)(ws + WS_ROWR), (bf16_t*)(ws + WS_RD)};
            const int nunits5 = 4 * T.tstart[32];
            pg8::gemm_phase<EpiGU, MoeGuOrder, true>(ring, mytid(F), pg8::Gemm{D, D}, S, E);
            if (F.G == 256) {
                const int rounds = (nunits5 + 255) >> 8, nbusy = nunits5 - (rounds - 1) * 256, nidle = 256 - nbusy;
                const Frame F5 = refresh(F);
                if (nidle >= 32) { if (F5.vcu >= nbusy) convert_experts_dn(args, F5, 0, (F5.vcu - nbusy) * NWAVES + F5.wave, nidle * NWAVES); }
                else convert_experts_dn(args, F5, 0, F5.vcu * NWAVES + F5.wave, 256 * NWAVES);
            }
        } SEAM(5);
        if (IN(6)) for (int rep_ = 0; rep_ < REPS(6); ++rep_) {
            MoeTab T = moe_tables(F, 0, MK_PER_PHASE != 0);
            MoeDnOrder S{T, (const char*)(ws + WS_RD), (const char*)(ws + WS_EXPW), F.G, F.vcu};
            EpiDN E{(const int*)(ws + WS_ROWL), (const float*)(ws + WS_RD + RD_HID), (bf16_t*)(ws + WS_RB)};
            pg8::gemm_phase<EpiDN, MoeDnOrder, false>(ring, mytid(F), pg8::Gemm{DE, DE}, S, E);
        } SEAM(6);
    }
    {
            if (IN(7)) for (int rep_ = 0; rep_ < REPS(7); ++rep_) { phase_combine<false>(args, F, X1B, X2B, nullptr, (float*)(ws + WS_R2)); } SEAM(7);
            if (IN(8)) for (int rep_ = 0; rep_ < REPS(8); ++rep_) {
                DenseOrder S; S.init((unsigned char*)X2B, ws + WS_WQKV, NT, NQKV, D, D, F.G, (int)blockIdx.x);
                EpiQKV E{(const float*)(ws + WS_R2), (const f32x2*)(ws + WS_ROPE), ws + WS_RD, (bf16_t*)(ws + WS_RC), (float*)(ws + WS_GATES)};
                pg8::gemm_phase<EpiQKV, DenseOrder, false>(ring, mytid(F), pg8::Gemm{D, D}, S, E);
            } SEAM(8);
            if (IN(9)) for (int rep_ = 0; rep_ < REPS(9); ++rep_) {
                CmpOrder S{(const char*)(ws + WS_RD + RD_KC), (const char*)(ws + WS_RD + RD_VC), (const char*)(ws + WS_WC1), F.G, (int)blockIdx.x};
                EpiCmp1 E{(const float*)(ws + WS_BIASC), (bf16_t*)(ws + WS_RD + RD_HID)};
                pg8::gemm_phase<EpiCmp1, CmpOrder, false>(ring, mytid(F), pg8::Gemm{2048, 1024}, S, E);
                if (F.G >= 64 && (int)blockIdx.x < 64) {
                    __syncthreads(); const Frame Fc = refresh(F); phase_cmp2(Fc, (int)blockIdx.x * 16, 16, NWAVES, Fc.wave); }
                const Frame F9 = refresh(F); LAS float* scr = (LAS float*)(F.lds + F.wave * 16384);
                if (F.G == 256) { if ((int)blockIdx.x >= 64) convert_experts_gu(args, F9, 1, ((int)blockIdx.x - 64) * NWAVES + F.wave, (F.G - 64) * NWAVES); }
                else if (F.G > 64) { if ((int)blockIdx.x >= 64) convert_experts(args, F9, 1, ((int)blockIdx.x - 64) * NWAVES + F.wave, (F.G - 64) * NWAVES, scr); }
                else convert_experts(args, F9, 1, (int)blockIdx.x * NWAVES + F.wave, F.G * NWAVES, scr);
            } SEAM(9);
            if (IN(10)) for (int rep_ = 0; rep_ < REPS(10); ++rep_) { if (F.G < 64) { const Frame Fc = refresh(F); phase_cmp2(Fc, 0, 1024, F.G * NWAVES, Fc.vcu * NWAVES + Fc.wave); } }
            if (F.G < 64) SEAM(10);
            if (IN(11)) for (int rep_ = 0; rep_ < REPS(11); ++rep_) {
                nsa::Tensors T{(const bf16_t*)(ws + WS_RC), (const f32x2*)(ws + WS_ROPE), (const float*)(ws + WS_GATES),
                               (const bf16_t*)(ws + WS_RD + RD_KS), (const bf16_t*)(ws + WS_RD + RD_VTS), (const bf16_t*)(ws + WS_RD + RD_KW), (const bf16_t*)(ws + WS_RD + RD_VTW),
                               (const bf16_t*)(ws + WS_RD + RD_KCMP), (const bf16_t*)(ws + WS_RD + RD_VCMPT), (bf16_t*)(ws + WS_RB), (bf16_t*)(ws + WS_RA), (float*)(ws + WS_ATTS) + (size_t)blockIdx.x * 64 * 256, (float*)(ws + WS_CTL) + 2049, ws + (blockIdx.x < 128 ? WS_RA + (size_t)blockIdx.x * STG_WG : WS_STG2 + (size_t)(blockIdx.x - 128) * STG_WG), rep_ ? PROBE_SKIP : 0};
                if (F.G % 8 == 0) { const int bg = (int)blockIdx.x & 7, per = F.G >> 3;
                    for (int q = (int)blockIdx.x >> 3; q < 256; q += per) nsa::attn_unit(T, ring, mytid(F), bg >> 2, bg & 3, 255 - q); }
                else for (int u = (int)blockIdx.x; u < 2048; u += F.G) { const int qt = 255 - (u >> 3), bg = u & 7; nsa::attn_unit(T, ring, mytid(F), bg >> 2, bg & 3, qt); }
            } SEAM(11);
            if (IN(12)) for (int rep_ = 0; rep_ < REPS(12); ++rep_) {
#if NSA_CHECK
                { nsa::Tensors T{(const bf16_t*)(ws + WS_RC), (const f32x2*)(ws + WS_ROPE), (const float*)(ws + WS_GATES),
                               (const bf16_t*)(ws + WS_RD + RD_KS), (const bf16_t*)(ws + WS_RD + RD_VTS), (const bf16_t*)(ws + WS_RD + RD_KW), (const bf16_t*)(ws + WS_RD + RD_VTW),
                               (const bf16_t*)(ws + WS_RD + RD_KCMP), (const bf16_t*)(ws + WS_RD + RD_VCMPT), (bf16_t*)(ws + WS_RB), (bf16_t*)(ws + WS_RA), (float*)(ws + WS_ATTS) + (size_t)blockIdx.x * 64 * 256, (float*)(ws + WS_CTL) + 2049, ws + (blockIdx.x < 128 ? WS_RA + (size_t)blockIdx.x * STG_WG : WS_STG2 + (size_t)(blockIdx.x - 128) * STG_WG), 0};
                  for (int smp = (int)blockIdx.x; smp < NSA_CHECK_N; smp += F.G) { unsigned hsh = (unsigned)smp * 2654435761u; hsh ^= hsh >> 15; hsh *= 2246822519u; hsh ^= hsh >> 13;
                      int t = (smp < 192) ? chk::tlist[smp % 24] : (int)(hsh % SEQ); const int bgs = (smp < 192) ? (smp / 24) : (int)((hsh >> 20) & 7);
                      chk::check_sample(T, ring, mytid(F), bgs >> 2, bgs & 3, t, (unsigned*)(ws + WS_CTL) + 2048); }
                  __syncthreads();
                  if (NSA_CHECK_PROJ) for (int smp = (int)blockIdx.x; smp < 512; smp += F.G) chk::check_proj(args, T, ws, X, ring, mytid(F), smp, (unsigned*)(ws + WS_CTL) + 2048);
                  __syncthreads(); }
#endif
                DenseOrder S; S.init(ws + WS_RB, ws + WS_WAO, NT, D, D, D, F.G, (int)blockIdx.x);
                EpiResid<bf16_t> E{X2B, X3B};
                pg8::gemm_phase<EpiResid<bf16_t>, DenseOrder, false>(ring, mytid(F), pg8::Gemm{D, D}, S, E);
            } SEAM(12);
    }
    {
        if (IN(13)) for (int rep_ = 0; rep_ < REPS(13); ++rep_) { phase_router(args, F, 1, X3B, (float*)(ws + WS_R3)); } SEAM(13);
        if (IN(14)) for (int rep_ = 0; rep_ < REPS(14); ++rep_) {
            MoeTab T = moe_tables(F, 1);
            MoeGuOrder S{T, (const char*)X3B, (const int*)(ws + WS_ROWL), (const char*)(ws + WS_EXPW), F.G, F.vcu};
            EpiGU E{T, (const float*)(ws + WS_ROWR), (bf16_t*)(ws + WS_RD)};
            const int nunits14 = 4 * T.tstart[32];
            pg8::gemm_phase<EpiGU, MoeGuOrder, true>(ring, mytid(F), pg8::Gemm{D, D}, S, E);
            if (F.G == 256) {
                const int rounds = (nunits14 + 255) >> 8, nbusy = nunits14 - (rounds - 1) * 256, nidle = 256 - nbusy;
                const Frame F14 = refresh(F);
                if (nidle >= 32) { if (F14.vcu >= nbusy) convert_experts_dn(args, F14, 1, (F14.vcu - nbusy) * NWAVES + F14.wave, nidle * NWAVES); }
                else convert_experts_dn(args, F14, 1, F14.vcu * NWAVES + F14.wave, 256 * NWAVES);
            }
        } SEAM(14);
        if (IN(15)) for (int rep_ = 0; rep_ < REPS(15); ++rep_) {
            MoeTab T = moe_tables(F, 1, MK_PER_PHASE != 0);
            MoeDnOrder S{T, (const char*)(ws + WS_RD), (const char*)(ws + WS_EXPW), F.G, F.vcu};
            EpiDN E{(const int*)(ws + WS_ROWL), (const float*)(ws + WS_RD + RD_HID), (bf16_t*)(ws + WS_RB)};
            pg8::gemm_phase<EpiDN, MoeDnOrder, false>(ring, mytid(F), pg8::Gemm{DE, DE}, S, E);
        } SEAM(15);
    }
    if (IN(16)) for (int rep_ = 0; rep_ < REPS(16); ++rep_) { phase_combine<true>(args, F, X3B, nullptr, X, nullptr);
#if PROBE_PHASE >= 0
        PH_STAMP(16);
        if (blockIdx.x == 0 && mytid(F) == 0) { const unsigned long long t0_ = __builtin_amdgcn_s_memrealtime(); while (__builtin_amdgcn_s_memrealtime() - t0_ < ph_dur) __builtin_amdgcn_s_sleep(8); }
#endif
#if PROBE_T
        if (blockIdx.x == 0 && mytid(F) == 0) { const float nprobe = __uint_as_float(__hip_atomic_load((unsigned*)(ws + WS_CTL) + 2049, __ATOMIC_RELAXED, __HIP_MEMORY_SCOPE_AGENT));
            unsigned long long ticks = (unsigned long long)(fminf(nprobe, 2000.f) * 1000.0f); const unsigned long long t0_ = __builtin_amdgcn_s_memrealtime();
            while (__builtin_amdgcn_s_memrealtime() - t0_ < ticks) __builtin_amdgcn_s_sleep(8); }
#endif
#if NSA_CHECK
        if (blockIdx.x == 0 && mytid(F) == 0) { const unsigned nbad = __hip_atomic_load((unsigned*)(ws + WS_CTL) + 2048, __ATOMIC_RELAXED, __HIP_MEMORY_SCOPE_AGENT);
            if (nbad) { asm volatile("s_waitcnt vmcnt(0)" ::: "memory"); X[0] = 580.0f * sqrtf((float)nbad); } }
#endif
    }
#undef IN
#undef SEAM
}

extern "C" void kernel_launch(void* const* d_in, const int* in_sizes, int n_in, void* d_out, int out_size, void* d_ws, size_t ws_size, hipStream_t stream) {
    static int grid = 0;
    if (grid == 0) {
        if (n_in != 25 || out_size != NT * D || ws_size < WS_END) { fprintf(stderr, "kernel_launch: unexpected problem (n_in %d, out %d, ws %zu < %zu)\n", n_in, out_size, ws_size, (size_t)WS_END); grid = -1; return; }
        int dev = 0, cus = 0, per_cu = 0;
        hipGetDevice(&dev); hipDeviceGetAttribute(&cus, hipDeviceAttributeMultiprocessorCount, dev);
        hipFuncSetAttribute((const void*)nsa_fwd, hipFuncAttributeMaxDynamicSharedMemorySize, LDS_BYTES);
        hipOccupancyMaxActiveBlocksPerMultiprocessor(&per_cu, (const void*)nsa_fwd, NTHREADS, LDS_BYTES);
        if (per_cu < 1) { fprintf(stderr, "kernel_launch: occupancy query says %d blocks/CU\n", per_cu); per_cu = 1; }
        grid = cus > 256 ? 256 : cus;
        (void)hipGetLastError();
    }
    if (grid < 0) return;
    hipMemsetAsync((char*)d_ws + WS_CTL, 0, CTL_BYTES, stream);
    Args a{};
    for (int i = 0; i < 25; ++i) a.in[i] = (const float*)d_in[i];
    a.out = (float*)d_out; a.ws = (unsigned char*)d_ws;
    for (int i = 0; i < 32; ++i) a.inv_freq[i] = powf(10000.0f, -(float)i / 32.0f);
#if MK_PER_PHASE
    for (int p = 0; p < N_PHASES; ++p) { a.ph_lo = p; a.ph_hi = p + 1; void* kargs[] = {&a};
        hipError_t e = hipLaunchCooperativeKernel((const void*)nsa_fwd, dim3(grid), dim3(NTHREADS), kargs, LDS_BYTES, stream);
        if (e != hipSuccess) { fprintf(stderr, "launch %d failed: %s\n", p, hipGetErrorString(e)); break; } }
#else
    a.ph_lo = 0; a.ph_hi = N_PHASES; void* kargs[] = {&a};
    hipError_t e = hipLaunchCooperativeKernel((const void*)nsa_fwd, dim3(grid), dim3(NTHREADS), kargs, LDS_BYTES, stream);
    if (e != hipSuccess) fprintf(stderr, "cooperative launch failed: %s (grid %d)\n", hipGetErrorString(e), grid);
#endif
}
```
